# Optimizing an MI355X kernel written in HIP

```python
import math
import jax
import jax.numpy as jnp
from jax import lax
import numpy as np

D_MODEL = 1024
BATCH = 4
SEQ = 4096
DEPTH = 2

GRID_W = 64
CTX_LEN = 256
HEAD_DIM = 64
ROPE_THETA = 10000.0
NORM_EPS = 1e-6
NEG_INF = -1e30

A_HEADS = 4
A_KV_HEADS = 2
WINDOW = 128
A_BLOCK = 128
SSD_HEADS = 4
SSD_HEAD_DIM = 64
SSD_GROUPS = 2
SSD_STATE = 64
SSD_CHUNK = 128
SSD_CONV = 4
LRU_WIDTH = 256
LRU_BLOCKS = 4
LRU_BLOCK_DIM = LRU_WIDTH // LRU_BLOCKS
LRU_CONV = 4
LRU_C = 8.0
D_HEADS = 4
D_KV_HEADS = 2
Q_BLOCK = 128
N_EXPERTS = 64
N_EXPERT_GROUPS = 8
TOPK_GROUPS = 4
TOP_K = 8
EXPERT_HIDDEN = 256
SHARED_HIDDEN = 256
ROUTED_SCALE = 2.5
MOE_BLOCK = 128

A_Q = A_HEADS * HEAD_DIM
A_KV = A_KV_HEADS * HEAD_DIM
SSD_INNER = SSD_HEADS * SSD_HEAD_DIM
SSD_BC = SSD_GROUPS * SSD_STATE
SSD_CONV_CH = SSD_INNER + 2 * SSD_BC
D_Q = D_HEADS * HEAD_DIM
D_KV = D_KV_HEADS * HEAD_DIM
IN_SPLITS = (A_Q, A_KV, A_KV,
             SSD_INNER, SSD_INNER, SSD_BC, SSD_BC, SSD_HEADS, SSD_HEADS,
             LRU_WIDTH, LRU_WIDTH,
             D_Q, D_KV, D_KV)
IN_PROJ = sum(IN_SPLITS)
IN_CUTS = tuple(sum(IN_SPLITS[:i + 1]) for i in range(len(IN_SPLITS) - 1))
MIX_WIDTH = A_Q + SSD_INNER + LRU_WIDTH + D_Q

kernel_name = 'hybrid_diffusion_block'


def rms_norm(x, gain):
    xf = x.astype(jnp.float32)
    y = xf * lax.rsqrt(jnp.mean(xf * xf, axis=-1, keepdims=True) + NORM_EPS)
    return (y * gain.astype(jnp.float32)).astype(x.dtype)


def modulate(x, shift, scale):
    return x * (1 + scale) + shift


def split_heads(t):
    return t.reshape(t.shape[:-1] + (t.shape[-1] // HEAD_DIM, HEAD_DIM))


def seq_cat(u, v):
    return jnp.concatenate([u, v], axis=1)


def rev_cat(u, v):
    return jnp.concatenate([jnp.flip(u, 1), jnp.flip(v, 1)], axis=1)


def axial_rope_tables(n_rows):
    t = jnp.arange(n_rows * GRID_W)
    row = (t // GRID_W).astype(jnp.float32)
    col = (t % GRID_W).astype(jnp.float32)
    axis_dim = HEAD_DIM // 2
    inv_freq = ROPE_THETA ** (-jnp.arange(0, axis_dim, 2, dtype=jnp.float32) / axis_dim)
    ang = jnp.concatenate([row[:, None] * inv_freq, col[:, None] * inv_freq], axis=-1)
    return jnp.cos(ang), jnp.sin(ang)


def apply_rope(x, cos, sin):
    xf = x.astype(jnp.float32).reshape(x.shape[:-1] + (HEAD_DIM // 2, 2))
    x1, x2 = xf[..., 0], xf[..., 1]
    c = cos[None, :, None, :]
    s = sin[None, :, None, :]
    out = jnp.stack([x1 * c - x2 * s, x1 * s + x2 * c], axis=-1)
    return out.reshape(x.shape).astype(x.dtype)


def dense_gqa(q, k, v, sink=None):
    b, tq, hq, d = q.shape
    hkv = k.shape[2]
    grp = hq // hkv
    qg = q.reshape(b, tq, hkv, grp, d)
    s = jnp.einsum('bqhgd,bkhd->bhgqk', qg, k).astype(jnp.float32) * d ** -0.5
    if sink is not None:
        s_sink = jnp.broadcast_to(sink.astype(jnp.float32).reshape(1, hkv, grp, 1, 1), s.shape[:-1] + (1,))
        p = jax.nn.softmax(jnp.concatenate([s, s_sink], axis=-1), axis=-1)[..., :-1]
    else:
        p = jax.nn.softmax(s, axis=-1)
    o = jnp.einsum('bhgqk,bkhd->bqhgd', p.astype(v.dtype), v)
    return o.reshape(b, tq, hq * d)


def window_attention(q_l, k_l, v_l, q_c, k_c, v_c, sink, with_ctx):
    b, S, hq, d = q_l.shape
    hkv = k_l.shape[2]
    grp = hq // hkv
    nb = S // A_BLOCK
    n_ctx = k_c.shape[1]
    qb = q_l.reshape(b, nb, A_BLOCK, hkv, grp, d)

    def band(t):
        z = jnp.zeros((b, A_BLOCK) + t.shape[2:], t.dtype)
        tp = jnp.concatenate([z, t, z], axis=1).reshape((b, nb + 2, A_BLOCK) + t.shape[2:])
        return jnp.concatenate([tp[:, :-2], tp[:, 1:-1], tp[:, 2:]], axis=2)

    kb, vb = band(k_l), band(v_l)
    scale = d ** -0.5
    s_win = jnp.einsum('bnqhgd,bnkhd->bnhgqk', qb, kb).astype(jnp.float32) * scale
    q_off = jnp.arange(A_BLOCK)[:, None]
    k_off = jnp.arange(3 * A_BLOCK)[None, :] - A_BLOCK
    k_abs = jnp.arange(nb)[:, None, None] * A_BLOCK + k_off
    valid = (jnp.abs(k_off - q_off) <= WINDOW) & (k_abs >= 0) & (k_abs < S)
    s_win = jnp.where(valid[None, :, None, None], s_win, NEG_INF)
    s_ctx = jnp.einsum('bnqhgd,bkhd->bnhgqk', qb, k_c).astype(jnp.float32) * scale
    s_sink = jnp.broadcast_to(sink.astype(jnp.float32).reshape(1, 1, hkv, grp, 1, 1), s_win.shape[:-1] + (1,))
    p = jax.nn.softmax(jnp.concatenate([s_win, s_ctx, s_sink], axis=-1), axis=-1).astype(v_l.dtype)
    n_win = 3 * A_BLOCK
    o = (jnp.einsum('bnhgqk,bnkhd->bnqhgd', p[..., :n_win], vb)
         + jnp.einsum('bnhgqk,bkhd->bnqhgd', p[..., n_win:n_win + n_ctx], v_c))
    o_l = o.reshape(b, S, hq * d)
    o_c = dense_gqa(q_c, k_c, v_c, sink) if with_ctx else None
    return o_c, o_l


def global_attention(q_l, k_l, v_l, q_c, k_c, v_c, with_ctx):
    b, S, hq, d = q_l.shape
    nb = S // Q_BLOCK
    k_all = seq_cat(k_c, k_l)
    v_all = seq_cat(v_c, v_l)
    q_blocks = jnp.moveaxis(q_l.reshape(b, nb, Q_BLOCK, hq, d), 1, 0)
    o = lax.map(lambda qb: dense_gqa(qb, k_all, v_all), q_blocks)
    o_l = jnp.moveaxis(o, 0, 1).reshape(b, S, hq * d)
    o_c = dense_gqa(q_c, k_c, v_c) if with_ctx else None
    return o_c, o_l


def depthwise_conv(x, w, bias):
    width, ch = w.shape
    left = width // 2
    y = lax.conv_general_dilated(x, w[:, None, :], (1,), [(left, width - 1 - left)],
                                 dimension_numbers=('NWC', 'WIO', 'NWC'), feature_group_count=ch)
    return y + bias


def ssd_chunked_scan(x, dt, a_neg, bmat, cmat):
    b, T, h, p = x.shape
    n = bmat.shape[-1]
    nc = T // SSD_CHUNK
    xc = x.astype(jnp.float32).reshape(b, nc, SSD_CHUNK, h, p)
    bc = bmat.astype(jnp.float32).reshape(b, nc, SSD_CHUNK, h, n)
    cc = cmat.astype(jnp.float32).reshape(b, nc, SSD_CHUNK, h, n)
    dtc = dt.astype(jnp.float32).reshape(b, nc, SSD_CHUNK, h)
    a_cum = jnp.cumsum(dtc * a_neg, axis=2)
    seg = a_cum[:, :, :, None, :] - a_cum[:, :, None, :, :]
    lower = jnp.tril(jnp.ones((SSD_CHUNK, SSD_CHUNK), bool))
    decay = jnp.exp(jnp.where(lower[:, :, None], seg, -jnp.inf))
    w_ij = jnp.einsum('bcihn,bcjhn->bcijh', cc, bc) * decay * dtc[:, :, None]
    y_intra = jnp.einsum('bcijh,bcjhp->bcihp', w_ij, xc)
    to_end = jnp.exp(a_cum[:, :, -1:] - a_cum) * dtc
    states = jnp.einsum('bcjhn,bcjh,bcjhp->bchpn', bc, to_end, xc)
    chunk_decay = jnp.exp(a_cum[:, :, -1])

    def step(carry, inp):
        st, dec = inp
        return carry * dec[..., None, None] + st, carry

    _, start = lax.scan(step, jnp.zeros((b, h, p, n), jnp.float32),
                        (jnp.moveaxis(states, 1, 0), jnp.moveaxis(chunk_decay, 1, 0)))
    start = jnp.moveaxis(start, 0, 1)
    y_inter = jnp.einsum('bcihn,bchpn->bcihp', cc, start) * jnp.exp(a_cum)[..., None]
    return (y_intra + y_inter).reshape(b, T, h, p)


def ssd_mixer(parts_c, parts_l, conv_w, conv_b, dt_bias, a_log, d_skip, norm_gain, with_ctx):
    def prep(z, xs, bm, cm, dt_f, dt_b):
        b, t = xs.shape[:2]
        xbc = jax.nn.silu(depthwise_conv(jnp.concatenate([xs, bm, cm], axis=-1), conv_w, conv_b))
        xs, bm, cm = jnp.split(xbc, (SSD_INNER, SSD_INNER + SSD_BC), axis=-1)
        to_heads = lambda u: jnp.repeat(u.reshape(b, t, SSD_GROUPS, SSD_STATE), SSD_HEADS // SSD_GROUPS, axis=2)
        dt = jax.nn.softplus(jnp.stack([dt_f, dt_b]).astype(jnp.float32)
                             + dt_bias[:, None, None, :].astype(jnp.float32))
        return z, xs.reshape(b, t, SSD_HEADS, SSD_HEAD_DIM), to_heads(bm), to_heads(cm), dt

    z_c, x_c, b_c, c_c, dt_c = prep(*parts_c)
    z_l, x_l, b_l, c_l, dt_l = prep(*parts_l)
    n_ctx = x_c.shape[1]
    a_neg = -jnp.exp(a_log.astype(jnp.float32))
    y_f = ssd_chunked_scan(seq_cat(x_c, x_l), seq_cat(dt_c[0], dt_l[0]), a_neg[0],
                           seq_cat(b_c, b_l), seq_cat(c_c, c_l))
    y_b = ssd_chunked_scan(rev_cat(x_c, x_l), rev_cat(dt_c[1], dt_l[1]), a_neg[1],
                           rev_cat(b_c, b_l), rev_cat(c_c, c_l))

    def finish(y_fwd, y_bwd_rev, xs, z):
        y = (y_fwd + jnp.flip(y_bwd_rev, 1)).astype(xs.dtype) + xs * d_skip[:, None]
        y = y.reshape(y.shape[:2] + (SSD_INNER,))
        return rms_norm(y * jax.nn.silu(z), norm_gain)

    out_l = finish(y_f[:, n_ctx:], y_b[:, n_ctx:], x_l, z_l)
    out_c = finish(y_f[:, :n_ctx], y_b[:, :n_ctx], x_c, z_c) if with_ctx else None
    return out_c, out_l


def rglru_scan(u, w_a, b_a, w_i, b_i, lam):
    b, T, ch = u.shape
    uf = u.astype(jnp.float32)
    ub = uf.reshape(b, T, LRU_BLOCKS, LRU_BLOCK_DIM)

    def gate(w, bias):
        return jax.nn.sigmoid(jnp.einsum('btki,kij->btkj', ub, w.astype(jnp.float32)).reshape(b, T, ch)
                              + bias.astype(jnp.float32))

    r = gate(w_a, b_a)
    i = gate(w_i, b_i)
    log_a = -LRU_C * r * jax.nn.softplus(-lam.astype(jnp.float32))
    a = jnp.exp(log_a)
    inp = jnp.sqrt(-jnp.expm1(2.0 * log_a)) * (i * uf)

    def combine(left, right):
        a1, h1 = left
        a2, h2 = right
        return a1 * a2, a2 * h1 + h2

    _, hs = lax.associative_scan(combine, (a, inp), axis=1)
    return hs


def rglru_mixer(x_c, g_c, x_l, g_l, conv_w, conv_b, w_a, b_a, w_i, b_i, lam, with_ctx):
    u_c = depthwise_conv(x_c, conv_w, conv_b)
    u_l = depthwise_conv(x_l, conv_w, conv_b)
    n_ctx = u_c.shape[1]
    h_f = rglru_scan(seq_cat(u_c, u_l), w_a[0], b_a[0], w_i[0], b_i[0], lam[0])
    h_b = rglru_scan(rev_cat(u_c, u_l), w_a[1], b_a[1], w_i[1], b_i[1], lam[1])

    def finish(hf, hb_rev, g):
        return (hf + jnp.flip(hb_rev, 1)).astype(g.dtype) * jax.nn.gelu(g)

    out_l = finish(h_f[:, n_ctx:], h_b[:, n_ctx:], g_l)
    out_c = finish(h_f[:, :n_ctx], h_b[:, :n_ctx], g_c) if with_ctx else None
    return out_c, out_l


def token_mixing(x_c, x_l, mod_c, mod_l, rope_cos, rope_sin, g_pre, g_post, w_in, w_out,
                 a_sink, ssd_conv_w, ssd_conv_b, ssd_dt_bias, ssd_a_log, ssd_d, ssd_norm,
                 lru_conv_w, lru_conv_b, lru_w_a, lru_b_a, lru_w_i, lru_b_i, lru_lambda,
                 d_q_norm, d_k_norm, with_ctx):
    shift_c, scale_c, gate_c = mod_c
    shift_l, scale_l, gate_l = mod_l

    def project(x, shift, scale):
        h = modulate(rms_norm(x, g_pre), shift, scale)
        return jnp.split(h @ w_in, IN_CUTS, axis=-1)

    pc = project(x_c, shift_c, scale_c)
    pl = project(x_l, shift_l, scale_l)
    rope = lambda t: apply_rope(t, rope_cos, rope_sin)
    qk_norm = lambda t, g: rms_norm(split_heads(t), g)

    oa_c, oa_l = window_attention(rope(split_heads(pl[0])), rope(split_heads(pl[1])), split_heads(pl[2]),
                                  split_heads(pc[0]), split_heads(pc[1]), split_heads(pc[2]), a_sink, with_ctx)
    ob_c, ob_l = ssd_mixer(pc[3:9], pl[3:9], ssd_conv_w, ssd_conv_b, ssd_dt_bias, ssd_a_log, ssd_d, ssd_norm,
                           with_ctx)
    oc_c, oc_l = rglru_mixer(pc[9], pc[10], pl[9], pl[10], lru_conv_w, lru_conv_b, lru_w_a, lru_b_a,
                             lru_w_i, lru_b_i, lru_lambda, with_ctx)
    od_c, od_l = global_attention(rope(qk_norm(pl[11], d_q_norm)), rope(qk_norm(pl[12], d_k_norm)),
                                  split_heads(pl[13]), qk_norm(pc[11], d_q_norm), qk_norm(pc[12], d_k_norm),
                                  split_heads(pc[13]), with_ctx)

    def merge(x, outs, gate):
        return x + gate * rms_norm(jnp.concatenate(outs, axis=-1) @ w_out, g_post)

    x_l = merge(x_l, (oa_l, ob_l, oc_l, od_l), gate_l)
    if with_ctx:
        x_c = merge(x_c, (oa_c, ob_c, oc_c, od_c), gate_c)
    return x_c, x_l


def routed_experts(h, expert_idx, expert_w, w_gate, w_up, w_down):
    n_tok, d = h.shape
    n_assign = n_tok * TOP_K
    flat_e = expert_idx.reshape(-1)
    order = jnp.argsort(flat_e)
    e_sorted = flat_e[order]
    counts = jnp.bincount(flat_e, length=N_EXPERTS)
    padded = (counts + MOE_BLOCK - 1) // MOE_BLOCK * MOE_BLOCK
    start = jnp.cumsum(counts) - counts
    padded_end = jnp.cumsum(padded)
    dest = (padded_end - padded)[e_sorted] + jnp.arange(n_assign) - start[e_sorted]
    n_blocks = -(-n_assign // MOE_BLOCK) + N_EXPERTS
    n_slots = n_blocks * MOE_BLOCK
    slot_tok = jnp.zeros((n_slots,), jnp.int32).at[dest].set((order // TOP_K).astype(jnp.int32))
    slot_w = jnp.zeros((n_slots,), h.dtype).at[dest].set(expert_w.reshape(-1)[order].astype(h.dtype))
    block_e = jnp.minimum(jnp.searchsorted(padded_end, jnp.arange(n_blocks) * MOE_BLOCK, side='right'),
                          N_EXPERTS - 1)

    def run_block(args):
        tok, wt, e = args
        xb = h[tok]
        hid = jax.nn.silu(xb @ w_gate[e]) * (xb @ w_up[e])
        return (hid @ w_down[e]) * wt[:, None]

    y = lax.map(run_block, (slot_tok.reshape(n_blocks, MOE_BLOCK), slot_w.reshape(n_blocks, MOE_BLOCK), block_e))
    return jax.ops.segment_sum(y.reshape(n_slots, d), slot_tok, num_segments=n_tok)


def moe_ffn(h, router_w, router_bias, w_gate, w_up, w_down, sh_gate, sh_up, sh_down):
    n_tok = h.shape[0]
    scores = jax.nn.sigmoid((h @ router_w).astype(jnp.float32))
    biased = scores + router_bias.astype(jnp.float32)
    grouped = biased.reshape(n_tok, N_EXPERT_GROUPS, N_EXPERTS // N_EXPERT_GROUPS)
    group_score = jnp.sum(lax.top_k(grouped, 2)[0], axis=-1)
    _, top_groups = lax.top_k(group_score, TOPK_GROUPS)
    group_mask = jnp.sum(jax.nn.one_hot(top_groups, N_EXPERT_GROUPS, dtype=jnp.float32), axis=1) > 0
    expert_mask = jnp.repeat(group_mask, N_EXPERTS // N_EXPERT_GROUPS, axis=1)
    _, idx = lax.top_k(jnp.where(expert_mask, biased, -jnp.inf), TOP_K)
    w = jnp.take_along_axis(scores, idx, axis=1)
    w = w / jnp.sum(w, axis=-1, keepdims=True) * ROUTED_SCALE
    shared = (jax.nn.silu(h @ sh_gate) * (h @ sh_up)) @ sh_down
    return routed_experts(h, idx, w, w_gate, w_up, w_down) + shared


def channel_mixing(x_c, x_l, mod_c, mod_l, g_pre, g_post, router_w, router_bias, w_gate, w_up, w_down,
                   sh_gate, sh_up, sh_down, with_ctx):
    shift_c, scale_c, gate_c = mod_c
    shift_l, scale_l, gate_l = mod_l
    b, S, d = x_l.shape
    tokens = modulate(rms_norm(x_l, g_pre), shift_l, scale_l).reshape(b * S, d)
    if with_ctx:
        h_c = modulate(rms_norm(x_c, g_pre), shift_c, scale_c).reshape(-1, d)
        tokens = jnp.concatenate([h_c, tokens], axis=0)
    y = moe_ffn(tokens, router_w, router_bias, w_gate, w_up, w_down, sh_gate, sh_up, sh_down)
    n_c = tokens.shape[0] - b * S
    x_l = x_l + gate_l * rms_norm(y[n_c:].reshape(b, S, d), g_post)
    if with_ctx:
        x_c = x_c + gate_c * rms_norm(y[:n_c].reshape(x_c.shape), g_post)
    return x_c, x_l


def setup_inputs(seed: int = 0) -> dict:
    key = jax.random.key(seed)
    ks = iter(jax.random.split(key, 48))
    L = DEPTH
    f32 = jnp.float32

    def normal(shape, scale):
        return jax.random.normal(next(ks), shape, f32) * scale

    def gain(shape):
        return 1.0 + normal(shape, 0.05)

    def uniform(shape, lo, hi):
        return jax.random.uniform(next(ks), shape, f32, lo, hi)

    a_pow = uniform((L, 2, LRU_WIDTH), 0.9, 0.999) ** (1.0 / LRU_C)
    dt0 = jnp.exp(uniform((L, 2, SSD_HEADS), math.log(1e-3), math.log(1e-1)))
    return {
        'x': normal((BATCH, SEQ, D_MODEL), 1.0),
        'c': normal((BATCH, D_MODEL), 1.0),
        'ctx': normal((BATCH, CTX_LEN, D_MODEL), 1.0),
        'c_ctx': normal((D_MODEL,), 1.0),
        'w_ada': normal((L, D_MODEL, 6 * D_MODEL), 0.5 * D_MODEL ** -0.5),
        'b_ada': normal((L, 6 * D_MODEL), 0.02),
        'g_mix_pre': gain((L, D_MODEL)),
        'g_mix_post': gain((L, D_MODEL)),
        'g_ffn_pre': gain((L, D_MODEL)),
        'g_ffn_post': gain((L, D_MODEL)),
        'w_in': normal((L, D_MODEL, IN_PROJ), D_MODEL ** -0.5),
        'w_out': normal((L, MIX_WIDTH, D_MODEL), MIX_WIDTH ** -0.5),
        'a_sink': normal((L, A_HEADS), 0.5),
        'ssd_conv_w': normal((L, SSD_CONV, SSD_CONV_CH), SSD_CONV ** -0.5),
        'ssd_conv_b': normal((L, SSD_CONV_CH), 0.02),
        'ssd_dt_bias': dt0 + jnp.log(-jnp.expm1(-dt0)),
        'ssd_a_log': jnp.log(uniform((L, 2, SSD_HEADS), 1.0, 16.0)),
        'ssd_d': gain((L, SSD_HEADS)),
        'ssd_norm': gain((L, SSD_INNER)),
        'lru_conv_w': normal((L, LRU_CONV, LRU_WIDTH), LRU_CONV ** -0.5),
        'lru_conv_b': normal((L, LRU_WIDTH), 0.02),
        'lru_w_a': normal((L, 2, LRU_BLOCKS, LRU_BLOCK_DIM, LRU_BLOCK_DIM), LRU_BLOCK_DIM ** -0.5),
        'lru_b_a': normal((L, 2, LRU_WIDTH), 0.02),
        'lru_w_i': normal((L, 2, LRU_BLOCKS, LRU_BLOCK_DIM, LRU_BLOCK_DIM), LRU_BLOCK_DIM ** -0.5),
        'lru_b_i': normal((L, 2, LRU_WIDTH), 0.02),
        'lru_lambda': jnp.log(a_pow) - jnp.log1p(-a_pow),
        'd_q_norm': gain((L, HEAD_DIM)),
        'd_k_norm': gain((L, HEAD_DIM)),
        'router_w': normal((L, D_MODEL, N_EXPERTS), D_MODEL ** -0.5),
        'router_bias': normal((L, N_EXPERTS), 0.01),
        'exp_w_gate': normal((L, N_EXPERTS, D_MODEL, EXPERT_HIDDEN), D_MODEL ** -0.5),
        'exp_w_up': normal((L, N_EXPERTS, D_MODEL, EXPERT_HIDDEN), D_MODEL ** -0.5),
        'exp_w_down': normal((L, N_EXPERTS, EXPERT_HIDDEN, D_MODEL), EXPERT_HIDDEN ** -0.5),
        'sh_w_gate': normal((L, D_MODEL, SHARED_HIDDEN), D_MODEL ** -0.5),
        'sh_w_up': normal((L, D_MODEL, SHARED_HIDDEN), D_MODEL ** -0.5),
        'sh_w_down': normal((L, SHARED_HIDDEN, D_MODEL), SHARED_HIDDEN ** -0.5),
    }


def reference(x, c, ctx, c_ctx, w_ada, b_ada, g_mix_pre, g_mix_post, g_ffn_pre, g_ffn_post, w_in, w_out,
              a_sink, ssd_conv_w, ssd_conv_b, ssd_dt_bias, ssd_a_log, ssd_d, ssd_norm,
              lru_conv_w, lru_conv_b, lru_w_a, lru_b_a, lru_w_i, lru_b_i, lru_lambda,
              d_q_norm, d_k_norm, router_w, router_bias, exp_w_gate, exp_w_up, exp_w_down,
              sh_w_gate, sh_w_up, sh_w_down):
    b = x.shape[0]
    n_rows = x.shape[1] // GRID_W
    rope_cos, rope_sin = axial_rope_tables(n_rows)
    silu_c = jax.nn.silu(c)
    silu_cc = jax.nn.silu(c_ctx)
    x_c, x_l = ctx, x
    for l in range(DEPTH):
        with_ctx = l < DEPTH - 1
        mod_l = (silu_c @ w_ada[l] + b_ada[l]).reshape(b, 6, 1, D_MODEL).transpose(1, 0, 2, 3)
        mod_c = (silu_cc @ w_ada[l] + b_ada[l]).reshape(6, D_MODEL)
        x_c, x_l = token_mixing(x_c, x_l, mod_c[:3], mod_l[:3], rope_cos, rope_sin,
                                g_mix_pre[l], g_mix_post[l], w_in[l], w_out[l],
                                a_sink[l], ssd_conv_w[l], ssd_conv_b[l], ssd_dt_bias[l], ssd_a_log[l],
                                ssd_d[l], ssd_norm[l], lru_conv_w[l], lru_conv_b[l], lru_w_a[l], lru_b_a[l],
                                lru_w_i[l], lru_b_i[l], lru_lambda[l], d_q_norm[l], d_k_norm[l], with_ctx)
        x_c, x_l = channel_mixing(x_c, x_l, mod_c[3:], mod_l[3:], g_ffn_pre[l], g_ffn_post[l],
                                  router_w[l], router_bias[l], exp_w_gate[l], exp_w_up[l], exp_w_down[l],
                                  sh_w_gate[l], sh_w_up[l], sh_w_down[l], with_ctx)
    return x_l
```

```cpp
#include <hip/hip_runtime.h>
#include <stdint.h>

#define DI __device__ __forceinline__
typedef unsigned short bf16_t;
typedef short bf16x8 __attribute__((ext_vector_type(8)));
typedef short s16x4 __attribute__((ext_vector_type(4)));
typedef float f32x4 __attribute__((ext_vector_type(4)));
typedef float f32x16 __attribute__((ext_vector_type(16)));
typedef unsigned u32x4 __attribute__((ext_vector_type(4)));

constexpr int NTHR = 512;
constexpr int DM = 1024, NB = 4, SEQ = 4096, CTXL = 256;
constexpr int NCTX = NB * CTXL, NLAT = NB * SEQ, NTOK = NCTX + NLAT;
constexpr int INP = 2312, INPP = 2432;
constexpr int CA_Q = 0, CA_K = 256, CA_V = 384, CB_Z = 512, CB_X = 768, CB_B = 1024, CB_C = 1152, CB_DTF = 1280, CB_DTB = 1284,
              CC_X = 1288, CC_G = 1544, CD_Q = 1800, CD_K = 2056, CD_V = 2184;
constexpr int NCHK = 34;
constexpr int HCAP = 8704;
constexpr float EPS = 1e-6f;

constexpr size_t MB = 1024 * 1024;
constexpr size_t OFF_BAR = 0;
constexpr size_t OFF_CNT = 16 * 1024;
constexpr size_t OFF_MOD = 32 * 1024;
constexpr size_t ZERO_BYTES = 32 * 1024 + 2 * 5 * 6144 * 4;
constexpr size_t OFF_ROPE = 512 * 1024;
constexpr size_t OFF_SLOT_TOK = 2 * MB;
constexpr size_t OFF_SLOT_W = 7 * MB;
constexpr size_t OFF_TOKSLOT = 12 * MB;
constexpr size_t OFF_LRUC = 13 * MB;
constexpr size_t OFF_SSDDEC = 14 * MB;
constexpr size_t OFF_XCTX = 15 * MB;
constexpr size_t OFF_WIN = 20 * MB;
constexpr size_t SZ_WIN1 = (size_t)INPP * DM * 2;
constexpr size_t OFF_WOUT = OFF_WIN + 2 * SZ_WIN1;
constexpr size_t SZ_WOUT1 = (size_t)DM * DM * 2;
constexpr size_t OFF_WGU = 36 * MB;
constexpr size_t OFF_WD = OFF_WGU + (size_t)65 * 512 * 1024 * 2;
constexpr size_t OFF_Y = 140 * MB;
constexpr size_t OFF_RA = 210 * MB;
constexpr size_t OFF_HID = OFF_RA + (size_t)NTOK * DM * 2;
constexpr size_t OFF_RB = 292 * MB;
constexpr size_t OFF_RC = 328 * MB;
constexpr size_t OFF_QA = OFF_RC;
constexpr size_t OFF_KA = OFF_QA + (size_t)NTOK * 256 * 2;
constexpr size_t OFF_QD = OFF_KA + (size_t)NTOK * 128 * 2;
constexpr size_t OFF_KD = OFF_QD + (size_t)NTOK * 256 * 2;
constexpr size_t OFF_SSDST = OFF_KD + (size_t)NTOK * 128 * 2;
constexpr size_t OFF_YPART = OFF_SSDST + (size_t)4 * 4 * 2 * 34 * 4096 * 4;
constexpr size_t OFF_CC = OFF_YPART + (size_t)NTOK * 256 * 4;
constexpr size_t OFF_EA = OFF_CC + (size_t)NTOK * 128 * 4;
constexpr size_t OFF_LRUH = OFF_EA + (size_t)NTOK * 8 * 4;
constexpr size_t OFF_YE = OFF_RC;
constexpr size_t WS_NEED = OFF_RC + (size_t)8 * HCAP * 1024 * 2 + MB;

struct Params {
    const float* in[36];
    float* out;
    char* ws;
};
enum { I_X = 0, I_C, I_CTX, I_CCTX, I_WADA, I_BADA, I_GMIXPRE, I_GMIXPOST, I_GFFNPRE, I_GFFNPOST, I_WIN, I_WOUT, I_ASINK, I_SSDCW, I_SSDCB, I_SSDDTB, I_SSDALOG,
       I_SSDD, I_SSDNORM, I_LRUCW, I_LRUCB, I_LRUWA, I_LRUBA, I_LRUWI, I_LRUBI, I_LRULAM, I_DQN, I_DKN, I_RW, I_RB, I_EG, I_EU, I_ED, I_SG, I_SU, I_SD };

DI float bf2f(bf16_t v) { return __uint_as_float(((unsigned)v) << 16); }
DI bf16_t f2bf(float f) { unsigned u = __float_as_uint(f); u += 0x7fffu + ((u >> 16) & 1u); return (bf16_t)(u >> 16); }
DI unsigned pack2(float lo, float hi) { return (unsigned)f2bf(lo) | ((unsigned)f2bf(hi) << 16); }
DI float wave_sum(float v) {
#pragma unroll
    for (int o = 32; o > 0; o >>= 1) v += __shfl_xor(v, o);
    return v;
}
DI float sigmoid_(float x) { return 1.f / (1.f + __expf(-x)); }
DI float silu_(float x) { return x / (1.f + __expf(-x)); }
DI float softplus_(float x) { return x > 20.f ? x : log1pf(__expf(x)); }
DI float gelu_tanh_(float x) { const float u = 0.7978845608028654f * (x + 0.044715f * x * x * x); return 0.5f * x * (1.f + tanhf(u)); }
DI int crow(int reg, int h) { return (reg & 3) + 8 * (reg >> 2) + 4 * h; }

DI const float* xrow_c(const Params& p, int r) { return r < NCTX ? (const float*)(p.ws + OFF_XCTX) + (size_t)r * DM : p.out + (size_t)(r - NCTX) * DM; }
DI float* xrow(const Params& p, int r) { return r < NCTX ? (float*)(p.ws + OFF_XCTX) + (size_t)r * DM : p.out + (size_t)(r - NCTX) * DM; }
DI const float* xin_row(const Params& p, int r) { return r < NCTX ? p.in[I_CTX] + (size_t)r * DM : p.in[I_X] + (size_t)(r - NCTX) * DM; }
DI int mod_idx(int r) { return r < NCTX ? 4 : ((r - NCTX) >> 12); }
DI const float* modp(const Params& p, int l, int bidx, int k) { return (const float*)(p.ws + OFF_MOD) + ((size_t)(l * 5 + bidx) * 6 + k) * DM; }
DI int half_lo(int l, int hf) { return hf == 0 ? (l == 0 ? 0 : NCTX) : (l == 0 ? 8704 : 9216); }
DI int half_hi(int l, int hf) { return hf == 0 ? (l == 0 ? 8704 : 9216) : NTOK; }

DI void transpose_tile(const float* __restrict__ src, int ld, int N, int k0, int n0, bf16_t* __restrict__ dst, int ldd, int mode, float* tile) {
    const int t = threadIdx.x;
    {
        const int col = t & 63, r8 = t >> 6;
#pragma unroll
        for (int i = 0; i < 8; ++i) { const int row = r8 + 8 * i; tile[row * 65 + col] = (n0 + col < N) ? src[(size_t)(k0 + row) * ld + n0 + col] : 0.f; }
    }
    __syncthreads();
    {
        const int n = t >> 3, kc = (t & 7) * 8;
        uint4 v;
        v.x = pack2(tile[(kc + 0) * 65 + n], tile[(kc + 1) * 65 + n]); v.y = pack2(tile[(kc + 2) * 65 + n], tile[(kc + 3) * 65 + n]);
        v.z = pack2(tile[(kc + 4) * 65 + n], tile[(kc + 5) * 65 + n]); v.w = pack2(tile[(kc + 6) * 65 + n], tile[(kc + 7) * 65 + n]);
        const int nn = n0 + n;
        int R = nn;
        if (mode) R = 128 * (nn >> 6) + 64 * ((nn >> 5) & 1) + (nn & 31) + (mode == 2 ? 32 : 0);
        *(uint4*)(dst + (size_t)R * ldd + k0 + kc) = v;
    }
    __syncthreads();
}
constexpr int CONV_UNITS_SMALL = 608 + 256, CONV_UNITS_EXP = 3 * 4160;
DI void convert_small_unit(const Params& p, int l, int u, char* smem) {
    float* tile = (float*)smem;
    if (u < 608) { const int kt = u / 38, nt = u % 38;
        transpose_tile(p.in[I_WIN] + (size_t)l * DM * INP, INP, INP, kt * 64, nt * 64, (bf16_t*)(p.ws + OFF_WIN + l * SZ_WIN1), DM, 0, tile); return; }
    u -= 608; { const int kt = u / 16, nt = u % 16;
        transpose_tile(p.in[I_WOUT] + (size_t)l * DM * DM, DM, DM, kt * 64, nt * 64, (bf16_t*)(p.ws + OFF_WOUT + l * SZ_WOUT1), DM, 0, tile); }
}
DI void convert_exp_unit(const Params& p, int l, int u, char* smem) {
    float* tile = (float*)smem;
    if (u < 2 * 4160) { const int up = u >= 4160; if (up) u -= 4160;
        const int e = u / 64, r = u % 64, kt = r / 4, nt = r % 4;
        const float* src = e < 64 ? p.in[up ? I_EU : I_EG] + ((size_t)l * 64 + e) * DM * 256 : p.in[up ? I_SU : I_SG] + (size_t)l * DM * 256;
        transpose_tile(src, 256, 256, kt * 64, nt * 64, (bf16_t*)(p.ws + OFF_WGU) + (size_t)e * 512 * 1024, 1024, up ? 2 : 1, tile); return; }
    u -= 2 * 4160; { const int e = u / 64, r = u % 64, kt = r / 16, nt = r % 16;
        const float* src = e < 64 ? p.in[I_ED] + ((size_t)l * 64 + e) * 256 * DM : p.in[I_SD] + (size_t)l * 256 * DM;
        transpose_tile(src, DM, DM, kt * 64, nt * 64, (bf16_t*)(p.ws + OFF_WD) + (size_t)e * 1024 * 256, 256, 0, tile); }
}
constexpr int MOD_UNITS = 2 * 96;
DI void mod_unit(const Params& p, int u, char* smem) {
    float* s = (float*)smem;
    float* part = s + 5 * 1024;
    const int l = u / 96, cb = u % 96, t = threadIdx.x, col = t & 63, kg = t >> 6;
    for (int i = t; i < 5 * 1024; i += NTHR) { const int v = i >> 10, k = i & 1023; const float c = v < 4 ? p.in[I_C][v * DM + k] : p.in[I_CCTX][k]; s[i] = silu_(c); }
    __syncthreads();
    const int j = cb * 64 + col;
    const float* w = p.in[I_WADA] + (size_t)l * DM * 6144 + (size_t)(kg * 128) * 6144 + j;
    float a0 = 0, a1 = 0, a2 = 0, a3 = 0, a4 = 0;
#pragma unroll 4
    for (int k = 0; k < 128; ++k) { const float wv = w[(size_t)k * 6144]; const int kk = kg * 128 + k;
        a0 += s[kk] * wv; a1 += s[1024 + kk] * wv; a2 += s[2048 + kk] * wv; a3 += s[3072 + kk] * wv; a4 += s[4096 + kk] * wv; }
    part[(kg * 5 + 0) * 64 + col] = a0; part[(kg * 5 + 1) * 64 + col] = a1; part[(kg * 5 + 2) * 64 + col] = a2; part[(kg * 5 + 3) * 64 + col] = a3; part[(kg * 5 + 4) * 64 + col] = a4;
    __syncthreads();
    if (t < 320) { const int v = t >> 6, c = t & 63; float acc = p.in[I_BADA][l * 6144 + cb * 64 + c];
#pragma unroll
        for (int g = 0; g < 8; ++g) acc += part[(g * 5 + v) * 64 + c];
        ((float*)(p.ws + OFF_MOD))[(size_t)(l * 5 + v) * 6144 + cb * 64 + c] = acc; }
    __syncthreads();
}
constexpr int ROPE_UNITS = 4096 * 32 / NTHR;
DI void rope_unit(const Params& p, int u) {
    const int idx = u * NTHR + threadIdx.x, t = idx >> 5, i = idx & 31;
    const float pos = (float)(i < 16 ? (t >> 6) : (t & 63));
    const float inv = powf(10000.f, -(float)(2 * (i & 15)) / 32.f);
    const float ang = pos * inv;
    ((float2*)(p.ws + OFF_ROPE))[idx] = make_float2(cosf(ang), sinf(ang));
}

template <int MODE>
DI void rowpost_unit(const Params& p, int l, int hf, int r0, char* smem) {
    float* hrow = (float*)smem;
    int* hoffU = (int*)(smem + 16 * 1024 * 4);
    const int tid = threadIdx.x, lane = tid & 63, w = tid >> 6;
    if (MODE >= 2) {
        if (tid < 64) { const int* cnt = (const int*)(p.ws + OFF_CNT) + (l * 2 + hf) * 64; int s = 0; for (int e = 0; e < tid; ++e) s += cnt[e]; hoffU[tid] = s; }
        __syncthreads();
    }
#pragma unroll 1
    for (int rr = 0; rr < 2; ++rr) {
        const int r = r0 + 2 * w + rr;
        const int bidx = mod_idx(r);
        f32x4 xv[4];
        if (MODE == 0) {
#pragma unroll
            for (int i = 0; i < 4; ++i) xv[i] = *(const f32x4*)(xin_row(p, r) + 4 * lane + 256 * i);
        } else {
            f32x4 yv[4];
            const float* Y = (const float*)(p.ws + OFF_Y) + (size_t)r * DM;
#pragma unroll
            for (int i = 0; i < 4; ++i) yv[i] = *(const f32x4*)(Y + 4 * lane + 256 * i);
            if (MODE >= 2) {
                const int* ts = (const int*)(p.ws + OFF_TOKSLOT) + (size_t)r * 8;
                const bf16_t* ye = (const bf16_t*)(p.ws + OFF_YE);
#pragma unroll 1
                for (int k = 0; k < 8; ++k) {
                    const int v = ts[k]; const int e = v >> 14, pos = v & 16383;
                    const bf16_t* yr = ye + (size_t)(hoffU[e] + pos) * DM;
#pragma unroll
                    for (int i = 0; i < 4; ++i) { const uint2 q = *(const uint2*)(yr + 4 * lane + 256 * i);
                        yv[i][0] += __uint_as_float(q.x << 16); yv[i][1] += __uint_as_float(q.x & 0xffff0000u); yv[i][2] += __uint_as_float(q.y << 16); yv[i][3] += __uint_as_float(q.y & 0xffff0000u); }
                }
            }
            const float* xs = (MODE == 1 && l == 0) ? xin_row(p, r) : xrow_c(p, r);
#pragma unroll
            for (int i = 0; i < 4; ++i) xv[i] = *(const f32x4*)(xs + 4 * lane + 256 * i);
            float ss = 0.f;
#pragma unroll
            for (int i = 0; i < 4; ++i) ss += yv[i][0] * yv[i][0] + yv[i][1] * yv[i][1] + yv[i][2] * yv[i][2] + yv[i][3] * yv[i][3];
            ss = wave_sum(ss);
            const float rs = rsqrtf(ss * (1.f / DM) + EPS);
            const float* gate = modp(p, l, bidx, MODE == 1 ? 2 : 5);
            const float* gp = p.in[MODE == 1 ? I_GMIXPOST : I_GFFNPOST] + l * DM;
            float* xo = xrow(p, r);
#pragma unroll
            for (int i = 0; i < 4; ++i) { const f32x4 g = *(const f32x4*)(gate + 4 * lane + 256 * i), q = *(const f32x4*)(gp + 4 * lane + 256 * i);
                xv[i] = xv[i] + g * (yv[i] * rs * q); *(f32x4*)(xo + 4 * lane + 256 * i) = xv[i]; }
        }
        if (MODE != 3) {
            const int lp = MODE == 2 ? l + 1 : l;
            float ss = 0.f;
#pragma unroll
            for (int i = 0; i < 4; ++i) ss += xv[i][0] * xv[i][0] + xv[i][1] * xv[i][1] + xv[i][2] * xv[i][2] + xv[i][3] * xv[i][3];
            ss = wave_sum(ss);
            const float rs = rsqrtf(ss * (1.f / DM) + EPS);
            const float* gpre = p.in[MODE == 1 ? I_GFFNPRE : I_GMIXPRE] + lp * DM;
            const float* sh = modp(p, lp, bidx, MODE == 1 ? 3 : 0);
            const float* sc = modp(p, lp, bidx, MODE == 1 ? 4 : 1);
            bf16_t* hb = (bf16_t*)(p.ws + (MODE == 1 ? OFF_RA : OFF_RB)) + (size_t)r * DM;
#pragma unroll
            for (int i = 0; i < 4; ++i) { const int c = 4 * lane + 256 * i;
                const f32x4 g = *(const f32x4*)(gpre + c), s1 = *(const f32x4*)(sh + c), s2 = *(const f32x4*)(sc + c);
                const f32x4 h = xv[i] * rs * g * (s2 + 1.f) + s1;
                uint2 q; q.x = pack2(h[0], h[1]); q.y = pack2(h[2], h[3]); *(uint2*)(hb + c) = q;
                if (MODE == 1) *(f32x4*)(hrow + (2 * w + rr) * DM + c) = h; }
        }
    }
    if (MODE == 1) {
        __syncthreads();
        const float* rw = p.in[I_RW] + (size_t)l * DM * 64 + lane;
        const float* h0 = hrow + (2 * w) * DM; const float* h1 = h0 + DM;
        float a0 = 0.f, a1 = 0.f;
#pragma unroll 8
        for (int k = 0; k < DM; ++k) { const float wv = rw[k * 64]; a0 += h0[k] * wv; a1 += h1[k] * wv; }
        const float rbias = p.in[I_RB][l * 64 + lane];
#pragma unroll 1
        for (int rr = 0; rr < 2; ++rr) {
            const int r = r0 + 2 * w + rr;
            const float s = sigmoid_(rr ? a1 : a0);
            const float v = s + rbias;
            float m1 = v;
            m1 = fmaxf(m1, __shfl_xor(m1, 1)); m1 = fmaxf(m1, __shfl_xor(m1, 2)); m1 = fmaxf(m1, __shfl_xor(m1, 4));
            int ix = (v == m1) ? lane : 64;
            ix = min(ix, __shfl_xor(ix, 1)); ix = min(ix, __shfl_xor(ix, 2)); ix = min(ix, __shfl_xor(ix, 4));
            float m2 = (lane == ix) ? -INFINITY : v;
            m2 = fmaxf(m2, __shfl_xor(m2, 1)); m2 = fmaxf(m2, __shfl_xor(m2, 2)); m2 = fmaxf(m2, __shfl_xor(m2, 4));
            const float gs = m1 + m2;
            const int g = lane >> 3; int grank = 0;
#pragma unroll
            for (int gg = 0; gg < 8; ++gg) { const float o = __shfl(gs, gg * 8); grank += (o > gs) || (o == gs && gg < g); }
            const bool gsel = grank < 4;
            const float vm = gsel ? v : -INFINITY;
            int rk = 0;
#pragma unroll 8
            for (int ee = 0; ee < 64; ++ee) { const float o = __shfl(vm, ee); rk += (o > vm) || (o == vm && ee < lane); }
            const bool sel = gsel && rk < 8;
            const float scs = sel ? s : 0.f;
            const float tot = wave_sum(scs);
            const float wgt = scs / tot * 2.5f;
            if (sel) {
                const int h = r >= half_lo(l, 1) ? 1 : 0;
                int* cnt = (int*)(p.ws + OFF_CNT) + (l * 2 + h) * 64;
                const int pos = atomicAdd(cnt + lane, 1);
                ((int*)(p.ws + OFF_SLOT_TOK))[(size_t)(h * 64 + lane) * HCAP + pos] = r;
                ((float*)(p.ws + OFF_SLOT_W))[(size_t)(h * 64 + lane) * HCAP + pos] = wgt;
                ((int*)(p.ws + OFF_TOKSLOT))[(size_t)r * 8 + rk] = (lane << 14) | pos;
            }
        }
    }
    __syncthreads();
}

constexpr int LDT = 72;
constexpr int GEMM_LDS = 2 * (256 + 128) * LDT * 2;
template <class AF, class EF>
DI void gemm_tile(AF arow, const bf16_t* __restrict__ Bt, int ldb, int K, EF epi, char* smem) {
    const int tid = threadIdx.x, lane = tid & 63, w = tid >> 6, wr = w >> 1, wc = w & 1, fr = lane & 15, fq = lane >> 4;
    bf16_t* As = (bf16_t*)smem;
    bf16_t* Bs = As + 2 * 256 * LDT;
    const int c = tid & 7, r0 = tid >> 3;
    const bf16_t* ap[4]; const bf16_t* bp[2];
#pragma unroll
    for (int i = 0; i < 4; ++i) ap[i] = arow(r0 + 64 * i) + c * 8;
#pragma unroll
    for (int i = 0; i < 2; ++i) bp[i] = Bt + (size_t)(r0 + 64 * i) * ldb + c * 8;
    u32x4 ra[4], rb[2];
#pragma unroll
    for (int i = 0; i < 4; ++i) ra[i] = *(const u32x4*)(ap[i]);
#pragma unroll
    for (int i = 0; i < 2; ++i) rb[i] = *(const u32x4*)(bp[i]);
#pragma unroll
    for (int i = 0; i < 4; ++i) *(u32x4*)(As + (r0 + 64 * i) * LDT + c * 8) = ra[i];
#pragma unroll
    for (int i = 0; i < 2; ++i) *(u32x4*)(Bs + (r0 + 64 * i) * LDT + c * 8) = rb[i];
    __syncthreads();
    f32x4 acc[4][4];
#pragma unroll
    for (int m = 0; m < 4; ++m)
#pragma unroll
        for (int n = 0; n < 4; ++n) acc[m][n] = (f32x4){0.f, 0.f, 0.f, 0.f};
    const int nk = K >> 6;
#pragma unroll 1
    for (int kt = 0; kt < nk; ++kt) {
        const bool more = kt + 1 < nk;
        if (more) {
#pragma unroll
            for (int i = 0; i < 4; ++i) ra[i] = *(const u32x4*)(ap[i] + (kt + 1) * 64);
#pragma unroll
            for (int i = 0; i < 2; ++i) rb[i] = *(const u32x4*)(bp[i] + (kt + 1) * 64);
        }
        const bf16_t* Ac = As + (kt & 1) * 256 * LDT;
        const bf16_t* Bc = Bs + (kt & 1) * 128 * LDT;
#pragma unroll
        for (int ks = 0; ks < 2; ++ks) {
            bf16x8 a[4], b[4];
#pragma unroll
            for (int m = 0; m < 4; ++m) a[m] = *(const bf16x8*)(Ac + (wr * 64 + m * 16 + fr) * LDT + ks * 32 + fq * 8);
#pragma unroll
            for (int n = 0; n < 4; ++n) b[n] = *(const bf16x8*)(Bc + (wc * 64 + n * 16 + fr) * LDT + ks * 32 + fq * 8);
#pragma unroll
            for (int m = 0; m < 4; ++m)
#pragma unroll
                for (int n = 0; n < 4; ++n) acc[m][n] = __builtin_amdgcn_mfma_f32_16x16x32_bf16(b[n], a[m], acc[m][n], 0, 0, 0);
        }
        if (more) {
            bf16_t* An = As + ((kt + 1) & 1) * 256 * LDT;
            bf16_t* Bn = Bs + ((kt + 1) & 1) * 128 * LDT;
#pragma unroll
            for (int i = 0; i < 4; ++i) *(u32x4*)(An + (r0 + 64 * i) * LDT + c * 8) = ra[i];
#pragma unroll
            for (int i = 0; i < 2; ++i) *(u32x4*)(Bn + (r0 + 64 * i) * LDT + c * 8) = rb[i];
        }
        __syncthreads();
    }
    epi(acc, wr, wc, fr, fq);
}

constexpr int INPROJ_UNITS = (NTOK / 256) * (INPP / 128);
DI void inproj_unit(const Params& p, int l, int u, char* smem) {
    const int mt = u / 19, nt = u % 19;
    const bf16_t* A = (const bf16_t*)(p.ws + OFF_RB) + (size_t)mt * 256 * DM;
    const bf16_t* Bt = (const bf16_t*)(p.ws + OFF_WIN + l * SZ_WIN1) + (size_t)nt * 128 * DM;
    bf16_t* C = (bf16_t*)(p.ws + OFF_RA) + (size_t)mt * 256 * INPP + nt * 128;
    gemm_tile([&](int r) { return A + (size_t)r * DM; }, Bt, DM, DM,
              [&](const f32x4 (&acc)[4][4], int wr, int wc, int fr, int fq) {
#pragma unroll
                  for (int m = 0; m < 4; ++m)
#pragma unroll
                      for (int n = 0; n < 4; ++n) { uint2 q; q.x = pack2(acc[m][n][0], acc[m][n][1]); q.y = pack2(acc[m][n][2], acc[m][n][3]);
                          *(uint2*)(C + (size_t)(wr * 64 + m * 16 + fr) * INPP + wc * 64 + n * 16 + fq * 4) = q; }
              }, smem);
}
DI int outproj_units(int l) { return (l == 0 ? 68 : 64) * 8; }
DI void outproj_unit(const Params& p, int l, int u, char* smem) {
    const int mt = u / 8, nt = u % 8, row0 = (l == 0 ? 0 : NCTX) + mt * 256;
    const bf16_t* A = (const bf16_t*)(p.ws + OFF_RB) + (size_t)row0 * DM;
    const bf16_t* Bt = (const bf16_t*)(p.ws + OFF_WOUT + l * SZ_WOUT1) + (size_t)nt * 128 * DM;
    float* C = (float*)(p.ws + OFF_Y) + (size_t)row0 * DM + nt * 128;
    gemm_tile([&](int r) { return A + (size_t)r * DM; }, Bt, DM, DM,
              [&](const f32x4 (&acc)[4][4], int wr, int wc, int fr, int fq) {
#pragma unroll
                  for (int m = 0; m < 4; ++m)
#pragma unroll
                      for (int n = 0; n < 4; ++n) *(f32x4*)(C + (size_t)(wr * 64 + m * 16 + fr) * DM + wc * 64 + n * 16 + fq * 4) = acc[m][n];
              }, smem);
}
struct MoeTab { int cnt[65]; int mstart[66]; int hoffP[65]; int hoffU[65]; };
DI void moe_table(const Params& p, int l, int hf, MoeTab* tb) {
    if (threadIdx.x == 0) {
        const int* cnt = (const int*)(p.ws + OFF_CNT) + (l * 2 + hf) * 64;
        int ms = 0, hp = 0, hu = 0;
        for (int e = 0; e < 65; ++e) { const int c = e < 64 ? cnt[e] : half_hi(l, hf) - half_lo(l, hf);
            tb->cnt[e] = c; tb->mstart[e] = ms; tb->hoffP[e] = hp; tb->hoffU[e] = hu; const int mt = (c + 255) >> 8; ms += mt; hp += mt * 256; hu += c; }
        tb->mstart[65] = ms;
    }
    __syncthreads();
}
DI void moe_find(const MoeTab* tb, int g, int& e, int& mt) { int lo = 0; while (tb->mstart[lo + 1] <= g) ++lo; e = lo; mt = g - tb->mstart[lo]; }
DI void moe1_unit(const Params& p, int l, int hf, const MoeTab* tb, int u, char* smem) {
    const int g = u >> 2, nt = u & 3; int e, mt; moe_find(tb, g, e, mt);
    const int cnt = tb->cnt[e], lo = half_lo(l, hf);
    const int* stok = (const int*)(p.ws + OFF_SLOT_TOK) + (size_t)(hf * 64 + (e & 63)) * HCAP;
    const bf16_t* T = (const bf16_t*)(p.ws + OFF_RA);
    const bf16_t* Bt = (const bf16_t*)(p.ws + OFF_WGU) + ((size_t)e * 512 + nt * 128) * 1024;
    bf16_t* H = (bf16_t*)(p.ws + OFF_HID) + (size_t)(tb->hoffP[e] + mt * 256) * 256 + nt * 64;
    gemm_tile([&](int r) { int pos = mt * 256 + r; pos = pos < cnt ? pos : cnt - 1; const int tok = e < 64 ? stok[pos] : lo + pos; return T + (size_t)tok * DM; }, Bt, 1024, 1024,
              [&](const f32x4 (&acc)[4][4], int wr, int wc, int fr, int fq) {
#pragma unroll
                  for (int m = 0; m < 4; ++m)
#pragma unroll
                      for (int n = 0; n < 2; ++n) { const f32x4 gt = acc[m][n], up = acc[m][n + 2];
                          uint2 q; q.x = pack2(silu_(gt[0]) * up[0], silu_(gt[1]) * up[1]); q.y = pack2(silu_(gt[2]) * up[2], silu_(gt[3]) * up[3]);
                          *(uint2*)(H + (size_t)(wr * 64 + m * 16 + fr) * 256 + wc * 32 + n * 16 + fq * 4) = q; }
              }, smem);
}
DI void moe2_unit(const Params& p, int l, int hf, const MoeTab* tb, int u, char* smem) {
    const int g = u >> 3, nt = u & 7; int e, mt; moe_find(tb, g, e, mt);
    const int cnt = tb->cnt[e], lo = half_lo(l, hf);
    const float* sw = (const float*)(p.ws + OFF_SLOT_W) + (size_t)(hf * 64 + (e & 63)) * HCAP;
    const bf16_t* A = (const bf16_t*)(p.ws + OFF_HID) + (size_t)(tb->hoffP[e] + mt * 256) * 256;
    const bf16_t* Bt = (const bf16_t*)(p.ws + OFF_WD) + ((size_t)e * 1024 + nt * 128) * 256;
    bf16_t* YE = (bf16_t*)(p.ws + OFF_YE) + (size_t)(tb->hoffU[e] + mt * 256) * DM + nt * 128;
    float* Y = (float*)(p.ws + OFF_Y) + (size_t)(lo + mt * 256) * DM + nt * 128;
    gemm_tile([&](int r) { return A + (size_t)r * 256; }, Bt, 256, 256,
              [&](const f32x4 (&acc)[4][4], int wr, int wc, int fr, int fq) {
#pragma unroll
                  for (int m = 0; m < 4; ++m) { const int row = wr * 64 + m * 16 + fr, pos = mt * 256 + row;
                      if (pos < cnt) {
                          if (e < 64) { const float wv = sw[pos];
#pragma unroll
                              for (int n = 0; n < 4; ++n) { uint2 q; q.x = pack2(acc[m][n][0] * wv, acc[m][n][1] * wv); q.y = pack2(acc[m][n][2] * wv, acc[m][n][3] * wv);
                                  *(uint2*)(YE + (size_t)row * DM + wc * 64 + n * 16 + fq * 4) = q; }
                          } else {
#pragma unroll
                              for (int n = 0; n < 4; ++n) *(f32x4*)(Y + (size_t)row * DM + wc * 64 + n * 16 + fq * 4) = acc[m][n];
                          } } }
              }, smem);
}

constexpr int PREP_UNITS = NTOK / 8;
DI void rope2(float& a, float& b, const float2 cs) { const float x1 = a, x2 = b; a = x1 * cs.x - x2 * cs.y; b = x1 * cs.y + x2 * cs.x; }
DI void prep_unit(const Params& p, int l, int u) {
    const int tid = threadIdx.x, lane = tid & 63, w = tid >> 6, r = u * 8 + w;
    const bool lat = r >= NCTX; const int pos = (r - NCTX) & (SEQ - 1);
    const bf16_t* pr = (const bf16_t*)(p.ws + OFF_RA) + (size_t)r * INPP;
    const float2* rt = (const float2*)(p.ws + OFF_ROPE) + (size_t)pos * 32;
    const float* gq = p.in[I_DQN] + l * 64; const float* gk = p.in[I_DKN] + l * 64;
    unsigned* QA = (unsigned*)(p.ws + OFF_QA) + (size_t)r * 128; unsigned* KA = (unsigned*)(p.ws + OFF_KA) + (size_t)r * 64;
    unsigned* QD = (unsigned*)(p.ws + OFF_QD) + (size_t)r * 128; unsigned* KD = (unsigned*)(p.ws + OFF_KD) + (size_t)r * 64;
#pragma unroll
    for (int i = 0; i < 2; ++i) {
        const int pq = lane + 64 * i, pi = pq & 31;
        const float2 cs = lat ? rt[pi] : make_float2(1.f, 0.f);
        { const unsigned v = *(const unsigned*)(pr + CA_Q + 2 * pq); float a = __uint_as_float(v << 16), b = __uint_as_float(v & 0xffff0000u);
          rope2(a, b, cs); QA[pq] = pack2(a * 0.125f, b * 0.125f); }
        { const unsigned v = *(const unsigned*)(pr + CD_Q + 2 * pq); float a = __uint_as_float(v << 16), b = __uint_as_float(v & 0xffff0000u);
          float ss = a * a + b * b;
#pragma unroll
          for (int o = 1; o < 32; o <<= 1) ss += __shfl_xor(ss, o);
          const float rs = rsqrtf(ss * (1.f / 64.f) + EPS);
          a = a * rs * gq[2 * pi]; b = b * rs * gq[2 * pi + 1];
          rope2(a, b, cs); QD[pq] = pack2(a * 0.125f, b * 0.125f); }
    }
    {
        const int pi = lane & 31;
        const float2 cs = lat ? rt[pi] : make_float2(1.f, 0.f);
        { const unsigned v = *(const unsigned*)(pr + CA_K + 2 * lane); float a = __uint_as_float(v << 16), b = __uint_as_float(v & 0xffff0000u);
          rope2(a, b, cs); KA[lane] = pack2(a, b); }
        { const unsigned v = *(const unsigned*)(pr + CD_K + 2 * lane); float a = __uint_as_float(v << 16), b = __uint_as_float(v & 0xffff0000u);
          float ss = a * a + b * b;
#pragma unroll
          for (int o = 1; o < 32; o <<= 1) ss += __shfl_xor(ss, o);
          const float rs = rsqrtf(ss * (1.f / 64.f) + EPS);
          a = a * rs * gk[2 * pi]; b = b * rs * gk[2 * pi + 1];
          rope2(a, b, cs); KD[lane] = pack2(a, b); }
    }
}

constexpr int ATT_LDS = 2 * 2 * 64 * LDT * 2;
struct AttnArgs {
    const bf16_t* Q; const bf16_t* K; const bf16_t* V;
    int qrow0;
    int g;
    int k0row, k0tiles;
    int k1row, k1t0, k1t1;
    int qpos0;
    const float* sink;
    bf16_t* O;
};
DI void attn_unit(const AttnArgs& a, char* smem) {
    const int tid = threadIdx.x, lane = tid & 63, w = tid >> 6, r32 = lane & 31, hi = lane >> 5;
    const int head = 2 * a.g + (w >> 2), qoff = (w & 3) * 32 + r32;
    bf16_t* Ks = (bf16_t*)smem;
    bf16_t* Vs = Ks + 2 * 64 * LDT;
    bf16x8 qr[4];
    { const bf16_t* qp = a.Q + (size_t)(a.qrow0 + qoff) * 256 + head * 64 + hi * 8;
#pragma unroll
      for (int d0 = 0; d0 < 4; ++d0) qr[d0] = *(const bf16x8*)(qp + d0 * 16); }
    float m_run, l_run;
    if (a.sink) { m_run = a.sink[head]; l_run = hi == 0 ? 1.f : 0.f; } else { m_run = -1e30f; l_run = 0.f; }
    f32x16 o0, o1;
#pragma unroll
    for (int i = 0; i < 16; ++i) { o0[i] = 0.f; o1[i] = 0.f; }
    const int nt = a.k0tiles + (a.k1t1 - a.k1t0);
    const int lrow = tid >> 3, lc = (tid & 7) * 8;
    auto tile_row0 = [&](int t) { return t < a.k0tiles ? a.k0row + t * 64 : a.k1row + (a.k1t0 + t - a.k0tiles) * 64; };
    u32x4 rk, rv;
    { const int kr = tile_row0(0) + lrow; rk = *(const u32x4*)(a.K + (size_t)kr * 128 + a.g * 64 + lc); rv = *(const u32x4*)(a.V + (size_t)kr * INPP + a.g * 64 + lc); }
    *(u32x4*)(Ks + lrow * LDT + lc) = rk; *(u32x4*)(Vs + lrow * LDT + lc) = rv;
    __syncthreads();
    const int q4 = (lane & 15) >> 2, p4 = lane & 3, blk = (lane >> 4) & 1;
#pragma unroll 1
    for (int t = 0; t < nt; ++t) {
        const bool more = t + 1 < nt;
        if (more) { const int kr = tile_row0(t + 1) + lrow; rk = *(const u32x4*)(a.K + (size_t)kr * 128 + a.g * 64 + lc); rv = *(const u32x4*)(a.V + (size_t)kr * INPP + a.g * 64 + lc); }
        const bf16_t* Kc = Ks + (t & 1) * 64 * LDT;
        const bf16_t* Vc = Vs + (t & 1) * 64 * LDT;
        f32x16 s0, s1;
#pragma unroll
        for (int i = 0; i < 16; ++i) { s0[i] = 0.f; s1[i] = 0.f; }
#pragma unroll
        for (int d0 = 0; d0 < 4; ++d0) {
            const bf16x8 k0 = *(const bf16x8*)(Kc + r32 * LDT + d0 * 16 + hi * 8);
            const bf16x8 k1 = *(const bf16x8*)(Kc + (32 + r32) * LDT + d0 * 16 + hi * 8);
            s0 = __builtin_amdgcn_mfma_f32_32x32x16_bf16(k0, qr[d0], s0, 0, 0, 0);
            s1 = __builtin_amdgcn_mfma_f32_32x32x16_bf16(k1, qr[d0], s1, 0, 0, 0);
        }
        if (a.qpos0 >= 0 && t >= a.k0tiles) {
            const int kb = (a.k1t0 + t - a.k0tiles) * 64, qp = a.qpos0 + qoff;
#pragma unroll
            for (int i = 0; i < 16; ++i) { const int kp = kb + crow(i, hi); int d = kp - qp; d = d < 0 ? -d : d; if (d > 128) s0[i] = -1e30f; d = kp + 32 - qp; d = d < 0 ? -d : d; if (d > 128) s1[i] = -1e30f; }
        }
        float mx = s0[0];
#pragma unroll
        for (int i = 1; i < 16; ++i) mx = fmaxf(mx, s0[i]);
#pragma unroll
        for (int i = 0; i < 16; ++i) mx = fmaxf(mx, s1[i]);
        mx = fmaxf(mx, __shfl_xor(mx, 32));
        const float m_new = fmaxf(m_run, mx);
        const float alpha = __expf(m_run - m_new);
        m_run = m_new;
        float ps = 0.f;
#pragma unroll
        for (int i = 0; i < 16; ++i) { s0[i] = __expf(s0[i] - m_new); s1[i] = __expf(s1[i] - m_new); ps += s0[i] + s1[i]; }
        l_run = l_run * alpha + ps;
#pragma unroll
        for (int i = 0; i < 16; ++i) { o0[i] *= alpha; o1[i] *= alpha; }
#pragma unroll
        for (int ks = 0; ks < 4; ++ks) {
            bf16x8 pf;
            {
                union { unsigned u[4]; bf16x8 v; } pk;
#pragma unroll
                for (int j = 0; j < 4; ++j) { const int rg = (ks & 1) * 8 + 2 * j; pk.u[j] = (ks < 2) ? pack2(s0[rg], s0[rg + 1]) : pack2(s1[rg], s1[rg + 1]); }
                pf = pk.v;
            }
#pragma unroll
            for (int ds = 0; ds < 2; ++ds) {
                const bf16_t* vp = Vc + (16 * ks + 4 * hi + q4) * LDT + 32 * ds + 16 * blk + 4 * p4;
                const s16x4 lo = __builtin_bit_cast(s16x4, __builtin_amdgcn_ds_read_tr16_b64_v4i16((__attribute__((address_space(3))) s16x4*)(vp)));
                const s16x4 hh = __builtin_bit_cast(s16x4, __builtin_amdgcn_ds_read_tr16_b64_v4i16((__attribute__((address_space(3))) s16x4*)(vp + 8 * LDT)));
                const bf16x8 vf = (bf16x8){lo[0], lo[1], lo[2], lo[3], hh[0], hh[1], hh[2], hh[3]};
                if (ds == 0) o0 = __builtin_amdgcn_mfma_f32_32x32x16_bf16(vf, pf, o0, 0, 0, 0);
                else o1 = __builtin_amdgcn_mfma_f32_32x32x16_bf16(vf, pf, o1, 0, 0, 0);
            }
        }
        if (more) { bf16_t* Kn = Ks + ((t + 1) & 1) * 64 * LDT; bf16_t* Vn = Vs + ((t + 1) & 1) * 64 * LDT; *(u32x4*)(Kn + lrow * LDT + lc) = rk; *(u32x4*)(Vn + lrow * LDT + lc) = rv; }
        __syncthreads();
    }
    l_run += __shfl_xor(l_run, 32);
    const float inv = 1.f / l_run;
    bf16_t* op = a.O + (size_t)(a.qrow0 + qoff) * DM + head * 64;
#pragma unroll
    for (int g4 = 0; g4 < 4; ++g4) {
        uint2 q; q.x = pack2(o0[4 * g4] * inv, o0[4 * g4 + 1] * inv); q.y = pack2(o0[4 * g4 + 2] * inv, o0[4 * g4 + 3] * inv);
        *(uint2*)(op + 8 * g4 + 4 * hi) = q;
        q.x = pack2(o1[4 * g4] * inv, o1[4 * g4 + 1] * inv); q.y = pack2(o1[4 * g4 + 2] * inv, o1[4 * g4 + 3] * inv);
        *(uint2*)(op + 32 + 8 * g4 + 4 * hi) = q;
    }
}
DI int attn_units(int l) { return l == 0 ? 544 : 512; }
DI void attn_dispatch(const Params& p, int l, int u, char* smem) {
    AttnArgs a;
    const bf16_t* proj = (const bf16_t*)(p.ws + OFF_RA);
    bf16_t* mix = (bf16_t*)(p.ws + OFF_RB);
    int type, b, g, tb;
    if (u < 512) { type = u >> 8; const int v = u & 255; b = v >> 6; g = (v >> 5) & 1; tb = v & 31; }
    else { const int v = u - 512; type = 2 + (v >> 4); b = (v >> 2) & 3; g = (v >> 1) & 1; tb = v & 1; }
    const bool isA = (type & 1);
    a.Q = (const bf16_t*)(p.ws + (isA ? OFF_QA : OFF_QD)); a.K = (const bf16_t*)(p.ws + (isA ? OFF_KA : OFF_KD)); a.V = proj + (isA ? CA_V : CD_V);
    a.g = g; a.sink = isA ? p.in[I_ASINK] + l * 4 : nullptr; a.O = mix + (isA ? 0 : 768);
    a.k0row = b * CTXL; a.k0tiles = 4; a.k1row = NCTX + b * SEQ; a.qpos0 = -1;
    if (type < 2) {
        a.qrow0 = NCTX + b * SEQ + tb * 128;
        if (isA) { a.qpos0 = tb * 128; int t0 = 2 * tb - 2, t1 = 2 * tb + 4; a.k1t0 = t0 < 0 ? 0 : t0; a.k1t1 = t1 > 64 ? 64 : t1; }
        else { a.k1t0 = 0; a.k1t1 = 64; }
    } else { a.qrow0 = b * CTXL + tb * 128; a.k1t0 = 0; a.k1t1 = 0; }
    attn_unit(a, smem);
}

DI int blk_row0(int b, int cb) { return cb < 2 ? b * CTXL + cb * 128 : NCTX + b * SEQ + (cb - 2) * 128; }
DI int bwd_seq(int cb) { return cb < 2 ? 1 - cb : 35 - cb; }
constexpr int SSD_LDS = (128 * 64 + 2 * 128 * 65 + 64 * 129 + 6 * 128) * 4;
DI int ssd_chunk_units() { return NB * NCHK * 4; }
DI void ssd_chunk_unit(const Params& p, int l, int u, char* smem) {
    const int tid = threadIdx.x;
    const int h = u & 3, cb = (u >> 2) % NCHK, b = (u >> 2) / NCHK, grp = h >> 1;
    const int row0 = blk_row0(b, cb);
    const int part0 = cb < 2 ? b * CTXL : NCTX + b * SEQ, partN = cb < 2 ? CTXL : SEQ;
    float* xs = (float*)smem;
    float* Bs = xs + 128 * 64;
    float* Cs = Bs + 128 * 65;
    float* Ws = Cs + 128 * 65;
    float* dtf = Ws + 64 * 129;
    float* dtb = dtf + 128; float* Af = dtb + 128; float* Ab = Af + 128; float* wef = Ab + 128; float* web = wef + 128;
    const bf16_t* proj = (const bf16_t*)(p.ws + OFF_RA);
    const float* cw = p.in[I_SSDCW] + l * 4 * 512; const float* cbias = p.in[I_SSDCB] + l * 512;
    const float aneg_f = -__expf(p.in[I_SSDALOG][l * 8 + h]), aneg_b = -__expf(p.in[I_SSDALOG][l * 8 + 4 + h]);
    for (int idx = tid; idx < 128 * 192; idx += NTHR) {
        const int i = idx / 192, cc = idx % 192;
        const int which = cc >> 6, c64 = cc & 63;
        const int ch = which == 0 ? h * 64 + c64 : (which == 1 ? 256 + grp * 64 + c64 : 384 + grp * 64 + c64);
        const int col = CB_X + ch;
        float acc = cbias[ch];
#pragma unroll
        for (int j = 0; j < 4; ++j) { const int rr = row0 + i + j - 2; if (rr >= part0 && rr < part0 + partN) acc += cw[j * 512 + ch] * bf2f(proj[(size_t)rr * INPP + col]); }
        const float v = silu_(acc);
        if (which == 0) xs[i * 64 + c64] = v; else if (which == 1) Bs[i * 65 + c64] = v; else Cs[i * 65 + c64] = v;
    }
    if (tid < 256) { const int i = tid & 127, d = tid >> 7;
        const float raw = bf2f(proj[(size_t)(row0 + i) * INPP + (d ? CB_DTB : CB_DTF) + h]);
        const float v = softplus_(raw + p.in[I_SSDDTB][l * 8 + d * 4 + h]);
        (d ? dtb : dtf)[i] = v; }
    __syncthreads();
    if (tid == 0) { float s = 0.f; for (int i = 0; i < 128; ++i) { s += dtf[i] * aneg_f; Af[i] = s; } }
    if (tid == 64) { float s = 0.f; for (int i = 127; i >= 0; --i) { s += dtb[i] * aneg_b; Ab[i] = s; } }
    __syncthreads();
    if (tid < 128) { wef[tid] = __expf(Af[127] - Af[tid]) * dtf[tid]; web[tid] = __expf(Ab[0] - Ab[tid]) * dtb[tid]; }
    if ((h & 1) == 0) { float* CC = (float*)(p.ws + OFF_CC);
        for (int idx = tid; idx < 128 * 64; idx += NTHR) { const int i = idx >> 6, n = idx & 63; CC[(size_t)(row0 + i) * 128 + grp * 64 + n] = Cs[i * 65 + n]; } }
    if (tid < 128) { float* EA = (float*)(p.ws + OFF_EA) + (size_t)(row0 + tid) * 8; EA[h] = __expf(Af[tid]); EA[4 + h] = __expf(Ab[tid]); }
    __syncthreads();
    {
        const int d = tid >> 8, pg = (tid >> 4) & 15, ng = tid & 15;
        const float* we = d ? web : wef;
        float acc[4][4];
#pragma unroll
        for (int a = 0; a < 4; ++a)
#pragma unroll
            for (int c = 0; c < 4; ++c) acc[a][c] = 0.f;
#pragma unroll 2
        for (int j = 0; j < 128; ++j) {
            const float wj = we[j];
            const f32x4 xv = *(const f32x4*)(xs + j * 64 + 4 * pg);
            float bv[4];
#pragma unroll
            for (int c = 0; c < 4; ++c) bv[c] = Bs[j * 65 + 4 * ng + c];
#pragma unroll
            for (int a = 0; a < 4; ++a) { const float xw = xv[a] * wj;
#pragma unroll
                for (int c = 0; c < 4; ++c) acc[a][c] += xw * bv[c]; }
        }
        const int s = d ? bwd_seq(cb) : cb;
        float* ST = (float*)(p.ws + OFF_SSDST) + ((size_t)((b * 4 + h) * 2 + d) * NCHK + s) * 4096;
#pragma unroll
        for (int a = 0; a < 4; ++a) *(f32x4*)(ST + (4 * pg + a) * 64 + 4 * ng) = (f32x4){acc[a][0], acc[a][1], acc[a][2], acc[a][3]};
        if ((tid & 255) == 0) ((float*)(p.ws + OFF_SSDDEC))[((b * 4 + h) * 2 + d) * NCHK + s] = d ? __expf(Ab[0]) : __expf(Af[127]);
    }
    const float dsk = p.in[I_SSDD][l * 4 + h];
    float* YP = (float*)(p.ws + OFF_YPART);
#pragma unroll 1
    for (int hb = 0; hb < 2; ++hb) {
        __syncthreads();
        {
            const int ig = tid >> 5, jg = tid & 31;
            float acc[4][4];
#pragma unroll
            for (int a = 0; a < 4; ++a)
#pragma unroll
                for (int c = 0; c < 4; ++c) acc[a][c] = 0.f;
#pragma unroll 4
            for (int n = 0; n < 64; ++n) {
                float cv[4], bv[4];
#pragma unroll
                for (int a = 0; a < 4; ++a) cv[a] = Cs[(64 * hb + ig + 16 * a) * 65 + n];
#pragma unroll
                for (int c = 0; c < 4; ++c) bv[c] = Bs[(jg + 32 * c) * 65 + n];
#pragma unroll
                for (int a = 0; a < 4; ++a)
#pragma unroll
                    for (int c = 0; c < 4; ++c) acc[a][c] += cv[a] * bv[c];
            }
#pragma unroll
            for (int a = 0; a < 4; ++a)
#pragma unroll
                for (int c = 0; c < 4; ++c) { const int il = ig + 16 * a, i = 64 * hb + il, j = jg + 32 * c;
                    float wgt = 0.f;
                    if (j <= i) wgt += __expf(Af[i] - Af[j]) * dtf[j];
                    if (j >= i) wgt += __expf(Ab[i] - Ab[j]) * dtb[j];
                    Ws[il * 129 + j] = acc[a][c] * wgt; }
        }
        __syncthreads();
        {
            const int ig = tid >> 4, pg = tid & 15;
            float acc[2][4];
#pragma unroll
            for (int a = 0; a < 2; ++a)
#pragma unroll
                for (int c = 0; c < 4; ++c) acc[a][c] = 0.f;
#pragma unroll 4
            for (int j = 0; j < 128; ++j) {
                const f32x4 xv = *(const f32x4*)(xs + j * 64 + 4 * pg);
                const float w0 = Ws[ig * 129 + j], w1 = Ws[(ig + 32) * 129 + j];
#pragma unroll
                for (int c = 0; c < 4; ++c) { acc[0][c] += w0 * xv[c]; acc[1][c] += w1 * xv[c]; }
            }
#pragma unroll
            for (int a = 0; a < 2; ++a) { const int i = 64 * hb + ig + 32 * a;
                const f32x4 xv = *(const f32x4*)(xs + i * 64 + 4 * pg);
                *(f32x4*)(YP + (size_t)(row0 + i) * 256 + h * 64 + 4 * pg) = (f32x4){acc[a][0] + dsk * xv[0], acc[a][1] + dsk * xv[1], acc[a][2] + dsk * xv[2], acc[a][3] + dsk * xv[3]}; }
        }
    }
    __syncthreads();
}
constexpr int SSDF_LDS = (2 * 64 * 65 + 128 * 65 + 128) * 4 + 128 * 256 * 2;
DI int ssd_fin_units(int l) { return NB * (l == 0 ? NCHK : NCHK - 2); }
DI void ssd_fin_unit(const Params& p, int l, int u, char* smem) {
    const int tid = threadIdx.x;
    const int nper = l == 0 ? NCHK : NCHK - 2;
    const int b = u / nper, cb = u % nper + (l == 0 ? 0 : 2);
    const int row0 = blk_row0(b, cb);
    float* stf = (float*)smem;
    float* stb = stf + 64 * 65;
    float* Cc = stb + 64 * 65;
    float* ssq = Cc + 128 * 65;
    bf16_t* ybuf = (bf16_t*)(ssq + 128);
    const bf16_t* proj = (const bf16_t*)(p.ws + OFF_RA);
    if (tid < 128) ssq[tid] = 0.f;
#pragma unroll 1
    for (int h = 0; h < 4; ++h) {
        __syncthreads();
        {
            const int d = tid >> 8, e = tid & 255;
            const int s = d ? bwd_seq(cb) : cb;
            const float* ST = (const float*)(p.ws + OFF_SSDST) + (size_t)((b * 4 + h) * 2 + d) * NCHK * 4096;
            const float* DEC = (const float*)(p.ws + OFF_SSDDEC) + ((b * 4 + h) * 2 + d) * NCHK;
            float st[16];
#pragma unroll
            for (int k = 0; k < 16; ++k) st[k] = 0.f;
#pragma unroll 1
            for (int sp = 0; sp < s; ++sp) { const float dc = DEC[sp];
#pragma unroll
                for (int k = 0; k < 16; ++k) st[k] = st[k] * dc + ST[(size_t)sp * 4096 + e + 256 * k]; }
            float* dst = d ? stb : stf;
#pragma unroll
            for (int k = 0; k < 16; ++k) { const int idx = e + 256 * k; dst[(idx >> 6) * 65 + (idx & 63)] = st[k]; }
        }
        if ((h & 1) == 0) { const float* CC = (const float*)(p.ws + OFF_CC);
            for (int idx = tid; idx < 128 * 64; idx += NTHR) { const int i = idx >> 6, n = idx & 63; Cc[i * 65 + n] = CC[(size_t)(row0 + i) * 128 + (h >> 1) * 64 + n]; } }
        __syncthreads();
        {
            const int ig = tid >> 4, pg = tid & 15;
            float af[4][4], ab[4][4];
#pragma unroll
            for (int a = 0; a < 4; ++a)
#pragma unroll
                for (int c = 0; c < 4; ++c) { af[a][c] = 0.f; ab[a][c] = 0.f; }
#pragma unroll 4
            for (int n = 0; n < 64; ++n) {
                float cv[4], sf[4], sb[4];
#pragma unroll
                for (int a = 0; a < 4; ++a) cv[a] = Cc[(ig + 32 * a) * 65 + n];
#pragma unroll
                for (int c = 0; c < 4; ++c) { sf[c] = stf[(pg + 16 * c) * 65 + n]; sb[c] = stb[(pg + 16 * c) * 65 + n]; }
#pragma unroll
                for (int a = 0; a < 4; ++a)
#pragma unroll
                    for (int c = 0; c < 4; ++c) { af[a][c] += cv[a] * sf[c]; ab[a][c] += cv[a] * sb[c]; }
            }
            const float* YP = (const float*)(p.ws + OFF_YPART);
            const float* EA = (const float*)(p.ws + OFF_EA);
#pragma unroll
            for (int a = 0; a < 4; ++a) { const int i = ig + 32 * a, r = row0 + i;
                const float ef = EA[(size_t)r * 8 + h], eb = EA[(size_t)r * 8 + 4 + h];
                float sq = 0.f;
#pragma unroll
                for (int c = 0; c < 4; ++c) { const int pp = pg + 16 * c;
                    const float y = YP[(size_t)r * 256 + h * 64 + pp] + ef * af[a][c] + eb * ab[a][c];
                    const float z = bf2f(proj[(size_t)r * INPP + CB_Z + h * 64 + pp]);
                    const float yg = y * silu_(z);
                    ybuf[i * 256 + h * 64 + pp] = f2bf(yg); sq += yg * yg; }
                sq += __shfl_xor(sq, 1); sq += __shfl_xor(sq, 2); sq += __shfl_xor(sq, 4); sq += __shfl_xor(sq, 8);
                if (pg == 0) ssq[i] += sq; }
        }
    }
    __syncthreads();
    {
        const float* gn = p.in[I_SSDNORM] + l * 256;
        bf16_t* mix = (bf16_t*)(p.ws + OFF_RB);
        for (int idx = tid; idx < 128 * 128; idx += NTHR) { const int i = idx >> 7, c2 = (idx & 127) * 2;
            const float rs = rsqrtf(ssq[i] * (1.f / 256.f) + EPS);
            const float a = bf2f(ybuf[i * 256 + c2]) * rs * gn[c2], bb = bf2f(ybuf[i * 256 + c2 + 1]) * rs * gn[c2 + 1];
            *(unsigned*)(mix + (size_t)(row0 + i) * DM + 256 + c2) = pack2(a, bb); }
    }
    __syncthreads();
}

constexpr int LRU_LDS = (128 * 65 + 4 * 64 * 64 + 2 * 8 * 64 * 2) * 4;
DI int lru_chunk_units() { return NB * NCHK * 4; }
DI void lru_chunk_unit(const Params& p, int l, int u, char* smem) {
    const int tid = threadIdx.x;
    const int kb = u & 3, cb = (u >> 2) % NCHK, b = (u >> 2) / NCHK;
    const int row0 = blk_row0(b, cb);
    const int part0 = cb < 2 ? b * CTXL : NCTX + b * SEQ, partN = cb < 2 ? CTXL : SEQ;
    float* us = (float*)smem;
    float* Wl = us + 128 * 65;
    float* segA = Wl + 4 * 64 * 64;
    float* segH = segA + 8 * 64;
    const bf16_t* proj = (const bf16_t*)(p.ws + OFF_RA);
    const float* cw = p.in[I_LRUCW] + l * 4 * 256; const float* cbias = p.in[I_LRUCB] + l * 256;
    for (int idx = tid; idx < 128 * 64; idx += NTHR) { const int i = idx >> 6, c = idx & 63, ch = kb * 64 + c;
        float acc = cbias[ch];
#pragma unroll
        for (int j = 0; j < 4; ++j) { const int rr = row0 + i + j - 2; if (rr >= part0 && rr < part0 + partN) acc += cw[j * 256 + ch] * bf2f(proj[(size_t)rr * INPP + CC_X + ch]); }
        us[i * 65 + c] = acc; }
    for (int idx = tid; idx < 4 * 4096; idx += NTHR) { const int g = idx >> 12, e = idx & 4095, d = g >> 1;
        const float* src = p.in[(g & 1) ? I_LRUWI : I_LRUWA] + ((size_t)((l * 2 + d) * 4 + kb)) * 4096;
        Wl[idx] = src[e]; }
    __syncthreads();
    const int tg = tid >> 4, cg = tid & 15;
    float acc[4][4][4];
#pragma unroll
    for (int g = 0; g < 4; ++g)
#pragma unroll
        for (int a = 0; a < 4; ++a)
#pragma unroll
            for (int c = 0; c < 4; ++c) acc[g][a][c] = 0.f;
#pragma unroll 2
    for (int i = 0; i < 64; ++i) {
        float uv[4];
#pragma unroll
        for (int a = 0; a < 4; ++a) uv[a] = us[(4 * tg + a) * 65 + i];
#pragma unroll
        for (int g = 0; g < 4; ++g) { const f32x4 wv = *(const f32x4*)(Wl + g * 4096 + i * 64 + 4 * cg);
#pragma unroll
            for (int a = 0; a < 4; ++a)
#pragma unroll
                for (int c = 0; c < 4; ++c) acc[g][a][c] += uv[a] * wv[c]; }
    }
    __syncthreads();
    float* aL = Wl; float* xL = Wl + 128 * 64;
    bf16_t* HB = (bf16_t*)(p.ws + OFF_LRUH);
    float* LC = (float*)(p.ws + OFF_LRUC);
#pragma unroll
    for (int d = 0; d < 2; ++d) {
#pragma unroll
        for (int c = 0; c < 4; ++c) { const int ch = kb * 64 + 4 * cg + c;
            const float ba = p.in[I_LRUBA][(l * 2 + d) * 256 + ch], bi = p.in[I_LRUBI][(l * 2 + d) * 256 + ch];
            const float spl = softplus_(-p.in[I_LRULAM][(l * 2 + d) * 256 + ch]);
#pragma unroll
            for (int a = 0; a < 4; ++a) { const int i = 4 * tg + a;
                const float rg = sigmoid_(acc[2 * d][a][c] + ba), ig = sigmoid_(acc[2 * d + 1][a][c] + bi);
                const float la = -8.f * rg * spl;
                const float av = __expf(la);
                const float mult = sqrtf(fmaxf(0.f, -expm1f(2.f * la)));
                aL[i * 64 + 4 * cg + c] = av; xL[i * 64 + 4 * cg + c] = mult * ig * us[i * 65 + 4 * cg + c]; }
        }
        __syncthreads();
        const int ch = tid & 63, sg = tid >> 6;
        float hacc = 0.f, pacc = 1.f;
#pragma unroll 1
        for (int t = 0; t < 16; ++t) { const int tau = sg * 16 + t, i = d ? 127 - tau : tau;
            const float av = aL[i * 64 + ch]; hacc = av * hacc + xL[i * 64 + ch]; pacc *= av; xL[i * 64 + ch] = hacc; aL[i * 64 + ch] = pacc; }
        segA[sg * 64 + ch] = pacc; segH[sg * 64 + ch] = hacc;
        __syncthreads();
        float carry = 0.f, cp = 1.f;
        for (int s2 = 0; s2 < sg; ++s2) { carry = carry * segA[s2 * 64 + ch] + segH[s2 * 64 + ch]; cp *= segA[s2 * 64 + ch]; }
        bf16_t* Hh = HB + (size_t)(2 * d) * NTOK * 256; bf16_t* Hp = HB + (size_t)(2 * d + 1) * NTOK * 256;
        float hl = 0.f, pl = 1.f;
#pragma unroll 1
        for (int t = 0; t < 16; ++t) { const int tau = sg * 16 + t, i = d ? 127 - tau : tau;
            hl = xL[i * 64 + ch] + aL[i * 64 + ch] * carry; pl = aL[i * 64 + ch] * cp;
            Hh[(size_t)(row0 + i) * 256 + kb * 64 + ch] = f2bf(hl); Hp[(size_t)(row0 + i) * 256 + kb * 64 + ch] = f2bf(pl); }
        if (sg == 7) { const int s = d ? bwd_seq(cb) : cb; const size_t o = ((size_t)(b * 2 + d) * NCHK + s) * 256 + kb * 64 + ch;
            LC[o] = hl; LC[(size_t)NB * 2 * NCHK * 256 + o] = pl; }
        __syncthreads();
    }
}
DI int lru_fin_units(int l) { return NB * (l == 0 ? NCHK : NCHK - 2); }
DI void lru_fin_unit(const Params& p, int l, int u, char* smem) {
    const int tid = threadIdx.x;
    const int nper = l == 0 ? NCHK : NCHK - 2;
    const int b = u / nper, cb = u % nper + (l == 0 ? 0 : 2);
    const int row0 = blk_row0(b, cb);
    float* car = (float*)smem;
    { const int d = tid >> 8, ch = tid & 255, s = d ? bwd_seq(cb) : cb;
      const float* LH = (const float*)(p.ws + OFF_LRUC) + (size_t)(b * 2 + d) * NCHK * 256 + ch; const float* LA = LH + (size_t)NB * 2 * NCHK * 256;
      float c = 0.f;
      for (int sp = 0; sp < s; ++sp) c = c * LA[sp * 256] + LH[sp * 256];
      car[tid] = c; }
    __syncthreads();
    const bf16_t* HB = (const bf16_t*)(p.ws + OFF_LRUH);
    const bf16_t* proj = (const bf16_t*)(p.ws + OFF_RA);
    bf16_t* mix = (bf16_t*)(p.ws + OFF_RB);
    for (int idx = tid; idx < 128 * 128; idx += NTHR) { const int i = idx >> 7, c2 = (idx & 127) * 2; const size_t o = (size_t)(row0 + i) * 256 + c2;
        float out[2];
#pragma unroll
        for (int q = 0; q < 2; ++q) {
            const float hf = bf2f(HB[o + q]), pf = bf2f(HB[(size_t)NTOK * 256 + o + q]), hb = bf2f(HB[(size_t)2 * NTOK * 256 + o + q]), pb = bf2f(HB[(size_t)3 * NTOK * 256 + o + q]);
            const float g = bf2f(proj[(size_t)(row0 + i) * INPP + CC_G + c2 + q]);
            out[q] = (hf + pf * car[c2 + q] + hb + pb * car[256 + c2 + q]) * gelu_tanh_(g); }
        *(unsigned*)(mix + (size_t)(row0 + i) * DM + 512 + c2) = pack2(out[0], out[1]); }
    __syncthreads();
}

enum { PH_PRO = 0, PH_CONVEXP, PH_PRE0, PH_INPROJ, PH_PREP, PH_MIX, PH_OUTPROJ, PH_POST1, PH_MOE1, PH_MOE2, PH_POST2, PH_POST3 };
constexpr int MAX_LDS = 140 * 1024;

template <int PH>
DI void run_phase(const Params& p, int l, int hf, char* smem) {
    const int G = gridDim.x, B = blockIdx.x;
    if (PH == PH_PRO) {
        const int n0 = MOD_UNITS, n1 = n0 + ROPE_UNITS, n2 = n1 + 2 * CONV_UNITS_SMALL, n3 = n2 + CONV_UNITS_EXP;
        for (int u = B; u < n3; u += G) {
            if (u < n0) mod_unit(p, u, smem);
            else if (u < n1) rope_unit(p, u - n0);
            else if (u < n2) { const int v = u - n1; convert_small_unit(p, v / CONV_UNITS_SMALL, v % CONV_UNITS_SMALL, smem); }
            else convert_exp_unit(p, 0, u - n2, smem);
        }
    } else if (PH == PH_CONVEXP) {
        for (int u = B; u < CONV_UNITS_EXP; u += G) convert_exp_unit(p, l, u, smem);
    } else if (PH == PH_PRE0) {
        for (int u = B; u < NTOK / 16; u += G) rowpost_unit<0>(p, 0, 0, u * 16, smem);
    } else if (PH == PH_INPROJ) {
        for (int u = B; u < INPROJ_UNITS; u += G) inproj_unit(p, l, u, smem);
    } else if (PH == PH_PREP) {
        const int n0 = ssd_chunk_units(), n1 = n0 + lru_chunk_units(), n2 = n1 + PREP_UNITS;
        for (int u = B; u < n2; u += G) {
            if (u < n0) ssd_chunk_unit(p, l, u, smem);
            else if (u < n1) lru_chunk_unit(p, l, u - n0, smem);
            else prep_unit(p, l, u - n1);
        }
    } else if (PH == PH_MIX) {
        const int n0 = attn_units(l), n1 = n0 + ssd_fin_units(l), n2 = n1 + lru_fin_units(l);
        for (int u = B; u < n2; u += G) {
            if (u < n0) attn_dispatch(p, l, u, smem);
            else if (u < n1) ssd_fin_unit(p, l, u - n0, smem);
            else lru_fin_unit(p, l, u - n1, smem);
        }
    } else if (PH == PH_OUTPROJ) {
        const int n = outproj_units(l);
        for (int u = B; u < n; u += G) outproj_unit(p, l, u, smem);
    } else if (PH == PH_POST1) {
        const int lo = l == 0 ? 0 : NCTX;
        for (int u = B; u < (NTOK - lo) / 16; u += G) rowpost_unit<1>(p, l, 0, lo + u * 16, smem);
    } else if (PH == PH_MOE1 || PH == PH_MOE2) {
        MoeTab* tb = (MoeTab*)(smem + GEMM_LDS);
        moe_table(p, l, hf, tb);
        const int n = tb->mstart[65] * (PH == PH_MOE1 ? 4 : 8);
        for (int u = B; u < n; u += G) { if (PH == PH_MOE1) moe1_unit(p, l, hf, tb, u, smem); else moe2_unit(p, l, hf, tb, u, smem); }
    } else if (PH == PH_POST2 || PH == PH_POST3) {
        const int lo = half_lo(l, hf), n = (half_hi(l, hf) - lo) / 16;
        for (int u = B; u < n; u += G) { if (PH == PH_POST2) rowpost_unit<2>(p, l, hf, lo + u * 16, smem); else rowpost_unit<3>(p, l, hf, lo + u * 16, smem); }
    }
}
template <int PH>
__global__ void __launch_bounds__(NTHR, 2) k_phase(Params p, int l, int hf) {
    extern __shared__ __attribute__((aligned(16))) char smem[];
    run_phase<PH>(p, l, hf, smem);
}
template <int PH>
static void launch_phase(const Params& p, int l, int hf, int grid, hipStream_t st) {
    static bool inited = false;
    if (!inited) { hipFuncSetAttribute((const void*)k_phase<PH>, hipFuncAttributeMaxDynamicSharedMemorySize, MAX_LDS); inited = true; }
    k_phase<PH><<<grid, NTHR, MAX_LDS, st>>>(p, l, hf);
}

extern "C" void kernel_launch(void* const* d_in, const int* in_sizes, int n_in, void* d_out, int out_size, void* d_ws, size_t ws_size, hipStream_t stream) {
    if (ws_size < WS_NEED || n_in < 36) return;
    Params p{};
    for (int i = 0; i < 36; ++i) p.in[i] = (const float*)d_in[i];
    p.out = (float*)d_out; p.ws = (char*)d_ws;
    const int G = 256;
    hipMemsetAsync(d_ws, 0, ZERO_BYTES, stream);
    launch_phase<PH_PRO>(p, 0, 0, G, stream);
    launch_phase<PH_PRE0>(p, 0, 0, G, stream);
    for (int l = 0; l < 2; ++l) {
        if (l == 1) launch_phase<PH_CONVEXP>(p, 1, 0, G, stream);
        launch_phase<PH_INPROJ>(p, l, 0, G, stream);
        launch_phase<PH_PREP>(p, l, 0, G, stream);
        launch_phase<PH_MIX>(p, l, 0, G, stream);
        launch_phase<PH_OUTPROJ>(p, l, 0, G, stream);
        launch_phase<PH_POST1>(p, l, 0, G, stream);
        for (int hf = 0; hf < 2; ++hf) {
            launch_phase<PH_MOE1>(p, l, hf, G, stream);
            launch_phase<PH_MOE2>(p, l, hf, G, stream);
            if (l == 0) launch_phase<PH_POST2>(p, l, hf, G, stream); else launch_phase<PH_POST3>(p, l, hf, G, stream);
        }
    }
}
```

```cpp
#include <hip/hip_runtime.h>
#include <stdint.h>

#define DI __device__ __forceinline__
typedef unsigned short bf16_t;
typedef short bf16x8 __attribute__((ext_vector_type(8)));
typedef short s16x4 __attribute__((ext_vector_type(4)));
typedef float f32x4 __attribute__((ext_vector_type(4)));
typedef float f32x16 __attribute__((ext_vector_type(16)));
typedef unsigned u32x4 __attribute__((ext_vector_type(4)));

constexpr int NTHR = 512;
constexpr int DM = 1024, NB = 4, SEQ = 4096, CTXL = 256;
constexpr int NCTX = NB * CTXL, NLAT = NB * SEQ, NTOK = NCTX + NLAT;
constexpr int INP = 2312, INPP = 2432;
constexpr int CA_Q = 0, CA_K = 256, CA_V = 384, CB_Z = 512, CB_X = 768, CB_B = 1024, CB_C = 1152, CB_DTF = 1280, CB_DTB = 1284,
              CC_X = 1288, CC_G = 1544, CD_Q = 1800, CD_K = 2056, CD_V = 2184;
constexpr int NCHK = 34;
constexpr int HCAP = 8704;
constexpr float EPS = 1e-6f;

constexpr size_t MB = 1024 * 1024;
constexpr size_t OFF_BAR = 0;
constexpr size_t OFF_CNT = 16 * 1024;
constexpr size_t OFF_MOD = 32 * 1024;
constexpr size_t ZERO_BYTES = 32 * 1024 + 2 * 5 * 6144 * 4;
constexpr size_t OFF_ROPE = 512 * 1024;
constexpr size_t OFF_SLOT_TOK = 2 * MB;
constexpr size_t OFF_SLOT_W = 7 * MB;
constexpr size_t OFF_TOKSLOT = 12 * MB;
constexpr size_t OFF_LRUC = 13 * MB;
constexpr size_t OFF_SSDDEC = 14 * MB;
constexpr size_t OFF_XCTX = 15 * MB;
constexpr size_t OFF_WIN = 20 * MB;
constexpr size_t SZ_WIN1 = (size_t)INPP * DM * 2;
constexpr size_t OFF_WOUT = OFF_WIN + 2 * SZ_WIN1;
constexpr size_t SZ_WOUT1 = (size_t)DM * DM * 2;
constexpr size_t OFF_WGU = 36 * MB;
constexpr size_t OFF_WD = OFF_WGU + (size_t)65 * 512 * 1024 * 2;
constexpr size_t OFF_Y = 140 * MB;
constexpr size_t OFF_RA = 210 * MB;
constexpr size_t OFF_HID = OFF_RA + (size_t)NTOK * DM * 2;
constexpr size_t OFF_RB = 292 * MB;
constexpr size_t OFF_RC = 328 * MB;
constexpr size_t OFF_QA = OFF_RC;
constexpr size_t OFF_KA = OFF_QA + (size_t)NTOK * 256 * 2;
constexpr size_t OFF_QD = OFF_KA + (size_t)NTOK * 128 * 2;
constexpr size_t OFF_KD = OFF_QD + (size_t)NTOK * 256 * 2;
constexpr size_t OFF_SSDST = OFF_KD + (size_t)NTOK * 128 * 2;
constexpr size_t OFF_YPART = OFF_SSDST + (size_t)4 * 4 * 2 * 34 * 4096 * 4;
constexpr size_t OFF_CC = OFF_YPART + (size_t)NTOK * 256 * 4;
constexpr size_t OFF_EA = OFF_CC + (size_t)NTOK * 128 * 4;
constexpr size_t OFF_LRUH = OFF_EA + (size_t)NTOK * 8 * 4;
constexpr size_t OFF_YE = OFF_RC;
constexpr size_t WS_NEED = OFF_RC + (size_t)8 * HCAP * 1024 * 2 + MB;

struct Params {
    const float* in[36];
    float* out;
    char* ws;
};
enum { I_X = 0, I_C, I_CTX, I_CCTX, I_WADA, I_BADA, I_GMIXPRE, I_GMIXPOST, I_GFFNPRE, I_GFFNPOST, I_WIN, I_WOUT, I_ASINK, I_SSDCW, I_SSDCB, I_SSDDTB, I_SSDALOG,
       I_SSDD, I_SSDNORM, I_LRUCW, I_LRUCB, I_LRUWA, I_LRUBA, I_LRUWI, I_LRUBI, I_LRULAM, I_DQN, I_DKN, I_RW, I_RB, I_EG, I_EU, I_ED, I_SG, I_SU, I_SD };

DI int tidx() { int t = threadIdx.x; asm volatile("" : "+v"(t)); return t; }
DI float bf2f(bf16_t v) { return __uint_as_float(((unsigned)v) << 16); }
DI bf16_t f2bf(float f) { unsigned u = __float_as_uint(f); u += 0x7fffu + ((u >> 16) & 1u); return (bf16_t)(u >> 16); }
DI unsigned pack2(float lo, float hi) { return (unsigned)f2bf(lo) | ((unsigned)f2bf(hi) << 16); }
DI float wave_sum(float v) {
#pragma unroll
    for (int o = 32; o > 0; o >>= 1) v += __shfl_xor(v, o);
    return v;
}
DI float sigmoid_(float x) { return 1.f / (1.f + __expf(-x)); }
DI float silu_(float x) { return x / (1.f + __expf(-x)); }
DI float softplus_(float x) { return x > 20.f ? x : log1pf(__expf(x)); }
DI float gelu_tanh_(float x) { const float u = 0.7978845608028654f * (x + 0.044715f * x * x * x); return 0.5f * x * (1.f + tanhf(u)); }
DI int crow(int reg, int h) { return (reg & 3) + 8 * (reg >> 2) + 4 * h; }

DI const float* xrow_c(const Params& p, int r) { return r < NCTX ? (const float*)(p.ws + OFF_XCTX) + (size_t)r * DM : p.out + (size_t)(r - NCTX) * DM; }
DI float* xrow(const Params& p, int r) { return r < NCTX ? (float*)(p.ws + OFF_XCTX) + (size_t)r * DM : p.out + (size_t)(r - NCTX) * DM; }
DI const float* xin_row(const Params& p, int r) { return r < NCTX ? p.in[I_CTX] + (size_t)r * DM : p.in[I_X] + (size_t)(r - NCTX) * DM; }
DI int mod_idx(int r) { return r < NCTX ? 4 : ((r - NCTX) >> 12); }
DI const float* modp(const Params& p, int l, int bidx, int k) { return (const float*)(p.ws + OFF_MOD) + ((size_t)(l * 5 + bidx) * 6 + k) * DM; }
DI int half_lo(int l, int hf) { return hf == 0 ? (l == 0 ? 0 : NCTX) : (l == 0 ? 8704 : 9216); }
DI int half_hi(int l, int hf) { return hf == 0 ? (l == 0 ? 8704 : 9216) : NTOK; }

DI void transpose_tile(const float* __restrict__ src, int ld, int N, int k0, int n0, bf16_t* __restrict__ dst, int ldd, int mode, float* tile) {
    const int t = tidx();
    {
        const int col = t & 63, r8 = t >> 6;
#pragma unroll
        for (int i = 0; i < 8; ++i) { const int row = r8 + 8 * i; tile[row * 65 + col] = (n0 + col < N) ? src[(size_t)(k0 + row) * ld + n0 + col] : 0.f; }
    }
    __syncthreads();
    {
        const int n = t >> 3, kc = (t & 7) * 8;
        uint4 v;
        v.x = pack2(tile[(kc + 0) * 65 + n], tile[(kc + 1) * 65 + n]); v.y = pack2(tile[(kc + 2) * 65 + n], tile[(kc + 3) * 65 + n]);
        v.z = pack2(tile[(kc + 4) * 65 + n], tile[(kc + 5) * 65 + n]); v.w = pack2(tile[(kc + 6) * 65 + n], tile[(kc + 7) * 65 + n]);
        const int nn = n0 + n;
        int R = nn;
        if (mode) R = 128 * (nn >> 6) + 64 * ((nn >> 5) & 1) + (nn & 31) + (mode == 2 ? 32 : 0);
        *(uint4*)(dst + (size_t)R * ldd + k0 + kc) = v;
    }
    __syncthreads();
}
constexpr int CONV_UNITS_SMALL = 608 + 256, CONV_UNITS_EXP = 3 * 4160;
DI void convert_small_unit(const Params& p, int l, int u, char* smem) {
    float* tile = (float*)smem;
    if (u < 608) { const int kt = u / 38, nt = u % 38;
        transpose_tile(p.in[I_WIN] + (size_t)l * DM * INP, INP, INP, kt * 64, nt * 64, (bf16_t*)(p.ws + OFF_WIN + l * SZ_WIN1), DM, 0, tile); return; }
    u -= 608; { const int kt = u / 16, nt = u % 16;
        transpose_tile(p.in[I_WOUT] + (size_t)l * DM * DM, DM, DM, kt * 64, nt * 64, (bf16_t*)(p.ws + OFF_WOUT + l * SZ_WOUT1), DM, 0, tile); }
}
DI void convert_exp_unit(const Params& p, int l, int u, char* smem) {
    float* tile = (float*)smem;
    if (u < 2 * 4160) { const int up = u >= 4160; if (up) u -= 4160;
        const int e = u / 64, r = u % 64, kt = r / 4, nt = r % 4;
        const float* src = e < 64 ? p.in[up ? I_EU : I_EG] + ((size_t)l * 64 + e) * DM * 256 : p.in[up ? I_SU : I_SG] + (size_t)l * DM * 256;
        transpose_tile(src, 256, 256, kt * 64, nt * 64, (bf16_t*)(p.ws + OFF_WGU) + (size_t)e * 512 * 1024, 1024, up ? 2 : 1, tile); return; }
    u -= 2 * 4160; { const int e = u / 64, r = u % 64, kt = r / 16, nt = r % 16;
        const float* src = e < 64 ? p.in[I_ED] + ((size_t)l * 64 + e) * 256 * DM : p.in[I_SD] + (size_t)l * 256 * DM;
        transpose_tile(src, DM, DM, kt * 64, nt * 64, (bf16_t*)(p.ws + OFF_WD) + (size_t)e * 1024 * 256, 256, 0, tile); }
}
constexpr int MOD_UNITS = 2 * 96;
DI void mod_unit(const Params& p, int u, char* smem) {
    float* s = (float*)smem;
    float* part = s + 5 * 1024;
    const int l = u / 96, cb = u % 96, t = tidx(), col = t & 63, kg = t >> 6;
    for (int i = t; i < 5 * 1024; i += NTHR) { const int v = i >> 10, k = i & 1023; const float c = v < 4 ? p.in[I_C][v * DM + k] : p.in[I_CCTX][k]; s[i] = silu_(c); }
    __syncthreads();
    const int j = cb * 64 + col;
    const float* w = p.in[I_WADA] + (size_t)l * DM * 6144 + (size_t)(kg * 128) * 6144 + j;
    float a0 = 0, a1 = 0, a2 = 0, a3 = 0, a4 = 0;
#pragma unroll 4
    for (int k = 0; k < 128; ++k) { const float wv = w[(size_t)k * 6144]; const int kk = kg * 128 + k;
        a0 += s[kk] * wv; a1 += s[1024 + kk] * wv; a2 += s[2048 + kk] * wv; a3 += s[3072 + kk] * wv; a4 += s[4096 + kk] * wv; }
    part[(kg * 5 + 0) * 64 + col] = a0; part[(kg * 5 + 1) * 64 + col] = a1; part[(kg * 5 + 2) * 64 + col] = a2; part[(kg * 5 + 3) * 64 + col] = a3; part[(kg * 5 + 4) * 64 + col] = a4;
    __syncthreads();
    if (t < 320) { const int v = t >> 6, c = t & 63; float acc = p.in[I_BADA][l * 6144 + cb * 64 + c];
#pragma unroll
        for (int g = 0; g < 8; ++g) acc += part[(g * 5 + v) * 64 + c];
        ((float*)(p.ws + OFF_MOD))[(size_t)(l * 5 + v) * 6144 + cb * 64 + c] = acc; }
    __syncthreads();
}
constexpr int ROPE_UNITS = 4096 * 32 / NTHR;
DI void rope_unit(const Params& p, int u) {
    const int idx = u * NTHR + tidx(), t = idx >> 5, i = idx & 31;
    const float pos = (float)(i < 16 ? (t >> 6) : (t & 63));
    const float inv = powf(10000.f, -(float)(2 * (i & 15)) / 32.f);
    const float ang = pos * inv;
    ((float2*)(p.ws + OFF_ROPE))[idx] = make_float2(cosf(ang), sinf(ang));
}

template <int MODE>
DI void rowpost_unit(const Params& p, int l, int hf, int r0, char* smem) {
    float* hrow = (float*)smem;
    int* hoffU = (int*)(smem + 16 * 1024 * 4);
    const int tid = tidx(), lane = tid & 63, w = tid >> 6;
    if (MODE >= 2) {
        if (tid < 64) { const int* cnt = (const int*)(p.ws + OFF_CNT) + (l * 2 + hf) * 64; int s = 0; for (int e = 0; e < tid; ++e) s += cnt[e]; hoffU[tid] = s; }
        __syncthreads();
    }
#pragma unroll 1
    for (int rr = 0; rr < 2; ++rr) {
        const int r = r0 + 2 * w + rr;
        const int bidx = mod_idx(r);
        f32x4 xv[4];
        if (MODE == 0) {
#pragma unroll
            for (int i = 0; i < 4; ++i) xv[i] = *(const f32x4*)(xin_row(p, r) + 4 * lane + 256 * i);
        } else {
            f32x4 yv[4];
            const float* Y = (const float*)(p.ws + OFF_Y) + (size_t)r * DM;
#pragma unroll
            for (int i = 0; i < 4; ++i) yv[i] = *(const f32x4*)(Y + 4 * lane + 256 * i);
            if (MODE >= 2) {
                const int* ts = (const int*)(p.ws + OFF_TOKSLOT) + (size_t)r * 8;
                const bf16_t* ye = (const bf16_t*)(p.ws + OFF_YE);
#pragma unroll 1
                for (int k = 0; k < 8; ++k) {
                    const int v = ts[k]; const int e = v >> 14, pos = v & 16383;
                    const bf16_t* yr = ye + (size_t)(hoffU[e] + pos) * DM;
#pragma unroll
                    for (int i = 0; i < 4; ++i) { const uint2 q = *(const uint2*)(yr + 4 * lane + 256 * i);
                        yv[i][0] += __uint_as_float(q.x << 16); yv[i][1] += __uint_as_float(q.x & 0xffff0000u); yv[i][2] += __uint_as_float(q.y << 16); yv[i][3] += __uint_as_float(q.y & 0xffff0000u); }
                }
            }
            const float* xs = (MODE == 1 && l == 0) ? xin_row(p, r) : xrow_c(p, r);
#pragma unroll
            for (int i = 0; i < 4; ++i) xv[i] = *(const f32x4*)(xs + 4 * lane + 256 * i);
            float ss = 0.f;
#pragma unroll
            for (int i = 0; i < 4; ++i) ss += yv[i][0] * yv[i][0] + yv[i][1] * yv[i][1] + yv[i][2] * yv[i][2] + yv[i][3] * yv[i][3];
            ss = wave_sum(ss);
            const float rs = rsqrtf(ss * (1.f / DM) + EPS);
            const float* gate = modp(p, l, bidx, MODE == 1 ? 2 : 5);
            const float* gp = p.in[MODE == 1 ? I_GMIXPOST : I_GFFNPOST] + l * DM;
            float* xo = xrow(p, r);
#pragma unroll
            for (int i = 0; i < 4; ++i) { const f32x4 g = *(const f32x4*)(gate + 4 * lane + 256 * i), q = *(const f32x4*)(gp + 4 * lane + 256 * i);
                xv[i] = xv[i] + g * (yv[i] * rs * q); *(f32x4*)(xo + 4 * lane + 256 * i) = xv[i]; }
        }
        if (MODE != 3) {
            const int lp = MODE == 2 ? l + 1 : l;
            float ss = 0.f;
#pragma unroll
            for (int i = 0; i < 4; ++i) ss += xv[i][0] * xv[i][0] + xv[i][1] * xv[i][1] + xv[i][2] * xv[i][2] + xv[i][3] * xv[i][3];
            ss = wave_sum(ss);
            const float rs = rsqrtf(ss * (1.f / DM) + EPS);
            const float* gpre = p.in[MODE == 1 ? I_GFFNPRE : I_GMIXPRE] + lp * DM;
            const float* sh = modp(p, lp, bidx, MODE == 1 ? 3 : 0);
            const float* sc = modp(p, lp, bidx, MODE == 1 ? 4 : 1);
            bf16_t* hb = (bf16_t*)(p.ws + (MODE == 1 ? OFF_RA : OFF_RB)) + (size_t)r * DM;
#pragma unroll
            for (int i = 0; i < 4; ++i) { const int c = 4 * lane + 256 * i;
                const f32x4 g = *(const f32x4*)(gpre + c), s1 = *(const f32x4*)(sh + c), s2 = *(const f32x4*)(sc + c);
                const f32x4 h = xv[i] * rs * g * (s2 + 1.f) + s1;
                uint2 q; q.x = pack2(h[0], h[1]); q.y = pack2(h[2], h[3]); *(uint2*)(hb + c) = q;
                if (MODE == 1) *(f32x4*)(hrow + (2 * w + rr) * DM + c) = h; }
        }
    }
    if (MODE == 1) {
        __syncthreads();
        const float* rw = p.in[I_RW] + (size_t)l * DM * 64 + lane;
        const float* h0 = hrow + (2 * w) * DM; const float* h1 = h0 + DM;
        float a0 = 0.f, a1 = 0.f;
#pragma unroll 8
        for (int k = 0; k < DM; ++k) { const float wv = rw[k * 64]; a0 += h0[k] * wv; a1 += h1[k] * wv; }
        const float rbias = p.in[I_RB][l * 64 + lane];
#pragma unroll 1
        for (int rr = 0; rr < 2; ++rr) {
            const int r = r0 + 2 * w + rr;
            const float s = sigmoid_(rr ? a1 : a0);
            const float v = s + rbias;
            float m1 = v;
            m1 = fmaxf(m1, __shfl_xor(m1, 1)); m1 = fmaxf(m1, __shfl_xor(m1, 2)); m1 = fmaxf(m1, __shfl_xor(m1, 4));
            int ix = (v == m1) ? lane : 64;
            ix = min(ix, __shfl_xor(ix, 1)); ix = min(ix, __shfl_xor(ix, 2)); ix = min(ix, __shfl_xor(ix, 4));
            float m2 = (lane == ix) ? -INFINITY : v;
            m2 = fmaxf(m2, __shfl_xor(m2, 1)); m2 = fmaxf(m2, __shfl_xor(m2, 2)); m2 = fmaxf(m2, __shfl_xor(m2, 4));
            const float gs = m1 + m2;
            const int g = lane >> 3; int grank = 0;
#pragma unroll
            for (int gg = 0; gg < 8; ++gg) { const float o = __shfl(gs, gg * 8); grank += (o > gs) || (o == gs && gg < g); }
            const bool gsel = grank < 4;
            const float vm = gsel ? v : -INFINITY;
            int rk = 0;
#pragma unroll 8
            for (int ee = 0; ee < 64; ++ee) { const float o = __shfl(vm, ee); rk += (o > vm) || (o == vm && ee < lane); }
            const bool sel = gsel && rk < 8;
            const float scs = sel ? s : 0.f;
            const float tot = wave_sum(scs);
            const float wgt = scs / tot * 2.5f;
            if (sel) {
                const int h = r >= half_lo(l, 1) ? 1 : 0;
                int* cnt = (int*)(p.ws + OFF_CNT) + (l * 2 + h) * 64;
                const int pos = atomicAdd(cnt + lane, 1);
                ((int*)(p.ws + OFF_SLOT_TOK))[(size_t)(h * 64 + lane) * HCAP + pos] = r;
                ((float*)(p.ws + OFF_SLOT_W))[(size_t)(h * 64 + lane) * HCAP + pos] = wgt;
                ((int*)(p.ws + OFF_TOKSLOT))[(size_t)r * 8 + rk] = (lane << 14) | pos;
            }
        }
    }
    __syncthreads();
}

constexpr int LDT = 72;
constexpr int GEMM_LDS = 2 * (256 + 128) * LDT * 2;
template <class AF, class EF>
DI void gemm_tile(AF arow, const bf16_t* __restrict__ Bt, int ldb, int K, EF epi, char* smem) {
    const int tid = tidx(), lane = tid & 63, w = tid >> 6, wr = w >> 1, wc = w & 1, fr = lane & 15, fq = lane >> 4;
    bf16_t* As = (bf16_t*)smem;
    bf16_t* Bs = As + 2 * 256 * LDT;
    const int c = tid & 7, r0 = tid >> 3;
    const bf16_t* ap[4]; const bf16_t* bp[2];
#pragma unroll
    for (int i = 0; i < 4; ++i) ap[i] = arow(r0 + 64 * i) + c * 8;
#pragma unroll
    for (int i = 0; i < 2; ++i) bp[i] = Bt + (size_t)(r0 + 64 * i) * ldb + c * 8;
    u32x4 ra[4], rb[2];
#pragma unroll
    for (int i = 0; i < 4; ++i) ra[i] = *(const u32x4*)(ap[i]);
#pragma unroll
    for (int i = 0; i < 2; ++i) rb[i] = *(const u32x4*)(bp[i]);
#pragma unroll
    for (int i = 0; i < 4; ++i) *(u32x4*)(As + (r0 + 64 * i) * LDT + c * 8) = ra[i];
#pragma unroll
    for (int i = 0; i < 2; ++i) *(u32x4*)(Bs + (r0 + 64 * i) * LDT + c * 8) = rb[i];
    __syncthreads();
    f32x4 acc[4][4];
#pragma unroll
    for (int m = 0; m < 4; ++m)
#pragma unroll
        for (int n = 0; n < 4; ++n) acc[m][n] = (f32x4){0.f, 0.f, 0.f, 0.f};
    const int nk = K >> 6;
#pragma unroll 1
    for (int kt = 0; kt < nk; ++kt) {
        const bool more = kt + 1 < nk;
        if (more) {
#pragma unroll
            for (int i = 0; i < 4; ++i) ra[i] = *(const u32x4*)(ap[i] + (kt + 1) * 64);
#pragma unroll
            for (int i = 0; i < 2; ++i) rb[i] = *(const u32x4*)(bp[i] + (kt + 1) * 64);
        }
        const bf16_t* Ac = As + (kt & 1) * 256 * LDT;
        const bf16_t* Bc = Bs + (kt & 1) * 128 * LDT;
#pragma unroll
        for (int ks = 0; ks < 2; ++ks) {
            bf16x8 a[4], b[4];
#pragma unroll
            for (int m = 0; m < 4; ++m) a[m] = *(const bf16x8*)(Ac + (wr * 64 + m * 16 + fr) * LDT + ks * 32 + fq * 8);
#pragma unroll
            for (int n = 0; n < 4; ++n) b[n] = *(const bf16x8*)(Bc + (wc * 64 + n * 16 + fr) * LDT + ks * 32 + fq * 8);
#pragma unroll
            for (int m = 0; m < 4; ++m)
#pragma unroll
                for (int n = 0; n < 4; ++n) acc[m][n] = __builtin_amdgcn_mfma_f32_16x16x32_bf16(b[n], a[m], acc[m][n], 0, 0, 0);
        }
        if (more) {
            bf16_t* An = As + ((kt + 1) & 1) * 256 * LDT;
            bf16_t* Bn = Bs + ((kt + 1) & 1) * 128 * LDT;
#pragma unroll
            for (int i = 0; i < 4; ++i) *(u32x4*)(An + (r0 + 64 * i) * LDT + c * 8) = ra[i];
#pragma unroll
            for (int i = 0; i < 2; ++i) *(u32x4*)(Bn + (r0 + 64 * i) * LDT + c * 8) = rb[i];
        }
        __syncthreads();
    }
    epi(acc, wr, wc, fr, fq);
}

constexpr int INPROJ_UNITS = (NTOK / 256) * (INPP / 128);
DI void inproj_unit(const Params& p, int l, int u, char* smem) {
    const int mt = u / 19, nt = u % 19;
    const bf16_t* A = (const bf16_t*)(p.ws + OFF_RB) + (size_t)mt * 256 * DM;
    const bf16_t* Bt = (const bf16_t*)(p.ws + OFF_WIN + l * SZ_WIN1) + (size_t)nt * 128 * DM;
    bf16_t* C = (bf16_t*)(p.ws + OFF_RA) + (size_t)mt * 256 * INPP + nt * 128;
    gemm_tile([&](int r) { return A + (size_t)r * DM; }, Bt, DM, DM,
              [&](const f32x4 (&acc)[4][4], int wr, int wc, int fr, int fq) {
#pragma unroll
                  for (int m = 0; m < 4; ++m)
#pragma unroll
                      for (int n = 0; n < 4; ++n) { uint2 q; q.x = pack2(acc[m][n][0], acc[m][n][1]); q.y = pack2(acc[m][n][2], acc[m][n][3]);
                          *(uint2*)(C + (size_t)(wr * 64 + m * 16 + fr) * INPP + wc * 64 + n * 16 + fq * 4) = q; }
              }, smem);
}
DI int outproj_units(int l) { return (l == 0 ? 68 : 64) * 8; }
DI void outproj_unit(const Params& p, int l, int u, char* smem) {
    const int mt = u / 8, nt = u % 8, row0 = (l == 0 ? 0 : NCTX) + mt * 256;
    const bf16_t* A = (const bf16_t*)(p.ws + OFF_RB) + (size_t)row0 * DM;
    const bf16_t* Bt = (const bf16_t*)(p.ws + OFF_WOUT + l * SZ_WOUT1) + (size_t)nt * 128 * DM;
    float* C = (float*)(p.ws + OFF_Y) + (size_t)row0 * DM + nt * 128;
    gemm_tile([&](int r) { return A + (size_t)r * DM; }, Bt, DM, DM,
              [&](const f32x4 (&acc)[4][4], int wr, int wc, int fr, int fq) {
#pragma unroll
                  for (int m = 0; m < 4; ++m)
#pragma unroll
                      for (int n = 0; n < 4; ++n) *(f32x4*)(C + (size_t)(wr * 64 + m * 16 + fr) * DM + wc * 64 + n * 16 + fq * 4) = acc[m][n];
              }, smem);
}
struct MoeTab { int cnt[65]; int mstart[66]; int hoffP[65]; int hoffU[65]; };
DI void moe_table(const Params& p, int l, int hf, MoeTab* tb) {
    if (tidx() == 0) {
        const int* cnt = (const int*)(p.ws + OFF_CNT) + (l * 2 + hf) * 64;
        int ms = 0, hp = 0, hu = 0;
        for (int e = 0; e < 65; ++e) { const int c = e < 64 ? cnt[e] : half_hi(l, hf) - half_lo(l, hf);
            tb->cnt[e] = c; tb->mstart[e] = ms; tb->hoffP[e] = hp; tb->hoffU[e] = hu; const int mt = (c + 255) >> 8; ms += mt; hp += mt * 256; hu += c; }
        tb->mstart[65] = ms;
    }
    __syncthreads();
}
DI void moe_find(const MoeTab* tb, int g, int& e, int& mt) { int lo = 0; while (tb->mstart[lo + 1] <= g) ++lo; e = lo; mt = g - tb->mstart[lo]; }
DI void moe1_unit(const Params& p, int l, int hf, const MoeTab* tb, int u, char* smem) {
    const int g = u >> 2, nt = u & 3; int e, mt; moe_find(tb, g, e, mt);
    const int cnt = tb->cnt[e], lo = half_lo(l, hf);
    const int* stok = (const int*)(p.ws + OFF_SLOT_TOK) + (size_t)(hf * 64 + (e & 63)) * HCAP;
    const bf16_t* T = (const bf16_t*)(p.ws + OFF_RA);
    const bf16_t* Bt = (const bf16_t*)(p.ws + OFF_WGU) + ((size_t)e * 512 + nt * 128) * 1024;
    bf16_t* H = (bf16_t*)(p.ws + OFF_HID) + (size_t)(tb->hoffP[e] + mt * 256) * 256 + nt * 64;
    gemm_tile([&](int r) { int pos = mt * 256 + r; pos = pos < cnt ? pos : cnt - 1; const int tok = e < 64 ? stok[pos] : lo + pos; return T + (size_t)tok * DM; }, Bt, 1024, 1024,
              [&](const f32x4 (&acc)[4][4], int wr, int wc, int fr, int fq) {
#pragma unroll
                  for (int m = 0; m < 4; ++m)
#pragma unroll
                      for (int n = 0; n < 2; ++n) { const f32x4 gt = acc[m][n], up = acc[m][n + 2];
                          uint2 q; q.x = pack2(silu_(gt[0]) * up[0], silu_(gt[1]) * up[1]); q.y = pack2(silu_(gt[2]) * up[2], silu_(gt[3]) * up[3]);
                          *(uint2*)(H + (size_t)(wr * 64 + m * 16 + fr) * 256 + wc * 32 + n * 16 + fq * 4) = q; }
              }, smem);
}
DI void moe2_unit(const Params& p, int l, int hf, const MoeTab* tb, int u, char* smem) {
    const int g = u >> 3, nt = u & 7; int e, mt; moe_find(tb, g, e, mt);
    const int cnt = tb->cnt[e], lo = half_lo(l, hf);
    const float* sw = (const float*)(p.ws + OFF_SLOT_W) + (size_t)(hf * 64 + (e & 63)) * HCAP;
    const bf16_t* A = (const bf16_t*)(p.ws + OFF_HID) + (size_t)(tb->hoffP[e] + mt * 256) * 256;
    const bf16_t* Bt = (const bf16_t*)(p.ws + OFF_WD) + ((size_t)e * 1024 + nt * 128) * 256;
    bf16_t* YE = (bf16_t*)(p.ws + OFF_YE) + (size_t)(tb->hoffU[e] + mt * 256) * DM + nt * 128;
    float* Y = (float*)(p.ws + OFF_Y) + (size_t)(lo + mt * 256) * DM + nt * 128;
    gemm_tile([&](int r) { return A + (size_t)r * 256; }, Bt, 256, 256,
              [&](const f32x4 (&acc)[4][4], int wr, int wc, int fr, int fq) {
#pragma unroll
                  for (int m = 0; m < 4; ++m) { const int row = wr * 64 + m * 16 + fr, pos = mt * 256 + row;
                      if (pos < cnt) {
                          if (e < 64) { const float wv = sw[pos];
#pragma unroll
                              for (int n = 0; n < 4; ++n) { uint2 q; q.x = pack2(acc[m][n][0] * wv, acc[m][n][1] * wv); q.y = pack2(acc[m][n][2] * wv, acc[m][n][3] * wv);
                                  *(uint2*)(YE + (size_t)row * DM + wc * 64 + n * 16 + fq * 4) = q; }
                          } else {
#pragma unroll
                              for (int n = 0; n < 4; ++n) *(f32x4*)(Y + (size_t)row * DM + wc * 64 + n * 16 + fq * 4) = acc[m][n];
                          } } }
              }, smem);
}

constexpr int PREP_UNITS = NTOK / 8;
DI void rope2(float& a, float& b, const float2 cs) { const float x1 = a, x2 = b; a = x1 * cs.x - x2 * cs.y; b = x1 * cs.y + x2 * cs.x; }
DI void prep_unit(const Params& p, int l, int u) {
    const int tid = tidx(), lane = tid & 63, w = tid >> 6, r = u * 8 + w;
    const bool lat = r >= NCTX; const int pos = (r - NCTX) & (SEQ - 1);
    const bf16_t* pr = (const bf16_t*)(p.ws + OFF_RA) + (size_t)r * INPP;
    const float2* rt = (const float2*)(p.ws + OFF_ROPE) + (size_t)pos * 32;
    const float* gq = p.in[I_DQN] + l * 64; const float* gk = p.in[I_DKN] + l * 64;
    unsigned* QA = (unsigned*)(p.ws + OFF_QA) + (size_t)r * 128; unsigned* KA = (unsigned*)(p.ws + OFF_KA) + (size_t)r * 64;
    unsigned* QD = (unsigned*)(p.ws + OFF_QD) + (size_t)r * 128; unsigned* KD = (unsigned*)(p.ws + OFF_KD) + (size_t)r * 64;
#pragma unroll
    for (int i = 0; i < 2; ++i) {
        const int pq = lane + 64 * i, pi = pq & 31;
        const float2 cs = lat ? rt[pi] : make_float2(1.f, 0.f);
        { const unsigned v = *(const unsigned*)(pr + CA_Q + 2 * pq); float a = __uint_as_float(v << 16), b = __uint_as_float(v & 0xffff0000u);
          rope2(a, b, cs); QA[pq] = pack2(a * 0.125f, b * 0.125f); }
        { const unsigned v = *(const unsigned*)(pr + CD_Q + 2 * pq); float a = __uint_as_float(v << 16), b = __uint_as_float(v & 0xffff0000u);
          float ss = a * a + b * b;
#pragma unroll
          for (int o = 1; o < 32; o <<= 1) ss += __shfl_xor(ss, o);
          const float rs = rsqrtf(ss * (1.f / 64.f) + EPS);
          a = a * rs * gq[2 * pi]; b = b * rs * gq[2 * pi + 1];
          rope2(a, b, cs); QD[pq] = pack2(a * 0.125f, b * 0.125f); }
    }
    {
        const int pi = lane & 31;
        const float2 cs = lat ? rt[pi] : make_float2(1.f, 0.f);
        { const unsigned v = *(const unsigned*)(pr + CA_K + 2 * lane); float a = __uint_as_float(v << 16), b = __uint_as_float(v & 0xffff0000u);
          rope2(a, b, cs); KA[lane] = pack2(a, b); }
        { const unsigned v = *(const unsigned*)(pr + CD_K + 2 * lane); float a = __uint_as_float(v << 16), b = __uint_as_float(v & 0xffff0000u);
          float ss = a * a + b * b;
#pragma unroll
          for (int o = 1; o < 32; o <<= 1) ss += __shfl_xor(ss, o);
          const float rs = rsqrtf(ss * (1.f / 64.f) + EPS);
          a = a * rs * gk[2 * pi]; b = b * rs * gk[2 * pi + 1];
          rope2(a, b, cs); KD[lane] = pack2(a, b); }
    }
}

constexpr int ATT_LDS = 2 * 2 * 64 * LDT * 2;
struct AttnArgs {
    const bf16_t* Q; const bf16_t* K; const bf16_t* V;
    int qrow0;
    int g;
    int k0row, k0tiles;
    int k1row, k1t0, k1t1;
    int qpos0;
    const float* sink;
    bf16_t* O;
};
DI void attn_unit(const AttnArgs& a, char* smem) {
    const int tid = tidx(), lane = tid & 63, w = tid >> 6, r32 = lane & 31, hi = lane >> 5;
    const int head = 2 * a.g + (w >> 2), qoff = (w & 3) * 32 + r32;
    bf16_t* Ks = (bf16_t*)smem;
    bf16_t* Vs = Ks + 2 * 64 * LDT;
    bf16x8 qr[4];
    { const bf16_t* qp = a.Q + (size_t)(a.qrow0 + qoff) * 256 + head * 64 + hi * 8;
#pragma unroll
      for (int d0 = 0; d0 < 4; ++d0) qr[d0] = *(const bf16x8*)(qp + d0 * 16); }
    float m_run, l_run;
    if (a.sink) { m_run = a.sink[head]; l_run = hi == 0 ? 1.f : 0.f; } else { m_run = -1e30f; l_run = 0.f; }
    f32x16 o0, o1;
#pragma unroll
    for (int i = 0; i < 16; ++i) { o0[i] = 0.f; o1[i] = 0.f; }
    const int nt = a.k0tiles + (a.k1t1 - a.k1t0);
    const int lrow = tid >> 3, lc = (tid & 7) * 8;
    auto tile_row0 = [&](int t) { return t < a.k0tiles ? a.k0row + t * 64 : a.k1row + (a.k1t0 + t - a.k0tiles) * 64; };
    u32x4 rk, rv;
    { const int kr = tile_row0(0) + lrow; rk = *(const u32x4*)(a.K + (size_t)kr * 128 + a.g * 64 + lc); rv = *(const u32x4*)(a.V + (size_t)kr * INPP + a.g * 64 + lc); }
    *(u32x4*)(Ks + lrow * LDT + lc) = rk; *(u32x4*)(Vs + lrow * LDT + lc) = rv;
    __syncthreads();
    const int q4 = (lane & 15) >> 2, p4 = lane & 3, blk = (lane >> 4) & 1;
#pragma unroll 1
    for (int t = 0; t < nt; ++t) {
        const bool more = t + 1 < nt;
        if (more) { const int kr = tile_row0(t + 1) + lrow; rk = *(const u32x4*)(a.K + (size_t)kr * 128 + a.g * 64 + lc); rv = *(const u32x4*)(a.V + (size_t)kr * INPP + a.g * 64 + lc); }
        const bf16_t* Kc = Ks + (t & 1) * 64 * LDT;
        const bf16_t* Vc = Vs + (t & 1) * 64 * LDT;
        f32x16 s0, s1;
#pragma unroll
        for (int i = 0; i < 16; ++i) { s0[i] = 0.f; s1[i] = 0.f; }
#pragma unroll
        for (int d0 = 0; d0 < 4; ++d0) {
            const bf16x8 k0 = *(const bf16x8*)(Kc + r32 * LDT + d0 * 16 + hi * 8);
            const bf16x8 k1 = *(const bf16x8*)(Kc + (32 + r32) * LDT + d0 * 16 + hi * 8);
            s0 = __builtin_amdgcn_mfma_f32_32x32x16_bf16(k0, qr[d0], s0, 0, 0, 0);
            s1 = __builtin_amdgcn_mfma_f32_32x32x16_bf16(k1, qr[d0], s1, 0, 0, 0);
        }
        if (a.qpos0 >= 0 && t >= a.k0tiles) {
            const int kb = (a.k1t0 + t - a.k0tiles) * 64, qp = a.qpos0 + qoff;
#pragma unroll
            for (int i = 0; i < 16; ++i) { const int kp = kb + crow(i, hi); int d = kp - qp; d = d < 0 ? -d : d; if (d > 128) s0[i] = -1e30f; d = kp + 32 - qp; d = d < 0 ? -d : d; if (d > 128) s1[i] = -1e30f; }
        }
        float mx = s0[0];
#pragma unroll
        for (int i = 1; i < 16; ++i) mx = fmaxf(mx, s0[i]);
#pragma unroll
        for (int i = 0; i < 16; ++i) mx = fmaxf(mx, s1[i]);
        mx = fmaxf(mx, __shfl_xor(mx, 32));
        const float m_new = fmaxf(m_run, mx);
        const float alpha = __expf(m_run - m_new);
        m_run = m_new;
        float ps = 0.f;
#pragma unroll
        for (int i = 0; i < 16; ++i) { s0[i] = __expf(s0[i] - m_new); s1[i] = __expf(s1[i] - m_new); ps += s0[i] + s1[i]; }
        l_run = l_run * alpha + ps;
#pragma unroll
        for (int i = 0; i < 16; ++i) { o0[i] *= alpha; o1[i] *= alpha; }
#pragma unroll
        for (int ks = 0; ks < 4; ++ks) {
            bf16x8 pf;
            {
                union { unsigned u[4]; bf16x8 v; } pk;
#pragma unroll
                for (int j = 0; j < 4; ++j) { const int rg = (ks & 1) * 8 + 2 * j; pk.u[j] = (ks < 2) ? pack2(s0[rg], s0[rg + 1]) : pack2(s1[rg], s1[rg + 1]); }
                pf = pk.v;
            }
#pragma unroll
            for (int ds = 0; ds < 2; ++ds) {
                const bf16_t* vp = Vc + (16 * ks + 4 * hi + q4) * LDT + 32 * ds + 16 * blk + 4 * p4;
                const s16x4 lo = __builtin_bit_cast(s16x4, __builtin_amdgcn_ds_read_tr16_b64_v4i16((__attribute__((address_space(3))) s16x4*)(vp)));
                const s16x4 hh = __builtin_bit_cast(s16x4, __builtin_amdgcn_ds_read_tr16_b64_v4i16((__attribute__((address_space(3))) s16x4*)(vp + 8 * LDT)));
                const bf16x8 vf = (bf16x8){lo[0], lo[1], lo[2], lo[3], hh[0], hh[1], hh[2], hh[3]};
                if (ds == 0) o0 = __builtin_amdgcn_mfma_f32_32x32x16_bf16(vf, pf, o0, 0, 0, 0);
                else o1 = __builtin_amdgcn_mfma_f32_32x32x16_bf16(vf, pf, o1, 0, 0, 0);
            }
        }
        if (more) { bf16_t* Kn = Ks + ((t + 1) & 1) * 64 * LDT; bf16_t* Vn = Vs + ((t + 1) & 1) * 64 * LDT; *(u32x4*)(Kn + lrow * LDT + lc) = rk; *(u32x4*)(Vn + lrow * LDT + lc) = rv; }
        __syncthreads();
    }
    l_run += __shfl_xor(l_run, 32);
    const float inv = 1.f / l_run;
    bf16_t* op = a.O + (size_t)(a.qrow0 + qoff) * DM + head * 64;
#pragma unroll
    for (int g4 = 0; g4 < 4; ++g4) {
        uint2 q; q.x = pack2(o0[4 * g4] * inv, o0[4 * g4 + 1] * inv); q.y = pack2(o0[4 * g4 + 2] * inv, o0[4 * g4 + 3] * inv);
        *(uint2*)(op + 8 * g4 + 4 * hi) = q;
        q.x = pack2(o1[4 * g4] * inv, o1[4 * g4 + 1] * inv); q.y = pack2(o1[4 * g4 + 2] * inv, o1[4 * g4 + 3] * inv);
        *(uint2*)(op + 32 + 8 * g4 + 4 * hi) = q;
    }
}
DI int attn_units(int l) { return l == 0 ? 544 : 512; }
DI void attn_dispatch(const Params& p, int l, int u, char* smem) {
    AttnArgs a;
    const bf16_t* proj = (const bf16_t*)(p.ws + OFF_RA);
    bf16_t* mix = (bf16_t*)(p.ws + OFF_RB);
    int type, b, g, tb;
    if (u < 512) { type = u >> 8; const int v = u & 255; b = v >> 6; g = (v >> 5) & 1; tb = v & 31; }
    else { const int v = u - 512; type = 2 + (v >> 4); b = (v >> 2) & 3; g = (v >> 1) & 1; tb = v & 1; }
    const bool isA = (type & 1);
    a.Q = (const bf16_t*)(p.ws + (isA ? OFF_QA : OFF_QD)); a.K = (const bf16_t*)(p.ws + (isA ? OFF_KA : OFF_KD)); a.V = proj + (isA ? CA_V : CD_V);
    a.g = g; a.sink = isA ? p.in[I_ASINK] + l * 4 : nullptr; a.O = mix + (isA ? 0 : 768);
    a.k0row = b * CTXL; a.k0tiles = 4; a.k1row = NCTX + b * SEQ; a.qpos0 = -1;
    if (type < 2) {
        a.qrow0 = NCTX + b * SEQ + tb * 128;
        if (isA) { a.qpos0 = tb * 128; int t0 = 2 * tb - 2, t1 = 2 * tb + 4; a.k1t0 = t0 < 0 ? 0 : t0; a.k1t1 = t1 > 64 ? 64 : t1; }
        else { a.k1t0 = 0; a.k1t1 = 64; }
    } else { a.qrow0 = b * CTXL + tb * 128; a.k1t0 = 0; a.k1t1 = 0; }
    attn_unit(a, smem);
}

DI int blk_row0(int b, int cb) { return cb < 2 ? b * CTXL + cb * 128 : NCTX + b * SEQ + (cb - 2) * 128; }
DI int bwd_seq(int cb) { return cb < 2 ? 1 - cb : 35 - cb; }
constexpr int SSD_LDS = (128 * 64 + 2 * 128 * 65 + 64 * 129 + 6 * 128) * 4;
DI int ssd_chunk_units() { return NB * NCHK * 4; }
DI void ssd_chunk_unit(const Params& p, int l, int u, char* smem) {
    const int tid = tidx();
    const int h = u & 3, cb = (u >> 2) % NCHK, b = (u >> 2) / NCHK, grp = h >> 1;
    const int row0 = blk_row0(b, cb);
    const int part0 = cb < 2 ? b * CTXL : NCTX + b * SEQ, partN = cb < 2 ? CTXL : SEQ;
    float* xs = (float*)smem;
    float* Bs = xs + 128 * 64;
    float* Cs = Bs + 128 * 65;
    float* Ws = Cs + 128 * 65;
    float* dtf = Ws + 64 * 129;
    float* dtb = dtf + 128; float* Af = dtb + 128; float* Ab = Af + 128; float* wef = Ab + 128; float* web = wef + 128;
    const bf16_t* proj = (const bf16_t*)(p.ws + OFF_RA);
    const float* cw = p.in[I_SSDCW] + l * 4 * 512; const float* cbias = p.in[I_SSDCB] + l * 512;
    const float aneg_f = -__expf(p.in[I_SSDALOG][l * 8 + h]), aneg_b = -__expf(p.in[I_SSDALOG][l * 8 + 4 + h]);
    for (int idx = tid; idx < 128 * 192; idx += NTHR) {
        const int i = idx / 192, cc = idx % 192;
        const int which = cc >> 6, c64 = cc & 63;
        const int ch = which == 0 ? h * 64 + c64 : (which == 1 ? 256 + grp * 64 + c64 : 384 + grp * 64 + c64);
        const int col = CB_X + ch;
        float acc = cbias[ch];
#pragma unroll
        for (int j = 0; j < 4; ++j) { const int rr = row0 + i + j - 2; if (rr >= part0 && rr < part0 + partN) acc += cw[j * 512 + ch] * bf2f(proj[(size_t)rr * INPP + col]); }
        const float v = silu_(acc);
        if (which == 0) xs[i * 64 + c64] = v; else if (which == 1) Bs[i * 65 + c64] = v; else Cs[i * 65 + c64] = v;
    }
    if (tid < 256) { const int i = tid & 127, d = tid >> 7;
        const float raw = bf2f(proj[(size_t)(row0 + i) * INPP + (d ? CB_DTB : CB_DTF) + h]);
        const float v = softplus_(raw + p.in[I_SSDDTB][l * 8 + d * 4 + h]);
        (d ? dtb : dtf)[i] = v; }
    __syncthreads();
    if (tid == 0) { float s = 0.f; for (int i = 0; i < 128; ++i) { s += dtf[i] * aneg_f; Af[i] = s; } }
    if (tid == 64) { float s = 0.f; for (int i = 127; i >= 0; --i) { s += dtb[i] * aneg_b; Ab[i] = s; } }
    __syncthreads();
    if (tid < 128) { wef[tid] = __expf(Af[127] - Af[tid]) * dtf[tid]; web[tid] = __expf(Ab[0] - Ab[tid]) * dtb[tid]; }
    if ((h & 1) == 0) { float* CC = (float*)(p.ws + OFF_CC);
        for (int idx = tid; idx < 128 * 64; idx += NTHR) { const int i = idx >> 6, n = idx & 63; CC[(size_t)(row0 + i) * 128 + grp * 64 + n] = Cs[i * 65 + n]; } }
    if (tid < 128) { float* EA = (float*)(p.ws + OFF_EA) + (size_t)(row0 + tid) * 8; EA[h] = __expf(Af[tid]); EA[4 + h] = __expf(Ab[tid]); }
    __syncthreads();
    {
        const int d = tid >> 8, pg = (tid >> 4) & 15, ng = tid & 15;
        const float* we = d ? web : wef;
        float acc[4][4];
#pragma unroll
        for (int a = 0; a < 4; ++a)
#pragma unroll
            for (int c = 0; c < 4; ++c) acc[a][c] = 0.f;
#pragma unroll 2
        for (int j = 0; j < 128; ++j) {
            const float wj = we[j];
            const f32x4 xv = *(const f32x4*)(xs + j * 64 + 4 * pg);
            float bv[4];
#pragma unroll
            for (int c = 0; c < 4; ++c) bv[c] = Bs[j * 65 + 4 * ng + c];
#pragma unroll
            for (int a = 0; a < 4; ++a) { const float xw = xv[a] * wj;
#pragma unroll
                for (int c = 0; c < 4; ++c) acc[a][c] += xw * bv[c]; }
        }
        const int s = d ? bwd_seq(cb) : cb;
        float* ST = (float*)(p.ws + OFF_SSDST) + ((size_t)((b * 4 + h) * 2 + d) * NCHK + s) * 4096;
#pragma unroll
        for (int a = 0; a < 4; ++a) *(f32x4*)(ST + (4 * pg + a) * 64 + 4 * ng) = (f32x4){acc[a][0], acc[a][1], acc[a][2], acc[a][3]};
        if ((tid & 255) == 0) ((float*)(p.ws + OFF_SSDDEC))[((b * 4 + h) * 2 + d) * NCHK + s] = d ? __expf(Ab[0]) : __expf(Af[127]);
    }
    const float dsk = p.in[I_SSDD][l * 4 + h];
    float* YP = (float*)(p.ws + OFF_YPART);
#pragma unroll 1
    for (int hb = 0; hb < 2; ++hb) {
        __syncthreads();
        {
            const int ig = tid >> 5, jg = tid & 31;
            float acc[4][4];
#pragma unroll
            for (int a = 0; a < 4; ++a)
#pragma unroll
                for (int c = 0; c < 4; ++c) acc[a][c] = 0.f;
#pragma unroll 4
            for (int n = 0; n < 64; ++n) {
                float cv[4], bv[4];
#pragma unroll
                for (int a = 0; a < 4; ++a) cv[a] = Cs[(64 * hb + ig + 16 * a) * 65 + n];
#pragma unroll
                for (int c = 0; c < 4; ++c) bv[c] = Bs[(jg + 32 * c) * 65 + n];
#pragma unroll
                for (int a = 0; a < 4; ++a)
#pragma unroll
                    for (int c = 0; c < 4; ++c) acc[a][c] += cv[a] * bv[c];
            }
#pragma unroll
            for (int a = 0; a < 4; ++a)
#pragma unroll
                for (int c = 0; c < 4; ++c) { const int il = ig + 16 * a, i = 64 * hb + il, j = jg + 32 * c;
                    float wgt = 0.f;
                    if (j <= i) wgt += __expf(Af[i] - Af[j]) * dtf[j];
                    if (j >= i) wgt += __expf(Ab[i] - Ab[j]) * dtb[j];
                    Ws[il * 129 + j] = acc[a][c] * wgt; }
        }
        __syncthreads();
        {
            const int ig = tid >> 4, pg = tid & 15;
            float acc[2][4];
#pragma unroll
            for (int a = 0; a < 2; ++a)
#pragma unroll
                for (int c = 0; c < 4; ++c) acc[a][c] = 0.f;
#pragma unroll 4
            for (int j = 0; j < 128; ++j) {
                const f32x4 xv = *(const f32x4*)(xs + j * 64 + 4 * pg);
                const float w0 = Ws[ig * 129 + j], w1 = Ws[(ig + 32) * 129 + j];
#pragma unroll
                for (int c = 0; c < 4; ++c) { acc[0][c] += w0 * xv[c]; acc[1][c] += w1 * xv[c]; }
            }
#pragma unroll
            for (int a = 0; a < 2; ++a) { const int i = 64 * hb + ig + 32 * a;
                const f32x4 xv = *(const f32x4*)(xs + i * 64 + 4 * pg);
                *(f32x4*)(YP + (size_t)(row0 + i) * 256 + h * 64 + 4 * pg) = (f32x4){acc[a][0] + dsk * xv[0], acc[a][1] + dsk * xv[1], acc[a][2] + dsk * xv[2], acc[a][3] + dsk * xv[3]}; }
        }
    }
    __syncthreads();
}
constexpr int SSDF_LDS = (2 * 64 * 65 + 128 * 65 + 128) * 4 + 128 * 256 * 2;
DI int ssd_fin_units(int l) { return NB * (l == 0 ? NCHK : NCHK - 2); }
DI void ssd_fin_unit(const Params& p, int l, int u, char* smem) {
    const int tid = tidx();
    const int nper = l == 0 ? NCHK : NCHK - 2;
    const int b = u / nper, cb = u % nper + (l == 0 ? 0 : 2);
    const int row0 = blk_row0(b, cb);
    float* stf = (float*)smem;
    float* stb = stf + 64 * 65;
    float* Cc = stb + 64 * 65;
    float* ssq = Cc + 128 * 65;
    bf16_t* ybuf = (bf16_t*)(ssq + 128);
    const bf16_t* proj = (const bf16_t*)(p.ws + OFF_RA);
    if (tid < 128) ssq[tid] = 0.f;
#pragma unroll 1
    for (int h = 0; h < 4; ++h) {
        __syncthreads();
        {
            const int d = tid >> 8, e = tid & 255;
            const int s = d ? bwd_seq(cb) : cb;
            const float* ST = (const float*)(p.ws + OFF_SSDST) + (size_t)((b * 4 + h) * 2 + d) * NCHK * 4096;
            const float* DEC = (const float*)(p.ws + OFF_SSDDEC) + ((b * 4 + h) * 2 + d) * NCHK;
            float st[16];
#pragma unroll
            for (int k = 0; k < 16; ++k) st[k] = 0.f;
#pragma unroll 1
            for (int sp = 0; sp < s; ++sp) { const float dc = DEC[sp];
#pragma unroll
                for (int k = 0; k < 16; ++k) st[k] = st[k] * dc + ST[(size_t)sp * 4096 + e + 256 * k]; }
            float* dst = d ? stb : stf;
#pragma unroll
            for (int k = 0; k < 16; ++k) { const int idx = e + 256 * k; dst[(idx >> 6) * 65 + (idx & 63)] = st[k]; }
        }
        if ((h & 1) == 0) { const float* CC = (const float*)(p.ws + OFF_CC);
            for (int idx = tid; idx < 128 * 64; idx += NTHR) { const int i = idx >> 6, n = idx & 63; Cc[i * 65 + n] = CC[(size_t)(row0 + i) * 128 + (h >> 1) * 64 + n]; } }
        __syncthreads();
        {
            const int ig = tid >> 4, pg = tid & 15;
            float af[4][4], ab[4][4];
#pragma unroll
            for (int a = 0; a < 4; ++a)
#pragma unroll
                for (int c = 0; c < 4; ++c) { af[a][c] = 0.f; ab[a][c] = 0.f; }
#pragma unroll 4
            for (int n = 0; n < 64; ++n) {
                float cv[4], sf[4], sb[4];
#pragma unroll
                for (int a = 0; a < 4; ++a) cv[a] = Cc[(ig + 32 * a) * 65 + n];
#pragma unroll
                for (int c = 0; c < 4; ++c) { sf[c] = stf[(pg + 16 * c) * 65 + n]; sb[c] = stb[(pg + 16 * c) * 65 + n]; }
#pragma unroll
                for (int a = 0; a < 4; ++a)
#pragma unroll
                    for (int c = 0; c < 4; ++c) { af[a][c] += cv[a] * sf[c]; ab[a][c] += cv[a] * sb[c]; }
            }
            const float* YP = (const float*)(p.ws + OFF_YPART);
            const float* EA = (const float*)(p.ws + OFF_EA);
#pragma unroll
            for (int a = 0; a < 4; ++a) { const int i = ig + 32 * a, r = row0 + i;
                const float ef = EA[(size_t)r * 8 + h], eb = EA[(size_t)r * 8 + 4 + h];
                float sq = 0.f;
#pragma unroll
                for (int c = 0; c < 4; ++c) { const int pp = pg + 16 * c;
                    const float y = YP[(size_t)r * 256 + h * 64 + pp] + ef * af[a][c] + eb * ab[a][c];
                    const float z = bf2f(proj[(size_t)r * INPP + CB_Z + h * 64 + pp]);
                    const float yg = y * silu_(z);
                    ybuf[i * 256 + h * 64 + pp] = f2bf(yg); sq += yg * yg; }
                sq += __shfl_xor(sq, 1); sq += __shfl_xor(sq, 2); sq += __shfl_xor(sq, 4); sq += __shfl_xor(sq, 8);
                if (pg == 0) ssq[i] += sq; }
        }
    }
    __syncthreads();
    {
        const float* gn = p.in[I_SSDNORM] + l * 256;
        bf16_t* mix = (bf16_t*)(p.ws + OFF_RB);
        for (int idx = tid; idx < 128 * 128; idx += NTHR) { const int i = idx >> 7, c2 = (idx & 127) * 2;
            const float rs = rsqrtf(ssq[i] * (1.f / 256.f) + EPS);
            const float a = bf2f(ybuf[i * 256 + c2]) * rs * gn[c2], bb = bf2f(ybuf[i * 256 + c2 + 1]) * rs * gn[c2 + 1];
            *(unsigned*)(mix + (size_t)(row0 + i) * DM + 256 + c2) = pack2(a, bb); }
    }
    __syncthreads();
}

constexpr int LRU_LDS = (128 * 65 + 4 * 64 * 64 + 2 * 8 * 64 * 2) * 4;
DI int lru_chunk_units() { return NB * NCHK * 4; }
DI void lru_chunk_unit(const Params& p, int l, int u, char* smem) {
    const int tid = tidx();
    const int kb = u & 3, cb = (u >> 2) % NCHK, b = (u >> 2) / NCHK;
    const int row0 = blk_row0(b, cb);
    const int part0 = cb < 2 ? b * CTXL : NCTX + b * SEQ, partN = cb < 2 ? CTXL : SEQ;
    float* us = (float*)smem;
    float* Wl = us + 128 * 65;
    float* segA = Wl + 4 * 64 * 64;
    float* segH = segA + 8 * 64;
    const bf16_t* proj = (const bf16_t*)(p.ws + OFF_RA);
    const float* cw = p.in[I_LRUCW] + l * 4 * 256; const float* cbias = p.in[I_LRUCB] + l * 256;
    for (int idx = tid; idx < 128 * 64; idx += NTHR) { const int i = idx >> 6, c = idx & 63, ch = kb * 64 + c;
        float acc = cbias[ch];
#pragma unroll
        for (int j = 0; j < 4; ++j) { const int rr = row0 + i + j - 2; if (rr >= part0 && rr < part0 + partN) acc += cw[j * 256 + ch] * bf2f(proj[(size_t)rr * INPP + CC_X + ch]); }
        us[i * 65 + c] = acc; }
    for (int idx = tid; idx < 4 * 4096; idx += NTHR) { const int g = idx >> 12, e = idx & 4095, d = g >> 1;
        const float* src = p.in[(g & 1) ? I_LRUWI : I_LRUWA] + ((size_t)((l * 2 + d) * 4 + kb)) * 4096;
        Wl[idx] = src[e]; }
    __syncthreads();
    const int tg = tid >> 4, cg = tid & 15;
    float acc[4][4][4];
#pragma unroll
    for (int g = 0; g < 4; ++g)
#pragma unroll
        for (int a = 0; a < 4; ++a)
#pragma unroll
            for (int c = 0; c < 4; ++c) acc[g][a][c] = 0.f;
#pragma unroll 2
    for (int i = 0; i < 64; ++i) {
        float uv[4];
#pragma unroll
        for (int a = 0; a < 4; ++a) uv[a] = us[(4 * tg + a) * 65 + i];
#pragma unroll
        for (int g = 0; g < 4; ++g) { const f32x4 wv = *(const f32x4*)(Wl + g * 4096 + i * 64 + 4 * cg);
#pragma unroll
            for (int a = 0; a < 4; ++a)
#pragma unroll
                for (int c = 0; c < 4; ++c) acc[g][a][c] += uv[a] * wv[c]; }
    }
    __syncthreads();
    float* aL = Wl; float* xL = Wl + 128 * 64;
    bf16_t* HB = (bf16_t*)(p.ws + OFF_LRUH);
    float* LC = (float*)(p.ws + OFF_LRUC);
#pragma unroll
    for (int d = 0; d < 2; ++d) {
#pragma unroll
        for (int c = 0; c < 4; ++c) { const int ch = kb * 64 + 4 * cg + c;
            const float ba = p.in[I_LRUBA][(l * 2 + d) * 256 + ch], bi = p.in[I_LRUBI][(l * 2 + d) * 256 + ch];
            const float spl = softplus_(-p.in[I_LRULAM][(l * 2 + d) * 256 + ch]);
#pragma unroll
            for (int a = 0; a < 4; ++a) { const int i = 4 * tg + a;
                const float rg = sigmoid_(acc[2 * d][a][c] + ba), ig = sigmoid_(acc[2 * d + 1][a][c] + bi);
                const float la = -8.f * rg * spl;
                const float av = __expf(la);
                const float mult = sqrtf(fmaxf(0.f, -expm1f(2.f * la)));
                aL[i * 64 + 4 * cg + c] = av; xL[i * 64 + 4 * cg + c] = mult * ig * us[i * 65 + 4 * cg + c]; }
        }
        __syncthreads();
        const int ch = tid & 63, sg = tid >> 6;
        float hacc = 0.f, pacc = 1.f;
#pragma unroll 1
        for (int t = 0; t < 16; ++t) { const int tau = sg * 16 + t, i = d ? 127 - tau : tau;
            const float av = aL[i * 64 + ch]; hacc = av * hacc + xL[i * 64 + ch]; pacc *= av; xL[i * 64 + ch] = hacc; aL[i * 64 + ch] = pacc; }
        segA[sg * 64 + ch] = pacc; segH[sg * 64 + ch] = hacc;
        __syncthreads();
        float carry = 0.f, cp = 1.f;
        for (int s2 = 0; s2 < sg; ++s2) { carry = carry * segA[s2 * 64 + ch] + segH[s2 * 64 + ch]; cp *= segA[s2 * 64 + ch]; }
        bf16_t* Hh = HB + (size_t)(2 * d) * NTOK * 256; bf16_t* Hp = HB + (size_t)(2 * d + 1) * NTOK * 256;
        float hl = 0.f, pl = 1.f;
#pragma unroll 1
        for (int t = 0; t < 16; ++t) { const int tau = sg * 16 + t, i = d ? 127 - tau : tau;
            hl = xL[i * 64 + ch] + aL[i * 64 + ch] * carry; pl = aL[i * 64 + ch] * cp;
            Hh[(size_t)(row0 + i) * 256 + kb * 64 + ch] = f2bf(hl); Hp[(size_t)(row0 + i) * 256 + kb * 64 + ch] = f2bf(pl); }
        if (sg == 7) { const int s = d ? bwd_seq(cb) : cb; const size_t o = ((size_t)(b * 2 + d) * NCHK + s) * 256 + kb * 64 + ch;
            LC[o] = hl; LC[(size_t)NB * 2 * NCHK * 256 + o] = pl; }
        __syncthreads();
    }
}
DI int lru_fin_units(int l) { return NB * (l == 0 ? NCHK : NCHK - 2); }
DI void lru_fin_unit(const Params& p, int l, int u, char* smem) {
    const int tid = tidx();
    const int nper = l == 0 ? NCHK : NCHK - 2;
    const int b = u / nper, cb = u % nper + (l == 0 ? 0 : 2);
    const int row0 = blk_row0(b, cb);
    float* car = (float*)smem;
    { const int d = tid >> 8, ch = tid & 255, s = d ? bwd_seq(cb) : cb;
      const float* LH = (const float*)(p.ws + OFF_LRUC) + (size_t)(b * 2 + d) * NCHK * 256 + ch; const float* LA = LH + (size_t)NB * 2 * NCHK * 256;
      float c = 0.f;
      for (int sp = 0; sp < s; ++sp) c = c * LA[sp * 256] + LH[sp * 256];
      car[tid] = c; }
    __syncthreads();
    const bf16_t* HB = (const bf16_t*)(p.ws + OFF_LRUH);
    const bf16_t* proj = (const bf16_t*)(p.ws + OFF_RA);
    bf16_t* mix = (bf16_t*)(p.ws + OFF_RB);
    for (int idx = tid; idx < 128 * 128; idx += NTHR) { const int i = idx >> 7, c2 = (idx & 127) * 2; const size_t o = (size_t)(row0 + i) * 256 + c2;
        float out[2];
#pragma unroll
        for (int q = 0; q < 2; ++q) {
            const float hf = bf2f(HB[o + q]), pf = bf2f(HB[(size_t)NTOK * 256 + o + q]), hb = bf2f(HB[(size_t)2 * NTOK * 256 + o + q]), pb = bf2f(HB[(size_t)3 * NTOK * 256 + o + q]);
            const float g = bf2f(proj[(size_t)(row0 + i) * INPP + CC_G + c2 + q]);
            out[q] = (hf + pf * car[c2 + q] + hb + pb * car[256 + c2 + q]) * gelu_tanh_(g); }
        *(unsigned*)(mix + (size_t)(row0 + i) * DM + 512 + c2) = pack2(out[0], out[1]); }
    __syncthreads();
}

#define XB_TMO      128
#define XB_XCNT(j)  (256  + 64 * (j))
#define XB_XSUB(j)  (1280 + 64 * (j))
#define XB_XGEN(j)  (2304 + 64 * (j))
#define XB_TOP      3328
#define XB_TOPGEN   3392
#define XCD_BAR_WORDS 3456
#define XB_SPIN_CAP (1u << 18)
#define LAS __attribute__((address_space(3)))

__device__ __forceinline__ unsigned xb_ld(unsigned* p)              { return __hip_atomic_load(p, __ATOMIC_RELAXED, __HIP_MEMORY_SCOPE_AGENT); }
__device__ __forceinline__ unsigned xb_add(unsigned* p, unsigned v) { return __hip_atomic_fetch_add(p, v, __ATOMIC_RELAXED, __HIP_MEMORY_SCOPE_AGENT); }
__device__ __forceinline__ unsigned xb_xcc_id() { return (unsigned)__builtin_amdgcn_s_getreg((3 << 11) | 20) & 0xFu; }
#define XB_SPIN(cond, bar) do { unsigned _sp = 0; while (cond) { __builtin_amdgcn_s_sleep(1); \
    if ((++_sp & 255u) == 0u) { if (xb_ld(&(bar)[XB_TMO])) break; if (_sp > XB_SPIN_CAP) { atomicAdd(&(bar)[XB_TMO], 1u); break; } } } } while (0)

struct XcdBarrier {
    unsigned* bar; unsigned x;
    volatile LAS unsigned* st;
};

__device__ __forceinline__ XcdBarrier xcd_barrier_post(unsigned* bar, volatile LAS unsigned* st) {
    XcdBarrier b; b.bar = bar; b.x = xb_xcc_id(); b.st = st;
    if (threadIdx.x == 0) (void)xb_add(&bar[XB_XCNT(b.x)], 1u);
    return b;
}
__device__ __forceinline__ void xcd_barrier_complete(unsigned* bar, unsigned x, unsigned& nloc, unsigned& nx) {
    const unsigned G = gridDim.x * gridDim.y * gridDim.z;
    unsigned sum, cnt, mine, sp = 0u;
    for (;;) {
        sum = 0u; cnt = 0u; mine = 0u;
#pragma unroll
        for (unsigned j = 0; j < 16; ++j) { const unsigned c = xb_ld(&bar[XB_XCNT(j)]); sum += c; cnt += (c > 0u) ? 1u : 0u; mine = (j == x) ? c : mine; }
        if (sum == G) break;
        __builtin_amdgcn_s_sleep(1);
        if ((++sp & 255u) == 0u) { if (xb_ld(&bar[XB_TMO])) break; if (sp > XB_SPIN_CAP) { atomicAdd(&bar[XB_TMO], 1u); break; } }
    }
    nloc = mine > 0u ? mine : 1u; nx = cnt > 0u ? cnt : 1u;
}

__device__ __forceinline__ void xcd_barrier(const XcdBarrier& b) {
    asm volatile("s_waitcnt vmcnt(0)" ::: "memory");
    __syncthreads();
    if (threadIdx.x == 0) {
        unsigned* bar = b.bar;
        __builtin_amdgcn_s_waitcnt(0);
        unsigned nloc = b.st[0], nx = b.st[1];
        if (nloc == 0u) { xcd_barrier_complete(bar, b.x, nloc, nx); b.st[0] = nloc; b.st[1] = nx; }
        const unsigned old = xb_add(&bar[XB_XSUB(b.x)], 1u);
        const unsigned gen = old / nloc;
        if (old + 1u == (gen + 1u) * nloc) {
            __builtin_amdgcn_fence(__ATOMIC_RELEASE, "agent");
            asm volatile("s_waitcnt vmcnt(0)" ::: "memory");
            const unsigned og = xb_add(&bar[XB_TOP], 1u);
            const unsigned tg = og / nx;
            if (og + 1u == (tg + 1u) * nx) xb_add(&bar[XB_TOPGEN], 1u);
            else XB_SPIN(xb_ld(&bar[XB_TOPGEN]) == tg, bar);
            __builtin_amdgcn_fence(__ATOMIC_ACQUIRE, "agent");
            xb_add(&bar[XB_XGEN(b.x)], 1u);
            asm volatile("s_waitcnt vmcnt(0)" ::: "memory");
        } else {
            XB_SPIN(xb_ld(&bar[XB_XGEN(b.x)]) == gen, bar);
            __builtin_amdgcn_fence(__ATOMIC_ACQUIRE, "agent");
            asm volatile("s_waitcnt vmcnt(0)" ::: "memory");
        }
    }
    __syncthreads();
}


enum { PH_PRO = 0, PH_CONVEXP, PH_PRE0, PH_INPROJ, PH_PREP, PH_MIX, PH_OUTPROJ, PH_POST1, PH_MOE1, PH_MOE2, PH_POST2, PH_POST3 };
constexpr int MAX_LDS = 140 * 1024;

template <int PH>
DI void run_phase(const Params& p, int l, int hf, char* smem) {
    const int G = gridDim.x, B = blockIdx.x;
    if (PH == PH_PRO) {
        const int n0 = MOD_UNITS, n1 = n0 + ROPE_UNITS, n2 = n1 + 2 * CONV_UNITS_SMALL, n3 = n2 + CONV_UNITS_EXP;
        for (int u = B; u < n3; u += G) {
            if (u < n0) mod_unit(p, u, smem);
            else if (u < n1) rope_unit(p, u - n0);
            else if (u < n2) { const int v = u - n1; convert_small_unit(p, v / CONV_UNITS_SMALL, v % CONV_UNITS_SMALL, smem); }
            else convert_exp_unit(p, 0, u - n2, smem);
        }
    } else if (PH == PH_CONVEXP) {
        for (int u = B; u < CONV_UNITS_EXP; u += G) convert_exp_unit(p, l, u, smem);
    } else if (PH == PH_PRE0) {
        for (int u = B; u < NTOK / 16; u += G) rowpost_unit<0>(p, 0, 0, u * 16, smem);
    } else if (PH == PH_INPROJ) {
        for (int u = B; u < INPROJ_UNITS; u += G) inproj_unit(p, l, u, smem);
    } else if (PH == PH_PREP) {
        const int n0 = ssd_chunk_units(), n1 = n0 + lru_chunk_units(), n2 = n1 + PREP_UNITS;
        for (int u = B; u < n2; u += G) {
            if (u < n0) ssd_chunk_unit(p, l, u, smem);
            else if (u < n1) lru_chunk_unit(p, l, u - n0, smem);
            else prep_unit(p, l, u - n1);
        }
    } else if (PH == PH_MIX) {
        const int n0 = attn_units(l), n1 = n0 + ssd_fin_units(l), n2 = n1 + lru_fin_units(l);
        for (int u = B; u < n2; u += G) {
            if (u < n0) attn_dispatch(p, l, u, smem);
            else if (u < n1) ssd_fin_unit(p, l, u - n0, smem);
            else lru_fin_unit(p, l, u - n1, smem);
        }
    } else if (PH == PH_OUTPROJ) {
        const int n = outproj_units(l);
        for (int u = B; u < n; u += G) outproj_unit(p, l, u, smem);
    } else if (PH == PH_POST1) {
        const int lo = l == 0 ? 0 : NCTX;
        for (int u = B; u < (NTOK - lo) / 16; u += G) rowpost_unit<1>(p, l, 0, lo + u * 16, smem);
    } else if (PH == PH_MOE1 || PH == PH_MOE2) {
        MoeTab* tb = (MoeTab*)(smem + GEMM_LDS);
        moe_table(p, l, hf, tb);
        const int n = tb->mstart[65] * (PH == PH_MOE1 ? 4 : 8);
        for (int u = B; u < n; u += G) { if (PH == PH_MOE1) moe1_unit(p, l, hf, tb, u, smem); else moe2_unit(p, l, hf, tb, u, smem); }
    } else if (PH == PH_POST2 || PH == PH_POST3) {
        const int lo = half_lo(l, hf), n = (half_hi(l, hf) - lo) / 16;
        for (int u = B; u < n; u += G) { if (PH == PH_POST2) rowpost_unit<2>(p, l, hf, lo + u * 16, smem); else rowpost_unit<3>(p, l, hf, lo + u * 16, smem); }
    }
}

#ifndef MULTI_LAUNCH
#define MULTI_LAUNCH 0
#endif
static_assert(XCD_BAR_WORDS * 4 <= 16 * 1024, "barrier words fit their region");
__global__ void __launch_bounds__(NTHR, 2) k_mega(Params p) {
    extern __shared__ __attribute__((aligned(16))) char smem[];
    uint4* xbw = (uint4*)(smem + MAX_LDS - 16);
    if (threadIdx.x == 0) *xbw = make_uint4(0u, 0u, 0u, 0u);
    __syncthreads();
    XcdBarrier bar = xcd_barrier_post((unsigned*)(p.ws + OFF_BAR), (volatile LAS unsigned*)xbw);
    run_phase<PH_PRO>(p, 0, 0, smem);
    xcd_barrier(bar);
    run_phase<PH_PRE0>(p, 0, 0, smem);
    xcd_barrier(bar);
#pragma unroll 1
    for (int l = 0; l < 2; ++l) {
        if (l == 1) run_phase<PH_CONVEXP>(p, 1, 0, smem);
        run_phase<PH_INPROJ>(p, l, 0, smem);
        xcd_barrier(bar);
        run_phase<PH_PREP>(p, l, 0, smem);
        xcd_barrier(bar);
        run_phase<PH_MIX>(p, l, 0, smem);
        xcd_barrier(bar);
        run_phase<PH_OUTPROJ>(p, l, 0, smem);
        xcd_barrier(bar);
        run_phase<PH_POST1>(p, l, 0, smem);
        xcd_barrier(bar);
        run_phase<PH_MOE1>(p, l, 0, smem);
        xcd_barrier(bar);
        run_phase<PH_MOE2>(p, l, 0, smem);
        xcd_barrier(bar);
        if (l == 0) run_phase<PH_POST2>(p, l, 0, smem); else run_phase<PH_POST3>(p, l, 0, smem);
        run_phase<PH_MOE1>(p, l, 1, smem);
        xcd_barrier(bar);
        run_phase<PH_MOE2>(p, l, 1, smem);
        xcd_barrier(bar);
        if (l == 0) { run_phase<PH_POST2>(p, l, 1, smem); xcd_barrier(bar); } else run_phase<PH_POST3>(p, l, 1, smem);
    }
}

#if MULTI_LAUNCH
template <int PH>
__global__ void __launch_bounds__(NTHR, 2) k_phase(Params p, int l, int hf) {
    extern __shared__ __attribute__((aligned(16))) char smem[];
    run_phase<PH>(p, l, hf, smem);
}
template <int PH>
static void launch_phase(const Params& p, int l, int hf, int grid, hipStream_t st) {
    static bool inited = false;
    if (!inited) { (void)hipFuncSetAttribute((const void*)k_phase<PH>, hipFuncAttributeMaxDynamicSharedMemorySize, MAX_LDS); inited = true; }
    k_phase<PH><<<grid, NTHR, MAX_LDS, st>>>(p, l, hf);
}
#endif

extern "C" void kernel_launch(void* const* d_in, const int* in_sizes, int n_in, void* d_out, int out_size, void* d_ws, size_t ws_size, hipStream_t stream) {
    if (ws_size < WS_NEED || n_in < 36) return;
    Params p{};
    for (int i = 0; i < 36; ++i) p.in[i] = (const float*)d_in[i];
    p.out = (float*)d_out; p.ws = (char*)d_ws;
    (void)hipMemsetAsync(d_ws, 0, ZERO_BYTES, stream);
#if MULTI_LAUNCH
    const int G = 256;
    launch_phase<PH_PRO>(p, 0, 0, G, stream);
    launch_phase<PH_PRE0>(p, 0, 0, G, stream);
    for (int l = 0; l < 2; ++l) {
        if (l == 1) launch_phase<PH_CONVEXP>(p, 1, 0, G, stream);
        launch_phase<PH_INPROJ>(p, l, 0, G, stream);
        launch_phase<PH_PREP>(p, l, 0, G, stream);
        launch_phase<PH_MIX>(p, l, 0, G, stream);
        launch_phase<PH_OUTPROJ>(p, l, 0, G, stream);
        launch_phase<PH_POST1>(p, l, 0, G, stream);
        for (int hf = 0; hf < 2; ++hf) {
            launch_phase<PH_MOE1>(p, l, hf, G, stream);
            launch_phase<PH_MOE2>(p, l, hf, G, stream);
            if (l == 0) launch_phase<PH_POST2>(p, l, hf, G, stream); else launch_phase<PH_POST3>(p, l, hf, G, stream);
        }
    }
#else
    static int grid = 0;
    if (!grid) {
        int dev = 0, cus = 0, per_cu = 0;
        (void)hipGetDevice(&dev);
        (void)hipDeviceGetAttribute(&cus, hipDeviceAttributeMultiprocessorCount, dev);
        (void)hipFuncSetAttribute((const void*)k_mega, hipFuncAttributeMaxDynamicSharedMemorySize, MAX_LDS);
        (void)hipOccupancyMaxActiveBlocksPerMultiprocessor(&per_cu, (const void*)k_mega, NTHR, MAX_LDS);
        grid = per_cu >= 1 ? cus : 0;
    }
    if (grid > 0) k_mega<<<grid, NTHR, MAX_LDS, stream>>>(p);
#endif
}
```

```cpp
#include <hip/hip_runtime.h>
#include <stdint.h>

#define DI __device__ __forceinline__
typedef unsigned short bf16_t;
typedef short bf16x8 __attribute__((ext_vector_type(8)));
typedef short s16x4 __attribute__((ext_vector_type(4)));
typedef float f32x4 __attribute__((ext_vector_type(4)));
typedef float f32x16 __attribute__((ext_vector_type(16)));
typedef unsigned u32x4 __attribute__((ext_vector_type(4)));

constexpr int NTHR = 512;
constexpr int DM = 1024, NB = 4, SEQ = 4096, CTXL = 256;
constexpr int NCTX = NB * CTXL, NLAT = NB * SEQ, NTOK = NCTX + NLAT;
constexpr int INP = 2312, INPP = 2560;
constexpr int CA_Q = 0, CA_K = 256, CA_V = 384, CB_Z = 512, CB_X = 768, CB_B = 1024, CB_C = 1152, CB_DTF = 1280, CB_DTB = 1284,
              CC_X = 1288, CC_G = 1544, CD_Q = 1800, CD_K = 2056, CD_V = 2184;
constexpr int NCHK = 34;
constexpr int HCAP = 8704;
constexpr float EPS = 1e-6f;

constexpr size_t MB = 1024 * 1024;
constexpr size_t OFF_BAR = 0;
constexpr size_t OFF_CNT = 16 * 1024;
constexpr size_t OFF_MOD = 32 * 1024;
constexpr size_t ZERO_BYTES = 32 * 1024 + 2 * 5 * 6144 * 4;
constexpr size_t OFF_ROPE = 512 * 1024;
constexpr size_t OFF_SLOT_TOK = 2 * MB;
constexpr size_t OFF_SLOT_W = 7 * MB;
constexpr size_t OFF_TOKSLOT = 12 * MB;
constexpr size_t OFF_LRUC = 13 * MB;
constexpr size_t OFF_SSDDEC = 14 * MB;
constexpr size_t OFF_XCTX = 15 * MB;
constexpr size_t OFF_WIN = 20 * MB;
constexpr size_t SZ_WIN1 = (size_t)INPP * DM * 2;
constexpr size_t OFF_WOUT = OFF_WIN + 2 * SZ_WIN1;
constexpr size_t SZ_WOUT1 = (size_t)DM * DM * 2;
constexpr size_t OFF_WGU = 36 * MB;
constexpr size_t OFF_WD = OFF_WGU + (size_t)65 * 512 * 1024 * 2;
constexpr size_t OFF_Y = 140 * MB;
constexpr size_t OFF_RA = 210 * MB;
constexpr size_t OFF_HID = OFF_RA + (size_t)NTOK * DM * 2;
constexpr size_t OFF_RB = 296 * MB;
constexpr size_t OFF_RC = 332 * MB;
constexpr size_t OFF_QA = OFF_RC;
constexpr size_t OFF_KA = OFF_QA + (size_t)NTOK * 256 * 2;
constexpr size_t OFF_QD = OFF_KA + (size_t)NTOK * 128 * 2;
constexpr size_t OFF_KD = OFF_QD + (size_t)NTOK * 256 * 2;
constexpr size_t OFF_SSDST = OFF_KD + (size_t)NTOK * 128 * 2;
constexpr size_t OFF_YPART = OFF_SSDST + (size_t)4 * 4 * 2 * 34 * 4096 * 4;
constexpr size_t OFF_CC = OFF_YPART + (size_t)NTOK * 256 * 4;
constexpr size_t OFF_EA = OFF_CC + (size_t)NTOK * 128 * 4;
constexpr size_t OFF_LRUH = OFF_EA + (size_t)NTOK * 8 * 4;
constexpr size_t OFF_YE = OFF_RC;
constexpr size_t WS_NEED = OFF_RC + (size_t)8 * HCAP * 1024 * 2 + MB;

struct Params {
    const float* in[36];
    float* out;
    char* ws;
};
enum { I_X = 0, I_C, I_CTX, I_CCTX, I_WADA, I_BADA, I_GMIXPRE, I_GMIXPOST, I_GFFNPRE, I_GFFNPOST, I_WIN, I_WOUT, I_ASINK, I_SSDCW, I_SSDCB, I_SSDDTB, I_SSDALOG,
       I_SSDD, I_SSDNORM, I_LRUCW, I_LRUCB, I_LRUWA, I_LRUBA, I_LRUWI, I_LRUBI, I_LRULAM, I_DQN, I_DKN, I_RW, I_RB, I_EG, I_EU, I_ED, I_SG, I_SU, I_SD };

DI int tidx() { int t = threadIdx.x; asm volatile("" : "+v"(t)); return t; }
DI float bf2f(bf16_t v) { return __uint_as_float(((unsigned)v) << 16); }
DI bf16_t f2bf(float f) { unsigned u = __float_as_uint(f); u += 0x7fffu + ((u >> 16) & 1u); return (bf16_t)(u >> 16); }
DI unsigned pack2(float lo, float hi) { return (unsigned)f2bf(lo) | ((unsigned)f2bf(hi) << 16); }
DI float wave_sum(float v) {
#pragma unroll
    for (int o = 32; o > 0; o >>= 1) v += __shfl_xor(v, o);
    return v;
}
DI float sigmoid_(float x) { return 1.f / (1.f + __expf(-x)); }
DI float silu_(float x) { return x / (1.f + __expf(-x)); }
DI float softplus_(float x) { return x > 20.f ? x : log1pf(__expf(x)); }
DI float gelu_tanh_(float x) { const float u = 0.7978845608028654f * (x + 0.044715f * x * x * x); return 0.5f * x * (1.f + tanhf(u)); }
DI int crow(int reg, int h) { return (reg & 3) + 8 * (reg >> 2) + 4 * h; }

DI const float* xrow_c(const Params& p, int r) { return r < NCTX ? (const float*)(p.ws + OFF_XCTX) + (size_t)r * DM : p.out + (size_t)(r - NCTX) * DM; }
DI float* xrow(const Params& p, int r) { return r < NCTX ? (float*)(p.ws + OFF_XCTX) + (size_t)r * DM : p.out + (size_t)(r - NCTX) * DM; }
DI const float* xin_row(const Params& p, int r) { return r < NCTX ? p.in[I_CTX] + (size_t)r * DM : p.in[I_X] + (size_t)(r - NCTX) * DM; }
DI int mod_idx(int r) { return r < NCTX ? 4 : ((r - NCTX) >> 12); }
DI const float* modp(const Params& p, int l, int bidx, int k) { return (const float*)(p.ws + OFF_MOD) + ((size_t)(l * 5 + bidx) * 6 + k) * DM; }
DI int half_lo(int l, int hf) { return hf == 0 ? (l == 0 ? 0 : NCTX) : (l == 0 ? 8704 : 9216); }
DI int half_hi(int l, int hf) { return hf == 0 ? (l == 0 ? 8704 : 9216) : NTOK; }

DI void transpose_tile(const float* __restrict__ src, int ld, int N, int k0, int n0, bf16_t* __restrict__ dst, int ldd, int mode, float* tile) {
    const int t = tidx();
    {
        const int col = t & 63, r8 = t >> 6;
#pragma unroll
        for (int i = 0; i < 8; ++i) { const int row = r8 + 8 * i; tile[row * 65 + col] = (n0 + col < N) ? src[(size_t)(k0 + row) * ld + n0 + col] : 0.f; }
    }
    __syncthreads();
    {
        const int n = t >> 3, kc = (t & 7) * 8;
        uint4 v;
        v.x = pack2(tile[(kc + 0) * 65 + n], tile[(kc + 1) * 65 + n]); v.y = pack2(tile[(kc + 2) * 65 + n], tile[(kc + 3) * 65 + n]);
        v.z = pack2(tile[(kc + 4) * 65 + n], tile[(kc + 5) * 65 + n]); v.w = pack2(tile[(kc + 6) * 65 + n], tile[(kc + 7) * 65 + n]);
        const int nn = n0 + n;
        int R = nn;
        if (mode) R = 256 * (nn >> 7) + (nn & 127) + (mode == 2 ? 128 : 0);
        *(uint4*)(dst + (size_t)R * ldd + k0 + kc) = v;
    }
    __syncthreads();
}
constexpr int CONV_UNITS_SMALL = 640 + 256, CONV_UNITS_EXP = 3 * 4160;
DI void convert_small_unit(const Params& p, int l, int u, char* smem) {
    float* tile = (float*)smem;
    if (u < 640) { const int kt = u / 40, nt = u % 40;
        transpose_tile(p.in[I_WIN] + (size_t)l * DM * INP, INP, INP, kt * 64, nt * 64, (bf16_t*)(p.ws + OFF_WIN + l * SZ_WIN1), DM, 0, tile); return; }
    u -= 640; { const int kt = u / 16, nt = u % 16;
        transpose_tile(p.in[I_WOUT] + (size_t)l * DM * DM, DM, DM, kt * 64, nt * 64, (bf16_t*)(p.ws + OFF_WOUT + l * SZ_WOUT1), DM, 0, tile); }
}
DI void convert_exp_unit(const Params& p, int l, int u, char* smem) {
    float* tile = (float*)smem;
    if (u < 2 * 4160) { const int up = u >= 4160; if (up) u -= 4160;
        const int e = u / 64, r = u % 64, kt = r / 4, nt = r % 4;
        const float* src = e < 64 ? p.in[up ? I_EU : I_EG] + ((size_t)l * 64 + e) * DM * 256 : p.in[up ? I_SU : I_SG] + (size_t)l * DM * 256;
        transpose_tile(src, 256, 256, kt * 64, nt * 64, (bf16_t*)(p.ws + OFF_WGU) + (size_t)e * 512 * 1024, 1024, up ? 2 : 1, tile); return; }
    u -= 2 * 4160; { const int e = u / 64, r = u % 64, kt = r / 16, nt = r % 16;
        const float* src = e < 64 ? p.in[I_ED] + ((size_t)l * 64 + e) * 256 * DM : p.in[I_SD] + (size_t)l * 256 * DM;
        transpose_tile(src, DM, DM, kt * 64, nt * 64, (bf16_t*)(p.ws + OFF_WD) + (size_t)e * 1024 * 256, 256, 0, tile); }
}
constexpr int MOD_UNITS = 2 * 96;
DI void mod_unit(const Params& p, int u, char* smem) {
    float* s = (float*)smem;
    float* part = s + 5 * 1024;
    const int l = u / 96, cb = u % 96, t = tidx(), col = t & 63, kg = t >> 6;
    for (int i = t; i < 5 * 1024; i += NTHR) { const int v = i >> 10, k = i & 1023; const float c = v < 4 ? p.in[I_C][v * DM + k] : p.in[I_CCTX][k]; s[i] = silu_(c); }
    __syncthreads();
    const int j = cb * 64 + col;
    const float* w = p.in[I_WADA] + (size_t)l * DM * 6144 + (size_t)(kg * 128) * 6144 + j;
    float a0 = 0, a1 = 0, a2 = 0, a3 = 0, a4 = 0;
#pragma unroll 16
    for (int k = 0; k < 128; ++k) { const float wv = w[(size_t)k * 6144]; const int kk = kg * 128 + k;
        a0 += s[kk] * wv; a1 += s[1024 + kk] * wv; a2 += s[2048 + kk] * wv; a3 += s[3072 + kk] * wv; a4 += s[4096 + kk] * wv; }
    part[(kg * 5 + 0) * 64 + col] = a0; part[(kg * 5 + 1) * 64 + col] = a1; part[(kg * 5 + 2) * 64 + col] = a2; part[(kg * 5 + 3) * 64 + col] = a3; part[(kg * 5 + 4) * 64 + col] = a4;
    __syncthreads();
    if (t < 320) { const int v = t >> 6, c = t & 63; float acc = p.in[I_BADA][l * 6144 + cb * 64 + c];
#pragma unroll
        for (int g = 0; g < 8; ++g) acc += part[(g * 5 + v) * 64 + c];
        ((float*)(p.ws + OFF_MOD))[(size_t)(l * 5 + v) * 6144 + cb * 64 + c] = acc; }
    __syncthreads();
}
constexpr int ROPE_UNITS = 4096 * 32 / NTHR;
DI void rope_unit(const Params& p, int u) {
    const int idx = u * NTHR + tidx(), t = idx >> 5, i = idx & 31;
    const float pos = (float)(i < 16 ? (t >> 6) : (t & 63));
    const float inv = powf(10000.f, -(float)(2 * (i & 15)) / 32.f);
    const float ang = pos * inv;
    ((float2*)(p.ws + OFF_ROPE))[idx] = make_float2(cosf(ang), sinf(ang));
}

constexpr int GEMM_LDS = 131072;
struct MoeTab { int cnt[65]; int mstart[66]; int hoffP[65]; int hoffU[65]; };
constexpr int HP = 1028;
template <int MODE>
DI void rowpost_unit(const Params& p, int l, int hf, int r0, char* smem) {
    float* hrow = (float*)smem;
    float* part = hrow + 16 * HP;
    const int* hoffU = ((const MoeTab*)(smem + GEMM_LDS))->hoffU;
    const int tid = tidx(), lane = tid & 63, w = tid >> 6;
#pragma unroll
    for (int rr = 0; rr < 2; ++rr) {
        const int r = r0 + 2 * w + rr;
        const int bidx = mod_idx(r);
        f32x4 xv[4];
        if (MODE == 0) {
            const float* xs = xin_row(p, r);
#pragma unroll
            for (int i = 0; i < 2; ++i) { xv[2 * i] = *(const f32x4*)(xs + 8 * lane + 512 * i); xv[2 * i + 1] = *(const f32x4*)(xs + 8 * lane + 512 * i + 4); }
        } else {
            f32x4 yv[4];
            const float* Y = (const float*)(p.ws + OFF_Y) + (size_t)r * DM;
            const float* xs = (MODE == 1 && l == 0) ? xin_row(p, r) : xrow_c(p, r);
            u32x4 q[8][2];
            if (MODE >= 2) {
                const int* ts = (const int*)(p.ws + OFF_TOKSLOT) + (size_t)r * 8;
                const int4 t0 = *(const int4*)ts, t1 = *(const int4*)(ts + 4);
                const int tv[8] = {t0.x, t0.y, t0.z, t0.w, t1.x, t1.y, t1.z, t1.w};
                const bf16_t* ye = (const bf16_t*)(p.ws + OFF_YE);
#pragma unroll
                for (int k = 0; k < 8; ++k) { const bf16_t* yr = ye + (size_t)(hoffU[tv[k] >> 14] + (tv[k] & 16383)) * DM + 8 * lane;
                    q[k][0] = *(const u32x4*)(yr); q[k][1] = *(const u32x4*)(yr + 512); }
            }
#pragma unroll
            for (int i = 0; i < 2; ++i) { yv[2 * i] = *(const f32x4*)(Y + 8 * lane + 512 * i); yv[2 * i + 1] = *(const f32x4*)(Y + 8 * lane + 512 * i + 4);
                xv[2 * i] = *(const f32x4*)(xs + 8 * lane + 512 * i); xv[2 * i + 1] = *(const f32x4*)(xs + 8 * lane + 512 * i + 4); }
            if (MODE >= 2) {
#pragma unroll
                for (int k = 0; k < 8; ++k)
#pragma unroll
                    for (int i = 0; i < 2; ++i) { const u32x4 v = q[k][i];
                        yv[2 * i][0] += __uint_as_float(v[0] << 16); yv[2 * i][1] += __uint_as_float(v[0] & 0xffff0000u); yv[2 * i][2] += __uint_as_float(v[1] << 16); yv[2 * i][3] += __uint_as_float(v[1] & 0xffff0000u);
                        yv[2 * i + 1][0] += __uint_as_float(v[2] << 16); yv[2 * i + 1][1] += __uint_as_float(v[2] & 0xffff0000u); yv[2 * i + 1][2] += __uint_as_float(v[3] << 16); yv[2 * i + 1][3] += __uint_as_float(v[3] & 0xffff0000u); }
            }
            float ss = 0.f;
#pragma unroll
            for (int i = 0; i < 4; ++i) ss += yv[i][0] * yv[i][0] + yv[i][1] * yv[i][1] + yv[i][2] * yv[i][2] + yv[i][3] * yv[i][3];
            ss = wave_sum(ss);
            const float rs = rsqrtf(ss * (1.f / DM) + EPS);
            const float* gate = modp(p, l, bidx, MODE == 1 ? 2 : 5);
            const float* gp = p.in[MODE == 1 ? I_GMIXPOST : I_GFFNPOST] + l * DM;
            float* xo = xrow(p, r);
#pragma unroll
            for (int i = 0; i < 4; ++i) { const int c = 8 * lane + 512 * (i >> 1) + 4 * (i & 1);
                const f32x4 g = *(const f32x4*)(gate + c), qq = *(const f32x4*)(gp + c);
                xv[i] = xv[i] + g * (yv[i] * rs * qq); *(f32x4*)(xo + c) = xv[i]; }
        }
        if (MODE != 3) {
            const int lp = MODE == 2 ? l + 1 : l;
            float ss = 0.f;
#pragma unroll
            for (int i = 0; i < 4; ++i) ss += xv[i][0] * xv[i][0] + xv[i][1] * xv[i][1] + xv[i][2] * xv[i][2] + xv[i][3] * xv[i][3];
            ss = wave_sum(ss);
            const float rs = rsqrtf(ss * (1.f / DM) + EPS);
            const float* gpre = p.in[MODE == 1 ? I_GFFNPRE : I_GMIXPRE] + lp * DM;
            const float* sh = modp(p, lp, bidx, MODE == 1 ? 3 : 0);
            const float* sc = modp(p, lp, bidx, MODE == 1 ? 4 : 1);
            bf16_t* hb = (bf16_t*)(p.ws + (MODE == 1 ? OFF_RA : OFF_RB)) + (size_t)r * DM;
#pragma unroll
            for (int i = 0; i < 2; ++i) { const int c = 8 * lane + 512 * i;
                f32x4 h[2];
#pragma unroll
                for (int j = 0; j < 2; ++j) { const f32x4 g = *(const f32x4*)(gpre + c + 4 * j), s1 = *(const f32x4*)(sh + c + 4 * j), s2 = *(const f32x4*)(sc + c + 4 * j);
                    h[j] = xv[2 * i + j] * rs * g * (s2 + 1.f) + s1;
                    if (MODE == 1) *(f32x4*)(hrow + (2 * w + rr) * HP + c + 4 * j) = h[j]; }
                u32x4 o; o[0] = pack2(h[0][0], h[0][1]); o[1] = pack2(h[0][2], h[0][3]); o[2] = pack2(h[1][0], h[1][1]); o[3] = pack2(h[1][2], h[1][3]);
                *(u32x4*)(hb + c) = o; }
        }
    }
    if (MODE == 1) {
        __syncthreads();
        {
            const float* rw = p.in[I_RW] + (size_t)l * DM * 64;
            const int i16 = lane & 15, kq = lane >> 4;
            f32x4 acc[4];
#pragma unroll
            for (int n = 0; n < 4; ++n) acc[n] = (f32x4){0.f, 0.f, 0.f, 0.f};
#pragma unroll 4
            for (int ks = 0; ks < 32; ++ks) { const int k = 128 * w + 4 * ks + kq;
                const float a = hrow[i16 * HP + k];
#pragma unroll
                for (int n = 0; n < 4; ++n) acc[n] = __builtin_amdgcn_mfma_f32_16x16x4f32(a, rw[k * 64 + n * 16 + i16], acc[n], 0, 0, 0); }
#pragma unroll
            for (int n = 0; n < 4; ++n)
#pragma unroll
                for (int j = 0; j < 4; ++j) part[(w * 16 + kq * 4 + j) * 64 + n * 16 + i16] = acc[n][j];
        }
        __syncthreads();
        const float rbias = p.in[I_RB][l * 64 + lane];
#pragma unroll 1
        for (int rr = 0; rr < 2; ++rr) {
            const int r = r0 + 2 * w + rr;
            float lg = 0.f;
#pragma unroll
            for (int g = 0; g < 8; ++g) lg += part[(g * 16 + 2 * w + rr) * 64 + lane];
            const float s = sigmoid_(lg);
            const float v = s + rbias;
            float m1 = v;
            m1 = fmaxf(m1, __shfl_xor(m1, 1)); m1 = fmaxf(m1, __shfl_xor(m1, 2)); m1 = fmaxf(m1, __shfl_xor(m1, 4));
            int ix = (v == m1) ? lane : 64;
            ix = min(ix, __shfl_xor(ix, 1)); ix = min(ix, __shfl_xor(ix, 2)); ix = min(ix, __shfl_xor(ix, 4));
            float m2 = (lane == ix) ? -INFINITY : v;
            m2 = fmaxf(m2, __shfl_xor(m2, 1)); m2 = fmaxf(m2, __shfl_xor(m2, 2)); m2 = fmaxf(m2, __shfl_xor(m2, 4));
            const float gs = m1 + m2;
            const int g = lane >> 3; int grank = 0;
#pragma unroll
            for (int gg = 0; gg < 8; ++gg) { const float o = __shfl(gs, gg * 8); grank += (o > gs) || (o == gs && gg < g); }
            const bool gsel = grank < 4;
            const float vm = gsel ? v : -INFINITY;
            int rk = 0;
#pragma unroll 8
            for (int ee = 0; ee < 64; ++ee) { const float o = __shfl(vm, ee); rk += (o > vm) || (o == vm && ee < lane); }
            const bool sel = gsel && rk < 8;
            const float scs = sel ? s : 0.f;
            const float tot = wave_sum(scs);
            const float wgt = scs / tot * 2.5f;
            if (sel) {
                const int h = r >= half_lo(l, 1) ? 1 : 0;
                int* cnt = (int*)(p.ws + OFF_CNT) + (l * 2 + h) * 64;
                const int pos = atomicAdd(cnt + lane, 1);
                ((int*)(p.ws + OFF_SLOT_TOK))[(size_t)(h * 64 + lane) * HCAP + pos] = r;
                ((float*)(p.ws + OFF_SLOT_W))[(size_t)(h * 64 + lane) * HCAP + pos] = wgt;
                ((int*)(p.ws + OFF_TOKSLOT))[(size_t)r * 8 + rk] = (lane << 14) | pos;
            }
        }
    }
    __syncthreads();
}

#define G8_LAS __attribute__((address_space(3)))
constexpr int LDT = 72;
constexpr int G8_HTB = 128 * 64 * 2;
static_assert(GEMM_LDS == 8 * G8_HTB, "stage region");
DI int g8_lds_byte(int r, int c) { const int st = (r >> 4) * 2 + (c >> 5), rr = r & 15, cc = c & 31, ob = rr * 64 + cc * 2; return st * 1024 + (ob ^ (((ob >> 9) & 1) << 5)); }
DI void g8_stage_rc(int b, int& R, int& C) { const int st = b / 1024, sb = b % 1024, swz = sb ^ (((sb >> 9) & 1) << 5); R = (st >> 1) * 16 + swz / 64; C = (st & 1) * 32 + (swz % 64) / 2; }
DI int g8_perm32(int rho) { const int n = rho >> 4, i = rho & 15; return 8 * (i >> 2) + 4 * n + (i & 3); }
template <bool PERM, class Sched>
DI void gemm8(char* smem, const char* Abase, int K, Sched& S) {
    G8_LAS unsigned char* lds = (G8_LAS unsigned char*)smem;
    const int tid = tidx(), wid = __builtin_amdgcn_readfirstlane(tid >> 6), lane = tid & 63, wr = wid >> 2, wc = wid & 3, fr = lane & 15, fq = lane >> 4;
    const int nt = K / 64;
    unsigned voffB[2];
#pragma unroll
    for (int i = 0; i < 2; ++i) { int R, C; g8_stage_rc(tid * 16 + i * 8192, R, C); const int Rb = PERM ? ((R & ~31) + g8_perm32(R & 31)) : R; voffB[i] = (unsigned)(Rb * K + C) * 2u; }
    const size_t kstep = 128, hstep = (size_t)128 * K * 2;
    const unsigned ldsw = (unsigned)wid * 1024u;
    const int aoff = g8_lds_byte(wr * 64 + fr, fq * 8), boff = g8_lds_byte(wc * 32 + fr, fq * 8);
#define G8_SA(b, h) (((b) * 2 + (h)) * G8_HTB)
#define G8_SB(b, h) ((4 + (b) * 2 + (h)) * G8_HTB)
#define G8_STAGEB(bufoff, gbase) do { _Pragma("unroll") for (int _i = 0; _i < 2; ++_i) \
        __builtin_amdgcn_global_load_lds((const unsigned*)((const char*)(gbase) + voffB[_i]), (G8_LAS unsigned*)(lds + (bufoff) + ldsw + _i * 8192), 16, 0, 0); } while (0)
#define G8_STAGEA(bufoff, ao, h, kb) do { _Pragma("unroll") for (int _i = 0; _i < 2; ++_i) \
        __builtin_amdgcn_global_load_lds((const unsigned*)(Abase + (size_t)(ao)[h][_i] + (kb)), (G8_LAS unsigned*)(lds + (bufoff) + ldsw + _i * 8192), 16, 0, 0); } while (0)
#define G8_LDA(dst, b, h) do { _Pragma("unroll") for (int m = 0; m < 4; ++m) _Pragma("unroll") for (int k = 0; k < 2; ++k) dst[m][k] = *(const G8_LAS bf16x8*)(lds + G8_SA(b, h) + aoff + m * 2048 + k * 1024); } while (0)
#define G8_LDB(dst, b, h) do { _Pragma("unroll") for (int n = 0; n < 2; ++n) _Pragma("unroll") for (int k = 0; k < 2; ++k) dst[n][k] = *(const G8_LAS bf16x8*)(lds + G8_SB(b, h) + boff + n * 2048 + k * 1024); } while (0)
#define G8_MMA(ai, bj, At, Bt) do { __builtin_amdgcn_s_setprio(1); _Pragma("unroll") for (int m = 0; m < 4; ++m) _Pragma("unroll") for (int n = 0; n < 2; ++n) _Pragma("unroll") for (int k = 0; k < 2; ++k) \
        acc[ai][bj][m][n] = __builtin_amdgcn_mfma_f32_16x16x32_bf16(Bt[n][k], At[m][k], acc[ai][bj][m][n], 0, 0, 0); __builtin_amdgcn_s_setprio(0); } while (0)
#define G8_WAIT_V(n) asm volatile("s_waitcnt vmcnt(" #n ")" ::: "memory")
#define G8_WAIT_L(n) asm volatile("s_waitcnt lgkmcnt(" #n ")" ::: "memory")
#define G8_BAR __builtin_amdgcn_s_barrier()
#define G8_SCHED __builtin_amdgcn_sched_barrier(0)
    typename Sched::U cur, nxt; int ui = 0;
    if (!S.next(0, cur)) return;
    f32x4 acc[2][2][4][2];
#pragma unroll
    for (int a = 0; a < 2; ++a)
#pragma unroll
        for (int b = 0; b < 2; ++b)
#pragma unroll
            for (int m = 0; m < 4; ++m)
#pragma unroll
                for (int n = 0; n < 2; ++n) acc[a][b][m][n] = (f32x4){0.f, 0.f, 0.f, 0.f};
    bf16x8 At[4][2], B0[2][2], B1[2][2];
    unsigned cao[2][2];
    S.aoffs(cur, cao);
    const char* cB = S.bbase(cur);
    G8_STAGEB(G8_SB(0, 0), cB); G8_STAGEA(G8_SA(0, 0), cao, 0, 0); G8_STAGEB(G8_SB(0, 1), cB + hstep); G8_STAGEA(G8_SA(0, 1), cao, 1, 0);
    if (wr == 1) G8_BAR;
    G8_WAIT_V(4); G8_BAR;
    G8_STAGEB(G8_SB(1, 0), cB + kstep); G8_STAGEA(G8_SA(1, 0), cao, 0, kstep); G8_STAGEB(G8_SB(1, 1), cB + hstep + kstep);
    G8_WAIT_V(6); G8_BAR;
    for (;;) {
        const bool has_next = S.next(ui + 1, nxt);
        const char* nB = cB;
#pragma unroll 1
        for (int t = 0; t < nt; t += 2) {
            const bool last = (t == nt - 2);
            if (last && has_next) nB = S.bbase(nxt);
            const size_t k1 = (size_t)(t + 1) * kstep;
            const size_t k2 = last ? 0 : (size_t)(t + 2) * kstep, k3 = k2 + kstep;
            const char* b2 = last ? nB : cB + k2; const char* b3 = b2 + kstep;
            G8_LDB(B0, 0, 0); G8_SCHED; G8_LDA(At, 0, 0); G8_STAGEA(G8_SA(1, 1), cao, 1, k1);
            if (last && has_next) S.aoffs(nxt, cao);
            G8_WAIT_L(8); G8_BAR; G8_WAIT_L(0); G8_MMA(0, 0, At, B0); G8_BAR; G8_SCHED;
            G8_LDB(B1, 0, 1); G8_STAGEB(G8_SB(0, 0), b2);
            G8_BAR; G8_WAIT_L(0); G8_MMA(0, 1, At, B1); G8_BAR;
            G8_LDA(At, 0, 1); G8_STAGEA(G8_SA(0, 0), cao, 0, k2);
            G8_BAR; G8_WAIT_L(0); G8_MMA(1, 0, At, B0); G8_BAR; G8_SCHED;
            G8_STAGEB(G8_SB(0, 1), b2 + hstep);
            G8_WAIT_V(6); G8_BAR; G8_MMA(1, 1, At, B1); G8_BAR;
            G8_LDB(B0, 1, 0); G8_SCHED; G8_LDA(At, 1, 0); G8_STAGEA(G8_SA(0, 1), cao, 1, k2);
            G8_WAIT_L(8); G8_BAR; G8_WAIT_L(0); G8_MMA(0, 0, At, B0); G8_BAR; G8_SCHED;
            G8_LDB(B1, 1, 1); G8_STAGEB(G8_SB(1, 0), b3);
            G8_BAR; G8_WAIT_L(0); G8_MMA(0, 1, At, B1); G8_BAR;
            G8_LDA(At, 1, 1); G8_STAGEA(G8_SA(1, 0), cao, 0, k3);
            G8_BAR; G8_WAIT_L(0); G8_MMA(1, 0, At, B0); G8_BAR; G8_SCHED;
            G8_STAGEB(G8_SB(1, 1), b3 + hstep);
            G8_WAIT_V(6); G8_BAR; G8_MMA(1, 1, At, B1); G8_BAR;
        }
        S.epi(acc, cur, wr, wc, fr, fq);
        if (!has_next) break;
#pragma unroll
        for (int a = 0; a < 2; ++a)
#pragma unroll
            for (int b = 0; b < 2; ++b)
#pragma unroll
                for (int m = 0; m < 4; ++m)
#pragma unroll
                    for (int n = 0; n < 2; ++n) acc[a][b][m][n] = (f32x4){0.f, 0.f, 0.f, 0.f};
        cur = nxt; cB = nB; ++ui;
    }
    G8_WAIT_V(0);
    if (wr == 0) G8_BAR;
    G8_BAR;
#undef G8_SA
#undef G8_SB
#undef G8_STAGEA
#undef G8_STAGEB
#undef G8_LDA
#undef G8_LDB
#undef G8_MMA
#undef G8_WAIT_V
#undef G8_WAIT_L
#undef G8_BAR
#undef G8_SCHED
}
DI bool g8_static(int i, int nM, int nN, int& pm, int& pn) {
    const int G = gridDim.x, nwg = nM * nN; const long L = (long)i * G + blockIdx.x; if (L >= nwg) return false;
    int wgid = (int)L; { const int q = nwg / 8, r = nwg % 8, xcd = wgid % 8, off = wgid / 8; wgid = (xcd < r ? xcd * (q + 1) : r * (q + 1) + (xcd - r) * q) + off; }
    const int nig = 8 * nN, gid = wgid / nig, fm = gid * 8, gsz = (nM - fm) < 8 ? (nM - fm) : 8;
    pm = fm + ((wgid % nig) % gsz); pn = (wgid % nig) / gsz; return true;
}
DI int g8_xcd_linear(int i, int n) {
    const long L = (long)i * gridDim.x + blockIdx.x; if (L >= n) return -1;
    const int q = n / 8, r = n % 8, xcd = (int)(L % 8), off = (int)(L / 8);
    return (xcd < r ? xcd * (q + 1) : r * (q + 1) + (xcd - r) * q) + off;
}
DI void g8_store_bf16(bf16_t* rowp, const f32x4& a, const f32x4& b) { u32x4 o; o[0] = pack2(a[0], a[1]); o[1] = pack2(a[2], a[3]); o[2] = pack2(b[0], b[1]); o[3] = pack2(b[2], b[3]); *(u32x4*)rowp = o; }

struct InprojS {
    struct U { int pm, pn; };
    const Params& p; int l;
    DI bool next(int i, U& u) const { return g8_static(i, NTOK / 256, INPP / 256, u.pm, u.pn); }
    DI void aoffs(const U& u, unsigned (&ao)[2][2]) const { int R[2], C[2]; { const int t_ = tidx(); g8_stage_rc(t_ * 16, R[0], C[0]); g8_stage_rc(t_ * 16 + 8192, R[1], C[1]); }
#pragma unroll
        for (int h = 0; h < 2; ++h)
#pragma unroll
            for (int i = 0; i < 2; ++i) ao[h][i] = (unsigned)((u.pm * 256 + h * 128 + R[i]) * DM + C[i]) * 2u; }
    DI const char* bbase(const U& u) const { return p.ws + OFF_WIN + l * SZ_WIN1 + (size_t)u.pn * 256 * DM * 2; }
    DI void epi(const f32x4 (&acc)[2][2][4][2], const U& u, int wr, int wc, int fr, int fq) const {
        bf16_t* C = (bf16_t*)(p.ws + OFF_RA) + (size_t)(u.pm * 256 + wr * 64 + fr) * INPP + u.pn * 256 + wc * 32 + 8 * fq;
#pragma unroll
        for (int ai = 0; ai < 2; ++ai)
#pragma unroll
            for (int m = 0; m < 4; ++m)
#pragma unroll
                for (int bj = 0; bj < 2; ++bj) g8_store_bf16(C + (size_t)(ai * 128 + m * 16) * INPP + bj * 128, acc[ai][bj][m][0], acc[ai][bj][m][1]);
    }
};
struct OutprojS {
    struct U { int pm, pn; };
    const Params& p; int l;
    DI bool next(int i, U& u) const { return g8_static(i, l == 0 ? 68 : 64, 4, u.pm, u.pn); }
    DI void aoffs(const U& u, unsigned (&ao)[2][2]) const { int R[2], C[2]; { const int t_ = tidx(); g8_stage_rc(t_ * 16, R[0], C[0]); g8_stage_rc(t_ * 16 + 8192, R[1], C[1]); }
        const int row0 = (l == 0 ? 0 : NCTX) + u.pm * 256;
#pragma unroll
        for (int h = 0; h < 2; ++h)
#pragma unroll
            for (int i = 0; i < 2; ++i) ao[h][i] = (unsigned)((row0 + h * 128 + R[i]) * DM + C[i]) * 2u; }
    DI const char* bbase(const U& u) const { return p.ws + OFF_WOUT + l * SZ_WOUT1 + (size_t)u.pn * 256 * DM * 2; }
    DI void epi(const f32x4 (&acc)[2][2][4][2], const U& u, int wr, int wc, int fr, int fq) const {
        const int row0 = (l == 0 ? 0 : NCTX) + u.pm * 256;
        float* C = (float*)(p.ws + OFF_Y) + (size_t)(row0 + wr * 64 + fr) * DM + u.pn * 256 + wc * 32 + 4 * fq;
#pragma unroll
        for (int ai = 0; ai < 2; ++ai)
#pragma unroll
            for (int m = 0; m < 4; ++m)
#pragma unroll
                for (int bj = 0; bj < 2; ++bj)
#pragma unroll
                    for (int n = 0; n < 2; ++n) *(f32x4*)(C + (size_t)(ai * 128 + m * 16) * DM + bj * 128 + n * 16) = acc[ai][bj][m][n];
    }
};
DI void moe_table(const Params& p, int l, int hf, MoeTab* tb) {
    const int tid = tidx();
    if (tid < 64) {
        const int c = ((const int*)(p.ws + OFF_CNT))[(l * 2 + hf) * 64 + tid];
        const int mt = (c + 255) >> 8;
        int ms = mt, hu = c;
#pragma unroll
        for (int o = 1; o < 64; o <<= 1) { const int a = __shfl_up(ms, o), b = __shfl_up(hu, o); if (tid >= o) { ms += a; hu += b; } }
        tb->cnt[tid] = c; tb->mstart[tid] = ms - mt; tb->hoffP[tid] = (ms - mt) * 256; tb->hoffU[tid] = hu - c;
        if (tid == 63) { const int cs = half_hi(l, hf) - half_lo(l, hf); tb->cnt[64] = cs; tb->mstart[64] = ms; tb->hoffP[64] = ms * 256; tb->hoffU[64] = hu; tb->mstart[65] = ms + ((cs + 255) >> 8); }
    }
    __syncthreads();
}
DI void moe_find(const MoeTab* tb, int g, int& e, int& mt) { int lo = 0; while (tb->mstart[lo + 1] <= g) ++lo; e = lo; mt = g - tb->mstart[lo]; }
struct Moe1S {
    struct U { int e, mt, pn, cnt, hrow0; };
    const Params& p; int l, hf; const MoeTab* tb;
    DI bool next(int i, U& u) const { const int g2 = g8_xcd_linear(i, tb->mstart[65] * 2); if (g2 < 0) return false;
        int e, mt; moe_find(tb, g2 >> 1, e, mt); e = __builtin_amdgcn_readfirstlane(e); mt = __builtin_amdgcn_readfirstlane(mt); u.e = e; u.mt = mt; u.pn = g2 & 1; u.cnt = __builtin_amdgcn_readfirstlane(tb->cnt[e]); u.hrow0 = __builtin_amdgcn_readfirstlane(tb->hoffP[e]) + mt * 256; return true; }
    DI void aoffs(const U& u, unsigned (&ao)[2][2]) const { int R[2], C[2]; { const int t_ = tidx(); g8_stage_rc(t_ * 16, R[0], C[0]); g8_stage_rc(t_ * 16 + 8192, R[1], C[1]); }
        const int* stok = (const int*)(p.ws + OFF_SLOT_TOK) + (size_t)(hf * 64 + (u.e & 63)) * HCAP; const int lo = half_lo(l, hf);
#pragma unroll
        for (int h = 0; h < 2; ++h)
#pragma unroll
            for (int i = 0; i < 2; ++i) { int pos = u.mt * 256 + h * 128 + R[i]; pos = pos < u.cnt ? pos : u.cnt - 1; const int tok = u.e < 64 ? stok[pos] : lo + pos;
                ao[h][i] = (unsigned)(tok * DM + C[i]) * 2u; } }
    DI const char* bbase(const U& u) const { return p.ws + OFF_WGU + ((size_t)u.e * 512 + u.pn * 256) * 1024 * 2; }
    DI void epi(const f32x4 (&acc)[2][2][4][2], const U& u, int wr, int wc, int fr, int fq) const {
        bf16_t* H = (bf16_t*)(p.ws + OFF_HID) + (size_t)(u.hrow0 + wr * 64 + fr) * 256 + u.pn * 128 + wc * 32 + 8 * fq;
#pragma unroll
        for (int ai = 0; ai < 2; ++ai)
#pragma unroll
            for (int m = 0; m < 4; ++m) { f32x4 o[2];
#pragma unroll
                for (int n = 0; n < 2; ++n) { const f32x4 gt = acc[ai][0][m][n], up = acc[ai][1][m][n]; o[n] = (f32x4){silu_(gt[0]) * up[0], silu_(gt[1]) * up[1], silu_(gt[2]) * up[2], silu_(gt[3]) * up[3]}; }
                g8_store_bf16(H + (size_t)(ai * 128 + m * 16) * 256, o[0], o[1]); }
    }
};
struct Moe2S {
    struct U { int e, mt, pn, cnt, hrow0, yrow0; };
    const Params& p; int l, hf; const MoeTab* tb;
    DI bool next(int i, U& u) const { const int g4 = g8_xcd_linear(i, tb->mstart[65] * 4); if (g4 < 0) return false;
        int e, mt; moe_find(tb, g4 >> 2, e, mt); e = __builtin_amdgcn_readfirstlane(e); mt = __builtin_amdgcn_readfirstlane(mt); u.e = e; u.mt = mt; u.pn = g4 & 3; u.cnt = __builtin_amdgcn_readfirstlane(tb->cnt[e]); u.hrow0 = __builtin_amdgcn_readfirstlane(tb->hoffP[e]) + mt * 256; u.yrow0 = __builtin_amdgcn_readfirstlane(tb->hoffU[e]) + mt * 256; return true; }
    DI void aoffs(const U& u, unsigned (&ao)[2][2]) const { int R[2], C[2]; { const int t_ = tidx(); g8_stage_rc(t_ * 16, R[0], C[0]); g8_stage_rc(t_ * 16 + 8192, R[1], C[1]); }
#pragma unroll
        for (int h = 0; h < 2; ++h)
#pragma unroll
            for (int i = 0; i < 2; ++i) ao[h][i] = (unsigned)((u.hrow0 + h * 128 + R[i]) * 256 + C[i]) * 2u; }
    DI const char* bbase(const U& u) const { return p.ws + OFF_WD + ((size_t)u.e * 1024 + u.pn * 256) * 256 * 2; }
    DI void epi(const f32x4 (&acc)[2][2][4][2], const U& u, int wr, int wc, int fr, int fq) const {
        const float* sw = (const float*)(p.ws + OFF_SLOT_W) + (size_t)(hf * 64 + (u.e & 63)) * HCAP;
        const int colb = u.pn * 256 + wc * 32 + 8 * fq;
#pragma unroll
        for (int ai = 0; ai < 2; ++ai)
#pragma unroll
            for (int m = 0; m < 4; ++m) { const int row = ai * 128 + wr * 64 + m * 16 + fr, pos = u.mt * 256 + row;
                if (pos < u.cnt) {
                    if (u.e < 64) { const float wv = sw[pos]; bf16_t* yr = (bf16_t*)(p.ws + OFF_YE) + (size_t)(u.yrow0 + row) * DM + colb;
#pragma unroll
                        for (int bj = 0; bj < 2; ++bj) g8_store_bf16(yr + bj * 128, acc[ai][bj][m][0] * wv, acc[ai][bj][m][1] * wv);
                    } else { float* yr = (float*)(p.ws + OFF_Y) + (size_t)(half_lo(l, hf) + pos) * DM + colb;
#pragma unroll
                        for (int bj = 0; bj < 2; ++bj) { *(f32x4*)(yr + bj * 128) = acc[ai][bj][m][0]; *(f32x4*)(yr + bj * 128 + 4) = acc[ai][bj][m][1]; } } } }
    }
};

constexpr int PREP_UNITS = NTOK / 8;
DI void rope2(float& a, float& b, const float2 cs) { const float x1 = a, x2 = b; a = x1 * cs.x - x2 * cs.y; b = x1 * cs.y + x2 * cs.x; }
DI void prep_unit(const Params& p, int l, int u) {
    const int tid = tidx(), lane = tid & 63, w = tid >> 6, r = u * 8 + w;
    const bool lat = r >= NCTX; const int pos = (r - NCTX) & (SEQ - 1);
    const bf16_t* pr = (const bf16_t*)(p.ws + OFF_RA) + (size_t)r * INPP;
    const float2* rt = (const float2*)(p.ws + OFF_ROPE) + (size_t)pos * 32;
    const float* gq = p.in[I_DQN] + l * 64; const float* gk = p.in[I_DKN] + l * 64;
    unsigned* QA = (unsigned*)(p.ws + OFF_QA) + (size_t)r * 128; unsigned* KA = (unsigned*)(p.ws + OFF_KA) + (size_t)r * 64;
    unsigned* QD = (unsigned*)(p.ws + OFF_QD) + (size_t)r * 128; unsigned* KD = (unsigned*)(p.ws + OFF_KD) + (size_t)r * 64;
#pragma unroll
    for (int i = 0; i < 2; ++i) {
        const int pq = lane + 64 * i, pi = pq & 31;
        const float2 cs = lat ? rt[pi] : make_float2(1.f, 0.f);
        { const unsigned v = *(const unsigned*)(pr + CA_Q + 2 * pq); float a = __uint_as_float(v << 16), b = __uint_as_float(v & 0xffff0000u);
          rope2(a, b, cs); QA[pq] = pack2(a * 0.125f, b * 0.125f); }
        { const unsigned v = *(const unsigned*)(pr + CD_Q + 2 * pq); float a = __uint_as_float(v << 16), b = __uint_as_float(v & 0xffff0000u);
          float ss = a * a + b * b;
#pragma unroll
          for (int o = 1; o < 32; o <<= 1) ss += __shfl_xor(ss, o);
          const float rs = rsqrtf(ss * (1.f / 64.f) + EPS);
          a = a * rs * gq[2 * pi]; b = b * rs * gq[2 * pi + 1];
          rope2(a, b, cs); QD[pq] = pack2(a * 0.125f, b * 0.125f); }
    }
    {
        const int pi = lane & 31;
        const float2 cs = lat ? rt[pi] : make_float2(1.f, 0.f);
        { const unsigned v = *(const unsigned*)(pr + CA_K + 2 * lane); float a = __uint_as_float(v << 16), b = __uint_as_float(v & 0xffff0000u);
          rope2(a, b, cs); KA[lane] = pack2(a, b); }
        { const unsigned v = *(const unsigned*)(pr + CD_K + 2 * lane); float a = __uint_as_float(v << 16), b = __uint_as_float(v & 0xffff0000u);
          float ss = a * a + b * b;
#pragma unroll
          for (int o = 1; o < 32; o <<= 1) ss += __shfl_xor(ss, o);
          const float rs = rsqrtf(ss * (1.f / 64.f) + EPS);
          a = a * rs * gk[2 * pi]; b = b * rs * gk[2 * pi + 1];
          rope2(a, b, cs); KD[lane] = pack2(a, b); }
    }
}

constexpr int ATT_LDS = 2 * 2 * 64 * LDT * 2;
struct AttnArgs {
    const bf16_t* Q; const bf16_t* K; const bf16_t* V;
    int qrow0;
    int g;
    int k0row, k0tiles;
    int k1row, k1t0, k1t1;
    int qpos0;
    const float* sink;
    bf16_t* O;
};
DI void attn_unit(const AttnArgs& a, char* smem) {
    const int tid = tidx(), lane = tid & 63, w = tid >> 6, r32 = lane & 31, hi = lane >> 5;
    const int head = 2 * a.g + (w >> 2), qoff = (w & 3) * 32 + r32;
    bf16_t* Ks = (bf16_t*)smem;
    bf16_t* Vs = Ks + 2 * 64 * LDT;
    bf16x8 qr[4];
    { const bf16_t* qp = a.Q + (size_t)(a.qrow0 + qoff) * 256 + head * 64 + hi * 8;
#pragma unroll
      for (int d0 = 0; d0 < 4; ++d0) qr[d0] = *(const bf16x8*)(qp + d0 * 16); }
    float m_run, l_run;
    if (a.sink) { m_run = a.sink[head]; l_run = hi == 0 ? 1.f : 0.f; } else { m_run = -1e30f; l_run = 0.f; }
    f32x16 o0, o1;
#pragma unroll
    for (int i = 0; i < 16; ++i) { o0[i] = 0.f; o1[i] = 0.f; }
    const int nt = a.k0tiles + (a.k1t1 - a.k1t0);
    const int lrow = tid >> 3, lc = (tid & 7) * 8;
    auto tile_row0 = [&](int t) { return t < a.k0tiles ? a.k0row + t * 64 : a.k1row + (a.k1t0 + t - a.k0tiles) * 64; };
    u32x4 rk, rv;
    { const int kr = tile_row0(0) + lrow; rk = *(const u32x4*)(a.K + (size_t)kr * 128 + a.g * 64 + lc); rv = *(const u32x4*)(a.V + (size_t)kr * INPP + a.g * 64 + lc); }
    *(u32x4*)(Ks + lrow * LDT + lc) = rk; *(u32x4*)(Vs + lrow * LDT + lc) = rv;
    __syncthreads();
    const int q4 = (lane & 15) >> 2, p4 = lane & 3, blk = (lane >> 4) & 1;
#pragma unroll 1
    for (int t = 0; t < nt; ++t) {
        const bool more = t + 1 < nt;
        if (more) { const int kr = tile_row0(t + 1) + lrow; rk = *(const u32x4*)(a.K + (size_t)kr * 128 + a.g * 64 + lc); rv = *(const u32x4*)(a.V + (size_t)kr * INPP + a.g * 64 + lc); }
        const bf16_t* Kc = Ks + (t & 1) * 64 * LDT;
        const bf16_t* Vc = Vs + (t & 1) * 64 * LDT;
        f32x16 s0, s1;
#pragma unroll
        for (int i = 0; i < 16; ++i) { s0[i] = 0.f; s1[i] = 0.f; }
#pragma unroll
        for (int d0 = 0; d0 < 4; ++d0) {
            const bf16x8 k0 = *(const bf16x8*)(Kc + r32 * LDT + d0 * 16 + hi * 8);
            const bf16x8 k1 = *(const bf16x8*)(Kc + (32 + r32) * LDT + d0 * 16 + hi * 8);
            s0 = __builtin_amdgcn_mfma_f32_32x32x16_bf16(k0, qr[d0], s0, 0, 0, 0);
            s1 = __builtin_amdgcn_mfma_f32_32x32x16_bf16(k1, qr[d0], s1, 0, 0, 0);
        }
        if (a.qpos0 >= 0 && t >= a.k0tiles) {
            const int kb = (a.k1t0 + t - a.k0tiles) * 64, qp = a.qpos0 + qoff;
#pragma unroll
            for (int i = 0; i < 16; ++i) { const int kp = kb + crow(i, hi); int d = kp - qp; d = d < 0 ? -d : d; if (d > 128) s0[i] = -1e30f; d = kp + 32 - qp; d = d < 0 ? -d : d; if (d > 128) s1[i] = -1e30f; }
        }
        float mx = s0[0];
#pragma unroll
        for (int i = 1; i < 16; ++i) mx = fmaxf(mx, s0[i]);
#pragma unroll
        for (int i = 0; i < 16; ++i) mx = fmaxf(mx, s1[i]);
        mx = fmaxf(mx, __shfl_xor(mx, 32));
        const float m_new = fmaxf(m_run, mx);
        const float alpha = __expf(m_run - m_new);
        m_run = m_new;
        float ps = 0.f;
#pragma unroll
        for (int i = 0; i < 16; ++i) { s0[i] = __expf(s0[i] - m_new); s1[i] = __expf(s1[i] - m_new); ps += s0[i] + s1[i]; }
        l_run = l_run * alpha + ps;
#pragma unroll
        for (int i = 0; i < 16; ++i) { o0[i] *= alpha; o1[i] *= alpha; }
#pragma unroll
        for (int ks = 0; ks < 4; ++ks) {
            bf16x8 pf;
            {
                union { unsigned u[4]; bf16x8 v; } pk;
#pragma unroll
                for (int j = 0; j < 4; ++j) { const int rg = (ks & 1) * 8 + 2 * j; pk.u[j] = (ks < 2) ? pack2(s0[rg], s0[rg + 1]) : pack2(s1[rg], s1[rg + 1]); }
                pf = pk.v;
            }
#pragma unroll
            for (int ds = 0; ds < 2; ++ds) {
                const bf16_t* vp = Vc + (16 * ks + 4 * hi + q4) * LDT + 32 * ds + 16 * blk + 4 * p4;
                const s16x4 lo = __builtin_bit_cast(s16x4, __builtin_amdgcn_ds_read_tr16_b64_v4i16((__attribute__((address_space(3))) s16x4*)(vp)));
                const s16x4 hh = __builtin_bit_cast(s16x4, __builtin_amdgcn_ds_read_tr16_b64_v4i16((__attribute__((address_space(3))) s16x4*)(vp + 8 * LDT)));
                const bf16x8 vf = (bf16x8){lo[0], lo[1], lo[2], lo[3], hh[0], hh[1], hh[2], hh[3]};
                if (ds == 0) o0 = __builtin_amdgcn_mfma_f32_32x32x16_bf16(vf, pf, o0, 0, 0, 0);
                else o1 = __builtin_amdgcn_mfma_f32_32x32x16_bf16(vf, pf, o1, 0, 0, 0);
            }
        }
        if (more) { bf16_t* Kn = Ks + ((t + 1) & 1) * 64 * LDT; bf16_t* Vn = Vs + ((t + 1) & 1) * 64 * LDT; *(u32x4*)(Kn + lrow * LDT + lc) = rk; *(u32x4*)(Vn + lrow * LDT + lc) = rv; }
        __syncthreads();
    }
    l_run += __shfl_xor(l_run, 32);
    const float inv = 1.f / l_run;
    bf16_t* op = a.O + (size_t)(a.qrow0 + qoff) * DM + head * 64;
#pragma unroll
    for (int g4 = 0; g4 < 4; ++g4) {
        uint2 q; q.x = pack2(o0[4 * g4] * inv, o0[4 * g4 + 1] * inv); q.y = pack2(o0[4 * g4 + 2] * inv, o0[4 * g4 + 3] * inv);
        *(uint2*)(op + 8 * g4 + 4 * hi) = q;
        q.x = pack2(o1[4 * g4] * inv, o1[4 * g4 + 1] * inv); q.y = pack2(o1[4 * g4 + 2] * inv, o1[4 * g4 + 3] * inv);
        *(uint2*)(op + 32 + 8 * g4 + 4 * hi) = q;
    }
}
DI int attn_units(int l) { return l == 0 ? 544 : 512; }
DI void attn_dispatch(const Params& p, int l, int u, char* smem) {
    AttnArgs a;
    const bf16_t* proj = (const bf16_t*)(p.ws + OFF_RA);
    bf16_t* mix = (bf16_t*)(p.ws + OFF_RB);
    int type, b, g, tb;
    if (u < 512) { type = u >> 8; const int v = u & 255; b = v >> 6; g = (v >> 5) & 1; tb = v & 31; }
    else { const int v = u - 512; type = 2 + (v >> 4); b = (v >> 2) & 3; g = (v >> 1) & 1; tb = v & 1; }
    const bool isA = (type & 1);
    a.Q = (const bf16_t*)(p.ws + (isA ? OFF_QA : OFF_QD)); a.K = (const bf16_t*)(p.ws + (isA ? OFF_KA : OFF_KD)); a.V = proj + (isA ? CA_V : CD_V);
    a.g = g; a.sink = isA ? p.in[I_ASINK] + l * 4 : nullptr; a.O = mix + (isA ? 0 : 768);
    a.k0row = b * CTXL; a.k0tiles = 4; a.k1row = NCTX + b * SEQ; a.qpos0 = -1;
    if (type < 2) {
        a.qrow0 = NCTX + b * SEQ + tb * 128;
        if (isA) { a.qpos0 = tb * 128; int t0 = 2 * tb - 2, t1 = 2 * tb + 4; a.k1t0 = t0 < 0 ? 0 : t0; a.k1t1 = t1 > 64 ? 64 : t1; }
        else { a.k1t0 = 0; a.k1t1 = 64; }
    } else { a.qrow0 = b * CTXL + tb * 128; a.k1t0 = 0; a.k1t1 = 0; }
    attn_unit(a, smem);
}

DI int blk_row0(int b, int cb) { return cb < 2 ? b * CTXL + cb * 128 : NCTX + b * SEQ + (cb - 2) * 128; }
DI int bwd_seq(int cb) { return cb < 2 ? 1 - cb : 35 - cb; }
constexpr int SSD_LDS = (128 * 64 + 2 * 128 * 65 + 64 * 129 + 6 * 128) * 4;
DI int ssd_chunk_units() { return NB * NCHK * 4; }
DI void ssd_chunk_unit(const Params& p, int l, int u, char* smem) {
    const int tid = tidx();
    const int h = u & 3, cb = (u >> 2) % NCHK, b = (u >> 2) / NCHK, grp = h >> 1;
    const int row0 = blk_row0(b, cb);
    const int part0 = cb < 2 ? b * CTXL : NCTX + b * SEQ, partN = cb < 2 ? CTXL : SEQ;
    float* xs = (float*)smem;
    float* Bs = xs + 128 * 64;
    float* Cs = Bs + 128 * 65;
    float* Ws = Cs + 128 * 65;
    float* dtf = Ws + 64 * 129;
    float* dtb = dtf + 128; float* Af = dtb + 128; float* Ab = Af + 128; float* wef = Ab + 128; float* web = wef + 128;
    const bf16_t* proj = (const bf16_t*)(p.ws + OFF_RA);
    const float* cw = p.in[I_SSDCW] + l * 4 * 512; const float* cbias = p.in[I_SSDCB] + l * 512;
    const float aneg_f = -__expf(p.in[I_SSDALOG][l * 8 + h]), aneg_b = -__expf(p.in[I_SSDALOG][l * 8 + 4 + h]);
    for (int idx = tid; idx < 128 * 192; idx += NTHR) {
        const int i = idx / 192, cc = idx % 192;
        const int which = cc >> 6, c64 = cc & 63;
        const int ch = which == 0 ? h * 64 + c64 : (which == 1 ? 256 + grp * 64 + c64 : 384 + grp * 64 + c64);
        const int col = CB_X + ch;
        float acc = cbias[ch];
#pragma unroll
        for (int j = 0; j < 4; ++j) { const int rr = row0 + i + j - 2; if (rr >= part0 && rr < part0 + partN) acc += cw[j * 512 + ch] * bf2f(proj[(size_t)rr * INPP + col]); }
        const float v = silu_(acc);
        if (which == 0) xs[i * 64 + c64] = v; else if (which == 1) Bs[i * 65 + c64] = v; else Cs[i * 65 + c64] = v;
    }
    if (tid < 256) { const int i = tid & 127, d = tid >> 7;
        const float raw = bf2f(proj[(size_t)(row0 + i) * INPP + (d ? CB_DTB : CB_DTF) + h]);
        const float v = softplus_(raw + p.in[I_SSDDTB][l * 8 + d * 4 + h]);
        (d ? dtb : dtf)[i] = v; }
    __syncthreads();
    if (tid < 128) {
        const int ln = tid & 63, bw = tid >> 6;
        const int i0 = bw ? 127 - 2 * ln : 2 * ln, i1 = bw ? 126 - 2 * ln : 2 * ln + 1;
        const float* dt = bw ? dtb : dtf; const float an = bw ? aneg_b : aneg_f;
        const float v0 = dt[i0] * an, v1 = dt[i1] * an;
        float sc = v0 + v1;
#pragma unroll
        for (int o = 1; o < 64; o <<= 1) { const float a = __shfl_up(sc, o); if (ln >= o) sc += a; }
        float* A = bw ? Ab : Af;
        A[i1] = sc; A[i0] = sc - v1;
    }
    __syncthreads();
    if (tid < 128) { wef[tid] = __expf(Af[127] - Af[tid]) * dtf[tid]; web[tid] = __expf(Ab[0] - Ab[tid]) * dtb[tid]; }
    if ((h & 1) == 0) { float* CC = (float*)(p.ws + OFF_CC);
        for (int idx = tid; idx < 128 * 64; idx += NTHR) { const int i = idx >> 6, n = idx & 63; CC[(size_t)(row0 + i) * 128 + grp * 64 + n] = Cs[i * 65 + n]; } }
    if (tid < 128) { float* EA = (float*)(p.ws + OFF_EA) + (size_t)(row0 + tid) * 8; EA[h] = __expf(Af[tid]); EA[4 + h] = __expf(Ab[tid]); }
    __syncthreads();
    {
        const int d = tid >> 8, pg = (tid >> 4) & 15, ng = tid & 15;
        const float* we = d ? web : wef;
        float acc[4][4];
#pragma unroll
        for (int a = 0; a < 4; ++a)
#pragma unroll
            for (int c = 0; c < 4; ++c) acc[a][c] = 0.f;
#pragma unroll 2
        for (int j = 0; j < 128; ++j) {
            const float wj = we[j];
            const f32x4 xv = *(const f32x4*)(xs + j * 64 + 4 * pg);
            float bv[4];
#pragma unroll
            for (int c = 0; c < 4; ++c) bv[c] = Bs[j * 65 + 4 * ng + c];
#pragma unroll
            for (int a = 0; a < 4; ++a) { const float xw = xv[a] * wj;
#pragma unroll
                for (int c = 0; c < 4; ++c) acc[a][c] += xw * bv[c]; }
        }
        const int s = d ? bwd_seq(cb) : cb;
        float* ST = (float*)(p.ws + OFF_SSDST) + ((size_t)((b * 4 + h) * 2 + d) * NCHK + s) * 4096;
#pragma unroll
        for (int a = 0; a < 4; ++a) *(f32x4*)(ST + (4 * pg + a) * 64 + 4 * ng) = (f32x4){acc[a][0], acc[a][1], acc[a][2], acc[a][3]};
        if ((tid & 255) == 0) ((float*)(p.ws + OFF_SSDDEC))[((b * 4 + h) * 2 + d) * NCHK + s] = d ? __expf(Ab[0]) : __expf(Af[127]);
    }
    const float dsk = p.in[I_SSDD][l * 4 + h];
    float* YP = (float*)(p.ws + OFF_YPART);
#pragma unroll 1
    for (int hb = 0; hb < 2; ++hb) {
        __syncthreads();
        {
            const int ig = tid >> 5, jg = tid & 31;
            float acc[4][4];
#pragma unroll
            for (int a = 0; a < 4; ++a)
#pragma unroll
                for (int c = 0; c < 4; ++c) acc[a][c] = 0.f;
#pragma unroll 4
            for (int n = 0; n < 64; ++n) {
                float cv[4], bv[4];
#pragma unroll
                for (int a = 0; a < 4; ++a) cv[a] = Cs[(64 * hb + ig + 16 * a) * 65 + n];
#pragma unroll
                for (int c = 0; c < 4; ++c) bv[c] = Bs[(jg + 32 * c) * 65 + n];
#pragma unroll
                for (int a = 0; a < 4; ++a)
#pragma unroll
                    for (int c = 0; c < 4; ++c) acc[a][c] += cv[a] * bv[c];
            }
#pragma unroll
            for (int a = 0; a < 4; ++a)
#pragma unroll
                for (int c = 0; c < 4; ++c) { const int il = ig + 16 * a, i = 64 * hb + il, j = jg + 32 * c;
                    float wgt = 0.f;
                    if (j <= i) wgt += __expf(Af[i] - Af[j]) * dtf[j];
                    if (j >= i) wgt += __expf(Ab[i] - Ab[j]) * dtb[j];
                    Ws[il * 129 + j] = acc[a][c] * wgt; }
        }
        __syncthreads();
        {
            const int ig = tid >> 4, pg = tid & 15;
            float acc[2][4];
#pragma unroll
            for (int a = 0; a < 2; ++a)
#pragma unroll
                for (int c = 0; c < 4; ++c) acc[a][c] = 0.f;
#pragma unroll 4
            for (int j = 0; j < 128; ++j) {
                const f32x4 xv = *(const f32x4*)(xs + j * 64 + 4 * pg);
                const float w0 = Ws[ig * 129 + j], w1 = Ws[(ig + 32) * 129 + j];
#pragma unroll
                for (int c = 0; c < 4; ++c) { acc[0][c] += w0 * xv[c]; acc[1][c] += w1 * xv[c]; }
            }
#pragma unroll
            for (int a = 0; a < 2; ++a) { const int i = 64 * hb + ig + 32 * a;
                const f32x4 xv = *(const f32x4*)(xs + i * 64 + 4 * pg);
                *(f32x4*)(YP + (size_t)(row0 + i) * 256 + h * 64 + 4 * pg) = (f32x4){acc[a][0] + dsk * xv[0], acc[a][1] + dsk * xv[1], acc[a][2] + dsk * xv[2], acc[a][3] + dsk * xv[3]}; }
        }
    }
    __syncthreads();
}
constexpr int SSDF_LDS = (2 * 64 * 65 + 128 * 65 + 128) * 4 + 128 * 256 * 2;
DI int ssd_fin_units(int l) { return NB * (l == 0 ? NCHK : NCHK - 2); }
DI void ssd_fin_unit(const Params& p, int l, int u, char* smem) {
    const int tid = tidx();
    const int nper = l == 0 ? NCHK : NCHK - 2;
    const int b = u / nper, cb = u % nper + (l == 0 ? 0 : 2);
    const int row0 = blk_row0(b, cb);
    float* stf = (float*)smem;
    float* stb = stf + 64 * 65;
    float* Cc = stb + 64 * 65;
    float* ssq = Cc + 128 * 65;
    bf16_t* ybuf = (bf16_t*)(ssq + 128);
    const bf16_t* proj = (const bf16_t*)(p.ws + OFF_RA);
    if (tid < 128) ssq[tid] = 0.f;
#pragma unroll 1
    for (int h = 0; h < 4; ++h) {
        __syncthreads();
        {
            const int d = tid >> 8, e = tid & 255;
            const int s = d ? bwd_seq(cb) : cb;
            const float* ST = (const float*)(p.ws + OFF_SSDST) + (size_t)((b * 4 + h) * 2 + d) * NCHK * 4096;
            const float* DEC = (const float*)(p.ws + OFF_SSDDEC) + ((b * 4 + h) * 2 + d) * NCHK;
            float st[16];
#pragma unroll
            for (int k = 0; k < 16; ++k) st[k] = 0.f;
#pragma unroll 4
            for (int sp = 0; sp < s; ++sp) { const float dc = DEC[sp];
#pragma unroll
                for (int k = 0; k < 16; ++k) st[k] = st[k] * dc + ST[(size_t)sp * 4096 + e + 256 * k]; }
            float* dst = d ? stb : stf;
#pragma unroll
            for (int k = 0; k < 16; ++k) { const int idx = e + 256 * k; dst[(idx >> 6) * 65 + (idx & 63)] = st[k]; }
        }
        if ((h & 1) == 0) { const float* CC = (const float*)(p.ws + OFF_CC);
            for (int idx = tid; idx < 128 * 64; idx += NTHR) { const int i = idx >> 6, n = idx & 63; Cc[i * 65 + n] = CC[(size_t)(row0 + i) * 128 + (h >> 1) * 64 + n]; } }
        __syncthreads();
        {
            const int ig = tid >> 4, pg = tid & 15;
            float af[4][4], ab[4][4];
#pragma unroll
            for (int a = 0; a < 4; ++a)
#pragma unroll
                for (int c = 0; c < 4; ++c) { af[a][c] = 0.f; ab[a][c] = 0.f; }
#pragma unroll 4
            for (int n = 0; n < 64; ++n) {
                float cv[4], sf[4], sb[4];
#pragma unroll
                for (int a = 0; a < 4; ++a) cv[a] = Cc[(ig + 32 * a) * 65 + n];
#pragma unroll
                for (int c = 0; c < 4; ++c) { sf[c] = stf[(pg + 16 * c) * 65 + n]; sb[c] = stb[(pg + 16 * c) * 65 + n]; }
#pragma unroll
                for (int a = 0; a < 4; ++a)
#pragma unroll
                    for (int c = 0; c < 4; ++c) { af[a][c] += cv[a] * sf[c]; ab[a][c] += cv[a] * sb[c]; }
            }
            const float* YP = (const float*)(p.ws + OFF_YPART);
            const float* EA = (const float*)(p.ws + OFF_EA);
#pragma unroll
            for (int a = 0; a < 4; ++a) { const int i = ig + 32 * a, r = row0 + i;
                const float ef = EA[(size_t)r * 8 + h], eb = EA[(size_t)r * 8 + 4 + h];
                float sq = 0.f;
#pragma unroll
                for (int c = 0; c < 4; ++c) { const int pp = pg + 16 * c;
                    const float y = YP[(size_t)r * 256 + h * 64 + pp] + ef * af[a][c] + eb * ab[a][c];
                    const float z = bf2f(proj[(size_t)r * INPP + CB_Z + h * 64 + pp]);
                    const float yg = y * silu_(z);
                    ybuf[i * 256 + h * 64 + pp] = f2bf(yg); sq += yg * yg; }
                sq += __shfl_xor(sq, 1); sq += __shfl_xor(sq, 2); sq += __shfl_xor(sq, 4); sq += __shfl_xor(sq, 8);
                if (pg == 0) ssq[i] += sq; }
        }
    }
    __syncthreads();
    {
        const float* gn = p.in[I_SSDNORM] + l * 256;
        bf16_t* mix = (bf16_t*)(p.ws + OFF_RB);
        for (int idx = tid; idx < 128 * 128; idx += NTHR) { const int i = idx >> 7, c2 = (idx & 127) * 2;
            const float rs = rsqrtf(ssq[i] * (1.f / 256.f) + EPS);
            const float a = bf2f(ybuf[i * 256 + c2]) * rs * gn[c2], bb = bf2f(ybuf[i * 256 + c2 + 1]) * rs * gn[c2 + 1];
            *(unsigned*)(mix + (size_t)(row0 + i) * DM + 256 + c2) = pack2(a, bb); }
    }
    __syncthreads();
}

constexpr int LRU_LDS = (128 * 65 + 4 * 64 * 64 + 2 * 8 * 64 * 2) * 4;
DI int lru_chunk_units() { return NB * NCHK * 4; }
DI void lru_chunk_unit(const Params& p, int l, int u, char* smem) {
    const int tid = tidx();
    const int kb = u & 3, cb = (u >> 2) % NCHK, b = (u >> 2) / NCHK;
    const int row0 = blk_row0(b, cb);
    const int part0 = cb < 2 ? b * CTXL : NCTX + b * SEQ, partN = cb < 2 ? CTXL : SEQ;
    float* us = (float*)smem;
    float* Wl = us + 128 * 65;
    float* segA = Wl + 4 * 64 * 64;
    float* segH = segA + 8 * 64;
    const bf16_t* proj = (const bf16_t*)(p.ws + OFF_RA);
    const float* cw = p.in[I_LRUCW] + l * 4 * 256; const float* cbias = p.in[I_LRUCB] + l * 256;
    for (int idx = tid; idx < 128 * 64; idx += NTHR) { const int i = idx >> 6, c = idx & 63, ch = kb * 64 + c;
        float acc = cbias[ch];
#pragma unroll
        for (int j = 0; j < 4; ++j) { const int rr = row0 + i + j - 2; if (rr >= part0 && rr < part0 + partN) acc += cw[j * 256 + ch] * bf2f(proj[(size_t)rr * INPP + CC_X + ch]); }
        us[i * 65 + c] = acc; }
    for (int idx = tid; idx < 4 * 4096; idx += NTHR) { const int g = idx >> 12, e = idx & 4095, d = g >> 1;
        const float* src = p.in[(g & 1) ? I_LRUWI : I_LRUWA] + ((size_t)((l * 2 + d) * 4 + kb)) * 4096;
        Wl[idx] = src[e]; }
    __syncthreads();
    const int tg = tid >> 4, cg = tid & 15;
    float acc[4][4][4];
#pragma unroll
    for (int g = 0; g < 4; ++g)
#pragma unroll
        for (int a = 0; a < 4; ++a)
#pragma unroll
            for (int c = 0; c < 4; ++c) acc[g][a][c] = 0.f;
#pragma unroll 2
    for (int i = 0; i < 64; ++i) {
        float uv[4];
#pragma unroll
        for (int a = 0; a < 4; ++a) uv[a] = us[(4 * tg + a) * 65 + i];
#pragma unroll
        for (int g = 0; g < 4; ++g) { const f32x4 wv = *(const f32x4*)(Wl + g * 4096 + i * 64 + 4 * cg);
#pragma unroll
            for (int a = 0; a < 4; ++a)
#pragma unroll
                for (int c = 0; c < 4; ++c) acc[g][a][c] += uv[a] * wv[c]; }
    }
    __syncthreads();
    float* aL = Wl; float* xL = Wl + 128 * 64;
    bf16_t* HB = (bf16_t*)(p.ws + OFF_LRUH);
    float* LC = (float*)(p.ws + OFF_LRUC);
#pragma unroll
    for (int d = 0; d < 2; ++d) {
#pragma unroll
        for (int c = 0; c < 4; ++c) { const int ch = kb * 64 + 4 * cg + c;
            const float ba = p.in[I_LRUBA][(l * 2 + d) * 256 + ch], bi = p.in[I_LRUBI][(l * 2 + d) * 256 + ch];
            const float spl = softplus_(-p.in[I_LRULAM][(l * 2 + d) * 256 + ch]);
#pragma unroll
            for (int a = 0; a < 4; ++a) { const int i = 4 * tg + a;
                const float rg = sigmoid_(acc[2 * d][a][c] + ba), ig = sigmoid_(acc[2 * d + 1][a][c] + bi);
                const float la = -8.f * rg * spl;
                const float av = __expf(la);
                const float mult = sqrtf(fmaxf(0.f, -expm1f(2.f * la)));
                aL[i * 64 + 4 * cg + c] = av; xL[i * 64 + 4 * cg + c] = mult * ig * us[i * 65 + 4 * cg + c]; }
        }
        __syncthreads();
        const int ch = tid & 63, sg = tid >> 6;
        float hacc = 0.f, pacc = 1.f;
#pragma unroll 1
        for (int t = 0; t < 16; ++t) { const int tau = sg * 16 + t, i = d ? 127 - tau : tau;
            const float av = aL[i * 64 + ch]; hacc = av * hacc + xL[i * 64 + ch]; pacc *= av; xL[i * 64 + ch] = hacc; aL[i * 64 + ch] = pacc; }
        segA[sg * 64 + ch] = pacc; segH[sg * 64 + ch] = hacc;
        __syncthreads();
        float carry = 0.f, cp = 1.f;
        for (int s2 = 0; s2 < sg; ++s2) { carry = carry * segA[s2 * 64 + ch] + segH[s2 * 64 + ch]; cp *= segA[s2 * 64 + ch]; }
        bf16_t* Hh = HB + (size_t)(2 * d) * NTOK * 256; bf16_t* Hp = HB + (size_t)(2 * d + 1) * NTOK * 256;
        float hl = 0.f, pl = 1.f;
#pragma unroll 1
        for (int t = 0; t < 16; ++t) { const int tau = sg * 16 + t, i = d ? 127 - tau : tau;
            hl = xL[i * 64 + ch] + aL[i * 64 + ch] * carry; pl = aL[i * 64 + ch] * cp;
            Hh[(size_t)(row0 + i) * 256 + kb * 64 + ch] = f2bf(hl); Hp[(size_t)(row0 + i) * 256 + kb * 64 + ch] = f2bf(pl); }
        if (sg == 7) { const int s = d ? bwd_seq(cb) : cb; const size_t o = ((size_t)(b * 2 + d) * NCHK + s) * 256 + kb * 64 + ch;
            LC[o] = hl; LC[(size_t)NB * 2 * NCHK * 256 + o] = pl; }
        __syncthreads();
    }
}
DI int lru_fin_units(int l) { return NB * (l == 0 ? NCHK : NCHK - 2); }
DI void lru_fin_unit(const Params& p, int l, int u, char* smem) {
    const int tid = tidx();
    const int nper = l == 0 ? NCHK : NCHK - 2;
    const int b = u / nper, cb = u % nper + (l == 0 ? 0 : 2);
    const int row0 = blk_row0(b, cb);
    float* car = (float*)smem;
    { const int d = tid >> 8, ch = tid & 255, s = d ? bwd_seq(cb) : cb;
      const float* LH = (const float*)(p.ws + OFF_LRUC) + (size_t)(b * 2 + d) * NCHK * 256 + ch; const float* LA = LH + (size_t)NB * 2 * NCHK * 256;
      float c = 0.f;
#pragma unroll 8
      for (int sp = 0; sp < s; ++sp) c = c * LA[sp * 256] + LH[sp * 256];
      car[tid] = c; }
    __syncthreads();
    const bf16_t* HB = (const bf16_t*)(p.ws + OFF_LRUH);
    const bf16_t* proj = (const bf16_t*)(p.ws + OFF_RA);
    bf16_t* mix = (bf16_t*)(p.ws + OFF_RB);
    for (int idx = tid; idx < 128 * 128; idx += NTHR) { const int i = idx >> 7, c2 = (idx & 127) * 2; const size_t o = (size_t)(row0 + i) * 256 + c2;
        float out[2];
#pragma unroll
        for (int q = 0; q < 2; ++q) {
            const float hf = bf2f(HB[o + q]), pf = bf2f(HB[(size_t)NTOK * 256 + o + q]), hb = bf2f(HB[(size_t)2 * NTOK * 256 + o + q]), pb = bf2f(HB[(size_t)3 * NTOK * 256 + o + q]);
            const float g = bf2f(proj[(size_t)(row0 + i) * INPP + CC_G + c2 + q]);
            out[q] = (hf + pf * car[c2 + q] + hb + pb * car[256 + c2 + q]) * gelu_tanh_(g); }
        *(unsigned*)(mix + (size_t)(row0 + i) * DM + 512 + c2) = pack2(out[0], out[1]); }
    __syncthreads();
}

#define XB_TMO      128
#define XB_XCNT(j)  (256  + 64 * (j))
#define XB_XSUB(j)  (1280 + 64 * (j))
#define XB_XGEN(j)  (2304 + 64 * (j))
#define XB_TOP      3328
#define XB_TOPGEN   3392
#define XCD_BAR_WORDS 3456
#define XB_SPIN_CAP (1u << 18)
#define LAS __attribute__((address_space(3)))

__device__ __forceinline__ unsigned xb_ld(unsigned* p)              { return __hip_atomic_load(p, __ATOMIC_RELAXED, __HIP_MEMORY_SCOPE_AGENT); }
__device__ __forceinline__ unsigned xb_add(unsigned* p, unsigned v) { return __hip_atomic_fetch_add(p, v, __ATOMIC_RELAXED, __HIP_MEMORY_SCOPE_AGENT); }
__device__ __forceinline__ unsigned xb_xcc_id() { return (unsigned)__builtin_amdgcn_s_getreg((3 << 11) | 20) & 0xFu; }
#define XB_SPIN(cond, bar) do { unsigned _sp = 0; while (cond) { __builtin_amdgcn_s_sleep(1); \
    if ((++_sp & 255u) == 0u) { if (xb_ld(&(bar)[XB_TMO])) break; if (_sp > XB_SPIN_CAP) { atomicAdd(&(bar)[XB_TMO], 1u); break; } } } } while (0)

struct XcdBarrier {
    unsigned* bar; unsigned x;
    volatile LAS unsigned* st;
};

__device__ __forceinline__ XcdBarrier xcd_barrier_post(unsigned* bar, volatile LAS unsigned* st) {
    XcdBarrier b; b.bar = bar; b.x = xb_xcc_id(); b.st = st;
    if (threadIdx.x == 0) (void)xb_add(&bar[XB_XCNT(b.x)], 1u);
    return b;
}
__device__ __forceinline__ void xcd_barrier_complete(unsigned* bar, unsigned x, unsigned& nloc, unsigned& nx) {
    const unsigned G = gridDim.x * gridDim.y * gridDim.z;
    unsigned sum, cnt, mine, sp = 0u;
    for (;;) {
        sum = 0u; cnt = 0u; mine = 0u;
#pragma unroll
        for (unsigned j = 0; j < 16; ++j) { const unsigned c = xb_ld(&bar[XB_XCNT(j)]); sum += c; cnt += (c > 0u) ? 1u : 0u; mine = (j == x) ? c : mine; }
        if (sum == G) break;
        __builtin_amdgcn_s_sleep(1);
        if ((++sp & 255u) == 0u) { if (xb_ld(&bar[XB_TMO])) break; if (sp > XB_SPIN_CAP) { atomicAdd(&bar[XB_TMO], 1u); break; } }
    }
    nloc = mine > 0u ? mine : 1u; nx = cnt > 0u ? cnt : 1u;
}

__device__ __forceinline__ void xcd_barrier(const XcdBarrier& b) {
    asm volatile("s_waitcnt vmcnt(0)" ::: "memory");
    __syncthreads();
    if (threadIdx.x == 0) {
        unsigned* bar = b.bar;
        __builtin_amdgcn_s_waitcnt(0);
        unsigned nloc = b.st[0], nx = b.st[1];
        if (nloc == 0u) { xcd_barrier_complete(bar, b.x, nloc, nx); b.st[0] = nloc; b.st[1] = nx; }
        const unsigned old = xb_add(&bar[XB_XSUB(b.x)], 1u);
        const unsigned gen = old / nloc;
        if (old + 1u == (gen + 1u) * nloc) {
            __builtin_amdgcn_fence(__ATOMIC_RELEASE, "agent");
            asm volatile("s_waitcnt vmcnt(0)" ::: "memory");
            const unsigned og = xb_add(&bar[XB_TOP], 1u);
            const unsigned tg = og / nx;
            if (og + 1u == (tg + 1u) * nx) xb_add(&bar[XB_TOPGEN], 1u);
            else XB_SPIN(xb_ld(&bar[XB_TOPGEN]) == tg, bar);
            __builtin_amdgcn_fence(__ATOMIC_ACQUIRE, "agent");
            xb_add(&bar[XB_XGEN(b.x)], 1u);
            asm volatile("s_waitcnt vmcnt(0)" ::: "memory");
        } else {
            XB_SPIN(xb_ld(&bar[XB_XGEN(b.x)]) == gen, bar);
            __builtin_amdgcn_fence(__ATOMIC_ACQUIRE, "agent");
            asm volatile("s_waitcnt vmcnt(0)" ::: "memory");
        }
    }
    __syncthreads();
}


#define PROBE_SUB 0
enum { PH_PRO = 0, PH_CONVEXP, PH_PRE0, PH_INPROJ, PH_PREP, PH_MIX, PH_OUTPROJ, PH_POST1, PH_MOE1, PH_MOE2, PH_POST2, PH_POST3 };
constexpr int MAX_LDS = 140 * 1024;

template <int PH>
DI void run_phase(const Params& p, int l, int hf, char* smem) {
    const int G = gridDim.x, B = blockIdx.x;
    if (PH == PH_PRO) {
        const int n0 = MOD_UNITS, n1 = n0 + ROPE_UNITS, n2 = n1 + 2 * CONV_UNITS_SMALL, n3 = n2 + CONV_UNITS_EXP;
        for (int u = B; u < n3; u += G) {
            if (u < n0) mod_unit(p, u, smem);
            else if (u < n1) rope_unit(p, u - n0);
            else if (u < n2) { const int v = u - n1; convert_small_unit(p, v / CONV_UNITS_SMALL, v % CONV_UNITS_SMALL, smem); }
            else convert_exp_unit(p, 0, u - n2, smem);
        }
    } else if (PH == PH_CONVEXP) {
        for (int u = B; u < CONV_UNITS_EXP; u += G) convert_exp_unit(p, l, u, smem);
    } else if (PH == PH_PRE0) {
        for (int u = B; u < NTOK / 16; u += G) rowpost_unit<0>(p, 0, 0, u * 16, smem);
    } else if (PH == PH_INPROJ) {
        InprojS S{p, l}; gemm8<true>(smem, p.ws + OFF_RB, DM, S);
    } else if (PH == PH_PREP) {
        const int n0 = ssd_chunk_units(), n1 = n0 + lru_chunk_units(), n2 = n1 + PREP_UNITS;
        for (int u = B; u < n2; u += G) {
            if (u < n0) ssd_chunk_unit(p, l, u, smem);
            else if (u < n1) lru_chunk_unit(p, l, u - n0, smem);
            else prep_unit(p, l, u - n1);
        }
        if (PROBE_SUB == 1) for (int u = B; u < n0; u += G) ssd_chunk_unit(p, l, u, smem);
        if (PROBE_SUB == 2) for (int u = B; u < n1 - n0; u += G) lru_chunk_unit(p, l, u, smem);
        if (PROBE_SUB == 3) for (int u = B; u < PREP_UNITS; u += G) prep_unit(p, l, u);
    } else if (PH == PH_MIX) {
        const int n0 = attn_units(l), n1 = n0 + ssd_fin_units(l), n2 = n1 + lru_fin_units(l);
        for (int u = B; u < n2; u += G) {
            if (u < n0) attn_dispatch(p, l, u, smem);
            else if (u < n1) ssd_fin_unit(p, l, u - n0, smem);
            else lru_fin_unit(p, l, u - n1, smem);
        }
        if (PROBE_SUB == 4) for (int u = B; u < 256; u += G) attn_dispatch(p, l, u, smem);
        if (PROBE_SUB == 5) for (int u = 256 + B; u < n0; u += G) attn_dispatch(p, l, u, smem);
        if (PROBE_SUB == 6) for (int u = B; u < n1 - n0; u += G) ssd_fin_unit(p, l, u, smem);
        if (PROBE_SUB == 7) for (int u = B; u < n2 - n1; u += G) lru_fin_unit(p, l, u, smem);
    } else if (PH == PH_OUTPROJ) {
        OutprojS S{p, l}; gemm8<false>(smem, p.ws + OFF_RB, DM, S);
    } else if (PH == PH_POST1) {
        const int lo = l == 0 ? 0 : NCTX;
        for (int u = B; u < (NTOK - lo) / 16; u += G) rowpost_unit<1>(p, l, 0, lo + u * 16, smem);
    } else if (PH == PH_MOE1 || PH == PH_MOE2) {
        MoeTab* tb = (MoeTab*)(smem + GEMM_LDS);
        moe_table(p, l, hf, tb);
        if (PH == PH_MOE1) { Moe1S S{p, l, hf, tb}; gemm8<true>(smem, p.ws + OFF_RA, 1024, S); }
        else { Moe2S S{p, l, hf, tb}; gemm8<true>(smem, p.ws + OFF_HID, 256, S); }
        __syncthreads();
    } else if (PH == PH_POST2 || PH == PH_POST3) {
        const int lo = half_lo(l, hf), n = (half_hi(l, hf) - lo) / 16;
        moe_table(p, l, hf, (MoeTab*)(smem + GEMM_LDS));
        for (int u = B; u < n; u += G) { if (PH == PH_POST2) rowpost_unit<2>(p, l, hf, lo + u * 16, smem); else rowpost_unit<3>(p, l, hf, lo + u * 16, smem); }
    }
}

#ifndef MULTI_LAUNCH
#define MULTI_LAUNCH 0
#endif
#define PROBE_PH -1
#define GBAR() do { XcdBarrier b2_ = bar; asm volatile("" : "+s"(b2_.x)); asm volatile("" : "+s"(b2_.bar)); xcd_barrier(b2_); } while (0)
#define RUNP(PH, l, hf) do { run_phase<PH>(p, l, hf, smem); if (PROBE_PH == PH) run_phase<PH>(p, l, hf, smem); } while (0)
static_assert(XCD_BAR_WORDS * 4 <= 16 * 1024, "barrier words fit their region");
__global__ void __launch_bounds__(NTHR, 2) k_mega(Params p) {
    extern __shared__ __attribute__((aligned(16))) char smem[];
    uint4* xbw = (uint4*)(smem + MAX_LDS - 16);
    if (threadIdx.x == 0) *xbw = make_uint4(0u, 0u, 0u, 0u);
    __syncthreads();
    XcdBarrier bar = xcd_barrier_post((unsigned*)(p.ws + OFF_BAR), (volatile LAS unsigned*)xbw);
    RUNP(PH_PRO, 0, 0);
    GBAR();
    RUNP(PH_PRE0, 0, 0);
    GBAR();
#pragma unroll 1
    for (int l = 0; l < 2; ++l) {
        if (l == 1) RUNP(PH_CONVEXP, 1, 0);
        RUNP(PH_INPROJ, l, 0);
        GBAR();
        RUNP(PH_PREP, l, 0);
        GBAR();
        RUNP(PH_MIX, l, 0);
        GBAR();
        RUNP(PH_OUTPROJ, l, 0);
        GBAR();
        RUNP(PH_POST1, l, 0);
        GBAR();
        RUNP(PH_MOE1, l, 0);
        GBAR();
        RUNP(PH_MOE2, l, 0);
        GBAR();
        if (l == 0) RUNP(PH_POST2, l, 0); else RUNP(PH_POST3, l, 0);
        RUNP(PH_MOE1, l, 1);
        GBAR();
        RUNP(PH_MOE2, l, 1);
        GBAR();
        if (l == 0) { RUNP(PH_POST2, l, 1); GBAR(); } else RUNP(PH_POST3, l, 1);
    }
}

#if MULTI_LAUNCH
template <int PH>
__global__ void __launch_bounds__(NTHR, 2) k_phase(Params p, int l, int hf) {
    extern __shared__ __attribute__((aligned(16))) char smem[];
    run_phase<PH>(p, l, hf, smem);
}
template <int PH>
static void launch_phase(const Params& p, int l, int hf, int grid, hipStream_t st) {
    static bool inited = false;
    if (!inited) { (void)hipFuncSetAttribute((const void*)k_phase<PH>, hipFuncAttributeMaxDynamicSharedMemorySize, MAX_LDS); inited = true; }
    k_phase<PH><<<grid, NTHR, MAX_LDS, st>>>(p, l, hf);
}
#endif

extern "C" void kernel_launch(void* const* d_in, const int* in_sizes, int n_in, void* d_out, int out_size, void* d_ws, size_t ws_size, hipStream_t stream) {
    if (ws_size < WS_NEED || n_in < 36) return;
    Params p{};
    for (int i = 0; i < 36; ++i) p.in[i] = (const float*)d_in[i];
    p.out = (float*)d_out; p.ws = (char*)d_ws;
    (void)hipMemsetAsync(d_ws, 0, ZERO_BYTES, stream);
#if MULTI_LAUNCH
    const int G = 256;
    launch_phase<PH_PRO>(p, 0, 0, G, stream);
    launch_phase<PH_PRE0>(p, 0, 0, G, stream);
    for (int l = 0; l < 2; ++l) {
        if (l == 1) launch_phase<PH_CONVEXP>(p, 1, 0, G, stream);
        launch_phase<PH_INPROJ>(p, l, 0, G, stream);
        launch_phase<PH_PREP>(p, l, 0, G, stream);
        launch_phase<PH_MIX>(p, l, 0, G, stream);
        launch_phase<PH_OUTPROJ>(p, l, 0, G, stream);
        launch_phase<PH_POST1>(p, l, 0, G, stream);
        for (int hf = 0; hf < 2; ++hf) {
            launch_phase<PH_MOE1>(p, l, hf, G, stream);
            launch_phase<PH_MOE2>(p, l, hf, G, stream);
            if (l == 0) launch_phase<PH_POST2>(p, l, hf, G, stream); else launch_phase<PH_POST3>(p, l, hf, G, stream);
        }
    }
#else
    static int grid = 0;
    if (!grid) {
        int dev = 0, cus = 0, per_cu = 0;
        (void)hipGetDevice(&dev);
        (void)hipDeviceGetAttribute(&cus, hipDeviceAttributeMultiprocessorCount, dev);
        (void)hipFuncSetAttribute((const void*)k_mega, hipFuncAttributeMaxDynamicSharedMemorySize, MAX_LDS);
        (void)hipOccupancyMaxActiveBlocksPerMultiprocessor(&per_cu, (const void*)k_mega, NTHR, MAX_LDS);
        grid = per_cu >= 1 ? cus : 0;
    }
    if (grid > 0) k_mega<<<grid, NTHR, MAX_LDS, stream>>>(p);
#endif
}
```

```cpp
#include <hip/hip_runtime.h>
#include <stdint.h>

#define DI __device__ __forceinline__
typedef unsigned short bf16_t;
typedef short bf16x8 __attribute__((ext_vector_type(8)));
typedef short s16x4 __attribute__((ext_vector_type(4)));
typedef float f32x4 __attribute__((ext_vector_type(4)));
typedef float f32x16 __attribute__((ext_vector_type(16)));
typedef unsigned u32x4 __attribute__((ext_vector_type(4)));

constexpr int NTHR = 512;
constexpr int DM = 1024, NB = 4, SEQ = 4096, CTXL = 256;
constexpr int NCTX = NB * CTXL, NLAT = NB * SEQ, NTOK = NCTX + NLAT;
constexpr int INP = 2312, INPP = 2560;
constexpr int CA_Q = 0, CA_K = 256, CA_V = 384, CB_Z = 512, CB_X = 768, CB_B = 1024, CB_C = 1152, CB_DTF = 1280, CB_DTB = 1284,
              CC_X = 1288, CC_G = 1544, CD_Q = 1800, CD_K = 2056, CD_V = 2184;
constexpr int NCHK = 34;
constexpr int HCAP = 8704;
constexpr float EPS = 1e-6f;

constexpr size_t MB = 1024 * 1024;
constexpr size_t OFF_BAR = 0;
constexpr size_t OFF_CNT = 16 * 1024;
constexpr size_t OFF_MOD = 32 * 1024;
constexpr size_t ZERO_BYTES = 32 * 1024 + 2 * 5 * 6144 * 4;
constexpr size_t OFF_ROPE = 512 * 1024;
constexpr size_t OFF_SLOT_TOK = 2 * MB;
constexpr size_t OFF_SLOT_W = 7 * MB;
constexpr size_t OFF_TOKSLOT = 12 * MB;
constexpr size_t OFF_LRUC = 13 * MB;
constexpr size_t OFF_SSDDEC = 14 * MB;
constexpr size_t OFF_XCTX = 15 * MB;
constexpr size_t OFF_WIN = 20 * MB;
constexpr size_t SZ_WIN1 = (size_t)INPP * DM * 2;
constexpr size_t OFF_WOUT = OFF_WIN + 2 * SZ_WIN1;
constexpr size_t SZ_WOUT1 = (size_t)DM * DM * 2;
constexpr size_t OFF_WGU = 36 * MB;
constexpr size_t OFF_WD = OFF_WGU + (size_t)65 * 512 * 1024 * 2;
constexpr size_t OFF_Y = 140 * MB;
constexpr size_t OFF_RA = 210 * MB;
constexpr size_t OFF_HID = OFF_RA + (size_t)NTOK * DM * 2;
constexpr size_t OFF_RB = 296 * MB;
constexpr size_t OFF_RC = 332 * MB;
constexpr size_t OFF_QA = OFF_RC;
constexpr size_t OFF_KA = OFF_QA + (size_t)NTOK * 256 * 2;
constexpr size_t OFF_QD = OFF_KA + (size_t)NTOK * 128 * 2;
constexpr size_t OFF_KD = OFF_QD + (size_t)NTOK * 256 * 2;
constexpr size_t OFF_SSDST = OFF_KD + (size_t)NTOK * 128 * 2;
constexpr size_t OFF_YPART = OFF_SSDST + (size_t)4 * 4 * 2 * 34 * 4096 * 4;
constexpr size_t OFF_CC = OFF_YPART + (size_t)NTOK * 256 * 4;
constexpr size_t OFF_EA = OFF_CC + (size_t)NTOK * 128 * 4;
constexpr size_t OFF_LRUH = OFF_EA + (size_t)NTOK * 8 * 4;
constexpr size_t OFF_YE = OFF_RC;
constexpr size_t WS_NEED = OFF_RC + (size_t)8 * HCAP * 1024 * 2 + MB;

struct Params {
    const float* in[36];
    float* out;
    char* ws;
};
enum { I_X = 0, I_C, I_CTX, I_CCTX, I_WADA, I_BADA, I_GMIXPRE, I_GMIXPOST, I_GFFNPRE, I_GFFNPOST, I_WIN, I_WOUT, I_ASINK, I_SSDCW, I_SSDCB, I_SSDDTB, I_SSDALOG,
       I_SSDD, I_SSDNORM, I_LRUCW, I_LRUCB, I_LRUWA, I_LRUBA, I_LRUWI, I_LRUBI, I_LRULAM, I_DQN, I_DKN, I_RW, I_RB, I_EG, I_EU, I_ED, I_SG, I_SU, I_SD };

DI int tidx() { int t = threadIdx.x; asm volatile("" : "+v"(t)); return t; }
DI float bf2f(bf16_t v) { return __uint_as_float(((unsigned)v) << 16); }
DI bf16_t f2bf(float f) { unsigned u = __float_as_uint(f); u += 0x7fffu + ((u >> 16) & 1u); return (bf16_t)(u >> 16); }
DI unsigned pack2(float lo, float hi) { return (unsigned)f2bf(lo) | ((unsigned)f2bf(hi) << 16); }
DI float wave_sum(float v) {
#pragma unroll
    for (int o = 32; o > 0; o >>= 1) v += __shfl_xor(v, o);
    return v;
}
DI float sigmoid_(float x) { return 1.f / (1.f + __expf(-x)); }
DI float silu_(float x) { return x / (1.f + __expf(-x)); }
DI float softplus_(float x) { return x > 20.f ? x : log1pf(__expf(x)); }
DI float gelu_tanh_(float x) { const float u = 0.7978845608028654f * (x + 0.044715f * x * x * x); return 0.5f * x * (1.f + tanhf(u)); }
DI int crow(int reg, int h) { return (reg & 3) + 8 * (reg >> 2) + 4 * h; }

DI const float* xrow_c(const Params& p, int r) { return r < NCTX ? (const float*)(p.ws + OFF_XCTX) + (size_t)r * DM : p.out + (size_t)(r - NCTX) * DM; }
DI float* xrow(const Params& p, int r) { return r < NCTX ? (float*)(p.ws + OFF_XCTX) + (size_t)r * DM : p.out + (size_t)(r - NCTX) * DM; }
DI const float* xin_row(const Params& p, int r) { return r < NCTX ? p.in[I_CTX] + (size_t)r * DM : p.in[I_X] + (size_t)(r - NCTX) * DM; }
DI int mod_idx(int r) { return r < NCTX ? 4 : ((r - NCTX) >> 12); }
DI const float* modp(const Params& p, int l, int bidx, int k) { return (const float*)(p.ws + OFF_MOD) + ((size_t)(l * 5 + bidx) * 6 + k) * DM; }
DI int half_lo(int l, int hf) { return hf == 0 ? (l == 0 ? 0 : NCTX) : (l == 0 ? 8704 : 9216); }
DI int half_hi(int l, int hf) { return hf == 0 ? (l == 0 ? 8704 : 9216) : NTOK; }

DI void transpose_tile(const float* __restrict__ src, int ld, int N, int k0, int n0, bf16_t* __restrict__ dst, int ldd, int mode, float* tile) {
    const int t = tidx();
    {
        const int col = t & 63, r8 = t >> 6;
#pragma unroll
        for (int i = 0; i < 8; ++i) { const int row = r8 + 8 * i; tile[row * 65 + col] = (n0 + col < N) ? src[(size_t)(k0 + row) * ld + n0 + col] : 0.f; }
    }
    __syncthreads();
    {
        const int n = t >> 3, kc = (t & 7) * 8;
        uint4 v;
        v.x = pack2(tile[(kc + 0) * 65 + n], tile[(kc + 1) * 65 + n]); v.y = pack2(tile[(kc + 2) * 65 + n], tile[(kc + 3) * 65 + n]);
        v.z = pack2(tile[(kc + 4) * 65 + n], tile[(kc + 5) * 65 + n]); v.w = pack2(tile[(kc + 6) * 65 + n], tile[(kc + 7) * 65 + n]);
        const int nn = n0 + n;
        int R = nn;
        if (mode) R = 256 * (nn >> 7) + (nn & 127) + (mode == 2 ? 128 : 0);
        *(uint4*)(dst + (size_t)R * ldd + k0 + kc) = v;
    }
    __syncthreads();
}
constexpr int CONV_UNITS_SMALL = 640 + 256, CONV_UNITS_EXP = 3 * 4160;
DI void convert_small_unit(const Params& p, int l, int u, char* smem) {
    float* tile = (float*)smem;
    if (u < 640) { const int kt = u / 40, nt = u % 40;
        transpose_tile(p.in[I_WIN] + (size_t)l * DM * INP, INP, INP, kt * 64, nt * 64, (bf16_t*)(p.ws + OFF_WIN + l * SZ_WIN1), DM, 0, tile); return; }
    u -= 640; { const int kt = u / 16, nt = u % 16;
        transpose_tile(p.in[I_WOUT] + (size_t)l * DM * DM, DM, DM, kt * 64, nt * 64, (bf16_t*)(p.ws + OFF_WOUT + l * SZ_WOUT1), DM, 0, tile); }
}
DI void convert_exp_unit(const Params& p, int l, int u, char* smem) {
    float* tile = (float*)smem;
    if (u < 2 * 4160) { const int up = u >= 4160; if (up) u -= 4160;
        const int e = u / 64, r = u % 64, kt = r / 4, nt = r % 4;
        const float* src = e < 64 ? p.in[up ? I_EU : I_EG] + ((size_t)l * 64 + e) * DM * 256 : p.in[up ? I_SU : I_SG] + (size_t)l * DM * 256;
        transpose_tile(src, 256, 256, kt * 64, nt * 64, (bf16_t*)(p.ws + OFF_WGU) + (size_t)e * 512 * 1024, 1024, up ? 2 : 1, tile); return; }
    u -= 2 * 4160; { const int e = u / 64, r = u % 64, kt = r / 16, nt = r % 16;
        const float* src = e < 64 ? p.in[I_ED] + ((size_t)l * 64 + e) * 256 * DM : p.in[I_SD] + (size_t)l * 256 * DM;
        transpose_tile(src, DM, DM, kt * 64, nt * 64, (bf16_t*)(p.ws + OFF_WD) + (size_t)e * 1024 * 256, 256, 0, tile); }
}
constexpr int MOD_UNITS = 2 * 96;
DI void mod_unit(const Params& p, int u, char* smem) {
    float* s = (float*)smem;
    float* part = s + 5 * 1024;
    const int l = u / 96, cb = u % 96, t = tidx(), col = t & 63, kg = t >> 6;
    for (int i = t; i < 5 * 1024; i += NTHR) { const int v = i >> 10, k = i & 1023; const float c = v < 4 ? p.in[I_C][v * DM + k] : p.in[I_CCTX][k]; s[i] = silu_(c); }
    __syncthreads();
    const int j = cb * 64 + col;
    const float* w = p.in[I_WADA] + (size_t)l * DM * 6144 + (size_t)(kg * 128) * 6144 + j;
    float a0 = 0, a1 = 0, a2 = 0, a3 = 0, a4 = 0;
#pragma unroll 16
    for (int k = 0; k < 128; ++k) { const float wv = w[(size_t)k * 6144]; const int kk = kg * 128 + k;
        a0 += s[kk] * wv; a1 += s[1024 + kk] * wv; a2 += s[2048 + kk] * wv; a3 += s[3072 + kk] * wv; a4 += s[4096 + kk] * wv; }
    part[(kg * 5 + 0) * 64 + col] = a0; part[(kg * 5 + 1) * 64 + col] = a1; part[(kg * 5 + 2) * 64 + col] = a2; part[(kg * 5 + 3) * 64 + col] = a3; part[(kg * 5 + 4) * 64 + col] = a4;
    __syncthreads();
    if (t < 320) { const int v = t >> 6, c = t & 63; float acc = p.in[I_BADA][l * 6144 + cb * 64 + c];
#pragma unroll
        for (int g = 0; g < 8; ++g) acc += part[(g * 5 + v) * 64 + c];
        ((float*)(p.ws + OFF_MOD))[(size_t)(l * 5 + v) * 6144 + cb * 64 + c] = acc; }
    __syncthreads();
}
constexpr int ROPE_UNITS = 4096 * 32 / NTHR;
DI void rope_unit(const Params& p, int u) {
    const int idx = u * NTHR + tidx(), t = idx >> 5, i = idx & 31;
    const float pos = (float)(i < 16 ? (t >> 6) : (t & 63));
    const float inv = powf(10000.f, -(float)(2 * (i & 15)) / 32.f);
    const float ang = pos * inv;
    ((float2*)(p.ws + OFF_ROPE))[idx] = make_float2(cosf(ang), sinf(ang));
}

constexpr int GEMM_LDS = 131072;
struct MoeTab { int cnt[65]; int mstart[66]; int hoffP[65]; int hoffU[65]; };
constexpr int HP = 1028;
template <int MODE>
DI void rowpost_unit(const Params& p, int l, int hf, int r0, char* smem) {
    float* hrow = (float*)smem;
    float* part = hrow + 16 * HP;
    const int* hoffU = ((const MoeTab*)(smem + GEMM_LDS))->hoffU;
    const int tid = tidx(), lane = tid & 63, w = tid >> 6;
#pragma unroll
    for (int rr = 0; rr < 2; ++rr) {
        const int r = r0 + 2 * w + rr;
        const int bidx = mod_idx(r);
        f32x4 xv[4];
        if (MODE == 0) {
            const float* xs = xin_row(p, r);
#pragma unroll
            for (int i = 0; i < 2; ++i) { xv[2 * i] = *(const f32x4*)(xs + 8 * lane + 512 * i); xv[2 * i + 1] = *(const f32x4*)(xs + 8 * lane + 512 * i + 4); }
        } else {
            f32x4 yv[4];
            const float* Y = (const float*)(p.ws + OFF_Y) + (size_t)r * DM;
            const float* xs = (MODE == 1 && l == 0) ? xin_row(p, r) : xrow_c(p, r);
            u32x4 q[8][2];
            if (MODE >= 2) {
                const int* ts = (const int*)(p.ws + OFF_TOKSLOT) + (size_t)r * 8;
                const int4 t0 = *(const int4*)ts, t1 = *(const int4*)(ts + 4);
                const int tv[8] = {t0.x, t0.y, t0.z, t0.w, t1.x, t1.y, t1.z, t1.w};
                const bf16_t* ye = (const bf16_t*)(p.ws + OFF_YE);
#pragma unroll
                for (int k = 0; k < 8; ++k) { const bf16_t* yr = ye + (size_t)(hoffU[tv[k] >> 14] + (tv[k] & 16383)) * DM + 8 * lane;
                    q[k][0] = *(const u32x4*)(yr); q[k][1] = *(const u32x4*)(yr + 512); }
            }
#pragma unroll
            for (int i = 0; i < 2; ++i) { yv[2 * i] = *(const f32x4*)(Y + 8 * lane + 512 * i); yv[2 * i + 1] = *(const f32x4*)(Y + 8 * lane + 512 * i + 4);
                xv[2 * i] = *(const f32x4*)(xs + 8 * lane + 512 * i); xv[2 * i + 1] = *(const f32x4*)(xs + 8 * lane + 512 * i + 4); }
            if (MODE >= 2) {
#pragma unroll
                for (int k = 0; k < 8; ++k)
#pragma unroll
                    for (int i = 0; i < 2; ++i) { const u32x4 v = q[k][i];
                        yv[2 * i][0] += __uint_as_float(v[0] << 16); yv[2 * i][1] += __uint_as_float(v[0] & 0xffff0000u); yv[2 * i][2] += __uint_as_float(v[1] << 16); yv[2 * i][3] += __uint_as_float(v[1] & 0xffff0000u);
                        yv[2 * i + 1][0] += __uint_as_float(v[2] << 16); yv[2 * i + 1][1] += __uint_as_float(v[2] & 0xffff0000u); yv[2 * i + 1][2] += __uint_as_float(v[3] << 16); yv[2 * i + 1][3] += __uint_as_float(v[3] & 0xffff0000u); }
            }
            float ss = 0.f;
#pragma unroll
            for (int i = 0; i < 4; ++i) ss += yv[i][0] * yv[i][0] + yv[i][1] * yv[i][1] + yv[i][2] * yv[i][2] + yv[i][3] * yv[i][3];
            ss = wave_sum(ss);
            const float rs = rsqrtf(ss * (1.f / DM) + EPS);
            const float* gate = modp(p, l, bidx, MODE == 1 ? 2 : 5);
            const float* gp = p.in[MODE == 1 ? I_GMIXPOST : I_GFFNPOST] + l * DM;
            float* xo = xrow(p, r);
#pragma unroll
            for (int i = 0; i < 4; ++i) { const int c = 8 * lane + 512 * (i >> 1) + 4 * (i & 1);
                const f32x4 g = *(const f32x4*)(gate + c), qq = *(const f32x4*)(gp + c);
                xv[i] = xv[i] + g * (yv[i] * rs * qq); *(f32x4*)(xo + c) = xv[i]; }
        }
        if (MODE != 3) {
            const int lp = MODE == 2 ? l + 1 : l;
            float ss = 0.f;
#pragma unroll
            for (int i = 0; i < 4; ++i) ss += xv[i][0] * xv[i][0] + xv[i][1] * xv[i][1] + xv[i][2] * xv[i][2] + xv[i][3] * xv[i][3];
            ss = wave_sum(ss);
            const float rs = rsqrtf(ss * (1.f / DM) + EPS);
            const float* gpre = p.in[MODE == 1 ? I_GFFNPRE : I_GMIXPRE] + lp * DM;
            const float* sh = modp(p, lp, bidx, MODE == 1 ? 3 : 0);
            const float* sc = modp(p, lp, bidx, MODE == 1 ? 4 : 1);
            bf16_t* hb = (bf16_t*)(p.ws + (MODE == 1 ? OFF_RA : OFF_RB)) + (size_t)r * DM;
#pragma unroll
            for (int i = 0; i < 2; ++i) { const int c = 8 * lane + 512 * i;
                f32x4 h[2];
#pragma unroll
                for (int j = 0; j < 2; ++j) { const f32x4 g = *(const f32x4*)(gpre + c + 4 * j), s1 = *(const f32x4*)(sh + c + 4 * j), s2 = *(const f32x4*)(sc + c + 4 * j);
                    h[j] = xv[2 * i + j] * rs * g * (s2 + 1.f) + s1;
                    if (MODE == 1) *(f32x4*)(hrow + (2 * w + rr) * HP + c + 4 * j) = h[j]; }
                u32x4 o; o[0] = pack2(h[0][0], h[0][1]); o[1] = pack2(h[0][2], h[0][3]); o[2] = pack2(h[1][0], h[1][1]); o[3] = pack2(h[1][2], h[1][3]);
                *(u32x4*)(hb + c) = o; }
        }
    }
    if (MODE == 1) {
        __syncthreads();
        {
            const float* rw = p.in[I_RW] + (size_t)l * DM * 64;
            const int i16 = lane & 15, kq = lane >> 4;
            f32x4 acc[4];
#pragma unroll
            for (int n = 0; n < 4; ++n) acc[n] = (f32x4){0.f, 0.f, 0.f, 0.f};
#pragma unroll 4
            for (int ks = 0; ks < 32; ++ks) { const int k = 128 * w + 4 * ks + kq;
                const float a = hrow[i16 * HP + k];
#pragma unroll
                for (int n = 0; n < 4; ++n) acc[n] = __builtin_amdgcn_mfma_f32_16x16x4f32(a, rw[k * 64 + n * 16 + i16], acc[n], 0, 0, 0); }
#pragma unroll
            for (int n = 0; n < 4; ++n)
#pragma unroll
                for (int j = 0; j < 4; ++j) part[(w * 16 + kq * 4 + j) * 64 + n * 16 + i16] = acc[n][j];
        }
        __syncthreads();
        const float rbias = p.in[I_RB][l * 64 + lane];
#pragma unroll 1
        for (int rr = 0; rr < 2; ++rr) {
            const int r = r0 + 2 * w + rr;
            float lg = 0.f;
#pragma unroll
            for (int g = 0; g < 8; ++g) lg += part[(g * 16 + 2 * w + rr) * 64 + lane];
            const float s = sigmoid_(lg);
            const float v = s + rbias;
            float m1 = v;
            m1 = fmaxf(m1, __shfl_xor(m1, 1)); m1 = fmaxf(m1, __shfl_xor(m1, 2)); m1 = fmaxf(m1, __shfl_xor(m1, 4));
            int ix = (v == m1) ? lane : 64;
            ix = min(ix, __shfl_xor(ix, 1)); ix = min(ix, __shfl_xor(ix, 2)); ix = min(ix, __shfl_xor(ix, 4));
            float m2 = (lane == ix) ? -INFINITY : v;
            m2 = fmaxf(m2, __shfl_xor(m2, 1)); m2 = fmaxf(m2, __shfl_xor(m2, 2)); m2 = fmaxf(m2, __shfl_xor(m2, 4));
            const float gs = m1 + m2;
            const int g = lane >> 3; int grank = 0;
#pragma unroll
            for (int gg = 0; gg < 8; ++gg) { const float o = __shfl(gs, gg * 8); grank += (o > gs) || (o == gs && gg < g); }
            const bool gsel = grank < 4;
            const float vm = gsel ? v : -INFINITY;
            int rk = 0;
#pragma unroll 8
            for (int ee = 0; ee < 64; ++ee) { const float o = __shfl(vm, ee); rk += (o > vm) || (o == vm && ee < lane); }
            const bool sel = gsel && rk < 8;
            const float scs = sel ? s : 0.f;
            const float tot = wave_sum(scs);
            const float wgt = scs / tot * 2.5f;
            if (sel) {
                const int h = r >= half_lo(l, 1) ? 1 : 0;
                int* cnt = (int*)(p.ws + OFF_CNT) + (l * 2 + h) * 64;
                const int pos = atomicAdd(cnt + lane, 1);
                ((int*)(p.ws + OFF_SLOT_TOK))[(size_t)(h * 64 + lane) * HCAP + pos] = r;
                ((float*)(p.ws + OFF_SLOT_W))[(size_t)(h * 64 + lane) * HCAP + pos] = wgt;
                ((int*)(p.ws + OFF_TOKSLOT))[(size_t)r * 8 + rk] = (lane << 14) | pos;
            }
        }
    }
    __syncthreads();
}

#define G8_LAS __attribute__((address_space(3)))
constexpr int LDT = 72;
constexpr int G8_HTB = 128 * 64 * 2;
static_assert(GEMM_LDS == 8 * G8_HTB, "stage region");
DI int g8_lds_byte(int r, int c) { const int st = (r >> 4) * 2 + (c >> 5), rr = r & 15, cc = c & 31, ob = rr * 64 + cc * 2; return st * 1024 + (ob ^ (((ob >> 9) & 1) << 5)); }
DI void g8_stage_rc(int b, int& R, int& C) { const int st = b / 1024, sb = b % 1024, swz = sb ^ (((sb >> 9) & 1) << 5); R = (st >> 1) * 16 + swz / 64; C = (st & 1) * 32 + (swz % 64) / 2; }
DI int g8_perm32(int rho) { const int n = rho >> 4, i = rho & 15; return 8 * (i >> 2) + 4 * n + (i & 3); }
template <bool PERM, class Sched>
DI void gemm8(char* smem, const char* Abase, int K, Sched& S) {
    G8_LAS unsigned char* lds = (G8_LAS unsigned char*)smem;
    const int tid = tidx(), wid = __builtin_amdgcn_readfirstlane(tid >> 6), lane = tid & 63, wr = wid >> 2, wc = wid & 3, fr = lane & 15, fq = lane >> 4;
    const int nt = K / 64;
    unsigned voffB[2];
#pragma unroll
    for (int i = 0; i < 2; ++i) { int R, C; g8_stage_rc(tid * 16 + i * 8192, R, C); const int Rb = PERM ? ((R & ~31) + g8_perm32(R & 31)) : R; voffB[i] = (unsigned)(Rb * K + C) * 2u; }
    const size_t kstep = 128, hstep = (size_t)128 * K * 2;
    const unsigned ldsw = (unsigned)wid * 1024u;
    const int aoff = g8_lds_byte(wr * 64 + fr, fq * 8), boff = g8_lds_byte(wc * 32 + fr, fq * 8);
#define G8_SA(b, h) (((b) * 2 + (h)) * G8_HTB)
#define G8_SB(b, h) ((4 + (b) * 2 + (h)) * G8_HTB)
#define G8_STAGEB(bufoff, gbase) do { _Pragma("unroll") for (int _i = 0; _i < 2; ++_i) \
        __builtin_amdgcn_global_load_lds((const unsigned*)((const char*)(gbase) + voffB[_i]), (G8_LAS unsigned*)(lds + (bufoff) + ldsw + _i * 8192), 16, 0, 0); } while (0)
#define G8_STAGEA(bufoff, ao, h, kb) do { _Pragma("unroll") for (int _i = 0; _i < 2; ++_i) \
        __builtin_amdgcn_global_load_lds((const unsigned*)(Abase + (size_t)(ao)[h][_i] + (kb)), (G8_LAS unsigned*)(lds + (bufoff) + ldsw + _i * 8192), 16, 0, 0); } while (0)
#define G8_LDA(dst, b, h) do { _Pragma("unroll") for (int m = 0; m < 4; ++m) _Pragma("unroll") for (int k = 0; k < 2; ++k) dst[m][k] = *(const G8_LAS bf16x8*)(lds + G8_SA(b, h) + aoff + m * 2048 + k * 1024); } while (0)
#define G8_LDB(dst, b, h) do { _Pragma("unroll") for (int n = 0; n < 2; ++n) _Pragma("unroll") for (int k = 0; k < 2; ++k) dst[n][k] = *(const G8_LAS bf16x8*)(lds + G8_SB(b, h) + boff + n * 2048 + k * 1024); } while (0)
#define G8_MMA(ai, bj, At, Bt) do { __builtin_amdgcn_s_setprio(1); _Pragma("unroll") for (int m = 0; m < 4; ++m) _Pragma("unroll") for (int n = 0; n < 2; ++n) _Pragma("unroll") for (int k = 0; k < 2; ++k) \
        acc[ai][bj][m][n] = __builtin_amdgcn_mfma_f32_16x16x32_bf16(Bt[n][k], At[m][k], acc[ai][bj][m][n], 0, 0, 0); __builtin_amdgcn_s_setprio(0); } while (0)
#define G8_WAIT_V(n) asm volatile("s_waitcnt vmcnt(" #n ")" ::: "memory")
#define G8_WAIT_L(n) asm volatile("s_waitcnt lgkmcnt(" #n ")" ::: "memory")
#define G8_BAR __builtin_amdgcn_s_barrier()
#define G8_SCHED __builtin_amdgcn_sched_barrier(0)
    typename Sched::U cur, nxt; int ui = 0;
    if (!S.next(0, cur)) return;
    f32x4 acc[2][2][4][2];
#pragma unroll
    for (int a = 0; a < 2; ++a)
#pragma unroll
        for (int b = 0; b < 2; ++b)
#pragma unroll
            for (int m = 0; m < 4; ++m)
#pragma unroll
                for (int n = 0; n < 2; ++n) acc[a][b][m][n] = (f32x4){0.f, 0.f, 0.f, 0.f};
    bf16x8 At[4][2], B0[2][2], B1[2][2];
    unsigned cao[2][2];
    S.aoffs(cur, cao);
    const char* cB = S.bbase(cur);
    G8_STAGEB(G8_SB(0, 0), cB); G8_STAGEA(G8_SA(0, 0), cao, 0, 0); G8_STAGEB(G8_SB(0, 1), cB + hstep); G8_STAGEA(G8_SA(0, 1), cao, 1, 0);
    if (wr == 1) G8_BAR;
    G8_WAIT_V(4); G8_BAR;
    G8_STAGEB(G8_SB(1, 0), cB + kstep); G8_STAGEA(G8_SA(1, 0), cao, 0, kstep); G8_STAGEB(G8_SB(1, 1), cB + hstep + kstep);
    G8_WAIT_V(6); G8_BAR;
    for (;;) {
        const bool has_next = S.next(ui + 1, nxt);
        const char* nB = cB;
#pragma unroll 1
        for (int t = 0; t < nt; t += 2) {
            const bool last = (t == nt - 2);
            if (last && has_next) nB = S.bbase(nxt);
            const size_t k1 = (size_t)(t + 1) * kstep;
            const size_t k2 = last ? 0 : (size_t)(t + 2) * kstep, k3 = k2 + kstep;
            const char* b2 = last ? nB : cB + k2; const char* b3 = b2 + kstep;
            G8_LDB(B0, 0, 0); G8_SCHED; G8_LDA(At, 0, 0); G8_STAGEA(G8_SA(1, 1), cao, 1, k1);
            if (last && has_next) S.aoffs(nxt, cao);
            G8_WAIT_L(8); G8_BAR; G8_WAIT_L(0); G8_MMA(0, 0, At, B0); G8_BAR; G8_SCHED;
            G8_LDB(B1, 0, 1); G8_STAGEB(G8_SB(0, 0), b2);
            G8_BAR; G8_WAIT_L(0); G8_MMA(0, 1, At, B1); G8_BAR;
            G8_LDA(At, 0, 1); G8_STAGEA(G8_SA(0, 0), cao, 0, k2);
            G8_BAR; G8_WAIT_L(0); G8_MMA(1, 0, At, B0); G8_BAR; G8_SCHED;
            G8_STAGEB(G8_SB(0, 1), b2 + hstep);
            G8_WAIT_V(6); G8_BAR; G8_MMA(1, 1, At, B1); G8_BAR;
            G8_LDB(B0, 1, 0); G8_SCHED; G8_LDA(At, 1, 0); G8_STAGEA(G8_SA(0, 1), cao, 1, k2);
            G8_WAIT_L(8); G8_BAR; G8_WAIT_L(0); G8_MMA(0, 0, At, B0); G8_BAR; G8_SCHED;
            G8_LDB(B1, 1, 1); G8_STAGEB(G8_SB(1, 0), b3);
            G8_BAR; G8_WAIT_L(0); G8_MMA(0, 1, At, B1); G8_BAR;
            G8_LDA(At, 1, 1); G8_STAGEA(G8_SA(1, 0), cao, 0, k3);
            G8_BAR; G8_WAIT_L(0); G8_MMA(1, 0, At, B0); G8_BAR; G8_SCHED;
            G8_STAGEB(G8_SB(1, 1), b3 + hstep);
            G8_WAIT_V(6); G8_BAR; G8_MMA(1, 1, At, B1); G8_BAR;
        }
        S.epi(acc, cur, wr, wc, fr, fq);
        if (!has_next) break;
#pragma unroll
        for (int a = 0; a < 2; ++a)
#pragma unroll
            for (int b = 0; b < 2; ++b)
#pragma unroll
                for (int m = 0; m < 4; ++m)
#pragma unroll
                    for (int n = 0; n < 2; ++n) acc[a][b][m][n] = (f32x4){0.f, 0.f, 0.f, 0.f};
        cur = nxt; cB = nB; ++ui;
    }
    G8_WAIT_V(0);
    if (wr == 0) G8_BAR;
    G8_BAR;
#undef G8_SA
#undef G8_SB
#undef G8_STAGEA
#undef G8_STAGEB
#undef G8_LDA
#undef G8_LDB
#undef G8_MMA
#undef G8_WAIT_V
#undef G8_WAIT_L
#undef G8_BAR
#undef G8_SCHED
}
DI bool g8_static(int i, int nM, int nN, int& pm, int& pn) {
    const int G = gridDim.x, nwg = nM * nN; const long L = (long)i * G + blockIdx.x; if (L >= nwg) return false;
    int wgid = (int)L; { const int q = nwg / 8, r = nwg % 8, xcd = wgid % 8, off = wgid / 8; wgid = (xcd < r ? xcd * (q + 1) : r * (q + 1) + (xcd - r) * q) + off; }
    const int nig = 8 * nN, gid = wgid / nig, fm = gid * 8, gsz = (nM - fm) < 8 ? (nM - fm) : 8;
    pm = fm + ((wgid % nig) % gsz); pn = (wgid % nig) / gsz; return true;
}
DI int g8_xcd_linear(int i, int n) {
    const long L = (long)i * gridDim.x + blockIdx.x; if (L >= n) return -1;
    const int q = n / 8, r = n % 8, xcd = (int)(L % 8), off = (int)(L / 8);
    return (xcd < r ? xcd * (q + 1) : r * (q + 1) + (xcd - r) * q) + off;
}
DI void g8_store_bf16(bf16_t* rowp, const f32x4& a, const f32x4& b) { u32x4 o; o[0] = pack2(a[0], a[1]); o[1] = pack2(a[2], a[3]); o[2] = pack2(b[0], b[1]); o[3] = pack2(b[2], b[3]); *(u32x4*)rowp = o; }

struct InprojS {
    struct U { int pm, pn; };
    const Params& p; int l;
    DI bool next(int i, U& u) const { return g8_static(i, NTOK / 256, INPP / 256, u.pm, u.pn); }
    DI void aoffs(const U& u, unsigned (&ao)[2][2]) const { int R[2], C[2]; { const int t_ = tidx(); g8_stage_rc(t_ * 16, R[0], C[0]); g8_stage_rc(t_ * 16 + 8192, R[1], C[1]); }
#pragma unroll
        for (int h = 0; h < 2; ++h)
#pragma unroll
            for (int i = 0; i < 2; ++i) ao[h][i] = (unsigned)((u.pm * 256 + h * 128 + R[i]) * DM + C[i]) * 2u; }
    DI const char* bbase(const U& u) const { return p.ws + OFF_WIN + l * SZ_WIN1 + (size_t)u.pn * 256 * DM * 2; }
    DI void epi(const f32x4 (&acc)[2][2][4][2], const U& u, int wr, int wc, int fr, int fq) const {
        bf16_t* C = (bf16_t*)(p.ws + OFF_RA) + (size_t)(u.pm * 256 + wr * 64 + fr) * INPP + u.pn * 256 + wc * 32 + 8 * fq;
#pragma unroll
        for (int ai = 0; ai < 2; ++ai)
#pragma unroll
            for (int m = 0; m < 4; ++m)
#pragma unroll
                for (int bj = 0; bj < 2; ++bj) g8_store_bf16(C + (size_t)(ai * 128 + m * 16) * INPP + bj * 128, acc[ai][bj][m][0], acc[ai][bj][m][1]);
    }
};
struct OutprojS {
    struct U { int pm, pn; };
    const Params& p; int l;
    DI bool next(int i, U& u) const { return g8_static(i, l == 0 ? 68 : 64, 4, u.pm, u.pn); }
    DI void aoffs(const U& u, unsigned (&ao)[2][2]) const { int R[2], C[2]; { const int t_ = tidx(); g8_stage_rc(t_ * 16, R[0], C[0]); g8_stage_rc(t_ * 16 + 8192, R[1], C[1]); }
        const int row0 = (l == 0 ? 0 : NCTX) + u.pm * 256;
#pragma unroll
        for (int h = 0; h < 2; ++h)
#pragma unroll
            for (int i = 0; i < 2; ++i) ao[h][i] = (unsigned)((row0 + h * 128 + R[i]) * DM + C[i]) * 2u; }
    DI const char* bbase(const U& u) const { return p.ws + OFF_WOUT + l * SZ_WOUT1 + (size_t)u.pn * 256 * DM * 2; }
    DI void epi(const f32x4 (&acc)[2][2][4][2], const U& u, int wr, int wc, int fr, int fq) const {
        const int row0 = (l == 0 ? 0 : NCTX) + u.pm * 256;
        float* C = (float*)(p.ws + OFF_Y) + (size_t)(row0 + wr * 64 + fr) * DM + u.pn * 256 + wc * 32 + 4 * fq;
#pragma unroll
        for (int ai = 0; ai < 2; ++ai)
#pragma unroll
            for (int m = 0; m < 4; ++m)
#pragma unroll
                for (int bj = 0; bj < 2; ++bj)
#pragma unroll
                    for (int n = 0; n < 2; ++n) *(f32x4*)(C + (size_t)(ai * 128 + m * 16) * DM + bj * 128 + n * 16) = acc[ai][bj][m][n];
    }
};
DI void moe_table(const Params& p, int l, int hf, MoeTab* tb) {
    const int tid = tidx();
    if (tid < 64) {
        const int c = ((const int*)(p.ws + OFF_CNT))[(l * 2 + hf) * 64 + tid];
        const int mt = (c + 255) >> 8;
        int ms = mt, hu = c;
#pragma unroll
        for (int o = 1; o < 64; o <<= 1) { const int a = __shfl_up(ms, o), b = __shfl_up(hu, o); if (tid >= o) { ms += a; hu += b; } }
        tb->cnt[tid] = c; tb->mstart[tid] = ms - mt; tb->hoffP[tid] = (ms - mt) * 256; tb->hoffU[tid] = hu - c;
        if (tid == 63) { const int cs = half_hi(l, hf) - half_lo(l, hf); tb->cnt[64] = cs; tb->mstart[64] = ms; tb->hoffP[64] = ms * 256; tb->hoffU[64] = hu; tb->mstart[65] = ms + ((cs + 255) >> 8); }
    }
    __syncthreads();
}
DI void moe_find(const MoeTab* tb, int g, int& e, int& mt) { int lo = 0; while (tb->mstart[lo + 1] <= g) ++lo; e = lo; mt = g - tb->mstart[lo]; }
struct Moe1S {
    struct U { int e, mt, pn, cnt, hrow0; };
    const Params& p; int l, hf; const MoeTab* tb;
    DI bool next(int i, U& u) const { const int g2 = g8_xcd_linear(i, tb->mstart[65] * 2); if (g2 < 0) return false;
        int e, mt; moe_find(tb, g2 >> 1, e, mt); e = __builtin_amdgcn_readfirstlane(e); mt = __builtin_amdgcn_readfirstlane(mt); u.e = e; u.mt = mt; u.pn = g2 & 1; u.cnt = __builtin_amdgcn_readfirstlane(tb->cnt[e]); u.hrow0 = __builtin_amdgcn_readfirstlane(tb->hoffP[e]) + mt * 256; return true; }
    DI void aoffs(const U& u, unsigned (&ao)[2][2]) const { int R[2], C[2]; { const int t_ = tidx(); g8_stage_rc(t_ * 16, R[0], C[0]); g8_stage_rc(t_ * 16 + 8192, R[1], C[1]); }
        const int* stok = (const int*)(p.ws + OFF_SLOT_TOK) + (size_t)(hf * 64 + (u.e & 63)) * HCAP; const int lo = half_lo(l, hf);
#pragma unroll
        for (int h = 0; h < 2; ++h)
#pragma unroll
            for (int i = 0; i < 2; ++i) { int pos = u.mt * 256 + h * 128 + R[i]; pos = pos < u.cnt ? pos : u.cnt - 1; const int tok = u.e < 64 ? stok[pos] : lo + pos;
                ao[h][i] = (unsigned)(tok * DM + C[i]) * 2u; } }
    DI const char* bbase(const U& u) const { return p.ws + OFF_WGU + ((size_t)u.e * 512 + u.pn * 256) * 1024 * 2; }
    DI void epi(const f32x4 (&acc)[2][2][4][2], const U& u, int wr, int wc, int fr, int fq) const {
        bf16_t* H = (bf16_t*)(p.ws + OFF_HID) + (size_t)(u.hrow0 + wr * 64 + fr) * 256 + u.pn * 128 + wc * 32 + 8 * fq;
#pragma unroll
        for (int ai = 0; ai < 2; ++ai)
#pragma unroll
            for (int m = 0; m < 4; ++m) { f32x4 o[2];
#pragma unroll
                for (int n = 0; n < 2; ++n) { const f32x4 gt = acc[ai][0][m][n], up = acc[ai][1][m][n]; o[n] = (f32x4){silu_(gt[0]) * up[0], silu_(gt[1]) * up[1], silu_(gt[2]) * up[2], silu_(gt[3]) * up[3]}; }
                g8_store_bf16(H + (size_t)(ai * 128 + m * 16) * 256, o[0], o[1]); }
    }
};
struct Moe2S {
    struct U { int e, mt, pn, cnt, hrow0, yrow0; };
    const Params& p; int l, hf; const MoeTab* tb;
    DI bool next(int i, U& u) const { const int g4 = g8_xcd_linear(i, tb->mstart[65] * 4); if (g4 < 0) return false;
        int e, mt; moe_find(tb, g4 >> 2, e, mt); e = __builtin_amdgcn_readfirstlane(e); mt = __builtin_amdgcn_readfirstlane(mt); u.e = e; u.mt = mt; u.pn = g4 & 3; u.cnt = __builtin_amdgcn_readfirstlane(tb->cnt[e]); u.hrow0 = __builtin_amdgcn_readfirstlane(tb->hoffP[e]) + mt * 256; u.yrow0 = __builtin_amdgcn_readfirstlane(tb->hoffU[e]) + mt * 256; return true; }
    DI void aoffs(const U& u, unsigned (&ao)[2][2]) const { int R[2], C[2]; { const int t_ = tidx(); g8_stage_rc(t_ * 16, R[0], C[0]); g8_stage_rc(t_ * 16 + 8192, R[1], C[1]); }
#pragma unroll
        for (int h = 0; h < 2; ++h)
#pragma unroll
            for (int i = 0; i < 2; ++i) ao[h][i] = (unsigned)((u.hrow0 + h * 128 + R[i]) * 256 + C[i]) * 2u; }
    DI const char* bbase(const U& u) const { return p.ws + OFF_WD + ((size_t)u.e * 1024 + u.pn * 256) * 256 * 2; }
    DI void epi(const f32x4 (&acc)[2][2][4][2], const U& u, int wr, int wc, int fr, int fq) const {
        const float* sw = (const float*)(p.ws + OFF_SLOT_W) + (size_t)(hf * 64 + (u.e & 63)) * HCAP;
        const int colb = u.pn * 256 + wc * 32 + 8 * fq;
#pragma unroll
        for (int ai = 0; ai < 2; ++ai)
#pragma unroll
            for (int m = 0; m < 4; ++m) { const int row = ai * 128 + wr * 64 + m * 16 + fr, pos = u.mt * 256 + row;
                if (pos < u.cnt) {
                    if (u.e < 64) { const float wv = sw[pos]; bf16_t* yr = (bf16_t*)(p.ws + OFF_YE) + (size_t)(u.yrow0 + row) * DM + colb;
#pragma unroll
                        for (int bj = 0; bj < 2; ++bj) g8_store_bf16(yr + bj * 128, acc[ai][bj][m][0] * wv, acc[ai][bj][m][1] * wv);
                    } else { float* yr = (float*)(p.ws + OFF_Y) + (size_t)(half_lo(l, hf) + pos) * DM + colb;
#pragma unroll
                        for (int bj = 0; bj < 2; ++bj) { *(f32x4*)(yr + bj * 128) = acc[ai][bj][m][0]; *(f32x4*)(yr + bj * 128 + 4) = acc[ai][bj][m][1]; } } } }
    }
};

constexpr int PREP_UNITS = NTOK / 8;
DI void rope2(float& a, float& b, const float2 cs) { const float x1 = a, x2 = b; a = x1 * cs.x - x2 * cs.y; b = x1 * cs.y + x2 * cs.x; }
DI void prep_unit(const Params& p, int l, int u) {
    const int tid = tidx(), lane = tid & 63, w = tid >> 6, r = u * 8 + w;
    const bool lat = r >= NCTX; const int pos = (r - NCTX) & (SEQ - 1);
    const bf16_t* pr = (const bf16_t*)(p.ws + OFF_RA) + (size_t)r * INPP;
    const float2* rt = (const float2*)(p.ws + OFF_ROPE) + (size_t)pos * 32;
    const float* gq = p.in[I_DQN] + l * 64; const float* gk = p.in[I_DKN] + l * 64;
    unsigned* QA = (unsigned*)(p.ws + OFF_QA) + (size_t)r * 128; unsigned* KA = (unsigned*)(p.ws + OFF_KA) + (size_t)r * 64;
    unsigned* QD = (unsigned*)(p.ws + OFF_QD) + (size_t)r * 128; unsigned* KD = (unsigned*)(p.ws + OFF_KD) + (size_t)r * 64;
#pragma unroll
    for (int i = 0; i < 2; ++i) {
        const int pq = lane + 64 * i, pi = pq & 31;
        const float2 cs = lat ? rt[pi] : make_float2(1.f, 0.f);
        { const unsigned v = *(const unsigned*)(pr + CA_Q + 2 * pq); float a = __uint_as_float(v << 16), b = __uint_as_float(v & 0xffff0000u);
          rope2(a, b, cs); QA[pq] = pack2(a * 0.125f, b * 0.125f); }
        { const unsigned v = *(const unsigned*)(pr + CD_Q + 2 * pq); float a = __uint_as_float(v << 16), b = __uint_as_float(v & 0xffff0000u);
          float ss = a * a + b * b;
#pragma unroll
          for (int o = 1; o < 32; o <<= 1) ss += __shfl_xor(ss, o);
          const float rs = rsqrtf(ss * (1.f / 64.f) + EPS);
          a = a * rs * gq[2 * pi]; b = b * rs * gq[2 * pi + 1];
          rope2(a, b, cs); QD[pq] = pack2(a * 0.125f, b * 0.125f); }
    }
    {
        const int pi = lane & 31;
        const float2 cs = lat ? rt[pi] : make_float2(1.f, 0.f);
        { const unsigned v = *(const unsigned*)(pr + CA_K + 2 * lane); float a = __uint_as_float(v << 16), b = __uint_as_float(v & 0xffff0000u);
          rope2(a, b, cs); KA[lane] = pack2(a, b); }
        { const unsigned v = *(const unsigned*)(pr + CD_K + 2 * lane); float a = __uint_as_float(v << 16), b = __uint_as_float(v & 0xffff0000u);
          float ss = a * a + b * b;
#pragma unroll
          for (int o = 1; o < 32; o <<= 1) ss += __shfl_xor(ss, o);
          const float rs = rsqrtf(ss * (1.f / 64.f) + EPS);
          a = a * rs * gk[2 * pi]; b = b * rs * gk[2 * pi + 1];
          rope2(a, b, cs); KD[lane] = pack2(a, b); }
    }
}

constexpr int ATT_LDS = 2 * 2 * 64 * LDT * 2;
struct AttnArgs {
    const bf16_t* Q; const bf16_t* K; const bf16_t* V;
    int qrow0;
    int g;
    int k0row, k0tiles;
    int k1row, k1t0, k1t1;
    int qpos0;
    const float* sink;
    bf16_t* O;
};
DI void attn_unit(const AttnArgs& a, char* smem) {
    const int tid = tidx(), lane = tid & 63, w = tid >> 6, r32 = lane & 31, hi = lane >> 5;
    const int head = 2 * a.g + (w >> 2), qoff = (w & 3) * 32 + r32;
    bf16_t* Ks = (bf16_t*)smem;
    bf16_t* Vs = Ks + 2 * 64 * LDT;
    bf16x8 qr[4];
    { const bf16_t* qp = a.Q + (size_t)(a.qrow0 + qoff) * 256 + head * 64 + hi * 8;
#pragma unroll
      for (int d0 = 0; d0 < 4; ++d0) qr[d0] = *(const bf16x8*)(qp + d0 * 16); }
    float m_run, l_run;
    if (a.sink) { m_run = a.sink[head]; l_run = hi == 0 ? 1.f : 0.f; } else { m_run = -1e30f; l_run = 0.f; }
    f32x16 o0, o1;
#pragma unroll
    for (int i = 0; i < 16; ++i) { o0[i] = 0.f; o1[i] = 0.f; }
    const int nt = a.k0tiles + (a.k1t1 - a.k1t0);
    const int lrow = tid >> 3, lc = (tid & 7) * 8;
    auto tile_row0 = [&](int t) { return t < a.k0tiles ? a.k0row + t * 64 : a.k1row + (a.k1t0 + t - a.k0tiles) * 64; };
    u32x4 rk, rv;
    { const int kr = tile_row0(0) + lrow; rk = *(const u32x4*)(a.K + (size_t)kr * 128 + a.g * 64 + lc); rv = *(const u32x4*)(a.V + (size_t)kr * INPP + a.g * 64 + lc); }
    *(u32x4*)(Ks + lrow * LDT + lc) = rk; *(u32x4*)(Vs + lrow * LDT + lc) = rv;
    __syncthreads();
    const int q4 = (lane & 15) >> 2, p4 = lane & 3, blk = (lane >> 4) & 1;
#pragma unroll 1
    for (int t = 0; t < nt; ++t) {
        const bool more = t + 1 < nt;
        if (more) { const int kr = tile_row0(t + 1) + lrow; rk = *(const u32x4*)(a.K + (size_t)kr * 128 + a.g * 64 + lc); rv = *(const u32x4*)(a.V + (size_t)kr * INPP + a.g * 64 + lc); }
        const bf16_t* Kc = Ks + (t & 1) * 64 * LDT;
        const bf16_t* Vc = Vs + (t & 1) * 64 * LDT;
        f32x16 s0, s1;
#pragma unroll
        for (int i = 0; i < 16; ++i) { s0[i] = 0.f; s1[i] = 0.f; }
#pragma unroll
        for (int d0 = 0; d0 < 4; ++d0) {
            const bf16x8 k0 = *(const bf16x8*)(Kc + r32 * LDT + d0 * 16 + hi * 8);
            const bf16x8 k1 = *(const bf16x8*)(Kc + (32 + r32) * LDT + d0 * 16 + hi * 8);
            s0 = __builtin_amdgcn_mfma_f32_32x32x16_bf16(k0, qr[d0], s0, 0, 0, 0);
            s1 = __builtin_amdgcn_mfma_f32_32x32x16_bf16(k1, qr[d0], s1, 0, 0, 0);
        }
        if (a.qpos0 >= 0 && t >= a.k0tiles) {
            const int kb = (a.k1t0 + t - a.k0tiles) * 64, qp = a.qpos0 + qoff;
#pragma unroll
            for (int i = 0; i < 16; ++i) { const int kp = kb + crow(i, hi); int d = kp - qp; d = d < 0 ? -d : d; if (d > 128) s0[i] = -1e30f; d = kp + 32 - qp; d = d < 0 ? -d : d; if (d > 128) s1[i] = -1e30f; }
        }
        float mx = s0[0];
#pragma unroll
        for (int i = 1; i < 16; ++i) mx = fmaxf(mx, s0[i]);
#pragma unroll
        for (int i = 0; i < 16; ++i) mx = fmaxf(mx, s1[i]);
        mx = fmaxf(mx, __shfl_xor(mx, 32));
        const float m_new = fmaxf(m_run, mx);
        const float alpha = __expf(m_run - m_new);
        m_run = m_new;
        float ps = 0.f;
#pragma unroll
        for (int i = 0; i < 16; ++i) { s0[i] = __expf(s0[i] - m_new); s1[i] = __expf(s1[i] - m_new); ps += s0[i] + s1[i]; }
        l_run = l_run * alpha + ps;
#pragma unroll
        for (int i = 0; i < 16; ++i) { o0[i] *= alpha; o1[i] *= alpha; }
#pragma unroll
        for (int ks = 0; ks < 4; ++ks) {
            bf16x8 pf;
            {
                union { unsigned u[4]; bf16x8 v; } pk;
#pragma unroll
                for (int j = 0; j < 4; ++j) { const int rg = (ks & 1) * 8 + 2 * j; pk.u[j] = (ks < 2) ? pack2(s0[rg], s0[rg + 1]) : pack2(s1[rg], s1[rg + 1]); }
                pf = pk.v;
            }
#pragma unroll
            for (int ds = 0; ds < 2; ++ds) {
                const bf16_t* vp = Vc + (16 * ks + 4 * hi + q4) * LDT + 32 * ds + 16 * blk + 4 * p4;
                const s16x4 lo = __builtin_bit_cast(s16x4, __builtin_amdgcn_ds_read_tr16_b64_v4i16((__attribute__((address_space(3))) s16x4*)(vp)));
                const s16x4 hh = __builtin_bit_cast(s16x4, __builtin_amdgcn_ds_read_tr16_b64_v4i16((__attribute__((address_space(3))) s16x4*)(vp + 8 * LDT)));
                const bf16x8 vf = (bf16x8){lo[0], lo[1], lo[2], lo[3], hh[0], hh[1], hh[2], hh[3]};
                if (ds == 0) o0 = __builtin_amdgcn_mfma_f32_32x32x16_bf16(vf, pf, o0, 0, 0, 0);
                else o1 = __builtin_amdgcn_mfma_f32_32x32x16_bf16(vf, pf, o1, 0, 0, 0);
            }
        }
        if (more) { bf16_t* Kn = Ks + ((t + 1) & 1) * 64 * LDT; bf16_t* Vn = Vs + ((t + 1) & 1) * 64 * LDT; *(u32x4*)(Kn + lrow * LDT + lc) = rk; *(u32x4*)(Vn + lrow * LDT + lc) = rv; }
        __syncthreads();
    }
    l_run += __shfl_xor(l_run, 32);
    const float inv = 1.f / l_run;
    bf16_t* op = a.O + (size_t)(a.qrow0 + qoff) * DM + head * 64;
#pragma unroll
    for (int g4 = 0; g4 < 4; ++g4) {
        uint2 q; q.x = pack2(o0[4 * g4] * inv, o0[4 * g4 + 1] * inv); q.y = pack2(o0[4 * g4 + 2] * inv, o0[4 * g4 + 3] * inv);
        *(uint2*)(op + 8 * g4 + 4 * hi) = q;
        q.x = pack2(o1[4 * g4] * inv, o1[4 * g4 + 1] * inv); q.y = pack2(o1[4 * g4 + 2] * inv, o1[4 * g4 + 3] * inv);
        *(uint2*)(op + 32 + 8 * g4 + 4 * hi) = q;
    }
}
DI int attn_units(int l) { return l == 0 ? 544 : 512; }
DI void attn_dispatch(const Params& p, int l, int u, char* smem) {
    AttnArgs a;
    const bf16_t* proj = (const bf16_t*)(p.ws + OFF_RA);
    bf16_t* mix = (bf16_t*)(p.ws + OFF_RB);
    int type, b, g, tb;
    if (u < 512) { type = u >> 8; const int v = u & 255; b = v >> 6; g = (v >> 5) & 1; tb = v & 31; }
    else { const int v = u - 512; type = 2 + (v >> 4); b = (v >> 2) & 3; g = (v >> 1) & 1; tb = v & 1; }
    const bool isA = (type & 1);
    a.Q = (const bf16_t*)(p.ws + (isA ? OFF_QA : OFF_QD)); a.K = (const bf16_t*)(p.ws + (isA ? OFF_KA : OFF_KD)); a.V = proj + (isA ? CA_V : CD_V);
    a.g = g; a.sink = isA ? p.in[I_ASINK] + l * 4 : nullptr; a.O = mix + (isA ? 0 : 768);
    a.k0row = b * CTXL; a.k0tiles = 4; a.k1row = NCTX + b * SEQ; a.qpos0 = -1;
    if (type < 2) {
        a.qrow0 = NCTX + b * SEQ + tb * 128;
        if (isA) { a.qpos0 = tb * 128; int t0 = 2 * tb - 2, t1 = 2 * tb + 4; a.k1t0 = t0 < 0 ? 0 : t0; a.k1t1 = t1 > 64 ? 64 : t1; }
        else { a.k1t0 = 0; a.k1t1 = 64; }
    } else { a.qrow0 = b * CTXL + tb * 128; a.k1t0 = 0; a.k1t1 = 0; }
    attn_unit(a, smem);
}

DI int blk_row0(int b, int cb) { return cb < 2 ? b * CTXL + cb * 128 : NCTX + b * SEQ + (cb - 2) * 128; }
DI int bwd_seq(int cb) { return cb < 2 ? 1 - cb : 35 - cb; }
DI s16x4 tr16(const bf16_t* p) { return __builtin_bit_cast(s16x4, __builtin_amdgcn_ds_read_tr16_b64_v4i16((__attribute__((address_space(3))) s16x4*)(p))); }
DI bf16x8 cat8(const s16x4 lo, const s16x4 hh) { return (bf16x8){lo[0], lo[1], lo[2], lo[3], hh[0], hh[1], hh[2], hh[3]}; }
DI bf16x8 packf8(float a0, float a1, float a2, float a3, float a4, float a5, float a6, float a7) { union { unsigned u[4]; bf16x8 v; } k; k.u[0] = pack2(a0, a1); k.u[1] = pack2(a2, a3); k.u[2] = pack2(a4, a5); k.u[3] = pack2(a6, a7); return k.v; }
constexpr int SC_RP = 200;
constexpr int SC_RAW = 0, SC_XS = 52480, SC_BS = SC_XS + 128 * LDT * 2, SC_CS = SC_BS + 128 * LDT * 2, SC_CW = SC_CS + 128 * LDT * 2, SC_VEC = SC_CW + 5 * 192 * 4, SSD_LDS = SC_VEC + 6 * 128 * 4;
DI int ssd_chunk_units() { return NB * NCHK * 4; }
DI void ssd_chunk_unit(const Params& p, int l, int u, char* smem) {
    const int tid = tidx(), lane = tid & 63, w = __builtin_amdgcn_readfirstlane(tid >> 6), r32 = lane & 31, hi = lane >> 5;
    const int h = u & 3, cb = (u >> 2) % NCHK, b = (u >> 2) / NCHK, grp = h >> 1;
    const int row0 = blk_row0(b, cb);
    const int part0 = cb < 2 ? b * CTXL : NCTX + b * SEQ, partN = cb < 2 ? CTXL : SEQ;
    bf16_t* raw = (bf16_t*)(smem + SC_RAW);
    bf16_t* Xs = (bf16_t*)(smem + SC_XS);
    bf16_t* Bs = (bf16_t*)(smem + SC_BS);
    bf16_t* Cs = (bf16_t*)(smem + SC_CS);
    float* cwl = (float*)(smem + SC_CW);
    float* dtf = (float*)(smem + SC_VEC); float* dtb = dtf + 128; float* Af = dtb + 128; float* Ab = Af + 128; float* wef = Ab + 128; float* web = wef + 128;
    const bf16_t* proj = (const bf16_t*)(p.ws + OFF_RA);
    const float aneg_f = -__expf(p.in[I_SSDALOG][l * 8 + h]), aneg_b = -__expf(p.in[I_SSDALOG][l * 8 + 4 + h]);
    {
        u32x4 v[7];
#pragma unroll
        for (int k = 0; k < 7; ++k) { const int item = tid + NTHR * k; v[k] = (u32x4){0u, 0u, 0u, 0u};
            if (item < 131 * 24) { const int r = item / 24, c = item % 24, gr = row0 - 2 + r;
                const int col = c < 8 ? CB_X + h * 64 + 8 * c : (c < 16 ? CB_B + grp * 64 + 8 * (c - 8) : CB_C + grp * 64 + 8 * (c - 16));
                if (gr >= part0 && gr < part0 + partN) v[k] = *(const u32x4*)(proj + (size_t)gr * INPP + col); } }
#pragma unroll
        for (int k = 0; k < 7; ++k) { const int item = tid + NTHR * k; if (item < 131 * 24) { const int r = item / 24, c = item % 24; *(u32x4*)(raw + r * SC_RP + 8 * c) = v[k]; } }
        for (int i = tid; i < 5 * 192; i += NTHR) { const int j = i / 192, cc = i % 192; const int ch = cc < 64 ? h * 64 + cc : (cc < 128 ? 256 + grp * 64 + cc - 64 : 384 + grp * 64 + cc - 128);
            cwl[i] = j < 4 ? p.in[I_SSDCW][l * 2048 + j * 512 + ch] : p.in[I_SSDCB][l * 512 + ch]; }
        if (tid < 256) { const int i = tid & 127, d = tid >> 7;
            const float rawdt = bf2f(proj[(size_t)(row0 + i) * INPP + (d ? CB_DTB : CB_DTF) + h]);
            (d ? dtb : dtf)[i] = softplus_(rawdt + p.in[I_SSDDTB][l * 8 + d * 4 + h]); }
    }
    __syncthreads();
#pragma unroll 2
    for (int k = 0; k < 6; ++k) { const int item = tid + NTHR * k, i = item / 24, c = item % 24;
        float acc[8];
        { const f32x4 b0 = *(const f32x4*)(cwl + 4 * 192 + 8 * c), b1 = *(const f32x4*)(cwl + 4 * 192 + 8 * c + 4);
          acc[0] = b0[0]; acc[1] = b0[1]; acc[2] = b0[2]; acc[3] = b0[3]; acc[4] = b1[0]; acc[5] = b1[1]; acc[6] = b1[2]; acc[7] = b1[3]; }
#pragma unroll
        for (int j = 0; j < 4; ++j) { const u32x4 q = *(const u32x4*)(raw + (i + j) * SC_RP + 8 * c);
            const f32x4 w0 = *(const f32x4*)(cwl + j * 192 + 8 * c), w1 = *(const f32x4*)(cwl + j * 192 + 8 * c + 4);
            acc[0] += w0[0] * __uint_as_float(q[0] << 16); acc[1] += w0[1] * __uint_as_float(q[0] & 0xffff0000u); acc[2] += w0[2] * __uint_as_float(q[1] << 16); acc[3] += w0[3] * __uint_as_float(q[1] & 0xffff0000u);
            acc[4] += w1[0] * __uint_as_float(q[2] << 16); acc[5] += w1[1] * __uint_as_float(q[2] & 0xffff0000u); acc[6] += w1[2] * __uint_as_float(q[3] << 16); acc[7] += w1[3] * __uint_as_float(q[3] & 0xffff0000u); }
        u32x4 o; o[0] = pack2(silu_(acc[0]), silu_(acc[1])); o[1] = pack2(silu_(acc[2]), silu_(acc[3])); o[2] = pack2(silu_(acc[4]), silu_(acc[5])); o[3] = pack2(silu_(acc[6]), silu_(acc[7]));
        bf16_t* dst = c < 8 ? Xs : (c < 16 ? Bs : Cs);
        *(u32x4*)(dst + i * LDT + 8 * (c & 7)) = o; }
    if (tid < 128) {
        const int ln = tid & 63, bw = tid >> 6;
        const int i0 = bw ? 127 - 2 * ln : 2 * ln, i1 = bw ? 126 - 2 * ln : 2 * ln + 1;
        const float* dt = bw ? dtb : dtf; const float an = bw ? aneg_b : aneg_f;
        const float v0 = dt[i0] * an, v1 = dt[i1] * an;
        float sc = v0 + v1;
#pragma unroll
        for (int o = 1; o < 64; o <<= 1) { const float a = __shfl_up(sc, o); if (ln >= o) sc += a; }
        float* A = bw ? Ab : Af;
        A[i1] = sc; A[i0] = sc - v1;
    }
    __syncthreads();
    if (tid < 128) { wef[tid] = __expf(Af[127] - Af[tid]) * dtf[tid]; web[tid] = __expf(Ab[0] - Ab[tid]) * dtb[tid];
        float* EA = (float*)(p.ws + OFF_EA) + (size_t)(row0 + tid) * 8; EA[h] = __expf(Af[tid]); EA[4 + h] = __expf(Ab[tid]); }
    __syncthreads();
    bf16_t* Bwf = raw; bf16_t* Bwb = raw + 128 * LDT;
    if ((h & 1) == 0) { bf16_t* CC = (bf16_t*)(p.ws + OFF_CC);
        for (int it = tid; it < 1024; it += NTHR) { const int i = it >> 3, c = it & 7; *(u32x4*)(CC + (size_t)(row0 + i) * 128 + grp * 64 + 8 * c) = *(const u32x4*)(Cs + i * LDT + 8 * c); } }
#pragma unroll
    for (int k = 0; k < 4; ++k) { const int it = tid + NTHR * k, d = it >> 10, j = (it >> 3) & 127, c = it & 7;
        const u32x4 q = *(const u32x4*)(Bs + j * LDT + 8 * c); const float sc = d ? web[j] : wef[j];
        u32x4 o;
#pragma unroll
        for (int e = 0; e < 4; ++e) o[e] = pack2(__uint_as_float(q[e] << 16) * sc, __uint_as_float(q[e] & 0xffff0000u) * sc);
        *(u32x4*)((d ? Bwb : Bwf) + j * LDT + 8 * c) = o; }
    __syncthreads();
    const int q4 = (lane & 15) >> 2, p4 = lane & 3, blk = (lane >> 4) & 1;
    {
        const int ib = w & 3, ph = w >> 2, i = 32 * ib + r32;
        bf16x8 cq[4];
#pragma unroll
        for (int s4 = 0; s4 < 4; ++s4) cq[s4] = *(const bf16x8*)(Cs + i * LDT + 16 * s4 + 8 * hi);
        const float Afi = Af[i], Abi = Ab[i];
        f32x16 y;
#pragma unroll
        for (int r = 0; r < 16; ++r) y[r] = 0.f;
#pragma unroll
        for (int jt = 0; jt < 4; ++jt) {
            f32x16 g;
#pragma unroll
            for (int r = 0; r < 16; ++r) g[r] = 0.f;
#pragma unroll
            for (int s4 = 0; s4 < 4; ++s4) { const bf16x8 bq = *(const bf16x8*)(Bs + (32 * jt + r32) * LDT + 16 * s4 + 8 * hi); g = __builtin_amdgcn_mfma_f32_32x32x16_bf16(bq, cq[s4], g, 0, 0, 0); }
#pragma unroll
            for (int g4 = 0; g4 < 4; ++g4) { const int j0 = 32 * jt + 8 * g4 + 4 * hi;
                f32x4 wv = (f32x4){0.f, 0.f, 0.f, 0.f};
                if (jt <= ib) { const f32x4 aj = *(const f32x4*)(Af + j0), dj = *(const f32x4*)(dtf + j0);
#pragma unroll
                    for (int e = 0; e < 4; ++e) { const float t = __expf(Afi - aj[e]) * dj[e]; wv[e] += (jt < ib || j0 + e <= i) ? t : 0.f; } }
                if (jt >= ib) { const f32x4 aj = *(const f32x4*)(Ab + j0), dj = *(const f32x4*)(dtb + j0);
#pragma unroll
                    for (int e = 0; e < 4; ++e) { const float t = __expf(Abi - aj[e]) * dj[e]; wv[e] += (jt > ib || j0 + e >= i) ? t : 0.f; } }
#pragma unroll
                for (int e = 0; e < 4; ++e) g[4 * g4 + e] *= wv[e]; }
#pragma unroll
            for (int s2 = 0; s2 < 2; ++s2) {
                const bf16x8 pf = packf8(g[8 * s2], g[8 * s2 + 1], g[8 * s2 + 2], g[8 * s2 + 3], g[8 * s2 + 4], g[8 * s2 + 5], g[8 * s2 + 6], g[8 * s2 + 7]);
                const bf16_t* xp = Xs + (32 * jt + 16 * s2 + 4 * hi + q4) * LDT + 32 * ph + 16 * blk + 4 * p4;
                const bf16x8 xf = cat8(tr16(xp), tr16(xp + 8 * LDT));
                y = __builtin_amdgcn_mfma_f32_32x32x16_bf16(xf, pf, y, 0, 0, 0); }
        }
        const float dsk = p.in[I_SSDD][l * 4 + h];
        float* YP = (float*)(p.ws + OFF_YPART) + (size_t)(row0 + i) * 256 + h * 64 + 32 * ph;
#pragma unroll
        for (int g4 = 0; g4 < 4; ++g4) { const uint2 xq = *(const uint2*)(Xs + i * LDT + 32 * ph + 8 * g4 + 4 * hi);
            *(f32x4*)(YP + 8 * g4 + 4 * hi) = (f32x4){y[4 * g4] + dsk * __uint_as_float(xq.x << 16), y[4 * g4 + 1] + dsk * __uint_as_float(xq.x & 0xffff0000u),
                                                    y[4 * g4 + 2] + dsk * __uint_as_float(xq.y << 16), y[4 * g4 + 3] + dsk * __uint_as_float(xq.y & 0xffff0000u)}; }
    }
    {
        const int d = w >> 2, pt = (w >> 1) & 1, nt2 = w & 1;
        const bf16_t* Bw = d ? Bwb : Bwf;
        f32x16 st;
#pragma unroll
        for (int r = 0; r < 16; ++r) st[r] = 0.f;
#pragma unroll
        for (int ks = 0; ks < 8; ++ks) {
            const bf16_t* xp = Xs + (16 * ks + 8 * hi + q4) * LDT + 32 * pt + 16 * blk + 4 * p4;
            const bf16_t* bp = Bw + (16 * ks + 8 * hi + q4) * LDT + 32 * nt2 + 16 * blk + 4 * p4;
            st = __builtin_amdgcn_mfma_f32_32x32x16_bf16(cat8(tr16(xp), tr16(xp + 4 * LDT)), cat8(tr16(bp), tr16(bp + 4 * LDT)), st, 0, 0, 0); }
        const int s = d ? bwd_seq(cb) : cb;
        float* ST = (float*)(p.ws + OFF_SSDST) + ((size_t)((b * 4 + h) * 2 + d) * NCHK + s) * 4096 + 32 * nt2 + r32;
#pragma unroll
        for (int r = 0; r < 16; ++r) ST[(32 * pt + crow(r, hi)) * 64] = st[r];
        if ((tid & 255) == 0) ((float*)(p.ws + OFF_SSDDEC))[((b * 4 + h) * 2 + d) * NCHK + s] = d ? __expf(Ab[0]) : __expf(Af[127]);
    }
    __syncthreads();
}
constexpr int SSDF_LDS = (2 * 64 * 65 + 128 * 65 + 128) * 4 + 128 * 256 * 2;
DI int ssd_fin_units(int l) { return NB * (l == 0 ? NCHK : NCHK - 2); }
DI void ssd_fin_unit(const Params& p, int l, int u, char* smem) {
    const int tid = tidx();
    const int nper = l == 0 ? NCHK : NCHK - 2;
    const int b = u / nper, cb = u % nper + (l == 0 ? 0 : 2);
    const int row0 = blk_row0(b, cb);
    float* stf = (float*)smem;
    float* stb = stf + 64 * 65;
    float* Cc = stb + 64 * 65;
    float* ssq = Cc + 128 * 65;
    bf16_t* ybuf = (bf16_t*)(ssq + 128);
    const bf16_t* proj = (const bf16_t*)(p.ws + OFF_RA);
    if (tid < 128) ssq[tid] = 0.f;
#pragma unroll 1
    for (int h = 0; h < 4; ++h) {
        __syncthreads();
        {
            const int d = tid >> 8, e = tid & 255;
            const int s = d ? bwd_seq(cb) : cb;
            const float* ST = (const float*)(p.ws + OFF_SSDST) + (size_t)((b * 4 + h) * 2 + d) * NCHK * 4096;
            const float* DEC = (const float*)(p.ws + OFF_SSDDEC) + ((b * 4 + h) * 2 + d) * NCHK;
            float st[16];
#pragma unroll
            for (int k = 0; k < 16; ++k) st[k] = 0.f;
#pragma unroll 4
            for (int sp = 0; sp < s; ++sp) { const float dc = DEC[sp];
#pragma unroll
                for (int k = 0; k < 16; ++k) st[k] = st[k] * dc + ST[(size_t)sp * 4096 + e + 256 * k]; }
            float* dst = d ? stb : stf;
#pragma unroll
            for (int k = 0; k < 16; ++k) { const int idx = e + 256 * k; dst[(idx >> 6) * 65 + (idx & 63)] = st[k]; }
        }
        if ((h & 1) == 0) { const bf16_t* CC = (const bf16_t*)(p.ws + OFF_CC);
            for (int idx = tid; idx < 128 * 64; idx += NTHR) { const int i = idx >> 6, n = idx & 63; Cc[i * 65 + n] = bf2f(CC[(size_t)(row0 + i) * 128 + (h >> 1) * 64 + n]); } }
        __syncthreads();
        {
            const int ig = tid >> 4, pg = tid & 15;
            float af[4][4], ab[4][4];
#pragma unroll
            for (int a = 0; a < 4; ++a)
#pragma unroll
                for (int c = 0; c < 4; ++c) { af[a][c] = 0.f; ab[a][c] = 0.f; }
#pragma unroll 4
            for (int n = 0; n < 64; ++n) {
                float cv[4], sf[4], sb[4];
#pragma unroll
                for (int a = 0; a < 4; ++a) cv[a] = Cc[(ig + 32 * a) * 65 + n];
#pragma unroll
                for (int c = 0; c < 4; ++c) { sf[c] = stf[(pg + 16 * c) * 65 + n]; sb[c] = stb[(pg + 16 * c) * 65 + n]; }
#pragma unroll
                for (int a = 0; a < 4; ++a)
#pragma unroll
                    for (int c = 0; c < 4; ++c) { af[a][c] += cv[a] * sf[c]; ab[a][c] += cv[a] * sb[c]; }
            }
            const float* YP = (const float*)(p.ws + OFF_YPART);
            const float* EA = (const float*)(p.ws + OFF_EA);
#pragma unroll
            for (int a = 0; a < 4; ++a) { const int i = ig + 32 * a, r = row0 + i;
                const float ef = EA[(size_t)r * 8 + h], eb = EA[(size_t)r * 8 + 4 + h];
                float sq = 0.f;
#pragma unroll
                for (int c = 0; c < 4; ++c) { const int pp = pg + 16 * c;
                    const float y = YP[(size_t)r * 256 + h * 64 + pp] + ef * af[a][c] + eb * ab[a][c];
                    const float z = bf2f(proj[(size_t)r * INPP + CB_Z + h * 64 + pp]);
                    const float yg = y * silu_(z);
                    ybuf[i * 256 + h * 64 + pp] = f2bf(yg); sq += yg * yg; }
                sq += __shfl_xor(sq, 1); sq += __shfl_xor(sq, 2); sq += __shfl_xor(sq, 4); sq += __shfl_xor(sq, 8);
                if (pg == 0) ssq[i] += sq; }
        }
    }
    __syncthreads();
    {
        const float* gn = p.in[I_SSDNORM] + l * 256;
        bf16_t* mix = (bf16_t*)(p.ws + OFF_RB);
        for (int idx = tid; idx < 128 * 128; idx += NTHR) { const int i = idx >> 7, c2 = (idx & 127) * 2;
            const float rs = rsqrtf(ssq[i] * (1.f / 256.f) + EPS);
            const float a = bf2f(ybuf[i * 256 + c2]) * rs * gn[c2], bb = bf2f(ybuf[i * 256 + c2 + 1]) * rs * gn[c2 + 1];
            *(unsigned*)(mix + (size_t)(row0 + i) * DM + 256 + c2) = pack2(a, bb); }
    }
    __syncthreads();
}

constexpr int LC_WB = 0, LC_RAW = 4 * 64 * LDT * 2, LC_US = 65536, LC_CW = LC_US + 128 * LDT * 2, LC_SEG = LC_CW + 5 * 64 * 4, LRU_LDS = LC_SEG + 2 * 8 * 64 * 4;
static_assert(LC_RAW + 131 * LDT * 2 <= 65536, "raw rows fit under the scan arrays");
DI int lru_chunk_units() { return NB * NCHK * 4; }
DI void lru_chunk_unit(const Params& p, int l, int u, char* smem) {
    const int tid = tidx(), lane = tid & 63, w = __builtin_amdgcn_readfirstlane(tid >> 6), r32 = lane & 31, hi = lane >> 5;
    const int kb = u & 3, cb = (u >> 2) % NCHK, b = (u >> 2) / NCHK;
    const int row0 = blk_row0(b, cb);
    const int part0 = cb < 2 ? b * CTXL : NCTX + b * SEQ, partN = cb < 2 ? CTXL : SEQ;
    bf16_t* Wb = (bf16_t*)(smem + LC_WB);
    bf16_t* raw = (bf16_t*)(smem + LC_RAW);
    float* aL = (float*)smem;
    float* xL = aL + 128 * 64;
    bf16_t* Us = (bf16_t*)(smem + LC_US);
    float* cwl = (float*)(smem + LC_CW);
    float* segA = (float*)(smem + LC_SEG); float* segH = segA + 8 * 64;
    const bf16_t* proj = (const bf16_t*)(p.ws + OFF_RA);
    {
        u32x4 v[3];
#pragma unroll
        for (int k = 0; k < 3; ++k) { const int item = tid + NTHR * k; v[k] = (u32x4){0u, 0u, 0u, 0u};
            if (item < 131 * 8) { const int r = item >> 3, c = item & 7, gr = row0 - 2 + r;
                if (gr >= part0 && gr < part0 + partN) v[k] = *(const u32x4*)(proj + (size_t)gr * INPP + CC_X + kb * 64 + 8 * c); } }
        f32x4 wv[8];
#pragma unroll
        for (int k = 0; k < 8; ++k) { const int idx = tid + NTHR * k, g = idx >> 10, e4 = idx & 1023, d = g >> 1;
            wv[k] = *(const f32x4*)(p.in[(g & 1) ? I_LRUWI : I_LRUWA] + ((size_t)((l * 2 + d) * 4 + kb)) * 4096 + 4 * e4); }
#pragma unroll
        for (int k = 0; k < 3; ++k) { const int item = tid + NTHR * k; if (item < 131 * 8) *(u32x4*)(raw + (item >> 3) * LDT + 8 * (item & 7)) = v[k]; }
#pragma unroll
        for (int k = 0; k < 8; ++k) { const int idx = tid + NTHR * k, g = idx >> 10, e4 = idx & 1023, i = e4 >> 4, j4 = (e4 & 15) * 4;
            uint2 q; q.x = pack2(wv[k][0], wv[k][1]); q.y = pack2(wv[k][2], wv[k][3]); *(uint2*)(Wb + (g * 64 + i) * LDT + j4) = q; }
        if (tid < 320) { const int j = tid >> 6, c = tid & 63; cwl[tid] = j < 4 ? p.in[I_LRUCW][l * 1024 + j * 256 + kb * 64 + c] : p.in[I_LRUCB][l * 256 + kb * 64 + c]; }
    }
    __syncthreads();
#pragma unroll
    for (int k = 0; k < 2; ++k) { const int item = tid + NTHR * k, i = item >> 3, c = item & 7;
        float acc[8];
        { const f32x4 b0 = *(const f32x4*)(cwl + 256 + 8 * c), b1 = *(const f32x4*)(cwl + 256 + 8 * c + 4);
          acc[0] = b0[0]; acc[1] = b0[1]; acc[2] = b0[2]; acc[3] = b0[3]; acc[4] = b1[0]; acc[5] = b1[1]; acc[6] = b1[2]; acc[7] = b1[3]; }
#pragma unroll
        for (int j = 0; j < 4; ++j) { const u32x4 q = *(const u32x4*)(raw + (i + j) * LDT + 8 * c);
            const f32x4 w0 = *(const f32x4*)(cwl + j * 64 + 8 * c), w1 = *(const f32x4*)(cwl + j * 64 + 8 * c + 4);
            acc[0] += w0[0] * __uint_as_float(q[0] << 16); acc[1] += w0[1] * __uint_as_float(q[0] & 0xffff0000u); acc[2] += w0[2] * __uint_as_float(q[1] << 16); acc[3] += w0[3] * __uint_as_float(q[1] & 0xffff0000u);
            acc[4] += w1[0] * __uint_as_float(q[2] << 16); acc[5] += w1[1] * __uint_as_float(q[2] & 0xffff0000u); acc[6] += w1[2] * __uint_as_float(q[3] << 16); acc[7] += w1[3] * __uint_as_float(q[3] & 0xffff0000u); }
        u32x4 o; o[0] = pack2(acc[0], acc[1]); o[1] = pack2(acc[2], acc[3]); o[2] = pack2(acc[4], acc[5]); o[3] = pack2(acc[6], acc[7]);
        *(u32x4*)(Us + i * LDT + 8 * c) = o; }
    __syncthreads();
    const int tt = w & 3, jt = w >> 2, q4 = (lane & 15) >> 2, p4 = lane & 3, blk = (lane >> 4) & 1;
    f32x16 acc[4];
#pragma unroll
    for (int g = 0; g < 4; ++g)
#pragma unroll
        for (int r = 0; r < 16; ++r) acc[g][r] = 0.f;
#pragma unroll
    for (int s4 = 0; s4 < 4; ++s4) {
        const bf16x8 uf = *(const bf16x8*)(Us + (32 * tt + r32) * LDT + 16 * s4 + 8 * hi);
#pragma unroll
        for (int g = 0; g < 4; ++g) { const bf16_t* wp = Wb + (g * 64 + 16 * s4 + 8 * hi + q4) * LDT + 32 * jt + 16 * blk + 4 * p4;
            acc[g] = __builtin_amdgcn_mfma_f32_32x32x16_bf16(uf, cat8(tr16(wp), tr16(wp + 4 * LDT)), acc[g], 0, 0, 0); }
    }
    float uv[16];
    const int chl = 32 * jt + r32, ch = kb * 64 + chl;
#pragma unroll
    for (int r = 0; r < 16; ++r) uv[r] = bf2f(Us[(32 * tt + crow(r, hi)) * LDT + chl]);
    __syncthreads();
    bf16_t* HB = (bf16_t*)(p.ws + OFF_LRUH);
    float* LC = (float*)(p.ws + OFF_LRUC);
#pragma unroll
    for (int d = 0; d < 2; ++d) {
        {
            const float ba = p.in[I_LRUBA][(l * 2 + d) * 256 + ch], bi = p.in[I_LRUBI][(l * 2 + d) * 256 + ch];
            const float spl = softplus_(-p.in[I_LRULAM][(l * 2 + d) * 256 + ch]);
#pragma unroll
            for (int r = 0; r < 16; ++r) { const int i = 32 * tt + crow(r, hi);
                const float rg = sigmoid_(acc[2 * d][r] + ba), ig = sigmoid_(acc[2 * d + 1][r] + bi);
                const float la = -8.f * rg * spl;
                const float av = __expf(la);
                const float mult = sqrtf(fmaxf(0.f, -expm1f(2.f * la)));
                aL[i * 64 + chl] = av; xL[i * 64 + chl] = mult * ig * uv[r]; }
        }
        __syncthreads();
        const int sch = tid & 63, sg = tid >> 6;
        float hacc = 0.f, pacc = 1.f;
#pragma unroll 1
        for (int t = 0; t < 16; ++t) { const int tau = sg * 16 + t, i = d ? 127 - tau : tau;
            const float av = aL[i * 64 + sch]; hacc = av * hacc + xL[i * 64 + sch]; pacc *= av; xL[i * 64 + sch] = hacc; aL[i * 64 + sch] = pacc; }
        segA[sg * 64 + sch] = pacc; segH[sg * 64 + sch] = hacc;
        __syncthreads();
        float carry = 0.f, cp = 1.f;
        for (int s2 = 0; s2 < sg; ++s2) { carry = carry * segA[s2 * 64 + sch] + segH[s2 * 64 + sch]; cp *= segA[s2 * 64 + sch]; }
        bf16_t* Hh = HB + (size_t)(2 * d) * NTOK * 256; bf16_t* Hp = HB + (size_t)(2 * d + 1) * NTOK * 256;
        float hl = 0.f, pl = 1.f;
#pragma unroll 1
        for (int t = 0; t < 16; ++t) { const int tau = sg * 16 + t, i = d ? 127 - tau : tau;
            hl = xL[i * 64 + sch] + aL[i * 64 + sch] * carry; pl = aL[i * 64 + sch] * cp;
            Hh[(size_t)(row0 + i) * 256 + kb * 64 + sch] = f2bf(hl); Hp[(size_t)(row0 + i) * 256 + kb * 64 + sch] = f2bf(pl); }
        if (sg == 7) { const int s = d ? bwd_seq(cb) : cb; const size_t o = ((size_t)(b * 2 + d) * NCHK + s) * 256 + kb * 64 + sch;
            LC[o] = hl; LC[(size_t)NB * 2 * NCHK * 256 + o] = pl; }
        __syncthreads();
    }
}
DI int lru_fin_units(int l) { return NB * (l == 0 ? NCHK : NCHK - 2); }
DI void lru_fin_unit(const Params& p, int l, int u, char* smem) {
    const int tid = tidx();
    const int nper = l == 0 ? NCHK : NCHK - 2;
    const int b = u / nper, cb = u % nper + (l == 0 ? 0 : 2);
    const int row0 = blk_row0(b, cb);
    float* car = (float*)smem;
    { const int d = tid >> 8, ch = tid & 255, s = d ? bwd_seq(cb) : cb;
      const float* LH = (const float*)(p.ws + OFF_LRUC) + (size_t)(b * 2 + d) * NCHK * 256 + ch; const float* LA = LH + (size_t)NB * 2 * NCHK * 256;
      float c = 0.f;
#pragma unroll 8
      for (int sp = 0; sp < s; ++sp) c = c * LA[sp * 256] + LH[sp * 256];
      car[tid] = c; }
    __syncthreads();
    const bf16_t* HB = (const bf16_t*)(p.ws + OFF_LRUH);
    const bf16_t* proj = (const bf16_t*)(p.ws + OFF_RA);
    bf16_t* mix = (bf16_t*)(p.ws + OFF_RB);
    for (int idx = tid; idx < 128 * 128; idx += NTHR) { const int i = idx >> 7, c2 = (idx & 127) * 2; const size_t o = (size_t)(row0 + i) * 256 + c2;
        float out[2];
#pragma unroll
        for (int q = 0; q < 2; ++q) {
            const float hf = bf2f(HB[o + q]), pf = bf2f(HB[(size_t)NTOK * 256 + o + q]), hb = bf2f(HB[(size_t)2 * NTOK * 256 + o + q]), pb = bf2f(HB[(size_t)3 * NTOK * 256 + o + q]);
            const float g = bf2f(proj[(size_t)(row0 + i) * INPP + CC_G + c2 + q]);
            out[q] = (hf + pf * car[c2 + q] + hb + pb * car[256 + c2 + q]) * gelu_tanh_(g); }
        *(unsigned*)(mix + (size_t)(row0 + i) * DM + 512 + c2) = pack2(out[0], out[1]); }
    __syncthreads();
}

#define XB_TMO      128
#define XB_XCNT(j)  (256  + 64 * (j))
#define XB_XSUB(j)  (1280 + 64 * (j))
#define XB_XGEN(j)  (2304 + 64 * (j))
#define XB_TOP      3328
#define XB_TOPGEN   3392
#define XCD_BAR_WORDS 3456
#define XB_SPIN_CAP (1u << 18)
#define LAS __attribute__((address_space(3)))

__device__ __forceinline__ unsigned xb_ld(unsigned* p)              { return __hip_atomic_load(p, __ATOMIC_RELAXED, __HIP_MEMORY_SCOPE_AGENT); }
__device__ __forceinline__ unsigned xb_add(unsigned* p, unsigned v) { return __hip_atomic_fetch_add(p, v, __ATOMIC_RELAXED, __HIP_MEMORY_SCOPE_AGENT); }
__device__ __forceinline__ unsigned xb_xcc_id() { return (unsigned)__builtin_amdgcn_s_getreg((3 << 11) | 20) & 0xFu; }
#define XB_SPIN(cond, bar) do { unsigned _sp = 0; while (cond) { __builtin_amdgcn_s_sleep(1); \
    if ((++_sp & 255u) == 0u) { if (xb_ld(&(bar)[XB_TMO])) break; if (_sp > XB_SPIN_CAP) { atomicAdd(&(bar)[XB_TMO], 1u); break; } } } } while (0)

struct XcdBarrier {
    unsigned* bar; unsigned x;
    volatile LAS unsigned* st;
};

__device__ __forceinline__ XcdBarrier xcd_barrier_post(unsigned* bar, volatile LAS unsigned* st) {
    XcdBarrier b; b.bar = bar; b.x = xb_xcc_id(); b.st = st;
    if (threadIdx.x == 0) (void)xb_add(&bar[XB_XCNT(b.x)], 1u);
    return b;
}
__device__ __forceinline__ void xcd_barrier_complete(unsigned* bar, unsigned x, unsigned& nloc, unsigned& nx) {
    const unsigned G = gridDim.x * gridDim.y * gridDim.z;
    unsigned sum, cnt, mine, sp = 0u;
    for (;;) {
        sum = 0u; cnt = 0u; mine = 0u;
#pragma unroll
        for (unsigned j = 0; j < 16; ++j) { const unsigned c = xb_ld(&bar[XB_XCNT(j)]); sum += c; cnt += (c > 0u) ? 1u : 0u; mine = (j == x) ? c : mine; }
        if (sum == G) break;
        __builtin_amdgcn_s_sleep(1);
        if ((++sp & 255u) == 0u) { if (xb_ld(&bar[XB_TMO])) break; if (sp > XB_SPIN_CAP) { atomicAdd(&bar[XB_TMO], 1u); break; } }
    }
    nloc = mine > 0u ? mine : 1u; nx = cnt > 0u ? cnt : 1u;
}

__device__ __forceinline__ void xcd_barrier(const XcdBarrier& b) {
    asm volatile("s_waitcnt vmcnt(0)" ::: "memory");
    __syncthreads();
    if (threadIdx.x == 0) {
        unsigned* bar = b.bar;
        __builtin_amdgcn_s_waitcnt(0);
        unsigned nloc = b.st[0], nx = b.st[1];
        if (nloc == 0u) { xcd_barrier_complete(bar, b.x, nloc, nx); b.st[0] = nloc; b.st[1] = nx; }
        const unsigned old = xb_add(&bar[XB_XSUB(b.x)], 1u);
        const unsigned gen = old / nloc;
        if (old + 1u == (gen + 1u) * nloc) {
            __builtin_amdgcn_fence(__ATOMIC_RELEASE, "agent");
            asm volatile("s_waitcnt vmcnt(0)" ::: "memory");
            const unsigned og = xb_add(&bar[XB_TOP], 1u);
            const unsigned tg = og / nx;
            if (og + 1u == (tg + 1u) * nx) xb_add(&bar[XB_TOPGEN], 1u);
            else XB_SPIN(xb_ld(&bar[XB_TOPGEN]) == tg, bar);
            __builtin_amdgcn_fence(__ATOMIC_ACQUIRE, "agent");
            xb_add(&bar[XB_XGEN(b.x)], 1u);
            asm volatile("s_waitcnt vmcnt(0)" ::: "memory");
        } else {
            XB_SPIN(xb_ld(&bar[XB_XGEN(b.x)]) == gen, bar);
            __builtin_amdgcn_fence(__ATOMIC_ACQUIRE, "agent");
            asm volatile("s_waitcnt vmcnt(0)" ::: "memory");
        }
    }
    __syncthreads();
}


#define PROBE_SUB 0
enum { PH_PRO = 0, PH_CONVEXP, PH_PRE0, PH_INPROJ, PH_PREP, PH_MIX, PH_OUTPROJ, PH_POST1, PH_MOE1, PH_MOE2, PH_POST2, PH_POST3 };
constexpr int MAX_LDS = 140 * 1024;

template <int PH>
DI void run_phase(const Params& p, int l, int hf, char* smem) {
    const int G = gridDim.x, B = blockIdx.x;
    if (PH == PH_PRO) {
        const int n0 = MOD_UNITS, n1 = n0 + ROPE_UNITS, n2 = n1 + 2 * CONV_UNITS_SMALL, n3 = n2 + CONV_UNITS_EXP;
        for (int u = B; u < n3; u += G) {
            if (u < n0) mod_unit(p, u, smem);
            else if (u < n1) rope_unit(p, u - n0);
            else if (u < n2) { const int v = u - n1; convert_small_unit(p, v / CONV_UNITS_SMALL, v % CONV_UNITS_SMALL, smem); }
            else convert_exp_unit(p, 0, u - n2, smem);
        }
    } else if (PH == PH_CONVEXP) {
        for (int u = B; u < CONV_UNITS_EXP; u += G) convert_exp_unit(p, l, u, smem);
    } else if (PH == PH_PRE0) {
        for (int u = B; u < NTOK / 16; u += G) rowpost_unit<0>(p, 0, 0, u * 16, smem);
    } else if (PH == PH_INPROJ) {
        InprojS S{p, l}; gemm8<true>(smem, p.ws + OFF_RB, DM, S);
    } else if (PH == PH_PREP) {
        const int n0 = ssd_chunk_units(), n1 = n0 + lru_chunk_units(), n2 = n1 + PREP_UNITS;
        for (int u = B; u < n2; u += G) {
            if (u < n0) ssd_chunk_unit(p, l, u, smem);
            else if (u < n1) lru_chunk_unit(p, l, u - n0, smem);
            else prep_unit(p, l, u - n1);
        }
        if (PROBE_SUB == 1) for (int u = B; u < n0; u += G) ssd_chunk_unit(p, l, u, smem);
        if (PROBE_SUB == 2) for (int u = B; u < n1 - n0; u += G) lru_chunk_unit(p, l, u, smem);
        if (PROBE_SUB == 3) for (int u = B; u < PREP_UNITS; u += G) prep_unit(p, l, u);
    } else if (PH == PH_MIX) {
        const int n0 = attn_units(l), n1 = n0 + ssd_fin_units(l), n2 = n1 + lru_fin_units(l);
        for (int u = B; u < n2; u += G) {
            if (u < n0) attn_dispatch(p, l, u, smem);
            else if (u < n1) ssd_fin_unit(p, l, u - n0, smem);
            else lru_fin_unit(p, l, u - n1, smem);
        }
        if (PROBE_SUB == 4) for (int u = B; u < 256; u += G) attn_dispatch(p, l, u, smem);
        if (PROBE_SUB == 5) for (int u = 256 + B; u < n0; u += G) attn_dispatch(p, l, u, smem);
        if (PROBE_SUB == 6) for (int u = B; u < n1 - n0; u += G) ssd_fin_unit(p, l, u, smem);
        if (PROBE_SUB == 7) for (int u = B; u < n2 - n1; u += G) lru_fin_unit(p, l, u, smem);
    } else if (PH == PH_OUTPROJ) {
        OutprojS S{p, l}; gemm8<false>(smem, p.ws + OFF_RB, DM, S);
    } else if (PH == PH_POST1) {
        const int lo = l == 0 ? 0 : NCTX;
        for (int u = B; u < (NTOK - lo) / 16; u += G) rowpost_unit<1>(p, l, 0, lo + u * 16, smem);
    } else if (PH == PH_MOE1 || PH == PH_MOE2) {
        MoeTab* tb = (MoeTab*)(smem + GEMM_LDS);
        moe_table(p, l, hf, tb);
        if (PH == PH_MOE1) { Moe1S S{p, l, hf, tb}; gemm8<true>(smem, p.ws + OFF_RA, 1024, S); }
        else { Moe2S S{p, l, hf, tb}; gemm8<true>(smem, p.ws + OFF_HID, 256, S); }
        __syncthreads();
    } else if (PH == PH_POST2 || PH == PH_POST3) {
        const int lo = half_lo(l, hf), n = (half_hi(l, hf) - lo) / 16;
        moe_table(p, l, hf, (MoeTab*)(smem + GEMM_LDS));
        for (int u = B; u < n; u += G) { if (PH == PH_POST2) rowpost_unit<2>(p, l, hf, lo + u * 16, smem); else rowpost_unit<3>(p, l, hf, lo + u * 16, smem); }
    }
}

#ifndef MULTI_LAUNCH
#define MULTI_LAUNCH 0
#endif
#define PROBE_PH -1
#define GBAR() do { XcdBarrier b2_ = bar; asm volatile("" : "+s"(b2_.x)); asm volatile("" : "+s"(b2_.bar)); xcd_barrier(b2_); } while (0)
#define RUNP(PH, l, hf) do { run_phase<PH>(p, l, hf, smem); if (PROBE_PH == PH) run_phase<PH>(p, l, hf, smem); } while (0)
static_assert(XCD_BAR_WORDS * 4 <= 16 * 1024, "barrier words fit their region");
__global__ void __launch_bounds__(NTHR, 2) k_mega(Params p) {
    extern __shared__ __attribute__((aligned(16))) char smem[];
    uint4* xbw = (uint4*)(smem + MAX_LDS - 16);
    if (threadIdx.x == 0) *xbw = make_uint4(0u, 0u, 0u, 0u);
    __syncthreads();
    XcdBarrier bar = xcd_barrier_post((unsigned*)(p.ws + OFF_BAR), (volatile LAS unsigned*)xbw);
    RUNP(PH_PRO, 0, 0);
    GBAR();
    RUNP(PH_PRE0, 0, 0);
    GBAR();
#pragma unroll 1
    for (int l = 0; l < 2; ++l) {
        if (l == 1) RUNP(PH_CONVEXP, 1, 0);
        RUNP(PH_INPROJ, l, 0);
        GBAR();
        RUNP(PH_PREP, l, 0);
        GBAR();
        RUNP(PH_MIX, l, 0);
        GBAR();
        RUNP(PH_OUTPROJ, l, 0);
        GBAR();
        RUNP(PH_POST1, l, 0);
        GBAR();
        RUNP(PH_MOE1, l, 0);
        GBAR();
        RUNP(PH_MOE2, l, 0);
        GBAR();
        if (l == 0) RUNP(PH_POST2, l, 0); else RUNP(PH_POST3, l, 0);
        RUNP(PH_MOE1, l, 1);
        GBAR();
        RUNP(PH_MOE2, l, 1);
        GBAR();
        if (l == 0) { RUNP(PH_POST2, l, 1); GBAR(); } else RUNP(PH_POST3, l, 1);
    }
}

#if MULTI_LAUNCH
template <int PH>
__global__ void __launch_bounds__(NTHR, 2) k_phase(Params p, int l, int hf) {
    extern __shared__ __attribute__((aligned(16))) char smem[];
    run_phase<PH>(p, l, hf, smem);
}
template <int PH>
static void launch_phase(const Params& p, int l, int hf, int grid, hipStream_t st) {
    static bool inited = false;
    if (!inited) { (void)hipFuncSetAttribute((const void*)k_phase<PH>, hipFuncAttributeMaxDynamicSharedMemorySize, MAX_LDS); inited = true; }
    k_phase<PH><<<grid, NTHR, MAX_LDS, st>>>(p, l, hf);
}
#endif

extern "C" void kernel_launch(void* const* d_in, const int* in_sizes, int n_in, void* d_out, int out_size, void* d_ws, size_t ws_size, hipStream_t stream) {
    if (ws_size < WS_NEED || n_in < 36) return;
    Params p{};
    for (int i = 0; i < 36; ++i) p.in[i] = (const float*)d_in[i];
    p.out = (float*)d_out; p.ws = (char*)d_ws;
    (void)hipMemsetAsync(d_ws, 0, ZERO_BYTES, stream);
#if MULTI_LAUNCH
    const int G = 256;
    launch_phase<PH_PRO>(p, 0, 0, G, stream);
    launch_phase<PH_PRE0>(p, 0, 0, G, stream);
    for (int l = 0; l < 2; ++l) {
        if (l == 1) launch_phase<PH_CONVEXP>(p, 1, 0, G, stream);
        launch_phase<PH_INPROJ>(p, l, 0, G, stream);
        launch_phase<PH_PREP>(p, l, 0, G, stream);
        launch_phase<PH_MIX>(p, l, 0, G, stream);
        launch_phase<PH_OUTPROJ>(p, l, 0, G, stream);
        launch_phase<PH_POST1>(p, l, 0, G, stream);
        for (int hf = 0; hf < 2; ++hf) {
            launch_phase<PH_MOE1>(p, l, hf, G, stream);
            launch_phase<PH_MOE2>(p, l, hf, G, stream);
            if (l == 0) launch_phase<PH_POST2>(p, l, hf, G, stream); else launch_phase<PH_POST3>(p, l, hf, G, stream);
        }
    }
#else
    static int grid = 0;
    if (!grid) {
        int dev = 0, cus = 0, per_cu = 0;
        (void)hipGetDevice(&dev);
        (void)hipDeviceGetAttribute(&cus, hipDeviceAttributeMultiprocessorCount, dev);
        (void)hipFuncSetAttribute((const void*)k_mega, hipFuncAttributeMaxDynamicSharedMemorySize, MAX_LDS);
        (void)hipOccupancyMaxActiveBlocksPerMultiprocessor(&per_cu, (const void*)k_mega, NTHR, MAX_LDS);
        grid = per_cu >= 1 ? cus : 0;
    }
    if (grid > 0) k_mega<<<grid, NTHR, MAX_LDS, stream>>>(p);
#endif
}
```

```cpp
#include <hip/hip_runtime.h>
#include <stdint.h>

#define DI __device__ __forceinline__
typedef unsigned short bf16_t;
typedef short bf16x8 __attribute__((ext_vector_type(8)));
typedef short s16x4 __attribute__((ext_vector_type(4)));
typedef float f32x4 __attribute__((ext_vector_type(4)));
typedef float f32x16 __attribute__((ext_vector_type(16)));
typedef unsigned u32x4 __attribute__((ext_vector_type(4)));

constexpr int NTHR = 512;
constexpr int DM = 1024, NB = 4, SEQ = 4096, CTXL = 256;
constexpr int NCTX = NB * CTXL, NLAT = NB * SEQ, NTOK = NCTX + NLAT;
constexpr int INP = 2312, INPP = 2560;
constexpr int CA_Q = 0, CA_K = 256, CA_V = 384, CB_Z = 512, CB_X = 768, CB_B = 1024, CB_C = 1152, CB_DTF = 1280, CB_DTB = 1284,
              CC_X = 1288, CC_G = 1544, CD_Q = 1800, CD_K = 2056, CD_V = 2184;
constexpr int NCHK = 34;
constexpr int HCAP = NTOK;
constexpr float EPS = 1e-6f;
constexpr float YE_SCALE = 8.f;
typedef float f32x2 __attribute__((ext_vector_type(2)));

constexpr size_t MB = 1024 * 1024;
constexpr size_t OFF_BAR = 0;
constexpr size_t OFF_CNT = 16 * 1024;
constexpr size_t OFF_MOD = 32 * 1024;
constexpr size_t ZERO_BYTES = 32 * 1024 + 2 * 5 * 6144 * 4;
constexpr size_t OFF_ROPE = 512 * 1024;
constexpr size_t OFF_SLOT_TOK = 2 * MB;
constexpr size_t OFF_SLOT_W = 7 * MB;
constexpr size_t OFF_TOKSLOT = 12 * MB;
constexpr size_t OFF_LRUC = 13 * MB;
constexpr size_t OFF_SSDDEC = 14 * MB;
constexpr size_t OFF_RWT = 14 * MB + 64 * 1024;
constexpr size_t OFF_XCTX = 15 * MB;
constexpr size_t OFF_WIN = 20 * MB;
constexpr size_t SZ_WIN1 = (size_t)INPP * DM * 2;
constexpr size_t OFF_WOUT = OFF_WIN + 2 * SZ_WIN1;
constexpr size_t SZ_WOUT1 = (size_t)DM * DM * 2;
constexpr size_t OFF_WGU = 36 * MB;
constexpr size_t OFF_WD = OFF_WGU + (size_t)65 * 512 * 1024 * 2;
constexpr size_t OFF_Y = 134 * MB;
constexpr size_t OFF_XB = 168 * MB;
constexpr size_t OFF_RA = 202 * MB;
constexpr size_t OFF_HID = OFF_RA + (size_t)NTOK * DM * 2;
constexpr size_t OFF_RB = 321 * MB;
constexpr size_t OFF_RC = 355 * MB;
constexpr size_t OFF_QA = OFF_RC;
constexpr size_t OFF_KA = OFF_QA + (size_t)NTOK * 256 * 2;
constexpr size_t OFF_QD = OFF_KA + (size_t)NTOK * 128 * 2;
constexpr size_t OFF_KD = OFF_QD + (size_t)NTOK * 256 * 2;
constexpr size_t OFF_SSDST = OFF_KD + (size_t)NTOK * 128 * 2;
constexpr size_t OFF_YPART = OFF_SSDST + (size_t)4 * 4 * 2 * 34 * 4096 * 4;
constexpr size_t OFF_CC = OFF_YPART + (size_t)NTOK * 256 * 4;
constexpr size_t OFF_EA = OFF_CC + (size_t)NTOK * 128 * 4;
constexpr size_t OFF_LRUH = OFF_EA + (size_t)NTOK * 8 * 4;
constexpr size_t OFF_START = OFF_LRUH + (size_t)4 * NTOK * 256 * 2;
constexpr size_t OFF_CARRY = OFF_START + (size_t)4 * 4 * 2 * 34 * 4096 * 2;
static_assert(OFF_CARRY + 4 * 2 * 34 * 256 * 4 <= OFF_RC + (size_t)8 * HCAP * 1024, "phase scratch fits under ye");
constexpr size_t OFF_YE = OFF_RC;
constexpr size_t OFF_WD2 = OFF_RC + (size_t)8 * HCAP * 1024 + MB;
constexpr size_t WS_NEED = OFF_WD2 + (size_t)65 * 1024 * 256 * 2 + MB;
static_assert(OFF_HID + (size_t)(8 * NTOK + 64 * 255 + NTOK + 256) * 512 <= OFF_RB, "hid fits between the tokens and h");

struct Params {
    const float* in[36];
    float* out;
    char* ws;
};
enum { I_X = 0, I_C, I_CTX, I_CCTX, I_WADA, I_BADA, I_GMIXPRE, I_GMIXPOST, I_GFFNPRE, I_GFFNPOST, I_WIN, I_WOUT, I_ASINK, I_SSDCW, I_SSDCB, I_SSDDTB, I_SSDALOG,
       I_SSDD, I_SSDNORM, I_LRUCW, I_LRUCB, I_LRUWA, I_LRUBA, I_LRUWI, I_LRUBI, I_LRULAM, I_DQN, I_DKN, I_RW, I_RB, I_EG, I_EU, I_ED, I_SG, I_SU, I_SD };

DI int tidx() { int t = threadIdx.x; asm volatile("" : "+v"(t)); return t; }
DI float bf2f(bf16_t v) { return __uint_as_float(((unsigned)v) << 16); }
DI unsigned pack2(float lo, float hi) { unsigned r; asm("v_cvt_pk_bf16_f32 %0, %1, %2" : "=v"(r) : "v"(lo), "v"(hi)); return r; }
DI bf16_t f2bf(float f) { return (bf16_t)(pack2(f, 0.f) & 0xffffu); }
#define DPPF(v, ctrl) __int_as_float(__builtin_amdgcn_update_dpp(0, __float_as_int(v), ctrl, 0xf, 0xf, true))
#define DPPI(v, ctrl) __builtin_amdgcn_update_dpp(0, (v), ctrl, 0xf, 0xf, true)
DI float row16_sum(float v) { v += DPPF(v, 0xB1); v += DPPF(v, 0x4E); v += DPPF(v, 0x141); v += DPPF(v, 0x140); return v; }
DI float wave_sum(float v) {
    v = row16_sum(v);
    return __int_as_float(__builtin_amdgcn_readlane(__float_as_int(v), 0)) + __int_as_float(__builtin_amdgcn_readlane(__float_as_int(v), 16))
         + __int_as_float(__builtin_amdgcn_readlane(__float_as_int(v), 32)) + __int_as_float(__builtin_amdgcn_readlane(__float_as_int(v), 48));
}
DI float xhalf_max(float v) { auto rr = __builtin_amdgcn_permlane32_swap(__float_as_uint(v), __float_as_uint(v), false, false); return fmaxf(__uint_as_float(rr[0]), __uint_as_float(rr[1])); }
DI float xhalf_sum(float v) { auto rr = __builtin_amdgcn_permlane32_swap(__float_as_uint(v), __float_as_uint(v), false, false); return __uint_as_float(rr[0]) + __uint_as_float(rr[1]); }
DI float grp8_max(float v) { v = fmaxf(v, DPPF(v, 0xB1)); v = fmaxf(v, DPPF(v, 0x4E)); v = fmaxf(v, DPPF(v, 0x141)); return v; }
DI int grp8_min(int v) { v = min(v, DPPI(v, 0xB1)); v = min(v, DPPI(v, 0x4E)); v = min(v, DPPI(v, 0x141)); return v; }
DI float sigmoid_(float x) { return __builtin_amdgcn_rcpf(1.f + __builtin_amdgcn_exp2f(-1.4426950408889634f * x)); }
DI float silu_(float x) { return x * sigmoid_(x); }
DI float softplus_(float x) { return x > 20.f ? x : log1pf(__expf(x)); }
DI float gelu_tanh_(float x) { const float u = 0.7978845608028654f * (x + 0.044715f * x * x * x); const float th = 1.f - 2.f * __builtin_amdgcn_rcpf(1.f + __builtin_amdgcn_exp2f(2.8853900817779268f * u)); return 0.5f * x * (1.f + th); }
DI void lds_barrier() { asm volatile("s_waitcnt lgkmcnt(0)" ::: "memory"); __builtin_amdgcn_s_barrier(); asm volatile("" ::: "memory"); }
DI int crow(int reg, int h) { return (reg & 3) + 8 * (reg >> 2) + 4 * h; }

DI void ld8bf(const bf16_t* q, f32x4& a, f32x4& b) { const u32x4 v = *(const u32x4*)q; a = (f32x4){__uint_as_float(v[0] << 16), __uint_as_float(v[0] & 0xffff0000u), __uint_as_float(v[1] << 16), __uint_as_float(v[1] & 0xffff0000u)};
    b = (f32x4){__uint_as_float(v[2] << 16), __uint_as_float(v[2] & 0xffff0000u), __uint_as_float(v[3] << 16), __uint_as_float(v[3] & 0xffff0000u)}; }
DI void st8bf(bf16_t* q, const f32x4& a, const f32x4& b) { u32x4 o; o[0] = pack2(a[0], a[1]); o[1] = pack2(a[2], a[3]); o[2] = pack2(b[0], b[1]); o[3] = pack2(b[2], b[3]); *(u32x4*)q = o; }
DI const float* xin_row(const Params& p, int r) { return r < NCTX ? p.in[I_CTX] + (size_t)r * DM : p.in[I_X] + (size_t)(r - NCTX) * DM; }
DI int mod_idx(int r) { return r < NCTX ? 4 : ((r - NCTX) >> 12); }
DI const float* modp(const Params& p, int l, int bidx, int k) { return (const float*)(p.ws + OFF_MOD) + ((size_t)(l * 5 + bidx) * 6 + k) * DM; }
DI int half_lo(int l, int hf) { return hf == 0 ? (l == 0 ? 0 : NCTX) : NTOK; }
DI int half_hi(int l, int hf) { return NTOK; }

DI void transpose_tile(const float* __restrict__ src, int ld, int N, int k0, int n0, bf16_t* __restrict__ dst, int ldd, int mode, float* tile) {
    const int t = tidx();
    {
        const int col = t & 63, r8 = t >> 6;
#pragma unroll
        for (int i = 0; i < 8; ++i) { const int row = r8 + 8 * i; tile[row * 65 + col] = (n0 + col < N) ? src[(size_t)(k0 + row) * ld + n0 + col] : 0.f; }
    }
    __syncthreads();
    {
        const int n = t >> 3, kc = (t & 7) * 8;
        uint4 v;
        v.x = pack2(tile[(kc + 0) * 65 + n], tile[(kc + 1) * 65 + n]); v.y = pack2(tile[(kc + 2) * 65 + n], tile[(kc + 3) * 65 + n]);
        v.z = pack2(tile[(kc + 4) * 65 + n], tile[(kc + 5) * 65 + n]); v.w = pack2(tile[(kc + 6) * 65 + n], tile[(kc + 7) * 65 + n]);
        const int nn = n0 + n;
        int R = nn;
        if (mode) R = 256 * (nn >> 7) + (nn & 127) + (mode == 2 ? 128 : 0);
        *(uint4*)(dst + (size_t)R * ldd + k0 + kc) = v;
    }
    __syncthreads();
}
constexpr int CONV_UNITS_SMALL = 640 + 256, CONV_UNITS_EXP = 3 * 4160;
DI void convert_small_unit(const Params& p, int l, int u, char* smem) {
    float* tile = (float*)smem;
    if (u < 640) { const int kt = u / 40, nt = u % 40;
        transpose_tile(p.in[I_WIN] + (size_t)l * DM * INP, INP, INP, kt * 64, nt * 64, (bf16_t*)(p.ws + OFF_WIN + l * SZ_WIN1), DM, 0, tile); return; }
    u -= 640; { const int kt = u / 16, nt = u % 16;
        transpose_tile(p.in[I_WOUT] + (size_t)l * DM * DM, DM, DM, kt * 64, nt * 64, (bf16_t*)(p.ws + OFF_WOUT + l * SZ_WOUT1), DM, 0, tile); }
}
struct ConvDesc { const float* src; bf16_t* dst; int ld, ldd, k0, n0, mode, nvalid; };
constexpr int CONV_SUPER = 65 * 3 * 16;
DI ConvDesc conv_exp_desc(const Params& p, int l, int su) {
    ConvDesc d; const int mi = su >> 4, r = su & 15;
    if (mi < 130) { const int up = mi >= 65, e = up ? mi - 65 : mi;
        d.src = e < 64 ? p.in[up ? I_EU : I_EG] + ((size_t)l * 64 + e) * DM * 256 : p.in[up ? I_SU : I_SG] + (size_t)l * DM * 256;
        d.ld = 256; d.k0 = (r >> 2) * 256; d.n0 = (r & 3) * 64; d.dst = (bf16_t*)(p.ws + OFF_WGU) + (size_t)e * 512 * 1024; d.ldd = 1024; d.mode = up ? 2 : 1; d.nvalid = 64; return d; }
    { const int e = mi - 130;
        d.src = e < 64 ? p.in[I_ED] + ((size_t)l * 64 + e) * 256 * DM : p.in[I_SD] + (size_t)l * 256 * DM;
        d.ld = DM; d.k0 = 0; d.n0 = r * 64; d.dst = (bf16_t*)(p.ws + (l == 0 ? OFF_WD : OFF_WD2)) + (size_t)e * 1024 * 256; d.ldd = 256; d.mode = 0; d.nvalid = 64; return d; }
}
constexpr int CONV_SMALL_SUPER = 4 * 40 + 4 * 16;
DI ConvDesc conv_small_desc(const Params& p, int l, int su) {
    ConvDesc d; d.mode = 0; d.ldd = DM;
    if (su < 160) { const int kq = su / 40, nt = su % 40; d.src = p.in[I_WIN] + (size_t)l * DM * INP; d.ld = INP; d.k0 = kq * 256; d.n0 = nt * 64; d.dst = (bf16_t*)(p.ws + OFF_WIN + l * SZ_WIN1); d.nvalid = INP - nt * 64; return d; }
    su -= 160; { const int kq = su >> 4, nt = su & 15; d.src = p.in[I_WOUT] + (size_t)l * DM * DM; d.ld = DM; d.k0 = kq * 256; d.n0 = nt * 64; d.dst = (bf16_t*)(p.ws + OFF_WOUT + l * SZ_WOUT1); d.nvalid = 64; return d; }
}
DI int conv_count(int which) { return which == 0 ? 2 * CONV_SMALL_SUPER : CONV_SUPER; }
DI ConvDesc conv_any_desc(const Params& p, int which, int su) {
    if (which == 1) return conv_exp_desc(p, 1, su);
    if (which == 5) return conv_exp_desc(p, 0, su);
    return conv_small_desc(p, su / CONV_SMALL_SUPER, su % CONV_SMALL_SUPER);
}
DI void convert_run(const Params& p, int which, char* smem, int su0 = 0, int cnt = -1, int rank = -1, int stride = 0) {
    float* tile = (float*)smem;
    const int t = tidx(), G = stride > 0 ? stride : (int)gridDim.x;
    const int lr = t >> 4, lc = (t & 15) * 4;
    const int sn = t >> 3, sk = (t & 7) * 8;
    int u = su0 + (rank >= 0 ? rank : (int)blockIdx.x);
    const int NSU = cnt >= 0 ? su0 + cnt : conv_count(which);
    if (u >= NSU) return;
    ConvDesc d = conv_any_desc(p, which, u);
    f32x4 v[4][2], w[4][2];
#pragma unroll
    for (int j = 0; j < 4; ++j) { const float* sp = d.src + (size_t)(d.k0 + 64 * j + lr) * d.ld + d.n0 + lc; const bool ok = lc < d.nvalid; v[j][0] = ok ? *(const f32x4*)sp : (f32x4){0.f, 0.f, 0.f, 0.f}; v[j][1] = ok ? *(const f32x4*)(sp + (size_t)32 * d.ld) : (f32x4){0.f, 0.f, 0.f, 0.f}; }
    for (;;) {
        const int un = u + G; const bool more = un < NSU;
        ConvDesc dn = d;
        if (more) { dn = conv_any_desc(p, which, un);
#pragma unroll
            for (int j = 0; j < 4; ++j) { const float* sp = dn.src + (size_t)(dn.k0 + 64 * j + lr) * dn.ld + dn.n0 + lc; const bool ok = lc < dn.nvalid; w[j][0] = ok ? *(const f32x4*)sp : (f32x4){0.f, 0.f, 0.f, 0.f}; w[j][1] = ok ? *(const f32x4*)(sp + (size_t)32 * dn.ld) : (f32x4){0.f, 0.f, 0.f, 0.f}; } }
#pragma unroll
        for (int j = 0; j < 4; ++j)
#pragma unroll
            for (int e = 0; e < 4; ++e) { tile[j * 64 * 65 + lr * 65 + lc + e] = v[j][0][e]; tile[j * 64 * 65 + (lr + 32) * 65 + lc + e] = v[j][1][e]; }
        __syncthreads();
        const int nn = d.n0 + sn;
        const int R = d.mode ? 256 * (nn >> 7) + (nn & 127) + (d.mode == 2 ? 128 : 0) : nn;
#pragma unroll
        for (int j = 0; j < 4; ++j) { const float* tb = tile + j * 64 * 65; u32x4 o;
            o[0] = pack2(tb[(sk + 0) * 65 + sn], tb[(sk + 1) * 65 + sn]); o[1] = pack2(tb[(sk + 2) * 65 + sn], tb[(sk + 3) * 65 + sn]);
            o[2] = pack2(tb[(sk + 4) * 65 + sn], tb[(sk + 5) * 65 + sn]); o[3] = pack2(tb[(sk + 6) * 65 + sn], tb[(sk + 7) * 65 + sn]);
            *(u32x4*)(d.dst + (size_t)R * d.ldd + d.k0 + 64 * j + sk) = o; }
        __syncthreads();
        if (!more) break;
        d = dn; u = un;
#pragma unroll
        for (int j = 0; j < 4; ++j) { v[j][0] = w[j][0]; v[j][1] = w[j][1]; }
    }
}
constexpr int CONV_A = 88 * 9, CONV_B = 240 * 9, CONV_GU = 130 * 16;
constexpr int MOD_UNITS = 2 * 96;
DI void mod_unit(const Params& p, int u, char* smem) {
    float* s = (float*)smem;
    float* part = s + 5 * 1024;
    const int l = u / 96, cb = u % 96, t = tidx(), col = t & 63, kg = t >> 6;
    for (int i = t; i < 5 * 1024; i += NTHR) { const int v = i >> 10, k = i & 1023; const float c = v < 4 ? p.in[I_C][v * DM + k] : p.in[I_CCTX][k]; s[i] = silu_(c); }
    __syncthreads();
    const int j = cb * 64 + col;
    const float* w = p.in[I_WADA] + (size_t)l * DM * 6144 + (size_t)(kg * 128) * 6144 + j;
    float a0 = 0, a1 = 0, a2 = 0, a3 = 0, a4 = 0;
#pragma unroll 16
    for (int k = 0; k < 128; ++k) { const float wv = w[(size_t)k * 6144]; const int kk = kg * 128 + k;
        a0 += s[kk] * wv; a1 += s[1024 + kk] * wv; a2 += s[2048 + kk] * wv; a3 += s[3072 + kk] * wv; a4 += s[4096 + kk] * wv; }
    part[(kg * 5 + 0) * 64 + col] = a0; part[(kg * 5 + 1) * 64 + col] = a1; part[(kg * 5 + 2) * 64 + col] = a2; part[(kg * 5 + 3) * 64 + col] = a3; part[(kg * 5 + 4) * 64 + col] = a4;
    __syncthreads();
    if (t < 320) { const int v = t >> 6, c = t & 63; float acc = p.in[I_BADA][l * 6144 + cb * 64 + c];
#pragma unroll
        for (int g = 0; g < 8; ++g) acc += part[(g * 5 + v) * 64 + c];
        ((float*)(p.ws + OFF_MOD))[(size_t)(l * 5 + v) * 6144 + cb * 64 + c] = acc; }
    __syncthreads();
}
constexpr int RWT_UNITS = 2 * 16;
DI void rwt_unit(const Params& p, int u, char* smem) {
    float* tile = (float*)smem; const int t = tidx(), l = u >> 4, k0 = (u & 15) * 64;
#pragma unroll
    for (int i = 0; i < 8; ++i) { const int idx = t + NTHR * i, k = idx >> 6, e = idx & 63; tile[k * 65 + e] = p.in[I_RW][(size_t)l * DM * 64 + (size_t)(k0 + k) * 64 + e]; }
    __syncthreads();
#pragma unroll
    for (int i = 0; i < 8; ++i) { const int idx = t + NTHR * i, e = idx >> 6, k = idx & 63; const float v = tile[k * 65 + e];
        const bf16_t hi = f2bf(v), lo = f2bf(v - bf2f(hi)); bf16_t* W = (bf16_t*)(p.ws + OFF_RWT) + (size_t)l * 2 * 64 * DM;
        const int kk = k0 + k;
        const size_t o = (((size_t)((kk >> 7) * 4 + ((kk >> 5) & 3)) * 2) * 4 + (e >> 4)) * 512 + (size_t)(((kk >> 3) & 3) * 16 + (e & 15)) * 8 + (kk & 7);
        W[o] = hi; W[o + 4 * 512] = lo; }
    __syncthreads();
}
constexpr int ROPE_UNITS = 4096 * 32 / NTHR;
DI void rope_unit(const Params& p, int u) {
    const int idx = u * NTHR + tidx(), t = idx >> 5, i = idx & 31;
    const float pos = (float)(i < 16 ? (t >> 6) : (t & 63));
    const float inv = powf(10000.f, -(float)(2 * (i & 15)) / 32.f);
    const float ang = pos * inv;
    ((float2*)(p.ws + OFF_ROPE))[idx] = make_float2(cosf(ang), sinf(ang));
}

constexpr int GEMM_LDS = 131072;
struct MoeTab { int cnt[65]; int mstart[66]; int hoffP[65]; int hoffU[65]; };
constexpr int HP = 1028;
#define PROBE_STAGE -1
#define STG(k) do { if (PROBE_STAGE >= 0) { __syncthreads(); if (blockIdx.x == 0 && threadIdx.x == 0) { const unsigned long long t_ = wall_clock64(); tacc[k] += t_ - tlast; tlast = t_; } } } while (0)
template <int MODE>
DI void rowpost_row(const Params& p, int l, int r, int lane, const int* hoffU, float* hdst) {
    const int bidx = mod_idx(r);
    f32x4 xv[4];
    if (MODE == 0) {
        const float* xs = xin_row(p, r);
#pragma unroll
        for (int i = 0; i < 2; ++i) { xv[2 * i] = *(const f32x4*)(xs + 8 * lane + 512 * i); xv[2 * i + 1] = *(const f32x4*)(xs + 8 * lane + 512 * i + 4); }
    } else {
        f32x4 yv[4];
        const bf16_t* Y = (const bf16_t*)(p.ws + OFF_Y) + (size_t)r * DM;
        const bf16_t* xb = (const bf16_t*)(p.ws + OFF_XB) + (size_t)r * DM;
        uint2 q[8][2];
        if (MODE >= 2) {
            const int* ts = (const int*)(p.ws + OFF_TOKSLOT) + (size_t)r * 8;
            const int4 t0 = *(const int4*)ts, t1 = *(const int4*)(ts + 4);
            const int tv[8] = {t0.x, t0.y, t0.z, t0.w, t1.x, t1.y, t1.z, t1.w};
            const unsigned char* ye = (const unsigned char*)(p.ws + OFF_YE);
#pragma unroll
            for (int k = 0; k < 8; ++k) { const unsigned char* yr = ye + (size_t)(hoffU[tv[k] >> 15] + (tv[k] & 32767)) * DM + 8 * lane;
                q[k][0] = *(const uint2*)(yr); q[k][1] = *(const uint2*)(yr + 512); }
        }
#pragma unroll
        for (int i = 0; i < 2; ++i) { ld8bf(Y + 8 * lane + 512 * i, yv[2 * i], yv[2 * i + 1]);
            if (MODE == 1 && l == 0) { const float* xs = xin_row(p, r); xv[2 * i] = *(const f32x4*)(xs + 8 * lane + 512 * i); xv[2 * i + 1] = *(const f32x4*)(xs + 8 * lane + 512 * i + 4); }
            else ld8bf(xb + 8 * lane + 512 * i, xv[2 * i], xv[2 * i + 1]); }
        if (MODE >= 2) {
            f32x4 ys[4];
#pragma unroll
            for (int i = 0; i < 4; ++i) ys[i] = (f32x4){0.f, 0.f, 0.f, 0.f};
#pragma unroll
            for (int k = 0; k < 8; ++k)
#pragma unroll
                for (int i = 0; i < 2; ++i) { const uint2 v = q[k][i];
                    const f32x2 a = __builtin_amdgcn_cvt_pk_f32_fp8((int)v.x, false), b = __builtin_amdgcn_cvt_pk_f32_fp8((int)v.x, true), c = __builtin_amdgcn_cvt_pk_f32_fp8((int)v.y, false), d = __builtin_amdgcn_cvt_pk_f32_fp8((int)v.y, true);
                    ys[2 * i][0] += a[0]; ys[2 * i][1] += a[1]; ys[2 * i][2] += b[0]; ys[2 * i][3] += b[1];
                    ys[2 * i + 1][0] += c[0]; ys[2 * i + 1][1] += c[1]; ys[2 * i + 1][2] += d[0]; ys[2 * i + 1][3] += d[1]; }
#pragma unroll
            for (int i = 0; i < 4; ++i) yv[i] = yv[i] + ys[i] * (1.f / YE_SCALE);
        }
        float ss = 0.f;
#pragma unroll
        for (int i = 0; i < 4; ++i) ss += yv[i][0] * yv[i][0] + yv[i][1] * yv[i][1] + yv[i][2] * yv[i][2] + yv[i][3] * yv[i][3];
        ss = wave_sum(ss);
        const float rs = rsqrtf(ss * (1.f / DM) + EPS);
        const float* gate = modp(p, l, bidx, MODE == 1 ? 2 : 5);
        const float* gp = p.in[MODE == 1 ? I_GMIXPOST : I_GFFNPOST] + l * DM;
#pragma unroll
        for (int i = 0; i < 4; ++i) { const int c = 8 * lane + 512 * (i >> 1) + 4 * (i & 1);
            const f32x4 g = *(const f32x4*)(gate + c), qq = *(const f32x4*)(gp + c);
            xv[i] = xv[i] + g * (yv[i] * rs * qq);
            if (MODE == 3) *(f32x4*)(p.out + (size_t)(r - NCTX) * DM + c) = xv[i]; }
        if (MODE != 3) { bf16_t* xo = (bf16_t*)(p.ws + OFF_XB) + (size_t)r * DM; st8bf(xo + 8 * lane, xv[0], xv[1]); st8bf(xo + 8 * lane + 512, xv[2], xv[3]); }
    }
    if (MODE != 3) {
        const int lp = MODE == 2 ? l + 1 : l;
        float ss = 0.f;
#pragma unroll
        for (int i = 0; i < 4; ++i) ss += xv[i][0] * xv[i][0] + xv[i][1] * xv[i][1] + xv[i][2] * xv[i][2] + xv[i][3] * xv[i][3];
        ss = wave_sum(ss);
        const float rs = rsqrtf(ss * (1.f / DM) + EPS);
        const float* gpre = p.in[MODE == 1 ? I_GFFNPRE : I_GMIXPRE] + lp * DM;
        const float* sh = modp(p, lp, bidx, MODE == 1 ? 3 : 0);
        const float* sc = modp(p, lp, bidx, MODE == 1 ? 4 : 1);
        bf16_t* hb = (bf16_t*)(p.ws + (MODE == 1 ? OFF_RA : OFF_RB)) + (size_t)r * DM;
#pragma unroll
        for (int i = 0; i < 2; ++i) { const int c = 8 * lane + 512 * i;
            f32x4 h[2];
#pragma unroll
            for (int j = 0; j < 2; ++j) { const f32x4 g = *(const f32x4*)(gpre + c + 4 * j), s1 = *(const f32x4*)(sh + c + 4 * j), s2 = *(const f32x4*)(sc + c + 4 * j);
                h[j] = xv[2 * i + j] * rs * g * (s2 + 1.f) + s1;
                if (MODE == 1) *(f32x4*)(hdst + c + 4 * j) = h[j]; }
            u32x4 o; o[0] = pack2(h[0][0], h[0][1]); o[1] = pack2(h[0][2], h[0][3]); o[2] = pack2(h[1][0], h[1][1]); o[3] = pack2(h[1][2], h[1][3]);
            *(u32x4*)(hb + c) = o; }
    }
}
template <int MODE>
DI void rowpost_unit(const Params& p, int l, int hf, int r0, char* smem) {
    const int* hoffU = ((const MoeTab*)(smem + GEMM_LDS))->hoffU;
    const int tid = tidx(), lane = tid & 63, w = tid >> 6;
#pragma unroll
    for (int rr = 0; rr < 2; ++rr) rowpost_row<MODE>(p, l, r0 + 2 * w + rr, lane, hoffU, nullptr);
}
DI void rp1_load(const Params& p, int l, int r, int lane, f32x4 (&yv)[4], f32x4 (&xv)[4]) {
    const bf16_t* Y = (const bf16_t*)(p.ws + OFF_Y) + (size_t)r * DM;
#pragma unroll
    for (int i = 0; i < 2; ++i) { ld8bf(Y + 8 * lane + 512 * i, yv[2 * i], yv[2 * i + 1]);
        if (l == 0) { const float* xs = xin_row(p, r); xv[2 * i] = *(const f32x4*)(xs + 8 * lane + 512 * i); xv[2 * i + 1] = *(const f32x4*)(xs + 8 * lane + 512 * i + 4); }
        else ld8bf((const bf16_t*)(p.ws + OFF_XB) + (size_t)r * DM + 8 * lane + 512 * i, xv[2 * i], xv[2 * i + 1]); }
}
DI void rp1_compute(const Params& p, int l, int r, int lane, const f32x4 (&yv)[4], f32x4 (&xv)[4], float* hdst) {
    const int bidx = mod_idx(r);
    float ss = 0.f;
#pragma unroll
    for (int i = 0; i < 4; ++i) ss += yv[i][0] * yv[i][0] + yv[i][1] * yv[i][1] + yv[i][2] * yv[i][2] + yv[i][3] * yv[i][3];
    ss = wave_sum(ss);
    const float rs = rsqrtf(ss * (1.f / DM) + EPS);
    const float* gate = modp(p, l, bidx, 2);
    const float* gp = p.in[I_GMIXPOST] + l * DM;
#pragma unroll
    for (int i = 0; i < 4; ++i) { const int c = 8 * lane + 512 * (i >> 1) + 4 * (i & 1);
        const f32x4 g = *(const f32x4*)(gate + c), qq = *(const f32x4*)(gp + c);
        xv[i] = xv[i] + g * (yv[i] * rs * qq); }
    { bf16_t* xo = (bf16_t*)(p.ws + OFF_XB) + (size_t)r * DM; st8bf(xo + 8 * lane, xv[0], xv[1]); st8bf(xo + 8 * lane + 512, xv[2], xv[3]); }
    float s2 = 0.f;
#pragma unroll
    for (int i = 0; i < 4; ++i) s2 += xv[i][0] * xv[i][0] + xv[i][1] * xv[i][1] + xv[i][2] * xv[i][2] + xv[i][3] * xv[i][3];
    s2 = wave_sum(s2);
    const float r2 = rsqrtf(s2 * (1.f / DM) + EPS);
    const float* gpre = p.in[I_GFFNPRE] + l * DM;
    const float* sh = modp(p, l, bidx, 3);
    const float* sc = modp(p, l, bidx, 4);
    bf16_t* hb = (bf16_t*)(p.ws + OFF_RA) + (size_t)r * DM;
#pragma unroll
    for (int i = 0; i < 2; ++i) { const int c = 8 * lane + 512 * i;
        f32x4 h[2];
#pragma unroll
        for (int j = 0; j < 2; ++j) { const f32x4 g = *(const f32x4*)(gpre + c + 4 * j), s1 = *(const f32x4*)(sh + c + 4 * j), sv = *(const f32x4*)(sc + c + 4 * j);
            h[j] = xv[2 * i + j] * r2 * g * (sv + 1.f) + s1; *(f32x4*)(hdst + c + 4 * j) = h[j]; }
        u32x4 o; o[0] = pack2(h[0][0], h[0][1]); o[1] = pack2(h[0][2], h[0][3]); o[2] = pack2(h[1][0], h[1][1]); o[3] = pack2(h[1][2], h[1][3]);
        *(u32x4*)(hb + c) = o; }
}
constexpr int RP_PART = 16 * HP * 4, RP_HIST = RP_PART + 8 * 16 * 64 * 4, RP_BASE = RP_HIST + 256, RP_SEL = RP_BASE + 256, RP_SELW = RP_SEL + 68 * 8 * 4;
DI void route_unit(const Params& p, int l, int rlo, int rhi, char* smem) {
    float* hrow = (float*)smem;
    float* part = (float*)(smem + RP_PART);
    int* hist = (int*)(smem + RP_HIST);
    int* base = (int*)(smem + RP_BASE);
    int* selv = (int*)(smem + RP_SEL);
    float* selw = (float*)(smem + RP_SELW);
    const int tid = tidx(), lane = tid & 63, w = tid >> 6;
    if (tid < 64) hist[tid] = 0;
    unsigned long long* tacc = (unsigned long long*)(smem + 140 * 1024 - 16 - 32 * 8 - 64); unsigned long long tlast = (PROBE_STAGE >= 0) ? wall_clock64() : 0ull;
    const float rbias = p.in[I_RB][l * 64 + lane];
    const float* rw = p.in[I_RW] + (size_t)l * DM * 64;
    f32x4 pyv[2][4], pxv[2][4];
#pragma unroll
    for (int rr = 0; rr < 2; ++rr) { const int r = rlo + 2 * w + rr; if (r < rhi) rp1_load(p, l, r, lane, pyv[rr], pxv[rr]); }
#pragma unroll 1
    for (int rb = rlo; rb < rhi; rb += 16) {
#pragma unroll
        for (int rr = 0; rr < 2; ++rr) { const int r = rb + 2 * w + rr; if (r < rhi) rp1_compute(p, l, r, lane, pyv[rr], pxv[rr], hrow + (2 * w + rr) * HP); }
#pragma unroll
        for (int rr = 0; rr < 2; ++rr) { const int r = rb + 16 + 2 * w + rr; if (r < rhi) rp1_load(p, l, r, lane, pyv[rr], pxv[rr]); }
        lds_barrier();
        STG(0);
        {
            const int i16 = lane & 15, kq = lane >> 4;
            const bf16_t* wt = (const bf16_t*)(p.ws + OFF_RWT) + (size_t)l * 2 * 64 * DM + (size_t)w * 4 * 2 * 4 * 512 + lane * 8;
            const float* hp = hrow + i16 * HP + 128 * w + 8 * kq;
            bf16x8 bh[4][4], bl[4][4];
#pragma unroll
            for (int ks = 0; ks < 4; ++ks)
#pragma unroll
                for (int n = 0; n < 4; ++n) { bh[ks][n] = *(const bf16x8*)(wt + ((ks * 2 + 0) * 4 + n) * 512); bl[ks][n] = *(const bf16x8*)(wt + ((ks * 2 + 1) * 4 + n) * 512); }
            f32x4 acc[4];
#pragma unroll
            for (int n = 0; n < 4; ++n) acc[n] = (f32x4){0.f, 0.f, 0.f, 0.f};
#pragma unroll
            for (int ks = 0; ks < 4; ++ks) {
                const f32x4 a0 = *(const f32x4*)(hp + 32 * ks), a1 = *(const f32x4*)(hp + 32 * ks + 4);
                union { unsigned u[4]; bf16x8 v; } ah, al;
                ah.u[0] = pack2(a0[0], a0[1]); ah.u[1] = pack2(a0[2], a0[3]); ah.u[2] = pack2(a1[0], a1[1]); ah.u[3] = pack2(a1[2], a1[3]);
                al.u[0] = pack2(a0[0] - __uint_as_float(ah.u[0] << 16), a0[1] - __uint_as_float(ah.u[0] & 0xffff0000u)); al.u[1] = pack2(a0[2] - __uint_as_float(ah.u[1] << 16), a0[3] - __uint_as_float(ah.u[1] & 0xffff0000u));
                al.u[2] = pack2(a1[0] - __uint_as_float(ah.u[2] << 16), a1[1] - __uint_as_float(ah.u[2] & 0xffff0000u)); al.u[3] = pack2(a1[2] - __uint_as_float(ah.u[3] << 16), a1[3] - __uint_as_float(ah.u[3] & 0xffff0000u));
#pragma unroll
                for (int n = 0; n < 4; ++n) {
                    acc[n] = __builtin_amdgcn_mfma_f32_16x16x32_bf16(ah.v, bh[ks][n], acc[n], 0, 0, 0);
                    acc[n] = __builtin_amdgcn_mfma_f32_16x16x32_bf16(ah.v, bl[ks][n], acc[n], 0, 0, 0);
                    acc[n] = __builtin_amdgcn_mfma_f32_16x16x32_bf16(al.v, bh[ks][n], acc[n], 0, 0, 0); }
            }
#pragma unroll
            for (int n = 0; n < 4; ++n)
#pragma unroll
                for (int j = 0; j < 4; ++j) part[(w * 16 + kq * 4 + j) * 64 + n * 16 + i16] = acc[n][j];
        }
        lds_barrier();
        STG(1);
#pragma unroll 1
        for (int rr = 0; rr < 2; ++rr) {
            const int r = rb + 2 * w + rr;
            if (r < rhi) {
                float lg = 0.f;
#pragma unroll
                for (int g = 0; g < 8; ++g) lg += part[(g * 16 + 2 * w + rr) * 64 + lane];
                const float s = sigmoid_(lg);
                const float v = s + rbias;
                const float m1 = grp8_max(v);
                const int ix = grp8_min((v == m1) ? lane : 64);
                const float m2 = grp8_max((lane == ix) ? -INFINITY : v);
                const float gs = m1 + m2;
                const int g = lane >> 3; int grank = 0;
#pragma unroll
                for (int gg = 0; gg < 8; ++gg) { const float o = __int_as_float(__builtin_amdgcn_readlane(__float_as_int(gs), gg * 8)); grank += (o > gs) || (o == gs && gg < g); }
                const bool gsel = grank < 4;
                const float vm = gsel ? v : -INFINITY;
                int rk = 0;
#pragma unroll
                for (int ee = 0; ee < 64; ++ee) { const float o = __int_as_float(__builtin_amdgcn_readlane(__float_as_int(vm), ee)); rk += (o > vm) || (o == vm && ee < lane); }
                const bool sel = gsel && rk < 8;
                const float scs = sel ? s : 0.f;
                const float tot = wave_sum(scs);
                if (sel) { const int lr = atomicAdd(&hist[lane], 1); selv[(r - rlo) * 8 + rk] = (lane << 8) | lr; selw[(r - rlo) * 8 + rk] = scs / tot * 2.5f; }
            }
        }
        STG(2);
    }
    __syncthreads();
    const int hh = rlo >= half_lo(l, 1) ? 1 : 0;
    if (tid < 64) { const int n = hist[tid]; base[tid] = n ? atomicAdd((int*)(p.ws + OFF_CNT) + (l * 2 + hh) * 64 + tid, n) : 0; }
    __syncthreads();
    for (int it = tid; it < (rhi - rlo) * 8; it += NTHR) { const int v = selv[it], e = v >> 8, pos = base[e] + (v & 255), r = rlo + (it >> 3);
        ((int*)(p.ws + OFF_SLOT_TOK))[(size_t)(hh * 64 + e) * HCAP + pos] = r;
        ((float*)(p.ws + OFF_SLOT_W))[(size_t)(hh * 64 + e) * HCAP + pos] = selw[it];
        ((int*)(p.ws + OFF_TOKSLOT))[(size_t)r * 8 + (it & 7)] = (e << 15) | pos; }
    __syncthreads();
}

#define G8_LAS __attribute__((address_space(3)))
constexpr int LDT = 72;
constexpr int G8_HTB = 128 * 64 * 2;
static_assert(GEMM_LDS == 8 * G8_HTB, "stage region");
DI int g8_lds_byte(int r, int c) { const int st = (r >> 4) * 2 + (c >> 5), rr = r & 15, cc = c & 31, ob = rr * 64 + cc * 2; return st * 1024 + (ob ^ (((ob >> 9) & 1) << 5)); }
DI void g8_stage_rc(int b, int& R, int& C) { const int st = b / 1024, sb = b % 1024, swz = sb ^ (((sb >> 9) & 1) << 5); R = (st >> 1) * 16 + swz / 64; C = (st & 1) * 32 + (swz % 64) / 2; }
DI int g8_perm32(int rho) { const int n = rho >> 4, i = rho & 15; return 8 * (i >> 2) + 4 * n + (i & 3); }
#define PROBE_G8 -1
#define G8_T0() do { if (PROBE_G8 == Sched::ID && blockIdx.x == 0 && threadIdx.x == 0) g8t = wall_clock64(); } while (0)
#define G8_T1(k) do { if (PROBE_G8 == Sched::ID && blockIdx.x == 0 && threadIdx.x == 0) { const unsigned long long t_ = wall_clock64(); ((unsigned long long*)(smem + 140 * 1024 - 16 - 32 * 8 - 64))[k] += t_ - g8t; g8t = t_; } } while (0)
template <bool PERM, class Sched>
DI void gemm8(char* smem, const char* Abase, int K, Sched& S) {
    G8_LAS unsigned char* lds = (G8_LAS unsigned char*)smem;
    const int tid = tidx(), wid = __builtin_amdgcn_readfirstlane(tid >> 6), lane = tid & 63, wr = wid >> 2, wc = wid & 3, fr = lane & 15, fq = lane >> 4;
    const int nt = K / 64;
    unsigned voffB[2];
#pragma unroll
    for (int i = 0; i < 2; ++i) { int R, C; g8_stage_rc(tid * 16 + i * 8192, R, C); const int Rb = PERM ? ((R & ~31) + g8_perm32(R & 31)) : R; voffB[i] = (unsigned)(Rb * K + C) * 2u; }
    const size_t kstep = 128, hstep = (size_t)128 * K * 2;
    const unsigned ldsw = (unsigned)wid * 1024u;
    const int aoff = g8_lds_byte(wr * 64 + fr, fq * 8), boff = g8_lds_byte(wc * 32 + fr, fq * 8);
#define G8_SA(b, h) (((b) * 2 + (h)) * G8_HTB)
#define G8_SB(b, h) ((4 + (b) * 2 + (h)) * G8_HTB)
#define G8_STAGEB(bufoff, gbase) do { _Pragma("unroll") for (int _i = 0; _i < 2; ++_i) \
        __builtin_amdgcn_global_load_lds((const unsigned*)((const char*)(gbase) + voffB[_i]), (G8_LAS unsigned*)(lds + (bufoff) + ldsw + _i * 8192), 16, 0, 0); } while (0)
#define G8_STAGEA(bufoff, ao, h, kb) do { _Pragma("unroll") for (int _i = 0; _i < 2; ++_i) \
        __builtin_amdgcn_global_load_lds((const unsigned*)(Abase + (size_t)(ao)[h][_i] + (kb)), (G8_LAS unsigned*)(lds + (bufoff) + ldsw + _i * 8192), 16, 0, 0); } while (0)
#define G8_LDA(dst, b, h) do { _Pragma("unroll") for (int m = 0; m < 4; ++m) _Pragma("unroll") for (int k = 0; k < 2; ++k) dst[m][k] = *(const G8_LAS bf16x8*)(lds + G8_SA(b, h) + aoff + m * 2048 + k * 1024); } while (0)
#define G8_LDB(dst, b, h) do { _Pragma("unroll") for (int n = 0; n < 2; ++n) _Pragma("unroll") for (int k = 0; k < 2; ++k) dst[n][k] = *(const G8_LAS bf16x8*)(lds + G8_SB(b, h) + boff + n * 2048 + k * 1024); } while (0)
#define G8_MMA(ai, bj, At, Bt) do { __builtin_amdgcn_s_setprio(1); _Pragma("unroll") for (int m = 0; m < 4; ++m) _Pragma("unroll") for (int n = 0; n < 2; ++n) _Pragma("unroll") for (int k = 0; k < 2; ++k) \
        acc[ai][bj][m][n] = __builtin_amdgcn_mfma_f32_16x16x32_bf16(Bt[n][k], At[m][k], acc[ai][bj][m][n], 0, 0, 0); __builtin_amdgcn_s_setprio(0); } while (0)
#define G8_WAIT_V(n) asm volatile("s_waitcnt vmcnt(" #n ")" ::: "memory")
#define G8_WAIT_L(n) asm volatile("s_waitcnt lgkmcnt(" #n ")" ::: "memory")
#define G8_BAR __builtin_amdgcn_s_barrier()
#define G8_SCHED __builtin_amdgcn_sched_barrier(0)
    typename Sched::U cur, nxt; int ui = 0; unsigned long long g8t = 0ull;
    if (!S.next(0, cur)) return;
    f32x4 acc[2][2][4][2];
#pragma unroll
    for (int a = 0; a < 2; ++a)
#pragma unroll
        for (int b = 0; b < 2; ++b)
#pragma unroll
            for (int m = 0; m < 4; ++m)
#pragma unroll
                for (int n = 0; n < 2; ++n) acc[a][b][m][n] = (f32x4){0.f, 0.f, 0.f, 0.f};
    bf16x8 At[4][2], B0[2][2], B1[2][2];
    unsigned cao[2][2];
    S.aoffs(cur, cao);
    const char* cB = S.bbase(cur);
    G8_STAGEB(G8_SB(0, 0), cB); G8_STAGEA(G8_SA(0, 0), cao, 0, 0); G8_STAGEB(G8_SB(0, 1), cB + hstep); G8_STAGEA(G8_SA(0, 1), cao, 1, 0);
    if (wr == 1) G8_BAR;
    G8_WAIT_V(4); G8_BAR;
    G8_STAGEB(G8_SB(1, 0), cB + kstep); G8_STAGEA(G8_SA(1, 0), cao, 0, kstep); G8_STAGEB(G8_SB(1, 1), cB + hstep + kstep);
    G8_WAIT_V(6); G8_BAR;
    for (;;) {
        nxt = cur;
        const bool has_next = S.next(ui + 1, nxt);
        const char* nB = cB;
        G8_T0();
#pragma unroll 1
        for (int t = 0; t < nt; t += 2) {
            const bool last = (t == nt - 2);
            if (last && has_next) nB = S.bbase(nxt);
            const size_t k1 = (size_t)(t + 1) * kstep;
            const size_t k2 = last ? 0 : (size_t)(t + 2) * kstep, k3 = k2 + kstep;
            const char* b2 = last ? nB : cB + k2; const char* b3 = b2 + kstep;
            G8_LDB(B0, 0, 0); G8_SCHED; G8_LDA(At, 0, 0); G8_STAGEA(G8_SA(1, 1), cao, 1, k1);
            if (last && has_next) S.aoffs(nxt, cao);
            G8_WAIT_L(8); G8_BAR; G8_WAIT_L(0); G8_MMA(0, 0, At, B0); G8_BAR; G8_SCHED;
            G8_LDB(B1, 0, 1); G8_STAGEB(G8_SB(0, 0), b2);
            G8_BAR; G8_WAIT_L(0); G8_MMA(0, 1, At, B1); G8_BAR;
            G8_LDA(At, 0, 1); G8_STAGEA(G8_SA(0, 0), cao, 0, k2);
            G8_BAR; G8_WAIT_L(0); G8_MMA(1, 0, At, B0); G8_BAR; G8_SCHED;
            G8_STAGEB(G8_SB(0, 1), b2 + hstep);
            G8_WAIT_V(6); G8_BAR; G8_MMA(1, 1, At, B1); G8_BAR;
            G8_LDB(B0, 1, 0); G8_SCHED; G8_LDA(At, 1, 0); G8_STAGEA(G8_SA(0, 1), cao, 1, k2);
            G8_WAIT_L(8); G8_BAR; G8_WAIT_L(0); G8_MMA(0, 0, At, B0); G8_BAR; G8_SCHED;
            G8_LDB(B1, 1, 1); G8_STAGEB(G8_SB(1, 0), b3);
            G8_BAR; G8_WAIT_L(0); G8_MMA(0, 1, At, B1); G8_BAR;
            G8_LDA(At, 1, 1); G8_STAGEA(G8_SA(1, 0), cao, 0, k3);
            G8_BAR; G8_WAIT_L(0); G8_MMA(1, 0, At, B0); G8_BAR; G8_SCHED;
            G8_STAGEB(G8_SB(1, 1), b3 + hstep);
            G8_WAIT_V(6); G8_BAR; G8_MMA(1, 1, At, B1); G8_BAR;
        }
        G8_T1(0);
        S.epi(acc, cur, wr, wc, fr, fq);
        G8_T1(1);
        if (!has_next) break;
#pragma unroll
        for (int a = 0; a < 2; ++a)
#pragma unroll
            for (int b = 0; b < 2; ++b)
#pragma unroll
                for (int m = 0; m < 4; ++m)
#pragma unroll
                    for (int n = 0; n < 2; ++n) acc[a][b][m][n] = (f32x4){0.f, 0.f, 0.f, 0.f};
        cur = nxt; cB = nB; ++ui;
    }
    G8_WAIT_V(0);
    if (wr == 0) G8_BAR;
    G8_BAR;
#undef G8_SA
#undef G8_SB
#undef G8_STAGEA
#undef G8_STAGEB
#undef G8_LDA
#undef G8_LDB
#undef G8_MMA
#undef G8_WAIT_V
#undef G8_WAIT_L
#undef G8_BAR
#undef G8_SCHED
}
DI bool g8_static(int i, int nM, int nN, int& pm, int& pn) {
    const int G = gridDim.x, nwg = nM * nN; const long L = (long)i * G + blockIdx.x; if (L >= nwg) return false;
    int wgid = (int)L; { const int q = nwg / 8, r = nwg % 8, xcd = wgid % 8, off = wgid / 8; wgid = (xcd < r ? xcd * (q + 1) : r * (q + 1) + (xcd - r) * q) + off; }
    const int nig = 8 * nN, gid = wgid / nig, fm = gid * 8, gsz = (nM - fm) < 8 ? (nM - fm) : 8;
    pm = fm + ((wgid % nig) % gsz); pn = (wgid % nig) / gsz; return true;
}
DI int g8_xcd_linear(int i, int n) {
    const long L = (long)i * gridDim.x + blockIdx.x; if (L >= n) return -1;
    const int q = n / 8, r = n % 8, xcd = (int)(L % 8), off = (int)(L / 8);
    return (xcd < r ? xcd * (q + 1) : r * (q + 1) + (xcd - r) * q) + off;
}
DI void g8_store_bf16(bf16_t* rowp, const f32x4& a, const f32x4& b) { u32x4 o; o[0] = pack2(a[0], a[1]); o[1] = pack2(a[2], a[3]); o[2] = pack2(b[0], b[1]); o[3] = pack2(b[2], b[3]); *(u32x4*)rowp = o; }

struct InprojS {
    static constexpr int ID = 0;
    struct U { int pm, pn; };
    const Params& p; int l;
    DI bool next(int i, U& u) const { return g8_static(i, NTOK / 256, INPP / 256, u.pm, u.pn); }
    DI void aoffs(const U& u, unsigned (&ao)[2][2]) const { int R[2], C[2]; { const int t_ = tidx(); g8_stage_rc(t_ * 16, R[0], C[0]); g8_stage_rc(t_ * 16 + 8192, R[1], C[1]); }
#pragma unroll
        for (int h = 0; h < 2; ++h)
#pragma unroll
            for (int i = 0; i < 2; ++i) ao[h][i] = (unsigned)((u.pm * 256 + h * 128 + R[i]) * DM + C[i]) * 2u; }
    DI const char* bbase(const U& u) const { return p.ws + OFF_WIN + l * SZ_WIN1 + (size_t)u.pn * 256 * DM * 2; }
    DI void epi(const f32x4 (&acc)[2][2][4][2], const U& u, int wr, int wc, int fr, int fq) const {
        bf16_t* C = (bf16_t*)(p.ws + OFF_RA) + (size_t)(u.pm * 256 + wr * 64 + fr) * INPP + u.pn * 256 + wc * 32 + 8 * fq;
#pragma unroll
        for (int ai = 0; ai < 2; ++ai)
#pragma unroll
            for (int m = 0; m < 4; ++m)
#pragma unroll
                for (int bj = 0; bj < 2; ++bj) g8_store_bf16(C + (size_t)(ai * 128 + m * 16) * INPP + bj * 128, acc[ai][bj][m][0], acc[ai][bj][m][1]);
    }
};
struct OutprojS {
    static constexpr int ID = 1;
    struct U { int pm, pn; };
    const Params& p; int l;
    DI bool next(int i, U& u) const { return g8_static(i, l == 0 ? 68 : 64, 4, u.pm, u.pn); }
    DI void aoffs(const U& u, unsigned (&ao)[2][2]) const { int R[2], C[2]; { const int t_ = tidx(); g8_stage_rc(t_ * 16, R[0], C[0]); g8_stage_rc(t_ * 16 + 8192, R[1], C[1]); }
        const int row0 = (l == 0 ? 0 : NCTX) + u.pm * 256;
#pragma unroll
        for (int h = 0; h < 2; ++h)
#pragma unroll
            for (int i = 0; i < 2; ++i) ao[h][i] = (unsigned)((row0 + h * 128 + R[i]) * DM + C[i]) * 2u; }
    DI const char* bbase(const U& u) const { return p.ws + OFF_WOUT + l * SZ_WOUT1 + (size_t)u.pn * 256 * DM * 2; }
    DI void epi(const f32x4 (&acc)[2][2][4][2], const U& u, int wr, int wc, int fr, int fq) const {
        const int row0 = (l == 0 ? 0 : NCTX) + u.pm * 256;
        bf16_t* C = (bf16_t*)(p.ws + OFF_Y) + (size_t)(row0 + wr * 64 + fr) * DM + u.pn * 256 + wc * 32 + 8 * fq;
#pragma unroll
        for (int ai = 0; ai < 2; ++ai)
#pragma unroll
            for (int m = 0; m < 4; ++m)
#pragma unroll
                for (int bj = 0; bj < 2; ++bj) g8_store_bf16(C + (size_t)(ai * 128 + m * 16) * DM + bj * 128, acc[ai][bj][m][0], acc[ai][bj][m][1]);
    }
};
DI void moe_table(const Params& p, int l, int hf, MoeTab* tb) {
    const int tid = tidx();
    __syncthreads();
    if (tid < 64) {
        const int c = ((const int*)(p.ws + OFF_CNT))[(l * 2 + hf) * 64 + tid];
        const int mt = (c + 255) >> 8;
        int ms = mt, hu = c;
#pragma unroll
        for (int o = 1; o < 64; o <<= 1) { const int a = __shfl_up(ms, o), b = __shfl_up(hu, o); if (tid >= o) { ms += a; hu += b; } }
        tb->cnt[tid] = c; tb->mstart[tid] = ms - mt; tb->hoffP[tid] = (ms - mt) * 256; tb->hoffU[tid] = hu - c;
        if (tid == 63) { const int cs = half_hi(l, hf) - half_lo(l, hf); tb->cnt[64] = cs; tb->mstart[64] = ms; tb->hoffP[64] = ms * 256; tb->hoffU[64] = hu; tb->mstart[65] = ms + ((cs + 255) >> 8); }
    }
    __syncthreads();
}
DI void moe_find(const MoeTab* tb, int g, int hint, int& e, int& mt) { int lo = hint; while (tb->mstart[lo + 1] <= g) ++lo; e = lo; mt = g - tb->mstart[lo]; }
struct Moe1S {
    static constexpr int ID = 2;
    struct U { int e, mt, pn, cnt, hrow0; };
    const Params& p; int l, hf; const MoeTab* tb;
    DI bool next(int i, U& u) const { const int g2 = g8_xcd_linear(i, tb->mstart[65] * 2); if (g2 < 0) return false;
        int e, mt; moe_find(tb, g2 >> 1, i ? u.e : 0, e, mt); e = __builtin_amdgcn_readfirstlane(e); mt = __builtin_amdgcn_readfirstlane(mt); u.e = e; u.mt = mt; u.pn = g2 & 1; u.cnt = __builtin_amdgcn_readfirstlane(tb->cnt[e]); u.hrow0 = __builtin_amdgcn_readfirstlane(tb->hoffP[e]) + mt * 256; return true; }
    DI void aoffs(const U& u, unsigned (&ao)[2][2]) const { int R[2], C[2]; { const int t_ = tidx(); g8_stage_rc(t_ * 16, R[0], C[0]); g8_stage_rc(t_ * 16 + 8192, R[1], C[1]); }
        const int* stok = (const int*)(p.ws + OFF_SLOT_TOK) + (size_t)(hf * 64 + (u.e & 63)) * HCAP; const int lo = half_lo(l, hf);
#pragma unroll
        for (int h = 0; h < 2; ++h)
#pragma unroll
            for (int i = 0; i < 2; ++i) { int pos = u.mt * 256 + h * 128 + R[i]; pos = pos < u.cnt ? pos : u.cnt - 1; const int tok = u.e < 64 ? stok[pos] : lo + pos;
                ao[h][i] = (unsigned)(tok * DM + C[i]) * 2u; } }
    DI const char* bbase(const U& u) const { return p.ws + OFF_WGU + ((size_t)u.e * 512 + u.pn * 256) * 1024 * 2; }
    DI void epi(const f32x4 (&acc)[2][2][4][2], const U& u, int wr, int wc, int fr, int fq) const {
        bf16_t* H = (bf16_t*)(p.ws + OFF_HID) + (size_t)(u.hrow0 + wr * 64 + fr) * 256 + u.pn * 128 + wc * 32 + 8 * fq;
        const float* sw = (const float*)(p.ws + OFF_SLOT_W) + (size_t)(hf * 64 + (u.e & 63)) * HCAP;
        float wvs[2][4];
#pragma unroll
        for (int ai = 0; ai < 2; ++ai)
#pragma unroll
            for (int m = 0; m < 4; ++m) { const int pos = u.mt * 256 + ai * 128 + wr * 64 + m * 16 + fr; wvs[ai][m] = u.e < 64 ? (pos < u.cnt ? sw[pos] : 0.f) : 1.f; }
#pragma unroll
        for (int ai = 0; ai < 2; ++ai)
#pragma unroll
            for (int m = 0; m < 4; ++m) { f32x4 o[2]; const float wv = wvs[ai][m];
#pragma unroll
                for (int n = 0; n < 2; ++n) { const f32x4 gt = acc[ai][0][m][n], up = acc[ai][1][m][n]; o[n] = (f32x4){silu_(gt[0]) * up[0] * wv, silu_(gt[1]) * up[1] * wv, silu_(gt[2]) * up[2] * wv, silu_(gt[3]) * up[3] * wv}; }
                g8_store_bf16(H + (size_t)(ai * 128 + m * 16) * 256, o[0], o[1]); }
    }
};
struct Moe2S {
    static constexpr int ID = 3;
    struct U { int e, mt, pn, cnt, hrow0, yrow0; };
    const Params& p; int l, hf; const MoeTab* tb;
    DI bool next(int i, U& u) const { const int g4 = g8_xcd_linear(i, tb->mstart[65] * 4); if (g4 < 0) return false;
        int e, mt; moe_find(tb, g4 >> 2, i ? u.e : 0, e, mt); e = __builtin_amdgcn_readfirstlane(e); mt = __builtin_amdgcn_readfirstlane(mt); u.e = e; u.mt = mt; u.pn = g4 & 3; u.cnt = __builtin_amdgcn_readfirstlane(tb->cnt[e]); u.hrow0 = __builtin_amdgcn_readfirstlane(tb->hoffP[e]) + mt * 256; u.yrow0 = __builtin_amdgcn_readfirstlane(tb->hoffU[e]) + mt * 256; return true; }
    DI void aoffs(const U& u, unsigned (&ao)[2][2]) const { int R[2], C[2]; { const int t_ = tidx(); g8_stage_rc(t_ * 16, R[0], C[0]); g8_stage_rc(t_ * 16 + 8192, R[1], C[1]); }
#pragma unroll
        for (int h = 0; h < 2; ++h)
#pragma unroll
            for (int i = 0; i < 2; ++i) ao[h][i] = (unsigned)((u.hrow0 + h * 128 + R[i]) * 256 + C[i]) * 2u; }
    DI const char* bbase(const U& u) const { return p.ws + (l == 0 ? OFF_WD : OFF_WD2) + ((size_t)u.e * 1024 + u.pn * 256) * 256 * 2; }
    DI void epi(const f32x4 (&acc)[2][2][4][2], const U& u, int wr, int wc, int fr, int fq) const {
        const int colb = u.pn * 256 + wc * 32 + 8 * fq;
#pragma unroll
        for (int ai = 0; ai < 2; ++ai)
#pragma unroll
            for (int m = 0; m < 4; ++m) { const int row = ai * 128 + wr * 64 + m * 16 + fr, pos = u.mt * 256 + row;
                if (pos < u.cnt) {
                    if (u.e < 64) { const float wv = YE_SCALE; unsigned char* yr = (unsigned char*)(p.ws + OFF_YE) + (size_t)(u.yrow0 + row) * DM + colb;
#pragma unroll
                        for (int bj = 0; bj < 2; ++bj) { const f32x4 a = acc[ai][bj][m][0] * wv, b = acc[ai][bj][m][1] * wv; uint2 o; int t = 0;
                            t = __builtin_amdgcn_cvt_pk_fp8_f32(a[0], a[1], t, false); t = __builtin_amdgcn_cvt_pk_fp8_f32(a[2], a[3], t, true); o.x = (unsigned)t;
                            t = __builtin_amdgcn_cvt_pk_fp8_f32(b[0], b[1], t, false); t = __builtin_amdgcn_cvt_pk_fp8_f32(b[2], b[3], t, true); o.y = (unsigned)t;
                            *(uint2*)(yr + bj * 128) = o; }
                    } else { bf16_t* yr = (bf16_t*)(p.ws + OFF_Y) + (size_t)(half_lo(l, hf) + pos) * DM + colb;
#pragma unroll
                        for (int bj = 0; bj < 2; ++bj) g8_store_bf16(yr + bj * 128, acc[ai][bj][m][0], acc[ai][bj][m][1]); } } }
    }
};

constexpr int PREP_UNITS = NTOK / 8;
constexpr float LOG2E = 1.4426950408889634f, QSCALE = 0.125f * LOG2E;
DI void rope2(float& a, float& b, const float2 cs) { const float x1 = a, x2 = b; a = x1 * cs.x - x2 * cs.y; b = x1 * cs.y + x2 * cs.x; }
DI void prep_unit(const Params& p, int l, int u) {
    const int tid = tidx(), lane = tid & 63, w = tid >> 6, r = u * 8 + w;
    const bool lat = r >= NCTX; const int pos = (r - NCTX) & (SEQ - 1);
    const bf16_t* pr = (const bf16_t*)(p.ws + OFF_RA) + (size_t)r * INPP;
    const float2* rt = (const float2*)(p.ws + OFF_ROPE) + (size_t)pos * 32;
    const float* gq = p.in[I_DQN] + l * 64; const float* gk = p.in[I_DKN] + l * 64;
    unsigned* QA = (unsigned*)(p.ws + OFF_QA) + (size_t)r * 128; unsigned* KA = (unsigned*)(p.ws + OFF_KA) + (size_t)r * 64;
    unsigned* QD = (unsigned*)(p.ws + OFF_QD) + (size_t)r * 128; unsigned* KD = (unsigned*)(p.ws + OFF_KD) + (size_t)r * 64;
#pragma unroll
    for (int i = 0; i < 2; ++i) {
        const int pq = lane + 64 * i, pi = pq & 31;
        const float2 cs = lat ? rt[pi] : make_float2(1.f, 0.f);
        { const unsigned v = *(const unsigned*)(pr + CA_Q + 2 * pq); float a = __uint_as_float(v << 16), b = __uint_as_float(v & 0xffff0000u);
          rope2(a, b, cs); QA[pq] = pack2(a * QSCALE, b * QSCALE); }
        { const unsigned v = *(const unsigned*)(pr + CD_Q + 2 * pq); float a = __uint_as_float(v << 16), b = __uint_as_float(v & 0xffff0000u);
          float ss = row16_sum(a * a + b * b); ss += __shfl_xor(ss, 16);
          const float rs = rsqrtf(ss * (1.f / 64.f) + EPS);
          a = a * rs * gq[2 * pi]; b = b * rs * gq[2 * pi + 1];
          rope2(a, b, cs); QD[pq] = pack2(a * QSCALE, b * QSCALE); }
    }
    {
        const int pi = lane & 31;
        const float2 cs = lat ? rt[pi] : make_float2(1.f, 0.f);
        { const unsigned v = *(const unsigned*)(pr + CA_K + 2 * lane); float a = __uint_as_float(v << 16), b = __uint_as_float(v & 0xffff0000u);
          rope2(a, b, cs); KA[lane] = pack2(a, b); }
        { const unsigned v = *(const unsigned*)(pr + CD_K + 2 * lane); float a = __uint_as_float(v << 16), b = __uint_as_float(v & 0xffff0000u);
          float ss = row16_sum(a * a + b * b); ss += __shfl_xor(ss, 16);
          const float rs = rsqrtf(ss * (1.f / 64.f) + EPS);
          a = a * rs * gk[2 * pi]; b = b * rs * gk[2 * pi + 1];
          rope2(a, b, cs); KD[lane] = pack2(a, b); }
    }
}

constexpr int ATT_LDS = 2 * 2 * 64 * LDT * 2;
struct AttnArgs {
    const bf16_t* Q; const bf16_t* K; const bf16_t* V;
    int qrow0;
    int g;
    int k0row, k0tiles;
    int k1row, k1t0, k1t1;
    int qpos0;
    const float* sink;
    bf16_t* O;
};
DI void attn_unit(const AttnArgs& a, char* smem) {
    const int tid = tidx(), lane = tid & 63, w = tid >> 6, r32 = lane & 31, hi = lane >> 5;
    const int head = 2 * a.g + (w >> 2), qoff = (w & 3) * 32 + r32;
    bf16_t* Ks = (bf16_t*)smem;
    bf16_t* Vs = Ks + 2 * 64 * LDT;
    bf16x8 qr[4];
    { const bf16_t* qp = a.Q + (size_t)(a.qrow0 + qoff) * 256 + head * 64 + hi * 8;
#pragma unroll
      for (int d0 = 0; d0 < 4; ++d0) qr[d0] = *(const bf16x8*)(qp + d0 * 16); }
    float m_run, l_run;
    if (a.sink) { m_run = a.sink[head] * LOG2E; l_run = hi == 0 ? 1.f : 0.f; } else { m_run = -1e30f; l_run = 0.f; }
    f32x16 o0, o1;
#pragma unroll
    for (int i = 0; i < 16; ++i) { o0[i] = 0.f; o1[i] = 0.f; }
    const int nt = a.k0tiles + (a.k1t1 - a.k1t0);
    const int lrow = tid >> 3, lc = (tid & 7) * 8;
    auto tile_row0 = [&](int t) { return t < a.k0tiles ? a.k0row + t * 64 : a.k1row + (a.k1t0 + t - a.k0tiles) * 64; };
    u32x4 rk, rv;
    { const int kr = tile_row0(0) + lrow; rk = *(const u32x4*)(a.K + (size_t)kr * 128 + a.g * 64 + lc); rv = *(const u32x4*)(a.V + (size_t)kr * INPP + a.g * 64 + lc); }
    *(u32x4*)(Ks + lrow * LDT + lc) = rk; *(u32x4*)(Vs + lrow * LDT + lc) = rv;
    __syncthreads();
    const int q4 = (lane & 15) >> 2, p4 = lane & 3, blk = (lane >> 4) & 1;
#pragma unroll 1
    for (int t = 0; t < nt; ++t) {
        const bool more = t + 1 < nt;
        if (more) { const int kr = tile_row0(t + 1) + lrow; rk = *(const u32x4*)(a.K + (size_t)kr * 128 + a.g * 64 + lc); rv = *(const u32x4*)(a.V + (size_t)kr * INPP + a.g * 64 + lc); }
        const bf16_t* Kc = Ks + (t & 1) * 64 * LDT;
        const bf16_t* Vc = Vs + (t & 1) * 64 * LDT;
        f32x16 s0, s1;
#pragma unroll
        for (int i = 0; i < 16; ++i) { s0[i] = 0.f; s1[i] = 0.f; }
#pragma unroll
        for (int d0 = 0; d0 < 4; ++d0) {
            const bf16x8 k0 = *(const bf16x8*)(Kc + r32 * LDT + d0 * 16 + hi * 8);
            const bf16x8 k1 = *(const bf16x8*)(Kc + (32 + r32) * LDT + d0 * 16 + hi * 8);
            s0 = __builtin_amdgcn_mfma_f32_32x32x16_bf16(k0, qr[d0], s0, 0, 0, 0);
            s1 = __builtin_amdgcn_mfma_f32_32x32x16_bf16(k1, qr[d0], s1, 0, 0, 0);
        }
        if (a.qpos0 >= 0 && t >= a.k0tiles) {
            const int kb = (a.k1t0 + t - a.k0tiles) * 64, qp = a.qpos0 + qoff;
#pragma unroll
            for (int i = 0; i < 16; ++i) { const int kp = kb + crow(i, hi); int d = kp - qp; d = d < 0 ? -d : d; if (d > 128) s0[i] = -1e30f; d = kp + 32 - qp; d = d < 0 ? -d : d; if (d > 128) s1[i] = -1e30f; }
        }
        float mx = s0[0];
#pragma unroll
        for (int i = 1; i < 16; ++i) mx = fmaxf(mx, s0[i]);
#pragma unroll
        for (int i = 0; i < 16; ++i) mx = fmaxf(mx, s1[i]);
        mx = xhalf_max(mx);
        const float m_new = fmaxf(m_run, mx);
        if (__any(m_new > m_run)) {
            const float alpha = __builtin_amdgcn_exp2f(m_run - m_new);
            l_run *= alpha;
#pragma unroll
            for (int i = 0; i < 16; ++i) { o0[i] *= alpha; o1[i] *= alpha; }
            m_run = m_new;
        }
        float ps = 0.f;
#pragma unroll
        for (int i = 0; i < 16; ++i) { s0[i] = __builtin_amdgcn_exp2f(s0[i] - m_run); s1[i] = __builtin_amdgcn_exp2f(s1[i] - m_run); ps += s0[i] + s1[i]; }
        l_run += ps;
#pragma unroll
        for (int ks = 0; ks < 4; ++ks) {
            bf16x8 pf;
            {
                union { unsigned u[4]; bf16x8 v; } pk;
#pragma unroll
                for (int j = 0; j < 4; ++j) { const int rg = (ks & 1) * 8 + 2 * j; pk.u[j] = (ks < 2) ? pack2(s0[rg], s0[rg + 1]) : pack2(s1[rg], s1[rg + 1]); }
                pf = pk.v;
            }
#pragma unroll
            for (int ds = 0; ds < 2; ++ds) {
                const bf16_t* vp = Vc + (16 * ks + 4 * hi + q4) * LDT + 32 * ds + 16 * blk + 4 * p4;
                const s16x4 lo = __builtin_bit_cast(s16x4, __builtin_amdgcn_ds_read_tr16_b64_v4i16((__attribute__((address_space(3))) s16x4*)(vp)));
                const s16x4 hh = __builtin_bit_cast(s16x4, __builtin_amdgcn_ds_read_tr16_b64_v4i16((__attribute__((address_space(3))) s16x4*)(vp + 8 * LDT)));
                const bf16x8 vf = (bf16x8){lo[0], lo[1], lo[2], lo[3], hh[0], hh[1], hh[2], hh[3]};
                if (ds == 0) o0 = __builtin_amdgcn_mfma_f32_32x32x16_bf16(vf, pf, o0, 0, 0, 0);
                else o1 = __builtin_amdgcn_mfma_f32_32x32x16_bf16(vf, pf, o1, 0, 0, 0);
            }
        }
        if (more) { bf16_t* Kn = Ks + ((t + 1) & 1) * 64 * LDT; bf16_t* Vn = Vs + ((t + 1) & 1) * 64 * LDT; *(u32x4*)(Kn + lrow * LDT + lc) = rk; *(u32x4*)(Vn + lrow * LDT + lc) = rv; }
        __syncthreads();
    }
    l_run = xhalf_sum(l_run);
    const float inv = 1.f / l_run;
    bf16_t* op = a.O + (size_t)(a.qrow0 + qoff) * DM + head * 64;
#pragma unroll
    for (int g4 = 0; g4 < 4; ++g4) {
        uint2 q; q.x = pack2(o0[4 * g4] * inv, o0[4 * g4 + 1] * inv); q.y = pack2(o0[4 * g4 + 2] * inv, o0[4 * g4 + 3] * inv);
        *(uint2*)(op + 8 * g4 + 4 * hi) = q;
        q.x = pack2(o1[4 * g4] * inv, o1[4 * g4 + 1] * inv); q.y = pack2(o1[4 * g4 + 2] * inv, o1[4 * g4 + 3] * inv);
        *(uint2*)(op + 32 + 8 * g4 + 4 * hi) = q;
    }
}
DI int attn_units(int l) { return l == 0 ? 544 : 512; }
DI void attn_dispatch(const Params& p, int l, int u, char* smem) {
    AttnArgs a;
    const bf16_t* proj = (const bf16_t*)(p.ws + OFF_RA);
    bf16_t* mix = (bf16_t*)(p.ws + OFF_RB);
    int type, b, g, tb;
    if (u < 512) { type = u >> 8; const int v = u & 255; b = v >> 6; g = (v >> 5) & 1; tb = v & 31; }
    else { const int v = u - 512; type = 2 + (v >> 4); b = (v >> 2) & 3; g = (v >> 1) & 1; tb = v & 1; }
    const bool isA = (type & 1);
    a.Q = (const bf16_t*)(p.ws + (isA ? OFF_QA : OFF_QD)); a.K = (const bf16_t*)(p.ws + (isA ? OFF_KA : OFF_KD)); a.V = proj + (isA ? CA_V : CD_V);
    a.g = g; a.sink = isA ? p.in[I_ASINK] + l * 4 : nullptr; a.O = mix + (isA ? 0 : 768);
    a.k0row = b * CTXL; a.k0tiles = 4; a.k1row = NCTX + b * SEQ; a.qpos0 = -1;
    if (type < 2) {
        a.qrow0 = NCTX + b * SEQ + tb * 128;
        if (isA) { a.qpos0 = tb * 128; int t0 = 2 * tb - 2, t1 = 2 * tb + 4; a.k1t0 = t0 < 0 ? 0 : t0; a.k1t1 = t1 > 64 ? 64 : t1; }
        else { a.k1t0 = 0; a.k1t1 = 64; }
    } else { a.qrow0 = b * CTXL + tb * 128; a.k1t0 = 0; a.k1t1 = 0; }
    attn_unit(a, smem);
}

DI int blk_row0(int b, int cb) { return cb < 2 ? b * CTXL + cb * 128 : NCTX + b * SEQ + (cb - 2) * 128; }
DI int bwd_seq(int cb) { return cb < 2 ? 1 - cb : 35 - cb; }
DI s16x4 tr16(const bf16_t* p) { return __builtin_bit_cast(s16x4, __builtin_amdgcn_ds_read_tr16_b64_v4i16((__attribute__((address_space(3))) s16x4*)(p))); }
DI bf16x8 cat8(const s16x4 lo, const s16x4 hh) { return (bf16x8){lo[0], lo[1], lo[2], lo[3], hh[0], hh[1], hh[2], hh[3]}; }
DI bf16x8 packf8(float a0, float a1, float a2, float a3, float a4, float a5, float a6, float a7) { union { unsigned u[4]; bf16x8 v; } k; k.u[0] = pack2(a0, a1); k.u[1] = pack2(a2, a3); k.u[2] = pack2(a4, a5); k.u[3] = pack2(a6, a7); return k.v; }
constexpr int SC_RP = 200;
constexpr int SC_RAW = 0, SC_XS = 52480, SC_BS = SC_XS + 128 * LDT * 2, SC_CS = SC_BS + 128 * LDT * 2, SC_CW = SC_CS + 128 * LDT * 2, SC_VEC = SC_CW + 5 * 192 * 4, SSD_LDS = SC_VEC + 6 * 128 * 4;
DI int ssd_chunk_units() { return NB * NCHK * 4; }
DI void ssd_chunk_unit(const Params& p, int l, int u, char* smem) {
    const int tid = tidx(), lane = tid & 63, w = __builtin_amdgcn_readfirstlane(tid >> 6), r32 = lane & 31, hi = lane >> 5;
    const int h = u & 3, cb = (u >> 2) % NCHK, b = (u >> 2) / NCHK, grp = h >> 1;
    const int row0 = blk_row0(b, cb);
    const int part0 = cb < 2 ? b * CTXL : NCTX + b * SEQ, partN = cb < 2 ? CTXL : SEQ;
    bf16_t* raw = (bf16_t*)(smem + SC_RAW);
    bf16_t* Xs = (bf16_t*)(smem + SC_XS);
    bf16_t* Bs = (bf16_t*)(smem + SC_BS);
    bf16_t* Cs = (bf16_t*)(smem + SC_CS);
    float* cwl = (float*)(smem + SC_CW);
    float* dtf = (float*)(smem + SC_VEC); float* dtb = dtf + 128; float* Af = dtb + 128; float* Ab = Af + 128; float* wef = Ab + 128; float* web = wef + 128;
    const bf16_t* proj = (const bf16_t*)(p.ws + OFF_RA);
    const float aneg_f = -__expf(p.in[I_SSDALOG][l * 8 + h]), aneg_b = -__expf(p.in[I_SSDALOG][l * 8 + 4 + h]);
    {
        u32x4 v[7];
#pragma unroll
        for (int k = 0; k < 7; ++k) { const int item = tid + NTHR * k; v[k] = (u32x4){0u, 0u, 0u, 0u};
            if (item < 131 * 24) { const int r = item / 24, c = item % 24, gr = row0 - 2 + r;
                const int col = c < 8 ? CB_X + h * 64 + 8 * c : (c < 16 ? CB_B + grp * 64 + 8 * (c - 8) : CB_C + grp * 64 + 8 * (c - 16));
                if (gr >= part0 && gr < part0 + partN) v[k] = *(const u32x4*)(proj + (size_t)gr * INPP + col); } }
#pragma unroll
        for (int k = 0; k < 7; ++k) { const int item = tid + NTHR * k; if (item < 131 * 24) { const int r = item / 24, c = item % 24; *(u32x4*)(raw + r * SC_RP + 8 * c) = v[k]; } }
        for (int i = tid; i < 5 * 192; i += NTHR) { const int j = i / 192, cc = i % 192; const int ch = cc < 64 ? h * 64 + cc : (cc < 128 ? 256 + grp * 64 + cc - 64 : 384 + grp * 64 + cc - 128);
            cwl[i] = j < 4 ? p.in[I_SSDCW][l * 2048 + j * 512 + ch] : p.in[I_SSDCB][l * 512 + ch]; }
        if (tid < 256) { const int i = tid & 127, d = tid >> 7;
            const float rawdt = bf2f(proj[(size_t)(row0 + i) * INPP + (d ? CB_DTB : CB_DTF) + h]);
            (d ? dtb : dtf)[i] = softplus_(rawdt + p.in[I_SSDDTB][l * 8 + d * 4 + h]); }
    }
    __syncthreads();
#pragma unroll 2
    for (int k = 0; k < 6; ++k) { const int item = tid + NTHR * k, i = item / 24, c = item % 24;
        float acc[8];
        { const f32x4 b0 = *(const f32x4*)(cwl + 4 * 192 + 8 * c), b1 = *(const f32x4*)(cwl + 4 * 192 + 8 * c + 4);
          acc[0] = b0[0]; acc[1] = b0[1]; acc[2] = b0[2]; acc[3] = b0[3]; acc[4] = b1[0]; acc[5] = b1[1]; acc[6] = b1[2]; acc[7] = b1[3]; }
#pragma unroll
        for (int j = 0; j < 4; ++j) { const u32x4 q = *(const u32x4*)(raw + (i + j) * SC_RP + 8 * c);
            const f32x4 w0 = *(const f32x4*)(cwl + j * 192 + 8 * c), w1 = *(const f32x4*)(cwl + j * 192 + 8 * c + 4);
            acc[0] += w0[0] * __uint_as_float(q[0] << 16); acc[1] += w0[1] * __uint_as_float(q[0] & 0xffff0000u); acc[2] += w0[2] * __uint_as_float(q[1] << 16); acc[3] += w0[3] * __uint_as_float(q[1] & 0xffff0000u);
            acc[4] += w1[0] * __uint_as_float(q[2] << 16); acc[5] += w1[1] * __uint_as_float(q[2] & 0xffff0000u); acc[6] += w1[2] * __uint_as_float(q[3] << 16); acc[7] += w1[3] * __uint_as_float(q[3] & 0xffff0000u); }
        u32x4 o; o[0] = pack2(silu_(acc[0]), silu_(acc[1])); o[1] = pack2(silu_(acc[2]), silu_(acc[3])); o[2] = pack2(silu_(acc[4]), silu_(acc[5])); o[3] = pack2(silu_(acc[6]), silu_(acc[7]));
        bf16_t* dst = c < 8 ? Xs : (c < 16 ? Bs : Cs);
        *(u32x4*)(dst + i * LDT + 8 * (c & 7)) = o; }
    if (tid < 128) {
        const int ln = tid & 63, bw = tid >> 6;
        const int i0 = bw ? 127 - 2 * ln : 2 * ln, i1 = bw ? 126 - 2 * ln : 2 * ln + 1;
        const float* dt = bw ? dtb : dtf; const float an = bw ? aneg_b : aneg_f;
        const float v0 = dt[i0] * an, v1 = dt[i1] * an;
        float sc = v0 + v1;
#pragma unroll
        for (int o = 1; o < 64; o <<= 1) { const float a = __shfl_up(sc, o); if (ln >= o) sc += a; }
        float* A = bw ? Ab : Af;
        A[i1] = sc; A[i0] = sc - v1;
    }
    __syncthreads();
    if (tid < 128) { wef[tid] = __expf(Af[127] - Af[tid]) * dtf[tid]; web[tid] = __expf(Ab[0] - Ab[tid]) * dtb[tid];
        float* EA = (float*)(p.ws + OFF_EA) + (size_t)(row0 + tid) * 8; EA[h] = __expf(Af[tid]); EA[4 + h] = __expf(Ab[tid]); }
    __syncthreads();
    bf16_t* Bwf = raw; bf16_t* Bwb = raw + 128 * LDT;
    if ((h & 1) == 0) { bf16_t* CC = (bf16_t*)(p.ws + OFF_CC);
        for (int it = tid; it < 1024; it += NTHR) { const int i = it >> 3, c = it & 7; *(u32x4*)(CC + (size_t)(row0 + i) * 128 + grp * 64 + 8 * c) = *(const u32x4*)(Cs + i * LDT + 8 * c); } }
#pragma unroll
    for (int k = 0; k < 4; ++k) { const int it = tid + NTHR * k, d = it >> 10, j = (it >> 3) & 127, c = it & 7;
        const u32x4 q = *(const u32x4*)(Bs + j * LDT + 8 * c); const float sc = d ? web[j] : wef[j];
        u32x4 o;
#pragma unroll
        for (int e = 0; e < 4; ++e) o[e] = pack2(__uint_as_float(q[e] << 16) * sc, __uint_as_float(q[e] & 0xffff0000u) * sc);
        *(u32x4*)((d ? Bwb : Bwf) + j * LDT + 8 * c) = o; }
    __syncthreads();
    const int q4 = (lane & 15) >> 2, p4 = lane & 3, blk = (lane >> 4) & 1;
    {
        const int ib = w & 3, ph = w >> 2, i = 32 * ib + r32;
        bf16x8 cq[4];
#pragma unroll
        for (int s4 = 0; s4 < 4; ++s4) cq[s4] = *(const bf16x8*)(Cs + i * LDT + 16 * s4 + 8 * hi);
        const float Afi = Af[i], Abi = Ab[i];
        f32x16 y;
#pragma unroll
        for (int r = 0; r < 16; ++r) y[r] = 0.f;
#pragma unroll
        for (int jt = 0; jt < 4; ++jt) {
            f32x16 g;
#pragma unroll
            for (int r = 0; r < 16; ++r) g[r] = 0.f;
#pragma unroll
            for (int s4 = 0; s4 < 4; ++s4) { const bf16x8 bq = *(const bf16x8*)(Bs + (32 * jt + r32) * LDT + 16 * s4 + 8 * hi); g = __builtin_amdgcn_mfma_f32_32x32x16_bf16(bq, cq[s4], g, 0, 0, 0); }
#pragma unroll
            for (int g4 = 0; g4 < 4; ++g4) { const int j0 = 32 * jt + 8 * g4 + 4 * hi;
                f32x4 wv = (f32x4){0.f, 0.f, 0.f, 0.f};
                if (jt <= ib) { const f32x4 aj = *(const f32x4*)(Af + j0), dj = *(const f32x4*)(dtf + j0);
#pragma unroll
                    for (int e = 0; e < 4; ++e) { const float t = __expf(Afi - aj[e]) * dj[e]; wv[e] += (jt < ib || j0 + e <= i) ? t : 0.f; } }
                if (jt >= ib) { const f32x4 aj = *(const f32x4*)(Ab + j0), dj = *(const f32x4*)(dtb + j0);
#pragma unroll
                    for (int e = 0; e < 4; ++e) { const float t = __expf(Abi - aj[e]) * dj[e]; wv[e] += (jt > ib || j0 + e >= i) ? t : 0.f; } }
#pragma unroll
                for (int e = 0; e < 4; ++e) g[4 * g4 + e] *= wv[e]; }
#pragma unroll
            for (int s2 = 0; s2 < 2; ++s2) {
                const bf16x8 pf = packf8(g[8 * s2], g[8 * s2 + 1], g[8 * s2 + 2], g[8 * s2 + 3], g[8 * s2 + 4], g[8 * s2 + 5], g[8 * s2 + 6], g[8 * s2 + 7]);
                const bf16_t* xp = Xs + (32 * jt + 16 * s2 + 4 * hi + q4) * LDT + 32 * ph + 16 * blk + 4 * p4;
                const bf16x8 xf = cat8(tr16(xp), tr16(xp + 8 * LDT));
                y = __builtin_amdgcn_mfma_f32_32x32x16_bf16(xf, pf, y, 0, 0, 0); }
        }
        const float dsk = p.in[I_SSDD][l * 4 + h];
        float* YP = (float*)(p.ws + OFF_YPART) + (size_t)(row0 + i) * 256 + h * 64 + 32 * ph;
#pragma unroll
        for (int g4 = 0; g4 < 4; ++g4) { const uint2 xq = *(const uint2*)(Xs + i * LDT + 32 * ph + 8 * g4 + 4 * hi);
            *(f32x4*)(YP + 8 * g4 + 4 * hi) = (f32x4){y[4 * g4] + dsk * __uint_as_float(xq.x << 16), y[4 * g4 + 1] + dsk * __uint_as_float(xq.x & 0xffff0000u),
                                                    y[4 * g4 + 2] + dsk * __uint_as_float(xq.y << 16), y[4 * g4 + 3] + dsk * __uint_as_float(xq.y & 0xffff0000u)}; }
    }
    {
        const int d = w >> 2, pt = (w >> 1) & 1, nt2 = w & 1;
        const bf16_t* Bw = d ? Bwb : Bwf;
        f32x16 st;
#pragma unroll
        for (int r = 0; r < 16; ++r) st[r] = 0.f;
#pragma unroll
        for (int ks = 0; ks < 8; ++ks) {
            const bf16_t* xp = Xs + (16 * ks + 8 * hi + q4) * LDT + 32 * pt + 16 * blk + 4 * p4;
            const bf16_t* bp = Bw + (16 * ks + 8 * hi + q4) * LDT + 32 * nt2 + 16 * blk + 4 * p4;
            st = __builtin_amdgcn_mfma_f32_32x32x16_bf16(cat8(tr16(xp), tr16(xp + 4 * LDT)), cat8(tr16(bp), tr16(bp + 4 * LDT)), st, 0, 0, 0); }
        const int s = d ? bwd_seq(cb) : cb;
        float* ST = (float*)(p.ws + OFF_SSDST) + ((size_t)((b * 4 + h) * 2 + d) * NCHK + s) * 4096 + 32 * nt2 + r32;
#pragma unroll
        for (int r = 0; r < 16; ++r) ST[(32 * pt + crow(r, hi)) * 64] = st[r];
        if ((tid & 255) == 0) ((float*)(p.ws + OFF_SSDDEC))[((b * 4 + h) * 2 + d) * NCHK + s] = d ? __expf(Ab[0]) : __expf(Af[127]);
    }
    __syncthreads();
}
constexpr int SCAN_UNITS = 32 * 8 + 4;
DI void scan_unit(const Params& p, int u) {
    const int tid = tidx();
    if (u < 256) {
        const int seq = u >> 3, e = (u & 7) * 512 + tid;
        const float* ST = (const float*)(p.ws + OFF_SSDST) + (size_t)seq * NCHK * 4096 + e;
        const float* DEC = (const float*)(p.ws + OFF_SSDDEC) + seq * NCHK;
        bf16_t* SS = (bf16_t*)(p.ws + OFF_START) + (size_t)seq * NCHK * 4096 + e;
        float v[NCHK];
#pragma unroll
        for (int s = 0; s < NCHK; ++s) v[s] = ST[(size_t)s * 4096];
        float st = 0.f;
#pragma unroll
        for (int s = 0; s < NCHK; ++s) { SS[(size_t)s * 4096] = f2bf(st); st = st * DEC[s] + v[s]; }
    } else {
        const int q = (u - 256) * 512 + tid, sq = q >> 8, ch = q & 255;
        const float* LH = (const float*)(p.ws + OFF_LRUC) + (size_t)sq * NCHK * 256 + ch; const float* LA = LH + (size_t)NB * 2 * NCHK * 256;
        float* CR = (float*)(p.ws + OFF_CARRY) + (size_t)sq * NCHK * 256 + ch;
        float hv[NCHK], av[NCHK];
#pragma unroll
        for (int s = 0; s < NCHK; ++s) { hv[s] = LH[s * 256]; av[s] = LA[s * 256]; }
        float c = 0.f;
#pragma unroll
        for (int s = 0; s < NCHK; ++s) { CR[s * 256] = c; c = c * av[s] + hv[s]; }
    }
}
constexpr int SF_ST = 0, SF_CC = 2 * 64 * LDT * 2, SF_YB = SF_CC + 128 * LDT * 2, SF_SQ = SF_YB + 128 * 256 * 2, SSDF_LDS = SF_SQ + 8 * 128 * 4;
DI int ssd_fin_units(int l) { return NB * (l == 0 ? NCHK : NCHK - 2); }
DI void ssd_fin_unit(const Params& p, int l, int u, char* smem) {
    const int tid = tidx(), lane = tid & 63, w = __builtin_amdgcn_readfirstlane(tid >> 6), r32 = lane & 31, hi = lane >> 5;
    const int nper = l == 0 ? NCHK : NCHK - 2;
    const int b = u / nper, cb = u % nper + (l == 0 ? 0 : 2);
    const int row0 = blk_row0(b, cb);
    bf16_t* St = (bf16_t*)(smem + SF_ST);
    bf16_t* Cc = (bf16_t*)(smem + SF_CC);
    bf16_t* ybuf = (bf16_t*)(smem + SF_YB);
    float* ssqp = (float*)(smem + SF_SQ);
    const bf16_t* proj = (const bf16_t*)(p.ws + OFF_RA);
    const int it = w & 3, pt = w >> 2, i = 32 * it + r32, r = row0 + i;
    bf16x8 cq[4];
#pragma unroll 1
    for (int h = 0; h < 4; ++h) {
        {
            const int d = tid >> 8, e8 = (tid & 255) * 16, s = d ? bwd_seq(cb) : cb;
            const bf16_t* SS = (const bf16_t*)(p.ws + OFF_START) + ((size_t)((b * 4 + h) * 2 + d) * NCHK + s) * 4096 + e8;
            const u32x4 v0 = *(const u32x4*)SS, v1 = *(const u32x4*)(SS + 8);
            bf16_t* dst = St + d * 64 * LDT + (e8 >> 6) * LDT + (e8 & 63);
            *(u32x4*)dst = v0; *(u32x4*)(dst + 8) = v1;
            if ((h & 1) == 0) { const bf16_t* CC = (const bf16_t*)(p.ws + OFF_CC);
#pragma unroll
                for (int k = 0; k < 2; ++k) { const int item = tid + NTHR * k, ri = item >> 3, c = item & 7; *(u32x4*)(Cc + ri * LDT + 8 * c) = *(const u32x4*)(CC + (size_t)(row0 + ri) * 128 + (h >> 1) * 64 + 8 * c); } }
        }
        __syncthreads();
        if ((h & 1) == 0) {
#pragma unroll
            for (int s4 = 0; s4 < 4; ++s4) cq[s4] = *(const bf16x8*)(Cc + i * LDT + 16 * s4 + 8 * hi);
        }
        f32x16 af, ab;
#pragma unroll
        for (int k = 0; k < 16; ++k) { af[k] = 0.f; ab[k] = 0.f; }
#pragma unroll
        for (int s4 = 0; s4 < 4; ++s4) {
            const bf16x8 sf = *(const bf16x8*)(St + (32 * pt + r32) * LDT + 16 * s4 + 8 * hi);
            const bf16x8 sb = *(const bf16x8*)(St + (64 + 32 * pt + r32) * LDT + 16 * s4 + 8 * hi);
            af = __builtin_amdgcn_mfma_f32_32x32x16_bf16(sf, cq[s4], af, 0, 0, 0);
            ab = __builtin_amdgcn_mfma_f32_32x32x16_bf16(sb, cq[s4], ab, 0, 0, 0);
        }
        const float* EA = (const float*)(p.ws + OFF_EA) + (size_t)r * 8;
        const float ef = EA[h], eb = EA[4 + h];
        const float* YP = (const float*)(p.ws + OFF_YPART) + (size_t)r * 256 + h * 64 + 32 * pt;
        const bf16_t* zp = proj + (size_t)r * INPP + CB_Z + h * 64 + 32 * pt;
        float sq = 0.f;
#pragma unroll
        for (int g4 = 0; g4 < 4; ++g4) {
            const f32x4 yp = *(const f32x4*)(YP + 8 * g4 + 4 * hi);
            const uint2 zq = *(const uint2*)(zp + 8 * g4 + 4 * hi);
            const float z[4] = {__uint_as_float(zq.x << 16), __uint_as_float(zq.x & 0xffff0000u), __uint_as_float(zq.y << 16), __uint_as_float(zq.y & 0xffff0000u)};
            float yg[4];
#pragma unroll
            for (int e = 0; e < 4; ++e) { const float y = yp[e] + ef * af[4 * g4 + e] + eb * ab[4 * g4 + e]; yg[e] = y * silu_(z[e]); sq += yg[e] * yg[e]; }
            uint2 o; o.x = pack2(yg[0], yg[1]); o.y = pack2(yg[2], yg[3]);
            *(uint2*)(ybuf + i * 256 + h * 64 + 32 * pt + 8 * g4 + 4 * hi) = o;
        }
        sq = xhalf_sum(sq);
        if (hi == 0) ssqp[(h * 2 + pt) * 128 + i] = sq;
        __syncthreads();
    }
    {
        const float* gn = p.in[I_SSDNORM] + l * 256;
        bf16_t* mix = (bf16_t*)(p.ws + OFF_RB);
#pragma unroll 2
        for (int k = 0; k < 8; ++k) { const int item = tid + NTHR * k, ri = item >> 5, c = (item & 31) * 8;
            float ss = 0.f;
#pragma unroll
            for (int q = 0; q < 8; ++q) ss += ssqp[q * 128 + ri];
            const float rs = rsqrtf(ss * (1.f / 256.f) + EPS);
            const u32x4 v = *(const u32x4*)(ybuf + ri * 256 + c);
            const f32x4 g0 = *(const f32x4*)(gn + c), g1 = *(const f32x4*)(gn + c + 4);
            u32x4 o;
            o[0] = pack2(__uint_as_float(v[0] << 16) * rs * g0[0], __uint_as_float(v[0] & 0xffff0000u) * rs * g0[1]);
            o[1] = pack2(__uint_as_float(v[1] << 16) * rs * g0[2], __uint_as_float(v[1] & 0xffff0000u) * rs * g0[3]);
            o[2] = pack2(__uint_as_float(v[2] << 16) * rs * g1[0], __uint_as_float(v[2] & 0xffff0000u) * rs * g1[1]);
            o[3] = pack2(__uint_as_float(v[3] << 16) * rs * g1[2], __uint_as_float(v[3] & 0xffff0000u) * rs * g1[3]);
            *(u32x4*)(mix + (size_t)(row0 + ri) * DM + 256 + c) = o; }
    }
    __syncthreads();
}

constexpr int LC_WB = 0, LC_RAW = 4 * 64 * LDT * 2, LC_US = 65536, LC_CW = LC_US + 128 * LDT * 2, LC_SEG = LC_CW + 5 * 64 * 4, LRU_LDS = LC_SEG + 2 * 8 * 64 * 4;
static_assert(LC_RAW + 131 * LDT * 2 <= 65536, "raw rows fit under the scan arrays");
DI int lru_chunk_units() { return NB * NCHK * 4; }
DI void lru_chunk_unit(const Params& p, int l, int u, char* smem) {
    const int tid = tidx(), lane = tid & 63, w = __builtin_amdgcn_readfirstlane(tid >> 6), r32 = lane & 31, hi = lane >> 5;
    const int kb = u & 3, cb = (u >> 2) % NCHK, b = (u >> 2) / NCHK;
    const int row0 = blk_row0(b, cb);
    const int part0 = cb < 2 ? b * CTXL : NCTX + b * SEQ, partN = cb < 2 ? CTXL : SEQ;
    bf16_t* Wb = (bf16_t*)(smem + LC_WB);
    bf16_t* raw = (bf16_t*)(smem + LC_RAW);
    float* aL = (float*)smem;
    float* xL = aL + 128 * 64;
    bf16_t* Us = (bf16_t*)(smem + LC_US);
    float* cwl = (float*)(smem + LC_CW);
    float* segA = (float*)(smem + LC_SEG); float* segH = segA + 8 * 64;
    const bf16_t* proj = (const bf16_t*)(p.ws + OFF_RA);
    {
        u32x4 v[3];
#pragma unroll
        for (int k = 0; k < 3; ++k) { const int item = tid + NTHR * k; v[k] = (u32x4){0u, 0u, 0u, 0u};
            if (item < 131 * 8) { const int r = item >> 3, c = item & 7, gr = row0 - 2 + r;
                if (gr >= part0 && gr < part0 + partN) v[k] = *(const u32x4*)(proj + (size_t)gr * INPP + CC_X + kb * 64 + 8 * c); } }
        f32x4 wv[8];
#pragma unroll
        for (int k = 0; k < 8; ++k) { const int idx = tid + NTHR * k, g = idx >> 10, e4 = idx & 1023, d = g >> 1;
            wv[k] = *(const f32x4*)(p.in[(g & 1) ? I_LRUWI : I_LRUWA] + ((size_t)((l * 2 + d) * 4 + kb)) * 4096 + 4 * e4); }
#pragma unroll
        for (int k = 0; k < 3; ++k) { const int item = tid + NTHR * k; if (item < 131 * 8) *(u32x4*)(raw + (item >> 3) * LDT + 8 * (item & 7)) = v[k]; }
#pragma unroll
        for (int k = 0; k < 8; ++k) { const int idx = tid + NTHR * k, g = idx >> 10, e4 = idx & 1023, i = e4 >> 4, j4 = (e4 & 15) * 4;
            uint2 q; q.x = pack2(wv[k][0], wv[k][1]); q.y = pack2(wv[k][2], wv[k][3]); *(uint2*)(Wb + (g * 64 + i) * LDT + j4) = q; }
        if (tid < 320) { const int j = tid >> 6, c = tid & 63; cwl[tid] = j < 4 ? p.in[I_LRUCW][l * 1024 + j * 256 + kb * 64 + c] : p.in[I_LRUCB][l * 256 + kb * 64 + c]; }
    }
    __syncthreads();
#pragma unroll
    for (int k = 0; k < 2; ++k) { const int item = tid + NTHR * k, i = item >> 3, c = item & 7;
        float acc[8];
        { const f32x4 b0 = *(const f32x4*)(cwl + 256 + 8 * c), b1 = *(const f32x4*)(cwl + 256 + 8 * c + 4);
          acc[0] = b0[0]; acc[1] = b0[1]; acc[2] = b0[2]; acc[3] = b0[3]; acc[4] = b1[0]; acc[5] = b1[1]; acc[6] = b1[2]; acc[7] = b1[3]; }
#pragma unroll
        for (int j = 0; j < 4; ++j) { const u32x4 q = *(const u32x4*)(raw + (i + j) * LDT + 8 * c);
            const f32x4 w0 = *(const f32x4*)(cwl + j * 64 + 8 * c), w1 = *(const f32x4*)(cwl + j * 64 + 8 * c + 4);
            acc[0] += w0[0] * __uint_as_float(q[0] << 16); acc[1] += w0[1] * __uint_as_float(q[0] & 0xffff0000u); acc[2] += w0[2] * __uint_as_float(q[1] << 16); acc[3] += w0[3] * __uint_as_float(q[1] & 0xffff0000u);
            acc[4] += w1[0] * __uint_as_float(q[2] << 16); acc[5] += w1[1] * __uint_as_float(q[2] & 0xffff0000u); acc[6] += w1[2] * __uint_as_float(q[3] << 16); acc[7] += w1[3] * __uint_as_float(q[3] & 0xffff0000u); }
        u32x4 o; o[0] = pack2(acc[0], acc[1]); o[1] = pack2(acc[2], acc[3]); o[2] = pack2(acc[4], acc[5]); o[3] = pack2(acc[6], acc[7]);
        *(u32x4*)(Us + i * LDT + 8 * c) = o; }
    __syncthreads();
    const int tt = w & 3, jt = w >> 2, q4 = (lane & 15) >> 2, p4 = lane & 3, blk = (lane >> 4) & 1;
    f32x16 acc[4];
#pragma unroll
    for (int g = 0; g < 4; ++g)
#pragma unroll
        for (int r = 0; r < 16; ++r) acc[g][r] = 0.f;
#pragma unroll
    for (int s4 = 0; s4 < 4; ++s4) {
        const bf16x8 uf = *(const bf16x8*)(Us + (32 * tt + r32) * LDT + 16 * s4 + 8 * hi);
#pragma unroll
        for (int g = 0; g < 4; ++g) { const bf16_t* wp = Wb + (g * 64 + 16 * s4 + 8 * hi + q4) * LDT + 32 * jt + 16 * blk + 4 * p4;
            acc[g] = __builtin_amdgcn_mfma_f32_32x32x16_bf16(uf, cat8(tr16(wp), tr16(wp + 4 * LDT)), acc[g], 0, 0, 0); }
    }
    float uv[16];
    const int chl = 32 * jt + r32, ch = kb * 64 + chl;
#pragma unroll
    for (int r = 0; r < 16; ++r) uv[r] = bf2f(Us[(32 * tt + crow(r, hi)) * LDT + chl]);
    __syncthreads();
    bf16_t* HB = (bf16_t*)(p.ws + OFF_LRUH);
    float* LC = (float*)(p.ws + OFF_LRUC);
#pragma unroll
    for (int d = 0; d < 2; ++d) {
        {
            const float ba = p.in[I_LRUBA][(l * 2 + d) * 256 + ch], bi = p.in[I_LRUBI][(l * 2 + d) * 256 + ch];
            const float spl = softplus_(-p.in[I_LRULAM][(l * 2 + d) * 256 + ch]);
#pragma unroll
            for (int r = 0; r < 16; ++r) { const int i = 32 * tt + crow(r, hi);
                const float rg = sigmoid_(acc[2 * d][r] + ba), ig = sigmoid_(acc[2 * d + 1][r] + bi);
                const float la = -8.f * rg * spl;
                const float av = __expf(la);
                const float mult = __builtin_amdgcn_sqrtf(fmaxf(0.f, 1.f - av * av));
                aL[i * 64 + chl] = av; xL[i * 64 + chl] = mult * ig * uv[r]; }
        }
        __syncthreads();
        const int sch = tid & 63, sg = tid >> 6;
        float hacc = 0.f, pacc = 1.f;
#pragma unroll 1
        for (int t = 0; t < 16; ++t) { const int tau = sg * 16 + t, i = d ? 127 - tau : tau;
            const float av = aL[i * 64 + sch]; hacc = av * hacc + xL[i * 64 + sch]; pacc *= av; xL[i * 64 + sch] = hacc; aL[i * 64 + sch] = pacc; }
        segA[sg * 64 + sch] = pacc; segH[sg * 64 + sch] = hacc;
        __syncthreads();
        float carry = 0.f, cp = 1.f;
        for (int s2 = 0; s2 < sg; ++s2) { carry = carry * segA[s2 * 64 + sch] + segH[s2 * 64 + sch]; cp *= segA[s2 * 64 + sch]; }
        bf16_t* Hh = HB + (size_t)(2 * d) * NTOK * 256; bf16_t* Hp = HB + (size_t)(2 * d + 1) * NTOK * 256;
        float hl = 0.f, pl = 1.f;
#pragma unroll 1
        for (int t = 0; t < 16; ++t) { const int tau = sg * 16 + t, i = d ? 127 - tau : tau;
            hl = xL[i * 64 + sch] + aL[i * 64 + sch] * carry; pl = aL[i * 64 + sch] * cp;
            Hh[(size_t)(row0 + i) * 256 + kb * 64 + sch] = f2bf(hl); Hp[(size_t)(row0 + i) * 256 + kb * 64 + sch] = f2bf(pl); }
        if (sg == 7) { const int s = d ? bwd_seq(cb) : cb; const size_t o = ((size_t)(b * 2 + d) * NCHK + s) * 256 + kb * 64 + sch;
            LC[o] = hl; LC[(size_t)NB * 2 * NCHK * 256 + o] = pl; }
        __syncthreads();
    }
}
DI int lru_fin_units(int l) { return NB * (l == 0 ? NCHK : NCHK - 2); }
DI void lru_fin_unit(const Params& p, int l, int u, char* smem) {
    const int tid = tidx();
    const int nper = l == 0 ? NCHK : NCHK - 2;
    const int b = u / nper, cb = u % nper + (l == 0 ? 0 : 2);
    const int row0 = blk_row0(b, cb);
    const bf16_t* HB = (const bf16_t*)(p.ws + OFF_LRUH);
    const bf16_t* proj = (const bf16_t*)(p.ws + OFF_RA);
    bf16_t* mix = (bf16_t*)(p.ws + OFF_RB);
    const int c = (tid & 31) * 8;
    const float* CF = (const float*)(p.ws + OFF_CARRY) + ((size_t)(b * 2 + 0) * NCHK + cb) * 256 + c;
    const float* CB2 = (const float*)(p.ws + OFF_CARRY) + ((size_t)(b * 2 + 1) * NCHK + bwd_seq(cb)) * 256 + c;
    float cf[8], cbk[8];
    { const f32x4 a0 = *(const f32x4*)CF, a1 = *(const f32x4*)(CF + 4), b0 = *(const f32x4*)CB2, b1 = *(const f32x4*)(CB2 + 4);
#pragma unroll
      for (int e = 0; e < 4; ++e) { cf[e] = a0[e]; cf[4 + e] = a1[e]; cbk[e] = b0[e]; cbk[4 + e] = b1[e]; } }
#pragma unroll 2
    for (int k = 0; k < 8; ++k) {
        const int ri = (tid >> 5) + 16 * k; const size_t o = (size_t)(row0 + ri) * 256 + c;
        const u32x4 hf = *(const u32x4*)(HB + o), pf = *(const u32x4*)(HB + (size_t)NTOK * 256 + o), hb = *(const u32x4*)(HB + (size_t)2 * NTOK * 256 + o), pb = *(const u32x4*)(HB + (size_t)3 * NTOK * 256 + o);
        const u32x4 g = *(const u32x4*)(proj + (size_t)(row0 + ri) * INPP + CC_G + c);
        u32x4 out;
#pragma unroll
        for (int e = 0; e < 4; ++e) {
            const float lo = (__uint_as_float(hf[e] << 16) + __uint_as_float(pf[e] << 16) * cf[2 * e] + __uint_as_float(hb[e] << 16) + __uint_as_float(pb[e] << 16) * cbk[2 * e]) * gelu_tanh_(__uint_as_float(g[e] << 16));
            const float hh = (__uint_as_float(hf[e] & 0xffff0000u) + __uint_as_float(pf[e] & 0xffff0000u) * cf[2 * e + 1] + __uint_as_float(hb[e] & 0xffff0000u) + __uint_as_float(pb[e] & 0xffff0000u) * cbk[2 * e + 1]) * gelu_tanh_(__uint_as_float(g[e] & 0xffff0000u));
            out[e] = pack2(lo, hh); }
        *(u32x4*)(mix + (size_t)(row0 + ri) * DM + 512 + c) = out;
    }
}

#define XB_TMO      128
#define XB_XCNT(j)  (256  + 64 * (j))
#define XB_XSUB(j)  (1280 + 64 * (j))
#define XB_XGEN(j)  (2304 + 64 * (j))
#define XB_TOP      3328
#define XB_TOPGEN   3392
#define XCD_BAR_WORDS 3456
#define XB_SPIN_CAP (1u << 18)
#define LAS __attribute__((address_space(3)))

__device__ __forceinline__ unsigned xb_ld(unsigned* p)              { return __hip_atomic_load(p, __ATOMIC_RELAXED, __HIP_MEMORY_SCOPE_AGENT); }
__device__ __forceinline__ unsigned xb_add(unsigned* p, unsigned v) { return __hip_atomic_fetch_add(p, v, __ATOMIC_RELAXED, __HIP_MEMORY_SCOPE_AGENT); }
__device__ __forceinline__ unsigned xb_xcc_id() { return (unsigned)__builtin_amdgcn_s_getreg((3 << 11) | 20) & 0xFu; }
#define XB_SPIN(cond, bar) do { unsigned _sp = 0; while (cond) { __builtin_amdgcn_s_sleep(1); \
    if ((++_sp & 255u) == 0u) { if (xb_ld(&(bar)[XB_TMO])) break; if (_sp > XB_SPIN_CAP) { atomicAdd(&(bar)[XB_TMO], 1u); break; } } } } while (0)

struct XcdBarrier {
    unsigned* bar; unsigned x;
    volatile LAS unsigned* st;
};

__device__ __forceinline__ XcdBarrier xcd_barrier_post(unsigned* bar, volatile LAS unsigned* st) {
    XcdBarrier b; b.bar = bar; b.x = xb_xcc_id(); b.st = st;
    if (threadIdx.x == 0) (void)xb_add(&bar[XB_XCNT(b.x)], 1u);
    return b;
}
__device__ __forceinline__ void xcd_barrier_complete(unsigned* bar, unsigned x, unsigned& nloc, unsigned& nx) {
    const unsigned G = gridDim.x * gridDim.y * gridDim.z;
    unsigned sum, cnt, mine, sp = 0u;
    for (;;) {
        sum = 0u; cnt = 0u; mine = 0u;
#pragma unroll
        for (unsigned j = 0; j < 16; ++j) { const unsigned c = xb_ld(&bar[XB_XCNT(j)]); sum += c; cnt += (c > 0u) ? 1u : 0u; mine = (j == x) ? c : mine; }
        if (sum == G) break;
        __builtin_amdgcn_s_sleep(1);
        if ((++sp & 255u) == 0u) { if (xb_ld(&bar[XB_TMO])) break; if (sp > XB_SPIN_CAP) { atomicAdd(&bar[XB_TMO], 1u); break; } }
    }
    nloc = mine > 0u ? mine : 1u; nx = cnt > 0u ? cnt : 1u;
}

__device__ __forceinline__ void xcd_barrier(const XcdBarrier& b) {
    asm volatile("s_waitcnt vmcnt(0)" ::: "memory");
    __syncthreads();
    if (threadIdx.x == 0) {
        unsigned* bar = b.bar;
        __builtin_amdgcn_s_waitcnt(0);
        unsigned nloc = b.st[0], nx = b.st[1];
        if (nloc == 0u) { xcd_barrier_complete(bar, b.x, nloc, nx); b.st[0] = nloc; b.st[1] = nx; }
        const unsigned old = xb_add(&bar[XB_XSUB(b.x)], 1u);
        const unsigned gen = old / nloc;
        if (old + 1u == (gen + 1u) * nloc) {
            __builtin_amdgcn_fence(__ATOMIC_RELEASE, "agent");
            asm volatile("s_waitcnt vmcnt(0)" ::: "memory");
            const unsigned og = xb_add(&bar[XB_TOP], 1u);
            const unsigned tg = og / nx;
            if (og + 1u == (tg + 1u) * nx) xb_add(&bar[XB_TOPGEN], 1u);
            else XB_SPIN(xb_ld(&bar[XB_TOPGEN]) == tg, bar);
            __builtin_amdgcn_fence(__ATOMIC_ACQUIRE, "agent");
            xb_add(&bar[XB_XGEN(b.x)], 1u);
            asm volatile("s_waitcnt vmcnt(0)" ::: "memory");
        } else {
            XB_SPIN(xb_ld(&bar[XB_XGEN(b.x)]) == gen, bar);
            __builtin_amdgcn_fence(__ATOMIC_ACQUIRE, "agent");
            asm volatile("s_waitcnt vmcnt(0)" ::: "memory");
        }
    }
    __syncthreads();
}


#define PROBE_SUB 0
enum { PH_PRO = 0, PH_CONVEXP, PH_PRE0, PH_INPROJ, PH_PREP, PH_MIX, PH_OUTPROJ, PH_POST1, PH_MOE1, PH_MOE2, PH_POST2, PH_POST3, PH_MIXB };
constexpr int MAX_LDS = 140 * 1024;

template <int PH>
DI void run_phase(const Params& p, int l, int hf, char* smem) {
    const int G = gridDim.x, B = blockIdx.x;
    if (PH == PH_PRO) {
        const int n0 = MOD_UNITS, n1 = n0 + ROPE_UNITS + RWT_UNITS;
        for (int u = B; u < n1; u += G) {
            if (u < n0) mod_unit(p, u, smem);
            else if (u < n0 + RWT_UNITS) rwt_unit(p, u - n0, smem);
            else rope_unit(p, u - n0 - RWT_UNITS);
        }
        convert_run(p, 0, smem);
    } else if (PH == PH_CONVEXP) {
        { MoeTab* tb = (MoeTab*)(smem + GEMM_LDS); moe_table(p, 0, 0, tb);
          const int nb1 = (tb->mstart[65] * 2) % G, nb2 = (tb->mstart[65] * 4) % G;
          const int k2 = nb2 ? min(CONV_GU, (G - nb2) * 4) : 0;
          __syncthreads();
          convert_run(p, 1, smem, k2, (nb1 ? CONV_GU : CONV_SUPER) - k2); }
    } else if (PH == PH_PRE0) {
        for (int u = B; u < NTOK / 16; u += G) rowpost_unit<0>(p, 0, 0, u * 16, smem);
    } else if (PH == PH_INPROJ) {
        InprojS S{p, l}; gemm8<true>(smem, p.ws + OFF_RB, DM, S);
        if (l == 0) { const int nu = (NTOK / 256) * (INPP / 256), nb = nu % G;
            if (nb && B >= nb) { __syncthreads(); convert_run(p, 5, smem, 0, CONV_A, B - nb, G - nb); } }
    } else if (PH == PH_PREP) {
        const int n0 = ssd_chunk_units(), n1 = n0 + lru_chunk_units(), n2 = n1 + PREP_UNITS;
        for (int u = B; u < n2; u += G) {
            if (u < n0) ssd_chunk_unit(p, l, u, smem);
            else if (u < n1) lru_chunk_unit(p, l, u - n0, smem);
            else prep_unit(p, l, u - n1);
        }
        if (PROBE_SUB == 1) for (int u = B; u < n0; u += G) ssd_chunk_unit(p, l, u, smem);
        if (PROBE_SUB == 2) for (int u = B; u < n1 - n0; u += G) lru_chunk_unit(p, l, u, smem);
        if (PROBE_SUB == 3) for (int u = B; u < PREP_UNITS; u += G) prep_unit(p, l, u);
    } else if (PH == PH_MIX) {
        const int n0 = SCAN_UNITS, n1 = n0 + attn_units(l);
        for (int u = B; u < n1; u += G) {
            if (u < n0) scan_unit(p, u);
            else attn_dispatch(p, l, u - n0, smem);
        }
    } else if (PH == PH_MIXB) {
        const int n0 = ssd_fin_units(l), n1 = n0 + lru_fin_units(l);
        for (int u = B; u < n1; u += G) {
            if (u < n0) ssd_fin_unit(p, l, u, smem);
            else lru_fin_unit(p, l, u - n0, smem);
        }
    } else if (PH == PH_OUTPROJ) {
        OutprojS S{p, l}; gemm8<true>(smem, p.ws + OFF_RB, DM, S);
        if (l == 0) { const int nb = (68 * 4) % G;
            if (nb && B >= nb) { __syncthreads(); convert_run(p, 5, smem, CONV_A, CONV_B, B - nb, G - nb); } }
    } else if (PH == PH_POST1) {
        const int lo = l == 0 ? 0 : NCTX, per = l == 0 ? 68 : 64;
        if (l == 0) convert_run(p, 5, smem, CONV_A + CONV_B, CONV_SUPER - CONV_A - CONV_B);
        for (int u = B; u < 256; u += G) route_unit(p, l, lo + u * per, lo + (u + 1) * per, smem);
    } else if (PH == PH_MOE1 || PH == PH_MOE2) {
        MoeTab* tb = (MoeTab*)(smem + GEMM_LDS);
        moe_table(p, l, hf, tb);
        if (PH == PH_MOE1) { Moe1S S{p, l, hf, tb}; gemm8<true>(smem, p.ws + OFF_RA, 1024, S); }
        else { Moe2S S{p, l, hf, tb}; gemm8<true>(smem, p.ws + OFF_HID, 256, S); }
        __syncthreads();
        if (l == 0) {
            const int nb = (tb->mstart[65] * (PH == PH_MOE1 ? 2 : 4)) % G;
            if (nb && B >= nb) { if (PH == PH_MOE1) convert_run(p, 1, smem, CONV_GU, CONV_SUPER - CONV_GU, B - nb, G - nb);
                                 else { const int k2 = min(CONV_GU, (G - nb) * 4); convert_run(p, 1, smem, 0, k2, B - nb, G - nb); } }
        }
    } else if (PH == PH_POST2 || PH == PH_POST3) {
        const int lo = half_lo(l, hf), n = (half_hi(l, hf) - lo) / 16;
        moe_table(p, l, hf, (MoeTab*)(smem + GEMM_LDS));
        for (int u = B; u < n; u += G) { if (PH == PH_POST2) rowpost_unit<2>(p, l, hf, lo + u * 16, smem); else rowpost_unit<3>(p, l, hf, lo + u * 16, smem); }
    }
}

#ifndef MULTI_LAUNCH
#define MULTI_LAUNCH 0
#endif
#define PROBE_PH -1
#define PROBE_TMASK 0ull
#define TSTAMP() do { if (PROBE_TMASK != 0ull && blockIdx.x == 0 && threadIdx.x == 0) tsl[bk] = wall_clock64(); ++bk; } while (0)
#define GBAR() do { XcdBarrier b2_ = bar; asm volatile("" : "+s"(b2_.x)); asm volatile("" : "+s"(b2_.bar)); xcd_barrier(b2_); TSTAMP(); } while (0)
#define RUNP(PH, l, hf) do { run_phase<PH>(p, l, hf, smem); if (PROBE_PH == PH) run_phase<PH>(p, l, hf, smem); } while (0)
static_assert(XCD_BAR_WORDS * 4 <= 16 * 1024, "barrier words fit their region");
__global__ void __launch_bounds__(NTHR, 2) k_mega(Params p) {
    extern __shared__ __attribute__((aligned(16))) char smem[];
    uint4* xbw = (uint4*)(smem + MAX_LDS - 16);
    if (threadIdx.x == 0) *xbw = make_uint4(0u, 0u, 0u, 0u);
    __syncthreads();
    XcdBarrier bar = xcd_barrier_post((unsigned*)(p.ws + OFF_BAR), (volatile LAS unsigned*)xbw);
    unsigned long long* tsl = (unsigned long long*)(smem + MAX_LDS - 16 - 32 * 8); int bk = 1;
    if (PROBE_TMASK != 0ull && blockIdx.x == 0 && threadIdx.x == 0) tsl[0] = wall_clock64();
    if (PROBE_STAGE >= 0 && threadIdx.x == 0) { unsigned long long* tacc0 = (unsigned long long*)(smem + MAX_LDS - 16 - 32 * 8 - 64); for (int k = 0; k < 4; ++k) tacc0[k] = 0ull; }
    RUNP(PH_PRO, 0, 0);
    GBAR();
    RUNP(PH_PRE0, 0, 0);
    GBAR();
#pragma unroll 1
    for (int l = 0; l < 2; ++l) {
        if (l == 1) RUNP(PH_CONVEXP, 1, 0);
        RUNP(PH_INPROJ, l, 0);
        GBAR();
        RUNP(PH_PREP, l, 0);
        GBAR();
        RUNP(PH_MIX, l, 0);
        GBAR();
        RUNP(PH_MIXB, l, 0);
        GBAR();
        RUNP(PH_OUTPROJ, l, 0);
        GBAR();
        RUNP(PH_POST1, l, 0);
        GBAR();
        RUNP(PH_MOE1, l, 0);
        GBAR();
        RUNP(PH_MOE2, l, 0);
        GBAR();
        if (l == 0) { RUNP(PH_POST2, l, 0); GBAR(); } else RUNP(PH_POST3, l, 0);
    }
    if ((PROBE_TMASK != 0ull || PROBE_STAGE >= 0) && blockIdx.x == 0) {
        __syncthreads();
        if (threadIdx.x == 0) { tsl[bk] = wall_clock64(); unsigned long long acc = 0ull;
            if (PROBE_STAGE >= 0) acc += ((unsigned long long*)(smem + MAX_LDS - 16 - 32 * 8 - 64))[PROBE_STAGE >= 0 ? PROBE_STAGE : 0];
            for (int k = 1; k <= bk; ++k) if ((PROBE_TMASK >> (k - 1)) & 1ull) acc += tsl[k] - tsl[k - 1];
            const unsigned long long t0 = wall_clock64(); while (wall_clock64() - t0 < acc) __builtin_amdgcn_s_sleep(32); }
    }
}

#if MULTI_LAUNCH
template <int PH>
__global__ void __launch_bounds__(NTHR, 2) k_phase(Params p, int l, int hf) {
    extern __shared__ __attribute__((aligned(16))) char smem[];
    run_phase<PH>(p, l, hf, smem);
}
template <int PH>
static void launch_phase(const Params& p, int l, int hf, int grid, hipStream_t st) {
    static bool inited = false;
    if (!inited) { (void)hipFuncSetAttribute((const void*)k_phase<PH>, hipFuncAttributeMaxDynamicSharedMemorySize, MAX_LDS); inited = true; }
    k_phase<PH><<<grid, NTHR, MAX_LDS, st>>>(p, l, hf);
}
#endif

extern "C" void kernel_launch(void* const* d_in, const int* in_sizes, int n_in, void* d_out, int out_size, void* d_ws, size_t ws_size, hipStream_t stream) {
    if (ws_size < WS_NEED || n_in < 36) return;
    Params p{};
    for (int i = 0; i < 36; ++i) p.in[i] = (const float*)d_in[i];
    p.out = (float*)d_out; p.ws = (char*)d_ws;
    (void)hipMemsetAsync(d_ws, 0, ZERO_BYTES, stream);
#if MULTI_LAUNCH
    const int G = 256;
    launch_phase<PH_PRO>(p, 0, 0, G, stream);
    launch_phase<PH_PRE0>(p, 0, 0, G, stream);
    for (int l = 0; l < 2; ++l) {
        if (l == 1) launch_phase<PH_CONVEXP>(p, 1, 0, G, stream);
        launch_phase<PH_INPROJ>(p, l, 0, G, stream);
        launch_phase<PH_PREP>(p, l, 0, G, stream);
        launch_phase<PH_MIX>(p, l, 0, G, stream);
        launch_phase<PH_MIXB>(p, l, 0, G, stream);
        launch_phase<PH_OUTPROJ>(p, l, 0, G, stream);
        launch_phase<PH_POST1>(p, l, 0, G, stream);
        for (int hf = 0; hf < 1; ++hf) {
            launch_phase<PH_MOE1>(p, l, hf, G, stream);
            launch_phase<PH_MOE2>(p, l, hf, G, stream);
            if (l == 0) launch_phase<PH_POST2>(p, l, hf, G, stream); else launch_phase<PH_POST3>(p, l, hf, G, stream);
        }
    }
#else
    static int grid = 0;
    if (!grid) {
        int dev = 0, cus = 0, per_cu = 0;
        (void)hipGetDevice(&dev);
        (void)hipDeviceGetAttribute(&cus, hipDeviceAttributeMultiprocessorCount, dev);
        (void)hipFuncSetAttribute((const void*)k_mega, hipFuncAttributeMaxDynamicSharedMemorySize, MAX_LDS);
        (void)hipOccupancyMaxActiveBlocksPerMultiprocessor(&per_cu, (const void*)k_mega, NTHR, MAX_LDS);
        grid = per_cu >= 1 ? cus : 0;
    }
    if (grid > 0) k_mega<<<grid, NTHR, MAX_LDS, stream>>>(p);
#endif
}
```

```cpp
#include <hip/hip_runtime.h>
#include <stdint.h>

#define DI __device__ __forceinline__
typedef unsigned short bf16_t;
typedef short bf16x8 __attribute__((ext_vector_type(8)));
typedef short s16x4 __attribute__((ext_vector_type(4)));
typedef float f32x4 __attribute__((ext_vector_type(4)));
typedef float f32x16 __attribute__((ext_vector_type(16)));
typedef unsigned u32x4 __attribute__((ext_vector_type(4)));

constexpr int NTHR = 512;
constexpr int DM = 1024, NB = 4, SEQ = 4096, CTXL = 256;
constexpr int NCTX = NB * CTXL, NLAT = NB * SEQ, NTOK = NCTX + NLAT;
constexpr int INP = 2312, INPP = 2560;
constexpr int CA_Q = 0, CA_K = 256, CA_V = 384, CB_Z = 512, CB_X = 768, CB_B = 1024, CB_C = 1152, CB_DTF = 1280, CB_DTB = 1284,
              CC_X = 1288, CC_G = 1544, CD_Q = 1800, CD_K = 2056, CD_V = 2184;
constexpr int NCHK = 34;
constexpr int HCAP = NTOK;
constexpr float EPS = 1e-6f;
constexpr float YE_SCALE = 8.f;
typedef float f32x2 __attribute__((ext_vector_type(2)));

constexpr size_t MB = 1024 * 1024;
constexpr size_t OFF_BAR = 0;
constexpr size_t OFF_CNT = 16 * 1024;
constexpr size_t OFF_MOD = 32 * 1024;
constexpr size_t ZERO_BYTES = 32 * 1024 + 2 * 5 * 6144 * 4;
constexpr size_t OFF_ROPE = 512 * 1024;
constexpr size_t OFF_SLOT_TOK = 2 * MB;
constexpr size_t OFF_SLOT_W = 7 * MB;
constexpr size_t OFF_TOKSLOT = 12 * MB;
constexpr size_t OFF_LRUC = 13 * MB;
constexpr size_t OFF_SSDDEC = 14 * MB;
constexpr size_t OFF_RWT = 14 * MB + 64 * 1024;
constexpr size_t OFF_XCTX = 15 * MB;
constexpr size_t OFF_WIN = 20 * MB;
constexpr size_t SZ_WIN1 = (size_t)INPP * DM * 2;
constexpr size_t OFF_WOUT = OFF_WIN + 2 * SZ_WIN1;
constexpr size_t SZ_WOUT1 = (size_t)DM * DM * 2;
constexpr size_t OFF_WGU = 36 * MB;
constexpr size_t OFF_WD = OFF_WGU + (size_t)65 * 512 * 1024 * 2;
constexpr size_t OFF_Y = 134 * MB;
constexpr size_t OFF_XB = 168 * MB;
constexpr size_t OFF_RA = 202 * MB;
constexpr size_t OFF_HID = OFF_RA + (size_t)NTOK * DM * 2;
constexpr size_t OFF_RB = 321 * MB;
constexpr size_t OFF_RC = 355 * MB;
constexpr size_t OFF_QA = OFF_RC;
constexpr size_t OFF_KA = OFF_QA + (size_t)NTOK * 256 * 2;
constexpr size_t OFF_QD = OFF_KA + (size_t)NTOK * 128 * 2;
constexpr size_t OFF_KD = OFF_QD + (size_t)NTOK * 256 * 2;
constexpr size_t OFF_SSDST = OFF_KD + (size_t)NTOK * 128 * 2;
constexpr size_t OFF_YPART = OFF_SSDST + (size_t)4 * 4 * 2 * 34 * 4096 * 4;
constexpr size_t OFF_CC = OFF_YPART + (size_t)NTOK * 256 * 4;
constexpr size_t OFF_EA = OFF_CC + (size_t)NTOK * 128 * 4;
constexpr size_t OFF_LRUH = OFF_EA + (size_t)NTOK * 8 * 4;
constexpr size_t OFF_START = OFF_LRUH + (size_t)4 * NTOK * 256 * 2;
constexpr size_t OFF_CARRY = OFF_START + (size_t)4 * 4 * 2 * 34 * 4096 * 2;
static_assert(OFF_CARRY + 4 * 2 * 34 * 256 * 4 <= OFF_RC + (size_t)8 * HCAP * 1024, "phase scratch fits under ye");
constexpr size_t OFF_YE = OFF_RC;
constexpr size_t WS_NEED = OFF_RC + (size_t)8 * HCAP * 1024 + MB;
static_assert(OFF_HID + (size_t)(8 * NTOK + 64 * 255 + NTOK + 256) * 512 <= OFF_RB, "hid fits between the tokens and h");

struct Params {
    const float* in[36];
    float* out;
    char* ws;
};
enum { I_X = 0, I_C, I_CTX, I_CCTX, I_WADA, I_BADA, I_GMIXPRE, I_GMIXPOST, I_GFFNPRE, I_GFFNPOST, I_WIN, I_WOUT, I_ASINK, I_SSDCW, I_SSDCB, I_SSDDTB, I_SSDALOG,
       I_SSDD, I_SSDNORM, I_LRUCW, I_LRUCB, I_LRUWA, I_LRUBA, I_LRUWI, I_LRUBI, I_LRULAM, I_DQN, I_DKN, I_RW, I_RB, I_EG, I_EU, I_ED, I_SG, I_SU, I_SD };

DI int tidx() { int t = threadIdx.x; asm volatile("" : "+v"(t)); return t; }
DI float bf2f(bf16_t v) { return __uint_as_float(((unsigned)v) << 16); }
DI unsigned pack2(float lo, float hi) { unsigned r; asm("v_cvt_pk_bf16_f32 %0, %1, %2" : "=v"(r) : "v"(lo), "v"(hi)); return r; }
DI bf16_t f2bf(float f) { return (bf16_t)(pack2(f, 0.f) & 0xffffu); }
#define DPPF(v, ctrl) __int_as_float(__builtin_amdgcn_update_dpp(0, __float_as_int(v), ctrl, 0xf, 0xf, true))
#define DPPI(v, ctrl) __builtin_amdgcn_update_dpp(0, (v), ctrl, 0xf, 0xf, true)
DI float row16_sum(float v) { v += DPPF(v, 0xB1); v += DPPF(v, 0x4E); v += DPPF(v, 0x141); v += DPPF(v, 0x140); return v; }
DI float wave_sum(float v) {
    v = row16_sum(v);
    return __int_as_float(__builtin_amdgcn_readlane(__float_as_int(v), 0)) + __int_as_float(__builtin_amdgcn_readlane(__float_as_int(v), 16))
         + __int_as_float(__builtin_amdgcn_readlane(__float_as_int(v), 32)) + __int_as_float(__builtin_amdgcn_readlane(__float_as_int(v), 48));
}
DI float xhalf_max(float v) { auto rr = __builtin_amdgcn_permlane32_swap(__float_as_uint(v), __float_as_uint(v), false, false); return fmaxf(__uint_as_float(rr[0]), __uint_as_float(rr[1])); }
DI float xhalf_sum(float v) { auto rr = __builtin_amdgcn_permlane32_swap(__float_as_uint(v), __float_as_uint(v), false, false); return __uint_as_float(rr[0]) + __uint_as_float(rr[1]); }
DI float grp8_max(float v) { v = fmaxf(v, DPPF(v, 0xB1)); v = fmaxf(v, DPPF(v, 0x4E)); v = fmaxf(v, DPPF(v, 0x141)); return v; }
DI int grp8_min(int v) { v = min(v, DPPI(v, 0xB1)); v = min(v, DPPI(v, 0x4E)); v = min(v, DPPI(v, 0x141)); return v; }
DI float sigmoid_(float x) { return __builtin_amdgcn_rcpf(1.f + __builtin_amdgcn_exp2f(-1.4426950408889634f * x)); }
DI float silu_(float x) { return x * sigmoid_(x); }
DI float softplus_(float x) { return x > 20.f ? x : log1pf(__expf(x)); }
DI float gelu_tanh_(float x) { const float u = 0.7978845608028654f * (x + 0.044715f * x * x * x); const float th = 1.f - 2.f * __builtin_amdgcn_rcpf(1.f + __builtin_amdgcn_exp2f(2.8853900817779268f * u)); return 0.5f * x * (1.f + th); }
DI void lds_barrier() { asm volatile("s_waitcnt lgkmcnt(0)" ::: "memory"); __builtin_amdgcn_s_barrier(); asm volatile("" ::: "memory"); }
DI int crow(int reg, int h) { return (reg & 3) + 8 * (reg >> 2) + 4 * h; }

DI void ld8bf(const bf16_t* q, f32x4& a, f32x4& b) { const u32x4 v = *(const u32x4*)q; a = (f32x4){__uint_as_float(v[0] << 16), __uint_as_float(v[0] & 0xffff0000u), __uint_as_float(v[1] << 16), __uint_as_float(v[1] & 0xffff0000u)};
    b = (f32x4){__uint_as_float(v[2] << 16), __uint_as_float(v[2] & 0xffff0000u), __uint_as_float(v[3] << 16), __uint_as_float(v[3] & 0xffff0000u)}; }
DI void st8bf(bf16_t* q, const f32x4& a, const f32x4& b) { u32x4 o; o[0] = pack2(a[0], a[1]); o[1] = pack2(a[2], a[3]); o[2] = pack2(b[0], b[1]); o[3] = pack2(b[2], b[3]); *(u32x4*)q = o; }
DI const float* xin_row(const Params& p, int r) { return r < NCTX ? p.in[I_CTX] + (size_t)r * DM : p.in[I_X] + (size_t)(r - NCTX) * DM; }
DI int mod_idx(int r) { return r < NCTX ? 4 : ((r - NCTX) >> 12); }
DI const float* modp(const Params& p, int l, int bidx, int k) { return (const float*)(p.ws + OFF_MOD) + ((size_t)(l * 5 + bidx) * 6 + k) * DM; }
DI int half_lo(int l, int hf) { return hf == 0 ? (l == 0 ? 0 : NCTX) : NTOK; }
DI int half_hi(int l, int hf) { return NTOK; }

DI void transpose_tile(const float* __restrict__ src, int ld, int N, int k0, int n0, bf16_t* __restrict__ dst, int ldd, int mode, float* tile) {
    const int t = tidx();
    {
        const int col = t & 63, r8 = t >> 6;
#pragma unroll
        for (int i = 0; i < 8; ++i) { const int row = r8 + 8 * i; tile[row * 65 + col] = (n0 + col < N) ? src[(size_t)(k0 + row) * ld + n0 + col] : 0.f; }
    }
    __syncthreads();
    {
        const int n = t >> 3, kc = (t & 7) * 8;
        uint4 v;
        v.x = pack2(tile[(kc + 0) * 65 + n], tile[(kc + 1) * 65 + n]); v.y = pack2(tile[(kc + 2) * 65 + n], tile[(kc + 3) * 65 + n]);
        v.z = pack2(tile[(kc + 4) * 65 + n], tile[(kc + 5) * 65 + n]); v.w = pack2(tile[(kc + 6) * 65 + n], tile[(kc + 7) * 65 + n]);
        const int nn = n0 + n;
        int R = nn;
        if (mode) R = 256 * (nn >> 7) + (nn & 127) + (mode == 2 ? 128 : 0);
        *(uint4*)(dst + (size_t)R * ldd + k0 + kc) = v;
    }
    __syncthreads();
}
constexpr int CONV_UNITS_SMALL = 640 + 256, CONV_UNITS_EXP = 3 * 4160;
DI void convert_small_unit(const Params& p, int l, int u, char* smem) {
    float* tile = (float*)smem;
    if (u < 640) { const int kt = u / 40, nt = u % 40;
        transpose_tile(p.in[I_WIN] + (size_t)l * DM * INP, INP, INP, kt * 64, nt * 64, (bf16_t*)(p.ws + OFF_WIN + l * SZ_WIN1), DM, 0, tile); return; }
    u -= 640; { const int kt = u / 16, nt = u % 16;
        transpose_tile(p.in[I_WOUT] + (size_t)l * DM * DM, DM, DM, kt * 64, nt * 64, (bf16_t*)(p.ws + OFF_WOUT + l * SZ_WOUT1), DM, 0, tile); }
}
struct ConvDesc { const float* src; bf16_t* dst; int ld, ldd, k0, n0, mode, nvalid; };
constexpr int CONV_SUPER = 65 * 3 * 16;
DI ConvDesc conv_exp_desc(const Params& p, int l, int su) {
    ConvDesc d; const int mi = su >> 4, r = su & 15;
    if (mi < 130) { const int up = mi >= 65, e = up ? mi - 65 : mi;
        d.src = e < 64 ? p.in[up ? I_EU : I_EG] + ((size_t)l * 64 + e) * DM * 256 : p.in[up ? I_SU : I_SG] + (size_t)l * DM * 256;
        d.ld = 256; d.k0 = (r >> 2) * 256; d.n0 = (r & 3) * 64; d.dst = (bf16_t*)(p.ws + OFF_WGU) + (size_t)e * 512 * 1024; d.ldd = 1024; d.mode = up ? 2 : 1; d.nvalid = 64; return d; }
    { const int e = mi - 130;
        d.src = e < 64 ? p.in[I_ED] + ((size_t)l * 64 + e) * 256 * DM : p.in[I_SD] + (size_t)l * 256 * DM;
        d.ld = DM; d.k0 = 0; d.n0 = r * 64; d.dst = (bf16_t*)(p.ws + OFF_WD) + (size_t)e * 1024 * 256; d.ldd = 256; d.mode = 0; d.nvalid = 64; return d; }
}
constexpr int CONV_SMALL_SUPER = 4 * 40 + 4 * 16;
DI ConvDesc conv_small_desc(const Params& p, int l, int su) {
    ConvDesc d; d.mode = 0; d.ldd = DM;
    if (su < 160) { const int kq = su / 40, nt = su % 40; d.src = p.in[I_WIN] + (size_t)l * DM * INP; d.ld = INP; d.k0 = kq * 256; d.n0 = nt * 64; d.dst = (bf16_t*)(p.ws + OFF_WIN + l * SZ_WIN1); d.nvalid = INP - nt * 64; return d; }
    su -= 160; { const int kq = su >> 4, nt = su & 15; d.src = p.in[I_WOUT] + (size_t)l * DM * DM; d.ld = DM; d.k0 = kq * 256; d.n0 = nt * 64; d.dst = (bf16_t*)(p.ws + OFF_WOUT + l * SZ_WOUT1); d.nvalid = 64; return d; }
}
DI int conv_count(int which) { return which == 0 ? 2 * CONV_SMALL_SUPER : CONV_SUPER; }
DI ConvDesc conv_any_desc(const Params& p, int which, int su) {
    if (which == 1) return conv_exp_desc(p, 1, su);
    if (which == 5) return conv_exp_desc(p, 0, su);
    return conv_small_desc(p, su / CONV_SMALL_SUPER, su % CONV_SMALL_SUPER);
}
DI void convert_run(const Params& p, int which, char* smem, int su0 = 0, int cnt = -1, int rank = -1, int stride = 0) {
    float* tile = (float*)smem;
    const int t = tidx(), G = stride > 0 ? stride : (int)gridDim.x;
    const int lr = t >> 4, lc = (t & 15) * 4;
    const int sn = t >> 3, sk = (t & 7) * 8;
    int u = su0 + (rank >= 0 ? rank : (int)blockIdx.x);
    const int NSU = cnt >= 0 ? su0 + cnt : conv_count(which);
    if (u >= NSU) return;
    ConvDesc d = conv_any_desc(p, which, u);
    f32x4 v[4][2], w[4][2];
#pragma unroll
    for (int j = 0; j < 4; ++j) { const float* sp = d.src + (size_t)(d.k0 + 64 * j + lr) * d.ld + d.n0 + lc; const bool ok = lc < d.nvalid; v[j][0] = ok ? *(const f32x4*)sp : (f32x4){0.f, 0.f, 0.f, 0.f}; v[j][1] = ok ? *(const f32x4*)(sp + (size_t)32 * d.ld) : (f32x4){0.f, 0.f, 0.f, 0.f}; }
    for (;;) {
        const int un = u + G; const bool more = un < NSU;
        ConvDesc dn = d;
        if (more) { dn = conv_any_desc(p, which, un);
#pragma unroll
            for (int j = 0; j < 4; ++j) { const float* sp = dn.src + (size_t)(dn.k0 + 64 * j + lr) * dn.ld + dn.n0 + lc; const bool ok = lc < dn.nvalid; w[j][0] = ok ? *(const f32x4*)sp : (f32x4){0.f, 0.f, 0.f, 0.f}; w[j][1] = ok ? *(const f32x4*)(sp + (size_t)32 * dn.ld) : (f32x4){0.f, 0.f, 0.f, 0.f}; } }
#pragma unroll
        for (int j = 0; j < 4; ++j)
#pragma unroll
            for (int e = 0; e < 4; ++e) { tile[j * 64 * 65 + lr * 65 + lc + e] = v[j][0][e]; tile[j * 64 * 65 + (lr + 32) * 65 + lc + e] = v[j][1][e]; }
        __syncthreads();
        const int nn = d.n0 + sn;
        const int R = d.mode ? 256 * (nn >> 7) + (nn & 127) + (d.mode == 2 ? 128 : 0) : nn;
#pragma unroll
        for (int j = 0; j < 4; ++j) { const float* tb = tile + j * 64 * 65; u32x4 o;
            o[0] = pack2(tb[(sk + 0) * 65 + sn], tb[(sk + 1) * 65 + sn]); o[1] = pack2(tb[(sk + 2) * 65 + sn], tb[(sk + 3) * 65 + sn]);
            o[2] = pack2(tb[(sk + 4) * 65 + sn], tb[(sk + 5) * 65 + sn]); o[3] = pack2(tb[(sk + 6) * 65 + sn], tb[(sk + 7) * 65 + sn]);
            *(u32x4*)(d.dst + (size_t)R * d.ldd + d.k0 + 64 * j + sk) = o; }
        __syncthreads();
        if (!more) break;
        d = dn; u = un;
#pragma unroll
        for (int j = 0; j < 4; ++j) { v[j][0] = w[j][0]; v[j][1] = w[j][1]; }
    }
}
constexpr int CONV_A = 88 * 9, CONV_B = 240 * 9;
constexpr int MOD_UNITS = 2 * 96;
DI void mod_unit(const Params& p, int u, char* smem) {
    float* s = (float*)smem;
    float* part = s + 5 * 1024;
    const int l = u / 96, cb = u % 96, t = tidx(), col = t & 63, kg = t >> 6;
    for (int i = t; i < 5 * 1024; i += NTHR) { const int v = i >> 10, k = i & 1023; const float c = v < 4 ? p.in[I_C][v * DM + k] : p.in[I_CCTX][k]; s[i] = silu_(c); }
    __syncthreads();
    const int j = cb * 64 + col;
    const float* w = p.in[I_WADA] + (size_t)l * DM * 6144 + (size_t)(kg * 128) * 6144 + j;
    float a0 = 0, a1 = 0, a2 = 0, a3 = 0, a4 = 0;
#pragma unroll 16
    for (int k = 0; k < 128; ++k) { const float wv = w[(size_t)k * 6144]; const int kk = kg * 128 + k;
        a0 += s[kk] * wv; a1 += s[1024 + kk] * wv; a2 += s[2048 + kk] * wv; a3 += s[3072 + kk] * wv; a4 += s[4096 + kk] * wv; }
    part[(kg * 5 + 0) * 64 + col] = a0; part[(kg * 5 + 1) * 64 + col] = a1; part[(kg * 5 + 2) * 64 + col] = a2; part[(kg * 5 + 3) * 64 + col] = a3; part[(kg * 5 + 4) * 64 + col] = a4;
    __syncthreads();
    if (t < 320) { const int v = t >> 6, c = t & 63; float acc = p.in[I_BADA][l * 6144 + cb * 64 + c];
#pragma unroll
        for (int g = 0; g < 8; ++g) acc += part[(g * 5 + v) * 64 + c];
        ((float*)(p.ws + OFF_MOD))[(size_t)(l * 5 + v) * 6144 + cb * 64 + c] = acc; }
    __syncthreads();
}
constexpr int RWT_UNITS = 2 * 16;
DI void rwt_unit(const Params& p, int u, char* smem) {
    float* tile = (float*)smem; const int t = tidx(), l = u >> 4, k0 = (u & 15) * 64;
#pragma unroll
    for (int i = 0; i < 8; ++i) { const int idx = t + NTHR * i, k = idx >> 6, e = idx & 63; tile[k * 65 + e] = p.in[I_RW][(size_t)l * DM * 64 + (size_t)(k0 + k) * 64 + e]; }
    __syncthreads();
#pragma unroll
    for (int i = 0; i < 8; ++i) { const int idx = t + NTHR * i, e = idx >> 6, k = idx & 63; const float v = tile[k * 65 + e];
        const bf16_t hi = f2bf(v), lo = f2bf(v - bf2f(hi)); bf16_t* W = (bf16_t*)(p.ws + OFF_RWT) + (size_t)l * 2 * 64 * DM;
        const int kk = k0 + k;
        const size_t o = (((size_t)((kk >> 7) * 4 + ((kk >> 5) & 3)) * 2) * 4 + (e >> 4)) * 512 + (size_t)(((kk >> 3) & 3) * 16 + (e & 15)) * 8 + (kk & 7);
        W[o] = hi; W[o + 4 * 512] = lo; }
    __syncthreads();
}
constexpr int ROPE_UNITS = 4096 * 32 / NTHR;
DI void rope_unit(const Params& p, int u) {
    const int idx = u * NTHR + tidx(), t = idx >> 5, i = idx & 31;
    const float pos = (float)(i < 16 ? (t >> 6) : (t & 63));
    const float inv = powf(10000.f, -(float)(2 * (i & 15)) / 32.f);
    const float ang = pos * inv;
    ((float2*)(p.ws + OFF_ROPE))[idx] = make_float2(cosf(ang), sinf(ang));
}

constexpr int GEMM_LDS = 131072;
struct MoeTab { int cnt[65]; int mstart[66]; int hoffP[65]; int hoffU[65]; };
constexpr int HP = 1028;
#define PROBE_STAGE -1
#define STG(k) do { if (PROBE_STAGE >= 0) { __syncthreads(); if (blockIdx.x == 0 && threadIdx.x == 0) { const unsigned long long t_ = wall_clock64(); tacc[k] += t_ - tlast; tlast = t_; } } } while (0)
template <int MODE>
DI void rowpost_row(const Params& p, int l, int r, int lane, const int* hoffU, float* hdst) {
    const int bidx = mod_idx(r);
    f32x4 xv[4];
    if (MODE == 0) {
        const float* xs = xin_row(p, r);
#pragma unroll
        for (int i = 0; i < 2; ++i) { xv[2 * i] = *(const f32x4*)(xs + 8 * lane + 512 * i); xv[2 * i + 1] = *(const f32x4*)(xs + 8 * lane + 512 * i + 4); }
    } else {
        f32x4 yv[4];
        const bf16_t* Y = (const bf16_t*)(p.ws + OFF_Y) + (size_t)r * DM;
        const bf16_t* xb = (const bf16_t*)(p.ws + OFF_XB) + (size_t)r * DM;
        uint2 q[8][2];
        if (MODE >= 2) {
            const int* ts = (const int*)(p.ws + OFF_TOKSLOT) + (size_t)r * 8;
            const int4 t0 = *(const int4*)ts, t1 = *(const int4*)(ts + 4);
            const int tv[8] = {t0.x, t0.y, t0.z, t0.w, t1.x, t1.y, t1.z, t1.w};
            const unsigned char* ye = (const unsigned char*)(p.ws + OFF_YE);
#pragma unroll
            for (int k = 0; k < 8; ++k) { const unsigned char* yr = ye + (size_t)(hoffU[tv[k] >> 15] + (tv[k] & 32767)) * DM + 8 * lane;
                q[k][0] = *(const uint2*)(yr); q[k][1] = *(const uint2*)(yr + 512); }
        }
#pragma unroll
        for (int i = 0; i < 2; ++i) { ld8bf(Y + 8 * lane + 512 * i, yv[2 * i], yv[2 * i + 1]);
            if (MODE == 1 && l == 0) { const float* xs = xin_row(p, r); xv[2 * i] = *(const f32x4*)(xs + 8 * lane + 512 * i); xv[2 * i + 1] = *(const f32x4*)(xs + 8 * lane + 512 * i + 4); }
            else ld8bf(xb + 8 * lane + 512 * i, xv[2 * i], xv[2 * i + 1]); }
        if (MODE >= 2) {
            f32x4 ys[4];
#pragma unroll
            for (int i = 0; i < 4; ++i) ys[i] = (f32x4){0.f, 0.f, 0.f, 0.f};
#pragma unroll
            for (int k = 0; k < 8; ++k)
#pragma unroll
                for (int i = 0; i < 2; ++i) { const uint2 v = q[k][i];
                    const f32x2 a = __builtin_amdgcn_cvt_pk_f32_fp8((int)v.x, false), b = __builtin_amdgcn_cvt_pk_f32_fp8((int)v.x, true), c = __builtin_amdgcn_cvt_pk_f32_fp8((int)v.y, false), d = __builtin_amdgcn_cvt_pk_f32_fp8((int)v.y, true);
                    ys[2 * i][0] += a[0]; ys[2 * i][1] += a[1]; ys[2 * i][2] += b[0]; ys[2 * i][3] += b[1];
                    ys[2 * i + 1][0] += c[0]; ys[2 * i + 1][1] += c[1]; ys[2 * i + 1][2] += d[0]; ys[2 * i + 1][3] += d[1]; }
#pragma unroll
            for (int i = 0; i < 4; ++i) yv[i] = yv[i] + ys[i] * (1.f / YE_SCALE);
        }
        float ss = 0.f;
#pragma unroll
        for (int i = 0; i < 4; ++i) ss += yv[i][0] * yv[i][0] + yv[i][1] * yv[i][1] + yv[i][2] * yv[i][2] + yv[i][3] * yv[i][3];
        ss = wave_sum(ss);
        const float rs = rsqrtf(ss * (1.f / DM) + EPS);
        const float* gate = modp(p, l, bidx, MODE == 1 ? 2 : 5);
        const float* gp = p.in[MODE == 1 ? I_GMIXPOST : I_GFFNPOST] + l * DM;
#pragma unroll
        for (int i = 0; i < 4; ++i) { const int c = 8 * lane + 512 * (i >> 1) + 4 * (i & 1);
            const f32x4 g = *(const f32x4*)(gate + c), qq = *(const f32x4*)(gp + c);
            xv[i] = xv[i] + g * (yv[i] * rs * qq);
            if (MODE == 3) *(f32x4*)(p.out + (size_t)(r - NCTX) * DM + c) = xv[i]; }
        if (MODE != 3) { bf16_t* xo = (bf16_t*)(p.ws + OFF_XB) + (size_t)r * DM; st8bf(xo + 8 * lane, xv[0], xv[1]); st8bf(xo + 8 * lane + 512, xv[2], xv[3]); }
    }
    if (MODE != 3) {
        const int lp = MODE == 2 ? l + 1 : l;
        float ss = 0.f;
#pragma unroll
        for (int i = 0; i < 4; ++i) ss += xv[i][0] * xv[i][0] + xv[i][1] * xv[i][1] + xv[i][2] * xv[i][2] + xv[i][3] * xv[i][3];
        ss = wave_sum(ss);
        const float rs = rsqrtf(ss * (1.f / DM) + EPS);
        const float* gpre = p.in[MODE == 1 ? I_GFFNPRE : I_GMIXPRE] + lp * DM;
        const float* sh = modp(p, lp, bidx, MODE == 1 ? 3 : 0);
        const float* sc = modp(p, lp, bidx, MODE == 1 ? 4 : 1);
        bf16_t* hb = (bf16_t*)(p.ws + (MODE == 1 ? OFF_RA : OFF_RB)) + (size_t)r * DM;
#pragma unroll
        for (int i = 0; i < 2; ++i) { const int c = 8 * lane + 512 * i;
            f32x4 h[2];
#pragma unroll
            for (int j = 0; j < 2; ++j) { const f32x4 g = *(const f32x4*)(gpre + c + 4 * j), s1 = *(const f32x4*)(sh + c + 4 * j), s2 = *(const f32x4*)(sc + c + 4 * j);
                h[j] = xv[2 * i + j] * rs * g * (s2 + 1.f) + s1;
                if (MODE == 1) *(f32x4*)(hdst + c + 4 * j) = h[j]; }
            u32x4 o; o[0] = pack2(h[0][0], h[0][1]); o[1] = pack2(h[0][2], h[0][3]); o[2] = pack2(h[1][0], h[1][1]); o[3] = pack2(h[1][2], h[1][3]);
            *(u32x4*)(hb + c) = o; }
    }
}
template <int MODE>
DI void rowpost_unit(const Params& p, int l, int hf, int r0, char* smem) {
    const int* hoffU = ((const MoeTab*)(smem + GEMM_LDS))->hoffU;
    const int tid = tidx(), lane = tid & 63, w = tid >> 6;
    if (MODE == 0) {
#pragma unroll
        for (int rr = 0; rr < 2; ++rr) rowpost_row<MODE>(p, l, r0 + 2 * w + rr, lane, hoffU, nullptr);
        return;
    }
    int4 t0[2], t1[2]; u32x4 yraw[2][2], xraw[2][2]; uint2 q[2][8][2];
#pragma unroll
    for (int rr = 0; rr < 2; ++rr) { const int r = r0 + 2 * w + rr;
        const int* ts = (const int*)(p.ws + OFF_TOKSLOT) + (size_t)r * 8; t0[rr] = *(const int4*)ts; t1[rr] = *(const int4*)(ts + 4);
        const bf16_t* Y = (const bf16_t*)(p.ws + OFF_Y) + (size_t)r * DM + 8 * lane; const bf16_t* xb = (const bf16_t*)(p.ws + OFF_XB) + (size_t)r * DM + 8 * lane;
        yraw[rr][0] = *(const u32x4*)Y; yraw[rr][1] = *(const u32x4*)(Y + 512); xraw[rr][0] = *(const u32x4*)xb; xraw[rr][1] = *(const u32x4*)(xb + 512); }
#pragma unroll
    for (int rr = 0; rr < 2; ++rr) {
        const int tv[8] = {t0[rr].x, t0[rr].y, t0[rr].z, t0[rr].w, t1[rr].x, t1[rr].y, t1[rr].z, t1[rr].w};
        const unsigned char* ye = (const unsigned char*)(p.ws + OFF_YE);
#pragma unroll
        for (int k = 0; k < 8; ++k) { const unsigned char* yr = ye + (size_t)(hoffU[tv[k] >> 15] + (tv[k] & 32767)) * DM + 8 * lane; q[rr][k][0] = *(const uint2*)(yr); q[rr][k][1] = *(const uint2*)(yr + 512); } }
    __builtin_amdgcn_sched_barrier(0);
#pragma unroll
    for (int rr = 0; rr < 2; ++rr) {
        const int r = r0 + 2 * w + rr, bidx = mod_idx(r);
        f32x4 yv[4], xv[4], ys[4];
#pragma unroll
        for (int i = 0; i < 2; ++i) { const u32x4 a = yraw[rr][i], b = xraw[rr][i];
            yv[2 * i] = (f32x4){__uint_as_float(a[0] << 16), __uint_as_float(a[0] & 0xffff0000u), __uint_as_float(a[1] << 16), __uint_as_float(a[1] & 0xffff0000u)};
            yv[2 * i + 1] = (f32x4){__uint_as_float(a[2] << 16), __uint_as_float(a[2] & 0xffff0000u), __uint_as_float(a[3] << 16), __uint_as_float(a[3] & 0xffff0000u)};
            xv[2 * i] = (f32x4){__uint_as_float(b[0] << 16), __uint_as_float(b[0] & 0xffff0000u), __uint_as_float(b[1] << 16), __uint_as_float(b[1] & 0xffff0000u)};
            xv[2 * i + 1] = (f32x4){__uint_as_float(b[2] << 16), __uint_as_float(b[2] & 0xffff0000u), __uint_as_float(b[3] << 16), __uint_as_float(b[3] & 0xffff0000u)}; }
#pragma unroll
        for (int i = 0; i < 4; ++i) ys[i] = (f32x4){0.f, 0.f, 0.f, 0.f};
#pragma unroll
        for (int k = 0; k < 8; ++k)
#pragma unroll
            for (int i = 0; i < 2; ++i) { const uint2 v = q[rr][k][i];
                const f32x2 a = __builtin_amdgcn_cvt_pk_f32_fp8((int)v.x, false), b = __builtin_amdgcn_cvt_pk_f32_fp8((int)v.x, true), c = __builtin_amdgcn_cvt_pk_f32_fp8((int)v.y, false), d = __builtin_amdgcn_cvt_pk_f32_fp8((int)v.y, true);
                ys[2 * i][0] += a[0]; ys[2 * i][1] += a[1]; ys[2 * i][2] += b[0]; ys[2 * i][3] += b[1];
                ys[2 * i + 1][0] += c[0]; ys[2 * i + 1][1] += c[1]; ys[2 * i + 1][2] += d[0]; ys[2 * i + 1][3] += d[1]; }
        float ss = 0.f;
#pragma unroll
        for (int i = 0; i < 4; ++i) { yv[i] = yv[i] + ys[i] * (1.f / YE_SCALE); ss += yv[i][0] * yv[i][0] + yv[i][1] * yv[i][1] + yv[i][2] * yv[i][2] + yv[i][3] * yv[i][3]; }
        ss = wave_sum(ss);
        const float rs = rsqrtf(ss * (1.f / DM) + EPS);
        const float* gate = modp(p, l, bidx, 5);
        const float* gp = p.in[I_GFFNPOST] + l * DM;
#pragma unroll
        for (int i = 0; i < 4; ++i) { const int c = 8 * lane + 512 * (i >> 1) + 4 * (i & 1);
            const f32x4 g = *(const f32x4*)(gate + c), qq = *(const f32x4*)(gp + c);
            xv[i] = xv[i] + g * (yv[i] * rs * qq);
            if (MODE == 3) *(f32x4*)(p.out + (size_t)(r - NCTX) * DM + c) = xv[i]; }
        if (MODE != 3) {
            bf16_t* xo = (bf16_t*)(p.ws + OFF_XB) + (size_t)r * DM; st8bf(xo + 8 * lane, xv[0], xv[1]); st8bf(xo + 8 * lane + 512, xv[2], xv[3]);
            float s2 = 0.f;
#pragma unroll
            for (int i = 0; i < 4; ++i) s2 += xv[i][0] * xv[i][0] + xv[i][1] * xv[i][1] + xv[i][2] * xv[i][2] + xv[i][3] * xv[i][3];
            s2 = wave_sum(s2);
            const float r2 = rsqrtf(s2 * (1.f / DM) + EPS);
            const float* gpre = p.in[I_GMIXPRE] + (l + 1) * DM; const float* sh = modp(p, l + 1, bidx, 0); const float* sc = modp(p, l + 1, bidx, 1);
            bf16_t* hb = (bf16_t*)(p.ws + OFF_RB) + (size_t)r * DM;
#pragma unroll
            for (int i = 0; i < 2; ++i) { const int c = 8 * lane + 512 * i; f32x4 h[2];
#pragma unroll
                for (int j = 0; j < 2; ++j) { const f32x4 g = *(const f32x4*)(gpre + c + 4 * j), s1 = *(const f32x4*)(sh + c + 4 * j), sv = *(const f32x4*)(sc + c + 4 * j); h[j] = xv[2 * i + j] * r2 * g * (sv + 1.f) + s1; }
                st8bf(hb + c, h[0], h[1]); }
        }
    }
}
DI void rp1_load(const Params& p, int l, int r, int lane, f32x4 (&yv)[4], f32x4 (&xv)[4]) {
    const bf16_t* Y = (const bf16_t*)(p.ws + OFF_Y) + (size_t)r * DM;
#pragma unroll
    for (int i = 0; i < 2; ++i) { ld8bf(Y + 8 * lane + 512 * i, yv[2 * i], yv[2 * i + 1]);
        if (l == 0) { const float* xs = xin_row(p, r); xv[2 * i] = *(const f32x4*)(xs + 8 * lane + 512 * i); xv[2 * i + 1] = *(const f32x4*)(xs + 8 * lane + 512 * i + 4); }
        else ld8bf((const bf16_t*)(p.ws + OFF_XB) + (size_t)r * DM + 8 * lane + 512 * i, xv[2 * i], xv[2 * i + 1]); }
}
DI void rp1_compute(const Params& p, int l, int r, int lane, const f32x4 (&yv)[4], f32x4 (&xv)[4], float* hdst) {
    const int bidx = mod_idx(r);
    float ss = 0.f;
#pragma unroll
    for (int i = 0; i < 4; ++i) ss += yv[i][0] * yv[i][0] + yv[i][1] * yv[i][1] + yv[i][2] * yv[i][2] + yv[i][3] * yv[i][3];
    ss = wave_sum(ss);
    const float rs = rsqrtf(ss * (1.f / DM) + EPS);
    const float* gate = modp(p, l, bidx, 2);
    const float* gp = p.in[I_GMIXPOST] + l * DM;
#pragma unroll
    for (int i = 0; i < 4; ++i) { const int c = 8 * lane + 512 * (i >> 1) + 4 * (i & 1);
        const f32x4 g = *(const f32x4*)(gate + c), qq = *(const f32x4*)(gp + c);
        xv[i] = xv[i] + g * (yv[i] * rs * qq); }
    { bf16_t* xo = (bf16_t*)(p.ws + OFF_XB) + (size_t)r * DM; st8bf(xo + 8 * lane, xv[0], xv[1]); st8bf(xo + 8 * lane + 512, xv[2], xv[3]); }
    float s2 = 0.f;
#pragma unroll
    for (int i = 0; i < 4; ++i) s2 += xv[i][0] * xv[i][0] + xv[i][1] * xv[i][1] + xv[i][2] * xv[i][2] + xv[i][3] * xv[i][3];
    s2 = wave_sum(s2);
    const float r2 = rsqrtf(s2 * (1.f / DM) + EPS);
    const float* gpre = p.in[I_GFFNPRE] + l * DM;
    const float* sh = modp(p, l, bidx, 3);
    const float* sc = modp(p, l, bidx, 4);
    bf16_t* hb = (bf16_t*)(p.ws + OFF_RA) + (size_t)r * DM;
#pragma unroll
    for (int i = 0; i < 2; ++i) { const int c = 8 * lane + 512 * i;
        f32x4 h[2];
#pragma unroll
        for (int j = 0; j < 2; ++j) { const f32x4 g = *(const f32x4*)(gpre + c + 4 * j), s1 = *(const f32x4*)(sh + c + 4 * j), sv = *(const f32x4*)(sc + c + 4 * j);
            h[j] = xv[2 * i + j] * r2 * g * (sv + 1.f) + s1; *(f32x4*)(hdst + c + 4 * j) = h[j]; }
        u32x4 o; o[0] = pack2(h[0][0], h[0][1]); o[1] = pack2(h[0][2], h[0][3]); o[2] = pack2(h[1][0], h[1][1]); o[3] = pack2(h[1][2], h[1][3]);
        *(u32x4*)(hb + c) = o; }
}
constexpr int RP_PART = 16 * HP * 4, RP_HIST = RP_PART + 8 * 16 * 64 * 4, RP_BASE = RP_HIST + 256, RP_SEL = RP_BASE + 256, RP_SELW = RP_SEL + 68 * 8 * 4;
DI void route_unit(const Params& p, int l, int rlo, int rhi, char* smem) {
    float* hrow = (float*)smem;
    float* part = (float*)(smem + RP_PART);
    int* hist = (int*)(smem + RP_HIST);
    int* base = (int*)(smem + RP_BASE);
    int* selv = (int*)(smem + RP_SEL);
    float* selw = (float*)(smem + RP_SELW);
    const int tid = tidx(), lane = tid & 63, w = tid >> 6;
    if (tid < 64) hist[tid] = 0;
    unsigned long long* tacc = (unsigned long long*)(smem + 140 * 1024 - 16 - 32 * 8 - 64); unsigned long long tlast = (PROBE_STAGE >= 0) ? wall_clock64() : 0ull;
    const float rbias = p.in[I_RB][l * 64 + lane];
    const float* rw = p.in[I_RW] + (size_t)l * DM * 64;
    f32x4 pyv[2][4], pxv[2][4];
#pragma unroll
    for (int rr = 0; rr < 2; ++rr) { const int r = rlo + 2 * w + rr; if (r < rhi) rp1_load(p, l, r, lane, pyv[rr], pxv[rr]); }
#pragma unroll 1
    for (int rb = rlo; rb < rhi; rb += 16) {
#pragma unroll
        for (int rr = 0; rr < 2; ++rr) { const int r = rb + 2 * w + rr; if (r < rhi) rp1_compute(p, l, r, lane, pyv[rr], pxv[rr], hrow + (2 * w + rr) * HP); }
#pragma unroll
        for (int rr = 0; rr < 2; ++rr) { const int r = rb + 16 + 2 * w + rr; if (r < rhi) rp1_load(p, l, r, lane, pyv[rr], pxv[rr]); }
        lds_barrier();
        STG(0);
        {
            const int i16 = lane & 15, kq = lane >> 4;
            const bf16_t* wt = (const bf16_t*)(p.ws + OFF_RWT) + (size_t)l * 2 * 64 * DM + (size_t)w * 4 * 2 * 4 * 512 + lane * 8;
            const float* hp = hrow + i16 * HP + 128 * w + 8 * kq;
            bf16x8 bh[4][4], bl[4][4];
#pragma unroll
            for (int ks = 0; ks < 4; ++ks)
#pragma unroll
                for (int n = 0; n < 4; ++n) { bh[ks][n] = *(const bf16x8*)(wt + ((ks * 2 + 0) * 4 + n) * 512); bl[ks][n] = *(const bf16x8*)(wt + ((ks * 2 + 1) * 4 + n) * 512); }
            f32x4 acc[4];
#pragma unroll
            for (int n = 0; n < 4; ++n) acc[n] = (f32x4){0.f, 0.f, 0.f, 0.f};
#pragma unroll
            for (int ks = 0; ks < 4; ++ks) {
                const f32x4 a0 = *(const f32x4*)(hp + 32 * ks), a1 = *(const f32x4*)(hp + 32 * ks + 4);
                union { unsigned u[4]; bf16x8 v; } ah, al;
                ah.u[0] = pack2(a0[0], a0[1]); ah.u[1] = pack2(a0[2], a0[3]); ah.u[2] = pack2(a1[0], a1[1]); ah.u[3] = pack2(a1[2], a1[3]);
                al.u[0] = pack2(a0[0] - __uint_as_float(ah.u[0] << 16), a0[1] - __uint_as_float(ah.u[0] & 0xffff0000u)); al.u[1] = pack2(a0[2] - __uint_as_float(ah.u[1] << 16), a0[3] - __uint_as_float(ah.u[1] & 0xffff0000u));
                al.u[2] = pack2(a1[0] - __uint_as_float(ah.u[2] << 16), a1[1] - __uint_as_float(ah.u[2] & 0xffff0000u)); al.u[3] = pack2(a1[2] - __uint_as_float(ah.u[3] << 16), a1[3] - __uint_as_float(ah.u[3] & 0xffff0000u));
#pragma unroll
                for (int n = 0; n < 4; ++n) {
                    acc[n] = __builtin_amdgcn_mfma_f32_16x16x32_bf16(ah.v, bh[ks][n], acc[n], 0, 0, 0);
                    acc[n] = __builtin_amdgcn_mfma_f32_16x16x32_bf16(ah.v, bl[ks][n], acc[n], 0, 0, 0);
                    acc[n] = __builtin_amdgcn_mfma_f32_16x16x32_bf16(al.v, bh[ks][n], acc[n], 0, 0, 0); }
            }
#pragma unroll
            for (int n = 0; n < 4; ++n)
#pragma unroll
                for (int j = 0; j < 4; ++j) part[(w * 16 + kq * 4 + j) * 64 + n * 16 + i16] = acc[n][j];
        }
        lds_barrier();
        STG(1);
#pragma unroll 1
        for (int rr = 0; rr < 2; ++rr) {
            const int r = rb + 2 * w + rr;
            if (r < rhi) {
                float lg = 0.f;
#pragma unroll
                for (int g = 0; g < 8; ++g) lg += part[(g * 16 + 2 * w + rr) * 64 + lane];
                const float s = sigmoid_(lg);
                const float v = s + rbias;
                const float m1 = grp8_max(v);
                const int ix = grp8_min((v == m1) ? lane : 64);
                const float m2 = grp8_max((lane == ix) ? -INFINITY : v);
                const float gs = m1 + m2;
                const int g = lane >> 3; int grank = 0;
#pragma unroll
                for (int gg = 0; gg < 8; ++gg) { const float o = __int_as_float(__builtin_amdgcn_readlane(__float_as_int(gs), gg * 8)); grank += (o > gs) || (o == gs && gg < g); }
                const bool gsel = grank < 4;
                const float vm = gsel ? v : -INFINITY;
                int rk = 0;
#pragma unroll
                for (int ee = 0; ee < 64; ++ee) { const float o = __int_as_float(__builtin_amdgcn_readlane(__float_as_int(vm), ee)); rk += (o > vm) || (o == vm && ee < lane); }
                const bool sel = gsel && rk < 8;
                const float scs = sel ? s : 0.f;
                const float tot = wave_sum(scs);
                if (sel) { const int lr = atomicAdd(&hist[lane], 1); selv[(r - rlo) * 8 + rk] = (lane << 8) | lr; selw[(r - rlo) * 8 + rk] = scs / tot * 2.5f; }
            }
        }
        STG(2);
    }
    __syncthreads();
    const int hh = rlo >= half_lo(l, 1) ? 1 : 0;
    if (tid < 64) { const int n = hist[tid]; base[tid] = n ? atomicAdd((int*)(p.ws + OFF_CNT) + (l * 2 + hh) * 64 + tid, n) : 0; }
    __syncthreads();
    for (int it = tid; it < (rhi - rlo) * 8; it += NTHR) { const int v = selv[it], e = v >> 8, pos = base[e] + (v & 255), r = rlo + (it >> 3);
        ((int*)(p.ws + OFF_SLOT_TOK))[(size_t)(hh * 64 + e) * HCAP + pos] = r;
        ((float*)(p.ws + OFF_SLOT_W))[(size_t)(hh * 64 + e) * HCAP + pos] = selw[it];
        ((int*)(p.ws + OFF_TOKSLOT))[(size_t)r * 8 + (it & 7)] = (e << 15) | pos; }
    __syncthreads();
}

#define G8_LAS __attribute__((address_space(3)))
constexpr int LDT = 72;
constexpr int G8_HTB = 128 * 64 * 2;
static_assert(GEMM_LDS == 8 * G8_HTB, "stage region");
DI int g8_lds_byte(int r, int c) { const int st = (r >> 4) * 2 + (c >> 5), rr = r & 15, cc = c & 31, ob = rr * 64 + cc * 2; return st * 1024 + (ob ^ (((ob >> 9) & 1) << 5)); }
DI void g8_stage_rc(int b, int& R, int& C) { const int st = b / 1024, sb = b % 1024, swz = sb ^ (((sb >> 9) & 1) << 5); R = (st >> 1) * 16 + swz / 64; C = (st & 1) * 32 + (swz % 64) / 2; }
DI int g8_perm32(int rho) { const int n = rho >> 4, i = rho & 15; return 8 * (i >> 2) + 4 * n + (i & 3); }
#define PROBE_G8 -1
#define G8_T0() do { if (PROBE_G8 == Sched::ID && blockIdx.x == 0 && threadIdx.x == 0) g8t = wall_clock64(); } while (0)
#define G8_T1(k) do { if (PROBE_G8 == Sched::ID && blockIdx.x == 0 && threadIdx.x == 0) { const unsigned long long t_ = wall_clock64(); ((unsigned long long*)(smem + 140 * 1024 - 16 - 32 * 8 - 64))[k] += t_ - g8t; g8t = t_; } } while (0)
template <bool PERM, class Sched>
DI void gemm8(char* smem, const char* Abase, int K, Sched& S) {
    G8_LAS unsigned char* lds = (G8_LAS unsigned char*)smem;
    const int tid = tidx(), wid = __builtin_amdgcn_readfirstlane(tid >> 6), lane = tid & 63, wr = wid >> 2, wc = wid & 3, fr = lane & 15, fq = lane >> 4;
    const int nt = K / 64;
    unsigned voffB[2];
#pragma unroll
    for (int i = 0; i < 2; ++i) { int R, C; g8_stage_rc(tid * 16 + i * 8192, R, C); const int Rb = PERM ? ((R & ~31) + g8_perm32(R & 31)) : R; voffB[i] = (unsigned)(Rb * K + C) * 2u; }
    const size_t kstep = 128, hstep = (size_t)128 * K * 2;
    const unsigned ldsw = (unsigned)wid * 1024u;
    const int aoff = g8_lds_byte(wr * 64 + fr, fq * 8), boff = g8_lds_byte(wc * 32 + fr, fq * 8);
#define G8_SA(b, h) (((b) * 2 + (h)) * G8_HTB)
#define G8_SB(b, h) ((4 + (b) * 2 + (h)) * G8_HTB)
#define G8_STAGEB(bufoff, gbase) do { _Pragma("unroll") for (int _i = 0; _i < 2; ++_i) \
        __builtin_amdgcn_global_load_lds((const unsigned*)((const char*)(gbase) + voffB[_i]), (G8_LAS unsigned*)(lds + (bufoff) + ldsw + _i * 8192), 16, 0, 0); } while (0)
#define G8_STAGEA(bufoff, ao, h, kb) do { _Pragma("unroll") for (int _i = 0; _i < 2; ++_i) \
        __builtin_amdgcn_global_load_lds((const unsigned*)(Abase + (size_t)(ao)[h][_i] + (kb)), (G8_LAS unsigned*)(lds + (bufoff) + ldsw + _i * 8192), 16, 0, 0); } while (0)
#define G8_LDA(dst, b, h) do { _Pragma("unroll") for (int m = 0; m < 4; ++m) _Pragma("unroll") for (int k = 0; k < 2; ++k) dst[m][k] = *(const G8_LAS bf16x8*)(lds + G8_SA(b, h) + aoff + m * 2048 + k * 1024); } while (0)
#define G8_LDB(dst, b, h) do { _Pragma("unroll") for (int n = 0; n < 2; ++n) _Pragma("unroll") for (int k = 0; k < 2; ++k) dst[n][k] = *(const G8_LAS bf16x8*)(lds + G8_SB(b, h) + boff + n * 2048 + k * 1024); } while (0)
#define G8_MMA(ai, bj, At, Bt) do { __builtin_amdgcn_s_setprio(1); _Pragma("unroll") for (int m = 0; m < 4; ++m) _Pragma("unroll") for (int n = 0; n < 2; ++n) _Pragma("unroll") for (int k = 0; k < 2; ++k) \
        acc[ai][bj][m][n] = __builtin_amdgcn_mfma_f32_16x16x32_bf16(Bt[n][k], At[m][k], acc[ai][bj][m][n], 0, 0, 0); __builtin_amdgcn_s_setprio(0); } while (0)
#define G8_WAIT_V(n) asm volatile("s_waitcnt vmcnt(" #n ")" ::: "memory")
#define G8_WAIT_L(n) asm volatile("s_waitcnt lgkmcnt(" #n ")" ::: "memory")
#define G8_BAR __builtin_amdgcn_s_barrier()
#define G8_SCHED __builtin_amdgcn_sched_barrier(0)
    typename Sched::U cur, nxt; int ui = 0; unsigned long long g8t = 0ull;
    if (!S.next(0, cur)) return;
    f32x4 acc[2][2][4][2];
#pragma unroll
    for (int a = 0; a < 2; ++a)
#pragma unroll
        for (int b = 0; b < 2; ++b)
#pragma unroll
            for (int m = 0; m < 4; ++m)
#pragma unroll
                for (int n = 0; n < 2; ++n) acc[a][b][m][n] = (f32x4){0.f, 0.f, 0.f, 0.f};
    bf16x8 At[4][2], B0[2][2], B1[2][2];
    unsigned cao[2][2];
    S.aoffs(cur, cao);
    const char* cB = S.bbase(cur);
    G8_STAGEB(G8_SB(0, 0), cB); G8_STAGEA(G8_SA(0, 0), cao, 0, 0); G8_STAGEB(G8_SB(0, 1), cB + hstep); G8_STAGEA(G8_SA(0, 1), cao, 1, 0);
    if (wr == 1) G8_BAR;
    G8_WAIT_V(4); G8_BAR;
    G8_STAGEB(G8_SB(1, 0), cB + kstep); G8_STAGEA(G8_SA(1, 0), cao, 0, kstep); G8_STAGEB(G8_SB(1, 1), cB + hstep + kstep);
    G8_WAIT_V(6); G8_BAR;
    for (;;) {
        nxt = cur;
        const bool has_next = S.next(ui + 1, nxt);
        const char* nB = cB;
        G8_T0();
#pragma unroll 1
        for (int t = 0; t < nt; t += 2) {
            const bool last = (t == nt - 2);
            if (last && has_next) nB = S.bbase(nxt);
            const size_t k1 = (size_t)(t + 1) * kstep;
            const size_t k2 = last ? 0 : (size_t)(t + 2) * kstep, k3 = k2 + kstep;
            const char* b2 = last ? nB : cB + k2; const char* b3 = b2 + kstep;
            G8_LDB(B0, 0, 0); G8_SCHED; G8_LDA(At, 0, 0); G8_STAGEA(G8_SA(1, 1), cao, 1, k1);
            if (last && has_next) S.aoffs(nxt, cao);
            G8_WAIT_L(8); G8_BAR; G8_WAIT_L(0); G8_MMA(0, 0, At, B0); G8_BAR; G8_SCHED;
            G8_LDB(B1, 0, 1); G8_STAGEB(G8_SB(0, 0), b2);
            G8_BAR; G8_WAIT_L(0); G8_MMA(0, 1, At, B1); G8_BAR;
            G8_LDA(At, 0, 1); G8_STAGEA(G8_SA(0, 0), cao, 0, k2);
            G8_BAR; G8_WAIT_L(0); G8_MMA(1, 0, At, B0); G8_BAR; G8_SCHED;
            G8_STAGEB(G8_SB(0, 1), b2 + hstep);
            G8_WAIT_V(6); G8_BAR; G8_MMA(1, 1, At, B1); G8_BAR;
            G8_LDB(B0, 1, 0); G8_SCHED; G8_LDA(At, 1, 0); G8_STAGEA(G8_SA(0, 1), cao, 1, k2);
            G8_WAIT_L(8); G8_BAR; G8_WAIT_L(0); G8_MMA(0, 0, At, B0); G8_BAR; G8_SCHED;
            G8_LDB(B1, 1, 1); G8_STAGEB(G8_SB(1, 0), b3);
            G8_BAR; G8_WAIT_L(0); G8_MMA(0, 1, At, B1); G8_BAR;
            G8_LDA(At, 1, 1); G8_STAGEA(G8_SA(1, 0), cao, 0, k3);
            G8_BAR; G8_WAIT_L(0); G8_MMA(1, 0, At, B0); G8_BAR; G8_SCHED;
            G8_STAGEB(G8_SB(1, 1), b3 + hstep);
            G8_WAIT_V(6); G8_BAR; G8_MMA(1, 1, At, B1); G8_BAR;
        }
        G8_T1(0);
        S.epi(acc, cur, wr, wc, fr, fq);
        G8_T1(1);
        if (!has_next) break;
#pragma unroll
        for (int a = 0; a < 2; ++a)
#pragma unroll
            for (int b = 0; b < 2; ++b)
#pragma unroll
                for (int m = 0; m < 4; ++m)
#pragma unroll
                    for (int n = 0; n < 2; ++n) acc[a][b][m][n] = (f32x4){0.f, 0.f, 0.f, 0.f};
        cur = nxt; cB = nB; ++ui;
    }
    G8_WAIT_V(0);
    if (wr == 0) G8_BAR;
    G8_BAR;
#undef G8_SA
#undef G8_SB
#undef G8_STAGEA
#undef G8_STAGEB
#undef G8_LDA
#undef G8_LDB
#undef G8_MMA
#undef G8_WAIT_V
#undef G8_WAIT_L
#undef G8_BAR
#undef G8_SCHED
}
DI bool g8_static(int i, int nM, int nN, int& pm, int& pn) {
    const int G = gridDim.x, nwg = nM * nN; const long L = (long)i * G + blockIdx.x; if (L >= nwg) return false;
    int wgid = (int)L; { const int q = nwg / 8, r = nwg % 8, xcd = wgid % 8, off = wgid / 8; wgid = (xcd < r ? xcd * (q + 1) : r * (q + 1) + (xcd - r) * q) + off; }
    const int nig = 8 * nN, gid = wgid / nig, fm = gid * 8, gsz = (nM - fm) < 8 ? (nM - fm) : 8;
    pm = fm + ((wgid % nig) % gsz); pn = (wgid % nig) / gsz; return true;
}
DI int g8_xcd_linear(int i, int n) {
    const long L = (long)i * gridDim.x + blockIdx.x; if (L >= n) return -1;
    const int q = n / 8, r = n % 8, xcd = (int)(L % 8), off = (int)(L / 8);
    return (xcd < r ? xcd * (q + 1) : r * (q + 1) + (xcd - r) * q) + off;
}
DI void g8_store_bf16(bf16_t* rowp, const f32x4& a, const f32x4& b) { u32x4 o; o[0] = pack2(a[0], a[1]); o[1] = pack2(a[2], a[3]); o[2] = pack2(b[0], b[1]); o[3] = pack2(b[2], b[3]); *(u32x4*)rowp = o; }

struct InprojS {
    static constexpr int ID = 0;
    struct U { int pm, pn; };
    const Params& p; int l;
    DI bool next(int i, U& u) const { return g8_static(i, NTOK / 256, INPP / 256, u.pm, u.pn); }
    DI void aoffs(const U& u, unsigned (&ao)[2][2]) const { int R[2], C[2]; { const int t_ = tidx(); g8_stage_rc(t_ * 16, R[0], C[0]); g8_stage_rc(t_ * 16 + 8192, R[1], C[1]); }
#pragma unroll
        for (int h = 0; h < 2; ++h)
#pragma unroll
            for (int i = 0; i < 2; ++i) ao[h][i] = (unsigned)((u.pm * 256 + h * 128 + R[i]) * DM + C[i]) * 2u; }
    DI const char* bbase(const U& u) const { return p.ws + OFF_WIN + l * SZ_WIN1 + (size_t)u.pn * 256 * DM * 2; }
    DI void epi(const f32x4 (&acc)[2][2][4][2], const U& u, int wr, int wc, int fr, int fq) const {
        bf16_t* C = (bf16_t*)(p.ws + OFF_RA) + (size_t)(u.pm * 256 + wr * 64 + fr) * INPP + u.pn * 256 + wc * 32 + 8 * fq;
#pragma unroll
        for (int ai = 0; ai < 2; ++ai)
#pragma unroll
            for (int m = 0; m < 4; ++m)
#pragma unroll
                for (int bj = 0; bj < 2; ++bj) g8_store_bf16(C + (size_t)(ai * 128 + m * 16) * INPP + bj * 128, acc[ai][bj][m][0], acc[ai][bj][m][1]);
    }
};
struct OutprojS {
    static constexpr int ID = 1;
    struct U { int pm, pn; };
    const Params& p; int l;
    DI bool next(int i, U& u) const { return g8_static(i, l == 0 ? 68 : 64, 4, u.pm, u.pn); }
    DI void aoffs(const U& u, unsigned (&ao)[2][2]) const { int R[2], C[2]; { const int t_ = tidx(); g8_stage_rc(t_ * 16, R[0], C[0]); g8_stage_rc(t_ * 16 + 8192, R[1], C[1]); }
        const int row0 = (l == 0 ? 0 : NCTX) + u.pm * 256;
#pragma unroll
        for (int h = 0; h < 2; ++h)
#pragma unroll
            for (int i = 0; i < 2; ++i) ao[h][i] = (unsigned)((row0 + h * 128 + R[i]) * DM + C[i]) * 2u; }
    DI const char* bbase(const U& u) const { return p.ws + OFF_WOUT + l * SZ_WOUT1 + (size_t)u.pn * 256 * DM * 2; }
    DI void epi(const f32x4 (&acc)[2][2][4][2], const U& u, int wr, int wc, int fr, int fq) const {
        const int row0 = (l == 0 ? 0 : NCTX) + u.pm * 256;
        bf16_t* C = (bf16_t*)(p.ws + OFF_Y) + (size_t)(row0 + wr * 64 + fr) * DM + u.pn * 256 + wc * 32 + 8 * fq;
#pragma unroll
        for (int ai = 0; ai < 2; ++ai)
#pragma unroll
            for (int m = 0; m < 4; ++m)
#pragma unroll
                for (int bj = 0; bj < 2; ++bj) g8_store_bf16(C + (size_t)(ai * 128 + m * 16) * DM + bj * 128, acc[ai][bj][m][0], acc[ai][bj][m][1]);
    }
};
DI void moe_table(const Params& p, int l, int hf, MoeTab* tb) {
    const int tid = tidx();
    __syncthreads();
    if (tid < 64) {
        const int c = ((const int*)(p.ws + OFF_CNT))[(l * 2 + hf) * 64 + tid];
        const int mt = (c + 255) >> 8;
        int ms = mt, hu = c;
#pragma unroll
        for (int o = 1; o < 64; o <<= 1) { const int a = __shfl_up(ms, o), b = __shfl_up(hu, o); if (tid >= o) { ms += a; hu += b; } }
        tb->cnt[tid] = c; tb->mstart[tid] = ms - mt; tb->hoffP[tid] = (ms - mt) * 256; tb->hoffU[tid] = hu - c;
        if (tid == 63) { const int cs = half_hi(l, hf) - half_lo(l, hf); tb->cnt[64] = cs; tb->mstart[64] = ms; tb->hoffP[64] = ms * 256; tb->hoffU[64] = hu; tb->mstart[65] = ms + ((cs + 255) >> 8); }
    }
    __syncthreads();
}
DI void moe_find(const MoeTab* tb, int g, int hint, int& e, int& mt) { int lo = hint; while (tb->mstart[lo + 1] <= g) ++lo; e = lo; mt = g - tb->mstart[lo]; }
struct Moe1S {
    static constexpr int ID = 2;
    struct U { int e, mt, pn, cnt, hrow0; };
    const Params& p; int l, hf; const MoeTab* tb;
    DI bool next(int i, U& u) const { const int g2 = g8_xcd_linear(i, tb->mstart[65] * 2); if (g2 < 0) return false;
        int e, mt; moe_find(tb, g2 >> 1, i ? u.e : 0, e, mt); e = __builtin_amdgcn_readfirstlane(e); mt = __builtin_amdgcn_readfirstlane(mt); u.e = e; u.mt = mt; u.pn = g2 & 1; u.cnt = __builtin_amdgcn_readfirstlane(tb->cnt[e]); u.hrow0 = __builtin_amdgcn_readfirstlane(tb->hoffP[e]) + mt * 256; return true; }
    DI void aoffs(const U& u, unsigned (&ao)[2][2]) const { int R[2], C[2]; { const int t_ = tidx(); g8_stage_rc(t_ * 16, R[0], C[0]); g8_stage_rc(t_ * 16 + 8192, R[1], C[1]); }
        const int* stok = (const int*)(p.ws + OFF_SLOT_TOK) + (size_t)(hf * 64 + (u.e & 63)) * HCAP; const int lo = half_lo(l, hf);
#pragma unroll
        for (int h = 0; h < 2; ++h)
#pragma unroll
            for (int i = 0; i < 2; ++i) { int pos = u.mt * 256 + h * 128 + R[i]; pos = pos < u.cnt ? pos : u.cnt - 1; const int tok = u.e < 64 ? stok[pos] : lo + pos;
                ao[h][i] = (unsigned)(tok * DM + C[i]) * 2u; } }
    DI const char* bbase(const U& u) const { return p.ws + OFF_WGU + ((size_t)u.e * 512 + u.pn * 256) * 1024 * 2; }
    DI void epi(const f32x4 (&acc)[2][2][4][2], const U& u, int wr, int wc, int fr, int fq) const {
        bf16_t* H = (bf16_t*)(p.ws + OFF_HID) + (size_t)(u.hrow0 + wr * 64 + fr) * 256 + u.pn * 128 + wc * 32 + 8 * fq;
        const float* sw = (const float*)(p.ws + OFF_SLOT_W) + (size_t)(hf * 64 + (u.e & 63)) * HCAP;
        float wvs[2][4];
#pragma unroll
        for (int ai = 0; ai < 2; ++ai)
#pragma unroll
            for (int m = 0; m < 4; ++m) { const int pos = u.mt * 256 + ai * 128 + wr * 64 + m * 16 + fr; wvs[ai][m] = u.e < 64 ? (pos < u.cnt ? sw[pos] : 0.f) : 1.f; }
#pragma unroll
        for (int ai = 0; ai < 2; ++ai)
#pragma unroll
            for (int m = 0; m < 4; ++m) { f32x4 o[2]; const float wv = wvs[ai][m];
#pragma unroll
                for (int n = 0; n < 2; ++n) { const f32x4 gt = acc[ai][0][m][n], up = acc[ai][1][m][n]; o[n] = (f32x4){silu_(gt[0]) * up[0] * wv, silu_(gt[1]) * up[1] * wv, silu_(gt[2]) * up[2] * wv, silu_(gt[3]) * up[3] * wv}; }
                g8_store_bf16(H + (size_t)(ai * 128 + m * 16) * 256, o[0], o[1]); }
    }
};
struct Moe2S {
    static constexpr int ID = 3;
    struct U { int e, mt, pn, cnt, hrow0, yrow0; };
    const Params& p; int l, hf; const MoeTab* tb;
    DI bool next(int i, U& u) const { const int g4 = g8_xcd_linear(i, tb->mstart[65] * 4); if (g4 < 0) return false;
        int e, mt; moe_find(tb, g4 >> 2, i ? u.e : 0, e, mt); e = __builtin_amdgcn_readfirstlane(e); mt = __builtin_amdgcn_readfirstlane(mt); u.e = e; u.mt = mt; u.pn = g4 & 3; u.cnt = __builtin_amdgcn_readfirstlane(tb->cnt[e]); u.hrow0 = __builtin_amdgcn_readfirstlane(tb->hoffP[e]) + mt * 256; u.yrow0 = __builtin_amdgcn_readfirstlane(tb->hoffU[e]) + mt * 256; return true; }
    DI void aoffs(const U& u, unsigned (&ao)[2][2]) const { int R[2], C[2]; { const int t_ = tidx(); g8_stage_rc(t_ * 16, R[0], C[0]); g8_stage_rc(t_ * 16 + 8192, R[1], C[1]); }
#pragma unroll
        for (int h = 0; h < 2; ++h)
#pragma unroll
            for (int i = 0; i < 2; ++i) ao[h][i] = (unsigned)((u.hrow0 + h * 128 + R[i]) * 256 + C[i]) * 2u; }
    DI const char* bbase(const U& u) const { return p.ws + OFF_WD + ((size_t)u.e * 1024 + u.pn * 256) * 256 * 2; }
    DI void epi(const f32x4 (&acc)[2][2][4][2], const U& u, int wr, int wc, int fr, int fq) const {
        const int colb = u.pn * 256 + wc * 32 + 8 * fq;
#pragma unroll
        for (int ai = 0; ai < 2; ++ai)
#pragma unroll
            for (int m = 0; m < 4; ++m) { const int row = ai * 128 + wr * 64 + m * 16 + fr, pos = u.mt * 256 + row;
                if (pos < u.cnt) {
                    if (u.e < 64) { const float wv = YE_SCALE; unsigned char* yr = (unsigned char*)(p.ws + OFF_YE) + (size_t)(u.yrow0 + row) * DM + colb;
#pragma unroll
                        for (int bj = 0; bj < 2; ++bj) { const f32x4 a = acc[ai][bj][m][0] * wv, b = acc[ai][bj][m][1] * wv; uint2 o; int t = 0;
                            t = __builtin_amdgcn_cvt_pk_fp8_f32(a[0], a[1], t, false); t = __builtin_amdgcn_cvt_pk_fp8_f32(a[2], a[3], t, true); o.x = (unsigned)t;
                            t = __builtin_amdgcn_cvt_pk_fp8_f32(b[0], b[1], t, false); t = __builtin_amdgcn_cvt_pk_fp8_f32(b[2], b[3], t, true); o.y = (unsigned)t;
                            *(uint2*)(yr + bj * 128) = o; }
                    } else { bf16_t* yr = (bf16_t*)(p.ws + OFF_Y) + (size_t)(half_lo(l, hf) + pos) * DM + colb;
#pragma unroll
                        for (int bj = 0; bj < 2; ++bj) g8_store_bf16(yr + bj * 128, acc[ai][bj][m][0], acc[ai][bj][m][1]); } } }
    }
};

constexpr int PREP_UNITS = NTOK / 32;
constexpr float LOG2E = 1.4426950408889634f, QSCALE = 0.125f * LOG2E;
DI void rope2(float& a, float& b, const float2 cs) { const float x1 = a, x2 = b; a = x1 * cs.x - x2 * cs.y; b = x1 * cs.y + x2 * cs.x; }
DI void prep_unit(const Params& p, int l, int u) {
    const int tid = tidx(), lane = tid & 63, w = tid >> 6, pi = lane & 31;
    const float gq0 = p.in[I_DQN][l * 64 + 2 * pi], gq1 = p.in[I_DQN][l * 64 + 2 * pi + 1], gk0 = p.in[I_DKN][l * 64 + 2 * pi], gk1 = p.in[I_DKN][l * 64 + 2 * pi + 1];
    unsigned vqa[4][2], vqd[4][2], vka[4], vkd[4]; float2 cs[4];
#pragma unroll
    for (int k = 0; k < 4; ++k) { const int r = u * 32 + 8 * k + w;
        const bf16_t* pr = (const bf16_t*)(p.ws + OFF_RA) + (size_t)r * INPP;
        vqa[k][0] = *(const unsigned*)(pr + CA_Q + 2 * lane); vqa[k][1] = *(const unsigned*)(pr + CA_Q + 2 * lane + 128);
        vqd[k][0] = *(const unsigned*)(pr + CD_Q + 2 * lane); vqd[k][1] = *(const unsigned*)(pr + CD_Q + 2 * lane + 128);
        vka[k] = *(const unsigned*)(pr + CA_K + 2 * lane); vkd[k] = *(const unsigned*)(pr + CD_K + 2 * lane);
        cs[k] = r >= NCTX ? ((const float2*)(p.ws + OFF_ROPE))[(size_t)((r - NCTX) & (SEQ - 1)) * 32 + pi] : make_float2(1.f, 0.f); }
    __builtin_amdgcn_sched_barrier(0);
#pragma unroll
    for (int k = 0; k < 4; ++k) { const int r = u * 32 + 8 * k + w;
        unsigned* QA = (unsigned*)(p.ws + OFF_QA) + (size_t)r * 128; unsigned* KA = (unsigned*)(p.ws + OFF_KA) + (size_t)r * 64;
        unsigned* QD = (unsigned*)(p.ws + OFF_QD) + (size_t)r * 128; unsigned* KD = (unsigned*)(p.ws + OFF_KD) + (size_t)r * 64;
#pragma unroll
        for (int i = 0; i < 2; ++i) {
            { float a = __uint_as_float(vqa[k][i] << 16), b = __uint_as_float(vqa[k][i] & 0xffff0000u); rope2(a, b, cs[k]); QA[lane + 64 * i] = pack2(a * QSCALE, b * QSCALE); }
            { float a = __uint_as_float(vqd[k][i] << 16), b = __uint_as_float(vqd[k][i] & 0xffff0000u);
              float ss = row16_sum(a * a + b * b); ss += __shfl_xor(ss, 16);
              const float rs = rsqrtf(ss * (1.f / 64.f) + EPS);
              a = a * rs * gq0; b = b * rs * gq1; rope2(a, b, cs[k]); QD[lane + 64 * i] = pack2(a * QSCALE, b * QSCALE); }
        }
        { float a = __uint_as_float(vka[k] << 16), b = __uint_as_float(vka[k] & 0xffff0000u); rope2(a, b, cs[k]); KA[lane] = pack2(a, b); }
        { float a = __uint_as_float(vkd[k] << 16), b = __uint_as_float(vkd[k] & 0xffff0000u);
          float ss = row16_sum(a * a + b * b); ss += __shfl_xor(ss, 16);
          const float rs = rsqrtf(ss * (1.f / 64.f) + EPS);
          a = a * rs * gk0; b = b * rs * gk1; rope2(a, b, cs[k]); KD[lane] = pack2(a, b); }
    }
}

constexpr int ATT_LDS = 2 * 2 * 64 * LDT * 2;
struct AttnArgs {
    const bf16_t* Q; const bf16_t* K; const bf16_t* V;
    int qrow0;
    int g;
    int k0row, k0tiles;
    int k1row, k1t0, k1t1;
    int qpos0;
    const float* sink;
    bf16_t* O;
};
DI void attn_unit(const AttnArgs& a, char* smem) {
    const int tid = tidx(), lane = tid & 63, w = tid >> 6, r32 = lane & 31, hi = lane >> 5;
    const int head = 2 * a.g + (w >> 2), qoff = (w & 3) * 32 + r32;
    bf16_t* Ks = (bf16_t*)smem;
    bf16_t* Vs = Ks + 2 * 64 * LDT;
    bf16x8 qr[4];
    { const bf16_t* qp = a.Q + (size_t)(a.qrow0 + qoff) * 256 + head * 64 + hi * 8;
#pragma unroll
      for (int d0 = 0; d0 < 4; ++d0) qr[d0] = *(const bf16x8*)(qp + d0 * 16); }
    float m_run, l_run;
    if (a.sink) { m_run = a.sink[head] * LOG2E; l_run = hi == 0 ? 1.f : 0.f; } else { m_run = -1e30f; l_run = 0.f; }
    f32x16 o0, o1;
#pragma unroll
    for (int i = 0; i < 16; ++i) { o0[i] = 0.f; o1[i] = 0.f; }
    const int nt = a.k0tiles + (a.k1t1 - a.k1t0);
    const int lrow = tid >> 3, lc = (tid & 7) * 8;
    auto tile_row0 = [&](int t) { return t < a.k0tiles ? a.k0row + t * 64 : a.k1row + (a.k1t0 + t - a.k0tiles) * 64; };
    u32x4 rk, rv;
    { const int kr = tile_row0(0) + lrow; rk = *(const u32x4*)(a.K + (size_t)kr * 128 + a.g * 64 + lc); rv = *(const u32x4*)(a.V + (size_t)kr * INPP + a.g * 64 + lc); }
    *(u32x4*)(Ks + lrow * LDT + lc) = rk; *(u32x4*)(Vs + lrow * LDT + lc) = rv;
    __syncthreads();
    const int q4 = (lane & 15) >> 2, p4 = lane & 3, blk = (lane >> 4) & 1;
#pragma unroll 1
    for (int t = 0; t < nt; ++t) {
        const bool more = t + 1 < nt;
        if (more) { const int kr = tile_row0(t + 1) + lrow; rk = *(const u32x4*)(a.K + (size_t)kr * 128 + a.g * 64 + lc); rv = *(const u32x4*)(a.V + (size_t)kr * INPP + a.g * 64 + lc); }
        const bf16_t* Kc = Ks + (t & 1) * 64 * LDT;
        const bf16_t* Vc = Vs + (t & 1) * 64 * LDT;
        f32x16 s0, s1;
#pragma unroll
        for (int i = 0; i < 16; ++i) { s0[i] = 0.f; s1[i] = 0.f; }
#pragma unroll
        for (int d0 = 0; d0 < 4; ++d0) {
            const bf16x8 k0 = *(const bf16x8*)(Kc + r32 * LDT + d0 * 16 + hi * 8);
            const bf16x8 k1 = *(const bf16x8*)(Kc + (32 + r32) * LDT + d0 * 16 + hi * 8);
            s0 = __builtin_amdgcn_mfma_f32_32x32x16_bf16(k0, qr[d0], s0, 0, 0, 0);
            s1 = __builtin_amdgcn_mfma_f32_32x32x16_bf16(k1, qr[d0], s1, 0, 0, 0);
        }
        if (a.qpos0 >= 0 && t >= a.k0tiles) {
            const int kb = (a.k1t0 + t - a.k0tiles) * 64, qp = a.qpos0 + qoff;
#pragma unroll
            for (int i = 0; i < 16; ++i) { const int kp = kb + crow(i, hi); int d = kp - qp; d = d < 0 ? -d : d; if (d > 128) s0[i] = -1e30f; d = kp + 32 - qp; d = d < 0 ? -d : d; if (d > 128) s1[i] = -1e30f; }
        }
        float mx = s0[0];
#pragma unroll
        for (int i = 1; i < 16; ++i) mx = fmaxf(mx, s0[i]);
#pragma unroll
        for (int i = 0; i < 16; ++i) mx = fmaxf(mx, s1[i]);
        mx = xhalf_max(mx);
        const float m_new = fmaxf(m_run, mx);
        if (__any(m_new > m_run)) {
            const float alpha = __builtin_amdgcn_exp2f(m_run - m_new);
            l_run *= alpha;
#pragma unroll
            for (int i = 0; i < 16; ++i) { o0[i] *= alpha; o1[i] *= alpha; }
            m_run = m_new;
        }
        float ps = 0.f;
#pragma unroll
        for (int i = 0; i < 16; ++i) { s0[i] = __builtin_amdgcn_exp2f(s0[i] - m_run); s1[i] = __builtin_amdgcn_exp2f(s1[i] - m_run); ps += s0[i] + s1[i]; }
        l_run += ps;
#pragma unroll
        for (int ks = 0; ks < 4; ++ks) {
            bf16x8 pf;
            {
                union { unsigned u[4]; bf16x8 v; } pk;
#pragma unroll
                for (int j = 0; j < 4; ++j) { const int rg = (ks & 1) * 8 + 2 * j; pk.u[j] = (ks < 2) ? pack2(s0[rg], s0[rg + 1]) : pack2(s1[rg], s1[rg + 1]); }
                pf = pk.v;
            }
#pragma unroll
            for (int ds = 0; ds < 2; ++ds) {
                const bf16_t* vp = Vc + (16 * ks + 4 * hi + q4) * LDT + 32 * ds + 16 * blk + 4 * p4;
                const s16x4 lo = __builtin_bit_cast(s16x4, __builtin_amdgcn_ds_read_tr16_b64_v4i16((__attribute__((address_space(3))) s16x4*)(vp)));
                const s16x4 hh = __builtin_bit_cast(s16x4, __builtin_amdgcn_ds_read_tr16_b64_v4i16((__attribute__((address_space(3))) s16x4*)(vp + 8 * LDT)));
                const bf16x8 vf = (bf16x8){lo[0], lo[1], lo[2], lo[3], hh[0], hh[1], hh[2], hh[3]};
                if (ds == 0) o0 = __builtin_amdgcn_mfma_f32_32x32x16_bf16(vf, pf, o0, 0, 0, 0);
                else o1 = __builtin_amdgcn_mfma_f32_32x32x16_bf16(vf, pf, o1, 0, 0, 0);
            }
        }
        if (more) { bf16_t* Kn = Ks + ((t + 1) & 1) * 64 * LDT; bf16_t* Vn = Vs + ((t + 1) & 1) * 64 * LDT; *(u32x4*)(Kn + lrow * LDT + lc) = rk; *(u32x4*)(Vn + lrow * LDT + lc) = rv; }
        __syncthreads();
    }
    l_run = xhalf_sum(l_run);
    const float inv = 1.f / l_run;
    bf16_t* op = a.O + (size_t)(a.qrow0 + qoff) * DM + head * 64;
#pragma unroll
    for (int g4 = 0; g4 < 4; ++g4) {
        uint2 q; q.x = pack2(o0[4 * g4] * inv, o0[4 * g4 + 1] * inv); q.y = pack2(o0[4 * g4 + 2] * inv, o0[4 * g4 + 3] * inv);
        *(uint2*)(op + 8 * g4 + 4 * hi) = q;
        q.x = pack2(o1[4 * g4] * inv, o1[4 * g4 + 1] * inv); q.y = pack2(o1[4 * g4 + 2] * inv, o1[4 * g4 + 3] * inv);
        *(uint2*)(op + 32 + 8 * g4 + 4 * hi) = q;
    }
}
DI int attn_units(int l) { return l == 0 ? 544 : 512; }
DI void attn_dispatch(const Params& p, int l, int u, char* smem) {
    AttnArgs a;
    const bf16_t* proj = (const bf16_t*)(p.ws + OFF_RA);
    bf16_t* mix = (bf16_t*)(p.ws + OFF_RB);
    int type, b, g, tb;
    if (u < 512) { type = u >> 8; const int v = u & 255; b = v >> 6; g = (v >> 5) & 1; tb = v & 31; }
    else { const int v = u - 512; type = 2 + (v >> 4); b = (v >> 2) & 3; g = (v >> 1) & 1; tb = v & 1; }
    const bool isA = (type & 1);
    a.Q = (const bf16_t*)(p.ws + (isA ? OFF_QA : OFF_QD)); a.K = (const bf16_t*)(p.ws + (isA ? OFF_KA : OFF_KD)); a.V = proj + (isA ? CA_V : CD_V);
    a.g = g; a.sink = isA ? p.in[I_ASINK] + l * 4 : nullptr; a.O = mix + (isA ? 0 : 768);
    a.k0row = b * CTXL; a.k0tiles = 4; a.k1row = NCTX + b * SEQ; a.qpos0 = -1;
    if (type < 2) {
        a.qrow0 = NCTX + b * SEQ + tb * 128;
        if (isA) { a.qpos0 = tb * 128; int t0 = 2 * tb - 2, t1 = 2 * tb + 4; a.k1t0 = t0 < 0 ? 0 : t0; a.k1t1 = t1 > 64 ? 64 : t1; }
        else { a.k1t0 = 0; a.k1t1 = 64; }
    } else { a.qrow0 = b * CTXL + tb * 128; a.k1t0 = 0; a.k1t1 = 0; }
    attn_unit(a, smem);
}

DI int blk_row0(int b, int cb) { return cb < 2 ? b * CTXL + cb * 128 : NCTX + b * SEQ + (cb - 2) * 128; }
DI int bwd_seq(int cb) { return cb < 2 ? 1 - cb : 35 - cb; }
DI s16x4 tr16(const bf16_t* p) { return __builtin_bit_cast(s16x4, __builtin_amdgcn_ds_read_tr16_b64_v4i16((__attribute__((address_space(3))) s16x4*)(p))); }
DI bf16x8 cat8(const s16x4 lo, const s16x4 hh) { return (bf16x8){lo[0], lo[1], lo[2], lo[3], hh[0], hh[1], hh[2], hh[3]}; }
DI bf16x8 packf8(float a0, float a1, float a2, float a3, float a4, float a5, float a6, float a7) { union { unsigned u[4]; bf16x8 v; } k; k.u[0] = pack2(a0, a1); k.u[1] = pack2(a2, a3); k.u[2] = pack2(a4, a5); k.u[3] = pack2(a6, a7); return k.v; }
constexpr int SC_RP = 200;
constexpr int SC_RAW = 0, SC_XS = 52480, SC_BS = SC_XS + 128 * LDT * 2, SC_CS = SC_BS + 128 * LDT * 2, SC_CW = SC_CS + 128 * LDT * 2, SC_VEC = SC_CW + 5 * 192 * 4, SSD_LDS = SC_VEC + 6 * 128 * 4;
DI int ssd_chunk_units() { return NB * NCHK * 4; }
DI void ssd_chunk_unit(const Params& p, int l, int u, char* smem) {
    const int tid = tidx(), lane = tid & 63, w = __builtin_amdgcn_readfirstlane(tid >> 6), r32 = lane & 31, hi = lane >> 5;
    const int h = u & 3, cb = (u >> 2) % NCHK, b = (u >> 2) / NCHK, grp = h >> 1;
    const int row0 = blk_row0(b, cb);
    const int part0 = cb < 2 ? b * CTXL : NCTX + b * SEQ, partN = cb < 2 ? CTXL : SEQ;
    bf16_t* raw = (bf16_t*)(smem + SC_RAW);
    bf16_t* Xs = (bf16_t*)(smem + SC_XS);
    bf16_t* Bs = (bf16_t*)(smem + SC_BS);
    bf16_t* Cs = (bf16_t*)(smem + SC_CS);
    float* cwl = (float*)(smem + SC_CW);
    float* dtf = (float*)(smem + SC_VEC); float* dtb = dtf + 128; float* Af = dtb + 128; float* Ab = Af + 128; float* wef = Ab + 128; float* web = wef + 128;
    const bf16_t* proj = (const bf16_t*)(p.ws + OFF_RA);
    const float aneg_f = -__expf(p.in[I_SSDALOG][l * 8 + h]), aneg_b = -__expf(p.in[I_SSDALOG][l * 8 + 4 + h]);
    {
        u32x4 v[7];
#pragma unroll
        for (int k = 0; k < 7; ++k) { const int item = tid + NTHR * k; v[k] = (u32x4){0u, 0u, 0u, 0u};
            if (item < 131 * 24) { const int r = item / 24, c = item % 24, gr = row0 - 2 + r;
                const int col = c < 8 ? CB_X + h * 64 + 8 * c : (c < 16 ? CB_B + grp * 64 + 8 * (c - 8) : CB_C + grp * 64 + 8 * (c - 16));
                if (gr >= part0 && gr < part0 + partN) v[k] = *(const u32x4*)(proj + (size_t)gr * INPP + col); } }
#pragma unroll
        for (int k = 0; k < 7; ++k) { const int item = tid + NTHR * k; if (item < 131 * 24) { const int r = item / 24, c = item % 24; *(u32x4*)(raw + r * SC_RP + 8 * c) = v[k]; } }
        for (int i = tid; i < 5 * 192; i += NTHR) { const int j = i / 192, cc = i % 192; const int ch = cc < 64 ? h * 64 + cc : (cc < 128 ? 256 + grp * 64 + cc - 64 : 384 + grp * 64 + cc - 128);
            cwl[i] = j < 4 ? p.in[I_SSDCW][l * 2048 + j * 512 + ch] : p.in[I_SSDCB][l * 512 + ch]; }
        if (tid < 256) { const int i = tid & 127, d = tid >> 7;
            const float rawdt = bf2f(proj[(size_t)(row0 + i) * INPP + (d ? CB_DTB : CB_DTF) + h]);
            (d ? dtb : dtf)[i] = softplus_(rawdt + p.in[I_SSDDTB][l * 8 + d * 4 + h]); }
    }
    __syncthreads();
#pragma unroll 2
    for (int k = 0; k < 6; ++k) { const int item = tid + NTHR * k, i = item / 24, c = item % 24;
        float acc[8];
        { const f32x4 b0 = *(const f32x4*)(cwl + 4 * 192 + 8 * c), b1 = *(const f32x4*)(cwl + 4 * 192 + 8 * c + 4);
          acc[0] = b0[0]; acc[1] = b0[1]; acc[2] = b0[2]; acc[3] = b0[3]; acc[4] = b1[0]; acc[5] = b1[1]; acc[6] = b1[2]; acc[7] = b1[3]; }
#pragma unroll
        for (int j = 0; j < 4; ++j) { const u32x4 q = *(const u32x4*)(raw + (i + j) * SC_RP + 8 * c);
            const f32x4 w0 = *(const f32x4*)(cwl + j * 192 + 8 * c), w1 = *(const f32x4*)(cwl + j * 192 + 8 * c + 4);
            acc[0] += w0[0] * __uint_as_float(q[0] << 16); acc[1] += w0[1] * __uint_as_float(q[0] & 0xffff0000u); acc[2] += w0[2] * __uint_as_float(q[1] << 16); acc[3] += w0[3] * __uint_as_float(q[1] & 0xffff0000u);
            acc[4] += w1[0] * __uint_as_float(q[2] << 16); acc[5] += w1[1] * __uint_as_float(q[2] & 0xffff0000u); acc[6] += w1[2] * __uint_as_float(q[3] << 16); acc[7] += w1[3] * __uint_as_float(q[3] & 0xffff0000u); }
        u32x4 o; o[0] = pack2(silu_(acc[0]), silu_(acc[1])); o[1] = pack2(silu_(acc[2]), silu_(acc[3])); o[2] = pack2(silu_(acc[4]), silu_(acc[5])); o[3] = pack2(silu_(acc[6]), silu_(acc[7]));
        bf16_t* dst = c < 8 ? Xs : (c < 16 ? Bs : Cs);
        *(u32x4*)(dst + i * LDT + 8 * (c & 7)) = o; }
    if (tid < 128) {
        const int ln = tid & 63, bw = tid >> 6;
        const int i0 = bw ? 127 - 2 * ln : 2 * ln, i1 = bw ? 126 - 2 * ln : 2 * ln + 1;
        const float* dt = bw ? dtb : dtf; const float an = bw ? aneg_b : aneg_f;
        const float v0 = dt[i0] * an, v1 = dt[i1] * an;
        float sc = v0 + v1;
#pragma unroll
        for (int o = 1; o < 64; o <<= 1) { const float a = __shfl_up(sc, o); if (ln >= o) sc += a; }
        float* A = bw ? Ab : Af;
        A[i1] = sc; A[i0] = sc - v1;
    }
    __syncthreads();
    if (tid < 128) { wef[tid] = __expf(Af[127] - Af[tid]) * dtf[tid]; web[tid] = __expf(Ab[0] - Ab[tid]) * dtb[tid];
        float* EA = (float*)(p.ws + OFF_EA) + (size_t)(row0 + tid) * 8; EA[h] = __expf(Af[tid]); EA[4 + h] = __expf(Ab[tid]); }
    __syncthreads();
    bf16_t* Bwf = raw; bf16_t* Bwb = raw + 128 * LDT;
    if ((h & 1) == 0) { bf16_t* CC = (bf16_t*)(p.ws + OFF_CC);
        for (int it = tid; it < 1024; it += NTHR) { const int i = it >> 3, c = it & 7; *(u32x4*)(CC + (size_t)(row0 + i) * 128 + grp * 64 + 8 * c) = *(const u32x4*)(Cs + i * LDT + 8 * c); } }
#pragma unroll
    for (int k = 0; k < 4; ++k) { const int it = tid + NTHR * k, d = it >> 10, j = (it >> 3) & 127, c = it & 7;
        const u32x4 q = *(const u32x4*)(Bs + j * LDT + 8 * c); const float sc = d ? web[j] : wef[j];
        u32x4 o;
#pragma unroll
        for (int e = 0; e < 4; ++e) o[e] = pack2(__uint_as_float(q[e] << 16) * sc, __uint_as_float(q[e] & 0xffff0000u) * sc);
        *(u32x4*)((d ? Bwb : Bwf) + j * LDT + 8 * c) = o; }
    __syncthreads();
    const int q4 = (lane & 15) >> 2, p4 = lane & 3, blk = (lane >> 4) & 1;
    {
        const int ib = w & 3, ph = w >> 2, i = 32 * ib + r32;
        bf16x8 cq[4];
#pragma unroll
        for (int s4 = 0; s4 < 4; ++s4) cq[s4] = *(const bf16x8*)(Cs + i * LDT + 16 * s4 + 8 * hi);
        const float Afi = Af[i], Abi = Ab[i];
        f32x16 y;
#pragma unroll
        for (int r = 0; r < 16; ++r) y[r] = 0.f;
#pragma unroll
        for (int jt = 0; jt < 4; ++jt) {
            f32x16 g;
#pragma unroll
            for (int r = 0; r < 16; ++r) g[r] = 0.f;
#pragma unroll
            for (int s4 = 0; s4 < 4; ++s4) { const bf16x8 bq = *(const bf16x8*)(Bs + (32 * jt + r32) * LDT + 16 * s4 + 8 * hi); g = __builtin_amdgcn_mfma_f32_32x32x16_bf16(bq, cq[s4], g, 0, 0, 0); }
#pragma unroll
            for (int g4 = 0; g4 < 4; ++g4) { const int j0 = 32 * jt + 8 * g4 + 4 * hi;
                f32x4 wv = (f32x4){0.f, 0.f, 0.f, 0.f};
                if (jt <= ib) { const f32x4 aj = *(const f32x4*)(Af + j0), dj = *(const f32x4*)(dtf + j0);
#pragma unroll
                    for (int e = 0; e < 4; ++e) { const float t = __expf(Afi - aj[e]) * dj[e]; wv[e] += (jt < ib || j0 + e <= i) ? t : 0.f; } }
                if (jt >= ib) { const f32x4 aj = *(const f32x4*)(Ab + j0), dj = *(const f32x4*)(dtb + j0);
#pragma unroll
                    for (int e = 0; e < 4; ++e) { const float t = __expf(Abi - aj[e]) * dj[e]; wv[e] += (jt > ib || j0 + e >= i) ? t : 0.f; } }
#pragma unroll
                for (int e = 0; e < 4; ++e) g[4 * g4 + e] *= wv[e]; }
#pragma unroll
            for (int s2 = 0; s2 < 2; ++s2) {
                const bf16x8 pf = packf8(g[8 * s2], g[8 * s2 + 1], g[8 * s2 + 2], g[8 * s2 + 3], g[8 * s2 + 4], g[8 * s2 + 5], g[8 * s2 + 6], g[8 * s2 + 7]);
                const bf16_t* xp = Xs + (32 * jt + 16 * s2 + 4 * hi + q4) * LDT + 32 * ph + 16 * blk + 4 * p4;
                const bf16x8 xf = cat8(tr16(xp), tr16(xp + 8 * LDT));
                y = __builtin_amdgcn_mfma_f32_32x32x16_bf16(xf, pf, y, 0, 0, 0); }
        }
        const float dsk = p.in[I_SSDD][l * 4 + h];
        float* YP = (float*)(p.ws + OFF_YPART) + (size_t)(row0 + i) * 256 + h * 64 + 32 * ph;
#pragma unroll
        for (int g4 = 0; g4 < 4; ++g4) { const uint2 xq = *(const uint2*)(Xs + i * LDT + 32 * ph + 8 * g4 + 4 * hi);
            *(f32x4*)(YP + 8 * g4 + 4 * hi) = (f32x4){y[4 * g4] + dsk * __uint_as_float(xq.x << 16), y[4 * g4 + 1] + dsk * __uint_as_float(xq.x & 0xffff0000u),
                                                    y[4 * g4 + 2] + dsk * __uint_as_float(xq.y << 16), y[4 * g4 + 3] + dsk * __uint_as_float(xq.y & 0xffff0000u)}; }
    }
    {
        const int d = w >> 2, pt = (w >> 1) & 1, nt2 = w & 1;
        const bf16_t* Bw = d ? Bwb : Bwf;
        f32x16 st;
#pragma unroll
        for (int r = 0; r < 16; ++r) st[r] = 0.f;
#pragma unroll
        for (int ks = 0; ks < 8; ++ks) {
            const bf16_t* xp = Xs + (16 * ks + 8 * hi + q4) * LDT + 32 * pt + 16 * blk + 4 * p4;
            const bf16_t* bp = Bw + (16 * ks + 8 * hi + q4) * LDT + 32 * nt2 + 16 * blk + 4 * p4;
            st = __builtin_amdgcn_mfma_f32_32x32x16_bf16(cat8(tr16(xp), tr16(xp + 4 * LDT)), cat8(tr16(bp), tr16(bp + 4 * LDT)), st, 0, 0, 0); }
        const int s = d ? bwd_seq(cb) : cb;
        float* ST = (float*)(p.ws + OFF_SSDST) + ((size_t)((b * 4 + h) * 2 + d) * NCHK + s) * 4096 + 32 * nt2 + r32;
#pragma unroll
        for (int r = 0; r < 16; ++r) ST[(32 * pt + crow(r, hi)) * 64] = st[r];
        if ((tid & 255) == 0) ((float*)(p.ws + OFF_SSDDEC))[((b * 4 + h) * 2 + d) * NCHK + s] = d ? __expf(Ab[0]) : __expf(Af[127]);
    }
    __syncthreads();
}
constexpr int SCAN_UNITS = 32 * 8 + 4;
DI void scan_unit(const Params& p, int u) {
    const int tid = tidx();
    if (u < 256) {
        const int seq = u >> 3, e = (u & 7) * 512 + tid;
        const float* ST = (const float*)(p.ws + OFF_SSDST) + (size_t)seq * NCHK * 4096 + e;
        const float* DEC = (const float*)(p.ws + OFF_SSDDEC) + seq * NCHK;
        bf16_t* SS = (bf16_t*)(p.ws + OFF_START) + (size_t)seq * NCHK * 4096 + e;
        float v[NCHK];
#pragma unroll
        for (int s = 0; s < NCHK; ++s) v[s] = ST[(size_t)s * 4096];
        float st = 0.f;
#pragma unroll
        for (int s = 0; s < NCHK; ++s) { SS[(size_t)s * 4096] = f2bf(st); st = st * DEC[s] + v[s]; }
    } else {
        const int q = (u - 256) * 512 + tid, sq = q >> 8, ch = q & 255;
        const float* LH = (const float*)(p.ws + OFF_LRUC) + (size_t)sq * NCHK * 256 + ch; const float* LA = LH + (size_t)NB * 2 * NCHK * 256;
        float* CR = (float*)(p.ws + OFF_CARRY) + (size_t)sq * NCHK * 256 + ch;
        float hv[NCHK], av[NCHK];
#pragma unroll
        for (int s = 0; s < NCHK; ++s) { hv[s] = LH[s * 256]; av[s] = LA[s * 256]; }
        float c = 0.f;
#pragma unroll
        for (int s = 0; s < NCHK; ++s) { CR[s * 256] = c; c = c * av[s] + hv[s]; }
    }
}
constexpr int SF_ST = 0, SF_CC = 2 * 64 * LDT * 2, SF_YB = SF_CC + 128 * LDT * 2, SF_SQ = SF_YB + 128 * 256 * 2, SSDF_LDS = SF_SQ + 8 * 128 * 4;
DI int ssd_fin_units(int l) { return NB * (l == 0 ? NCHK : NCHK - 2); }
DI void ssd_fin_unit(const Params& p, int l, int u, char* smem) {
    const int tid = tidx(), lane = tid & 63, w = __builtin_amdgcn_readfirstlane(tid >> 6), r32 = lane & 31, hi = lane >> 5;
    const int nper = l == 0 ? NCHK : NCHK - 2;
    const int b = u / nper, cb = u % nper + (l == 0 ? 0 : 2);
    const int row0 = blk_row0(b, cb);
    bf16_t* St = (bf16_t*)(smem + SF_ST);
    bf16_t* Cc = (bf16_t*)(smem + SF_CC);
    bf16_t* ybuf = (bf16_t*)(smem + SF_YB);
    float* ssqp = (float*)(smem + SF_SQ);
    const bf16_t* proj = (const bf16_t*)(p.ws + OFF_RA);
    const int it = w & 3, pt = w >> 2, i = 32 * it + r32, r = row0 + i;
    bf16x8 cq[4];
#pragma unroll 1
    for (int h = 0; h < 4; ++h) {
        {
            const int d = tid >> 8, e8 = (tid & 255) * 16, s = d ? bwd_seq(cb) : cb;
            const bf16_t* SS = (const bf16_t*)(p.ws + OFF_START) + ((size_t)((b * 4 + h) * 2 + d) * NCHK + s) * 4096 + e8;
            const u32x4 v0 = *(const u32x4*)SS, v1 = *(const u32x4*)(SS + 8);
            bf16_t* dst = St + d * 64 * LDT + (e8 >> 6) * LDT + (e8 & 63);
            *(u32x4*)dst = v0; *(u32x4*)(dst + 8) = v1;
            if ((h & 1) == 0) { const bf16_t* CC = (const bf16_t*)(p.ws + OFF_CC);
#pragma unroll
                for (int k = 0; k < 2; ++k) { const int item = tid + NTHR * k, ri = item >> 3, c = item & 7; *(u32x4*)(Cc + ri * LDT + 8 * c) = *(const u32x4*)(CC + (size_t)(row0 + ri) * 128 + (h >> 1) * 64 + 8 * c); } }
        }
        __syncthreads();
        if ((h & 1) == 0) {
#pragma unroll
            for (int s4 = 0; s4 < 4; ++s4) cq[s4] = *(const bf16x8*)(Cc + i * LDT + 16 * s4 + 8 * hi);
        }
        const float* EA = (const float*)(p.ws + OFF_EA) + (size_t)r * 8;
        const float ef = EA[h], eb = EA[4 + h];
        const float* YP = (const float*)(p.ws + OFF_YPART) + (size_t)r * 256 + h * 64 + 32 * pt;
        const bf16_t* zp = proj + (size_t)r * INPP + CB_Z + h * 64 + 32 * pt;
        f32x4 ypv[4]; uint2 zqv[4];
#pragma unroll
        for (int g4 = 0; g4 < 4; ++g4) { ypv[g4] = *(const f32x4*)(YP + 8 * g4 + 4 * hi); zqv[g4] = *(const uint2*)(zp + 8 * g4 + 4 * hi); }
        f32x16 af, ab;
#pragma unroll
        for (int k = 0; k < 16; ++k) { af[k] = 0.f; ab[k] = 0.f; }
#pragma unroll
        for (int s4 = 0; s4 < 4; ++s4) {
            const bf16x8 sf = *(const bf16x8*)(St + (32 * pt + r32) * LDT + 16 * s4 + 8 * hi);
            const bf16x8 sb = *(const bf16x8*)(St + (64 + 32 * pt + r32) * LDT + 16 * s4 + 8 * hi);
            af = __builtin_amdgcn_mfma_f32_32x32x16_bf16(sf, cq[s4], af, 0, 0, 0);
            ab = __builtin_amdgcn_mfma_f32_32x32x16_bf16(sb, cq[s4], ab, 0, 0, 0);
        }
        float sq = 0.f;
#pragma unroll
        for (int g4 = 0; g4 < 4; ++g4) {
            const f32x4 yp = ypv[g4];
            const uint2 zq = zqv[g4];
            const float z[4] = {__uint_as_float(zq.x << 16), __uint_as_float(zq.x & 0xffff0000u), __uint_as_float(zq.y << 16), __uint_as_float(zq.y & 0xffff0000u)};
            float yg[4];
#pragma unroll
            for (int e = 0; e < 4; ++e) { const float y = yp[e] + ef * af[4 * g4 + e] + eb * ab[4 * g4 + e]; yg[e] = y * silu_(z[e]); sq += yg[e] * yg[e]; }
            uint2 o; o.x = pack2(yg[0], yg[1]); o.y = pack2(yg[2], yg[3]);
            *(uint2*)(ybuf + i * 256 + h * 64 + 32 * pt + 8 * g4 + 4 * hi) = o;
        }
        sq = xhalf_sum(sq);
        if (hi == 0) ssqp[(h * 2 + pt) * 128 + i] = sq;
        __syncthreads();
    }
    {
        const float* gn = p.in[I_SSDNORM] + l * 256;
        bf16_t* mix = (bf16_t*)(p.ws + OFF_RB);
#pragma unroll 2
        for (int k = 0; k < 8; ++k) { const int item = tid + NTHR * k, ri = item >> 5, c = (item & 31) * 8;
            float ss = 0.f;
#pragma unroll
            for (int q = 0; q < 8; ++q) ss += ssqp[q * 128 + ri];
            const float rs = rsqrtf(ss * (1.f / 256.f) + EPS);
            const u32x4 v = *(const u32x4*)(ybuf + ri * 256 + c);
            const f32x4 g0 = *(const f32x4*)(gn + c), g1 = *(const f32x4*)(gn + c + 4);
            u32x4 o;
            o[0] = pack2(__uint_as_float(v[0] << 16) * rs * g0[0], __uint_as_float(v[0] & 0xffff0000u) * rs * g0[1]);
            o[1] = pack2(__uint_as_float(v[1] << 16) * rs * g0[2], __uint_as_float(v[1] & 0xffff0000u) * rs * g0[3]);
            o[2] = pack2(__uint_as_float(v[2] << 16) * rs * g1[0], __uint_as_float(v[2] & 0xffff0000u) * rs * g1[1]);
            o[3] = pack2(__uint_as_float(v[3] << 16) * rs * g1[2], __uint_as_float(v[3] & 0xffff0000u) * rs * g1[3]);
            *(u32x4*)(mix + (size_t)(row0 + ri) * DM + 256 + c) = o; }
    }
    __syncthreads();
}

constexpr int LC_WB = 0, LC_RAW = 4 * 64 * LDT * 2, LC_US = 65536, LC_CW = LC_US + 128 * LDT * 2, LC_SEG = LC_CW + 5 * 64 * 4, LRU_LDS = LC_SEG + 2 * 8 * 64 * 4;
static_assert(LC_RAW + 131 * LDT * 2 <= 65536, "raw rows fit under the scan arrays");
DI int lru_chunk_units() { return NB * NCHK * 4; }
DI void lru_chunk_unit(const Params& p, int l, int u, char* smem) {
    const int tid = tidx(), lane = tid & 63, w = __builtin_amdgcn_readfirstlane(tid >> 6), r32 = lane & 31, hi = lane >> 5;
    const int kb = u & 3, cb = (u >> 2) % NCHK, b = (u >> 2) / NCHK;
    const int row0 = blk_row0(b, cb);
    const int part0 = cb < 2 ? b * CTXL : NCTX + b * SEQ, partN = cb < 2 ? CTXL : SEQ;
    bf16_t* Wb = (bf16_t*)(smem + LC_WB);
    bf16_t* raw = (bf16_t*)(smem + LC_RAW);
    float* aL = (float*)smem;
    float* xL = aL + 128 * 64;
    bf16_t* Us = (bf16_t*)(smem + LC_US);
    float* cwl = (float*)(smem + LC_CW);
    float* segA = (float*)(smem + LC_SEG); float* segH = segA + 8 * 64;
    const bf16_t* proj = (const bf16_t*)(p.ws + OFF_RA);
    {
        u32x4 v[3];
#pragma unroll
        for (int k = 0; k < 3; ++k) { const int item = tid + NTHR * k; v[k] = (u32x4){0u, 0u, 0u, 0u};
            if (item < 131 * 8) { const int r = item >> 3, c = item & 7, gr = row0 - 2 + r;
                if (gr >= part0 && gr < part0 + partN) v[k] = *(const u32x4*)(proj + (size_t)gr * INPP + CC_X + kb * 64 + 8 * c); } }
        f32x4 wv[8];
#pragma unroll
        for (int k = 0; k < 8; ++k) { const int idx = tid + NTHR * k, g = idx >> 10, e4 = idx & 1023, d = g >> 1;
            wv[k] = *(const f32x4*)(p.in[(g & 1) ? I_LRUWI : I_LRUWA] + ((size_t)((l * 2 + d) * 4 + kb)) * 4096 + 4 * e4); }
#pragma unroll
        for (int k = 0; k < 3; ++k) { const int item = tid + NTHR * k; if (item < 131 * 8) *(u32x4*)(raw + (item >> 3) * LDT + 8 * (item & 7)) = v[k]; }
#pragma unroll
        for (int k = 0; k < 8; ++k) { const int idx = tid + NTHR * k, g = idx >> 10, e4 = idx & 1023, i = e4 >> 4, j4 = (e4 & 15) * 4;
            uint2 q; q.x = pack2(wv[k][0], wv[k][1]); q.y = pack2(wv[k][2], wv[k][3]); *(uint2*)(Wb + (g * 64 + i) * LDT + j4) = q; }
        if (tid < 320) { const int j = tid >> 6, c = tid & 63; cwl[tid] = j < 4 ? p.in[I_LRUCW][l * 1024 + j * 256 + kb * 64 + c] : p.in[I_LRUCB][l * 256 + kb * 64 + c]; }
    }
    __syncthreads();
#pragma unroll
    for (int k = 0; k < 2; ++k) { const int item = tid + NTHR * k, i = item >> 3, c = item & 7;
        float acc[8];
        { const f32x4 b0 = *(const f32x4*)(cwl + 256 + 8 * c), b1 = *(const f32x4*)(cwl + 256 + 8 * c + 4);
          acc[0] = b0[0]; acc[1] = b0[1]; acc[2] = b0[2]; acc[3] = b0[3]; acc[4] = b1[0]; acc[5] = b1[1]; acc[6] = b1[2]; acc[7] = b1[3]; }
#pragma unroll
        for (int j = 0; j < 4; ++j) { const u32x4 q = *(const u32x4*)(raw + (i + j) * LDT + 8 * c);
            const f32x4 w0 = *(const f32x4*)(cwl + j * 64 + 8 * c), w1 = *(const f32x4*)(cwl + j * 64 + 8 * c + 4);
            acc[0] += w0[0] * __uint_as_float(q[0] << 16); acc[1] += w0[1] * __uint_as_float(q[0] & 0xffff0000u); acc[2] += w0[2] * __uint_as_float(q[1] << 16); acc[3] += w0[3] * __uint_as_float(q[1] & 0xffff0000u);
            acc[4] += w1[0] * __uint_as_float(q[2] << 16); acc[5] += w1[1] * __uint_as_float(q[2] & 0xffff0000u); acc[6] += w1[2] * __uint_as_float(q[3] << 16); acc[7] += w1[3] * __uint_as_float(q[3] & 0xffff0000u); }
        u32x4 o; o[0] = pack2(acc[0], acc[1]); o[1] = pack2(acc[2], acc[3]); o[2] = pack2(acc[4], acc[5]); o[3] = pack2(acc[6], acc[7]);
        *(u32x4*)(Us + i * LDT + 8 * c) = o; }
    __syncthreads();
    const int tt = w & 3, jt = w >> 2, q4 = (lane & 15) >> 2, p4 = lane & 3, blk = (lane >> 4) & 1;
    f32x16 acc[4];
#pragma unroll
    for (int g = 0; g < 4; ++g)
#pragma unroll
        for (int r = 0; r < 16; ++r) acc[g][r] = 0.f;
#pragma unroll
    for (int s4 = 0; s4 < 4; ++s4) {
        const bf16x8 uf = *(const bf16x8*)(Us + (32 * tt + r32) * LDT + 16 * s4 + 8 * hi);
#pragma unroll
        for (int g = 0; g < 4; ++g) { const bf16_t* wp = Wb + (g * 64 + 16 * s4 + 8 * hi + q4) * LDT + 32 * jt + 16 * blk + 4 * p4;
            acc[g] = __builtin_amdgcn_mfma_f32_32x32x16_bf16(uf, cat8(tr16(wp), tr16(wp + 4 * LDT)), acc[g], 0, 0, 0); }
    }
    float uv[16];
    const int chl = 32 * jt + r32, ch = kb * 64 + chl;
#pragma unroll
    for (int r = 0; r < 16; ++r) uv[r] = bf2f(Us[(32 * tt + crow(r, hi)) * LDT + chl]);
    __syncthreads();
    bf16_t* HB = (bf16_t*)(p.ws + OFF_LRUH);
    float* LC = (float*)(p.ws + OFF_LRUC);
#pragma unroll
    for (int d = 0; d < 2; ++d) {
        {
            const float ba = p.in[I_LRUBA][(l * 2 + d) * 256 + ch], bi = p.in[I_LRUBI][(l * 2 + d) * 256 + ch];
            const float spl = softplus_(-p.in[I_LRULAM][(l * 2 + d) * 256 + ch]);
#pragma unroll
            for (int r = 0; r < 16; ++r) { const int i = 32 * tt + crow(r, hi);
                const float rg = sigmoid_(acc[2 * d][r] + ba), ig = sigmoid_(acc[2 * d + 1][r] + bi);
                const float la = -8.f * rg * spl;
                const float av = __expf(la);
                const float mult = __builtin_amdgcn_sqrtf(fmaxf(0.f, 1.f - av * av));
                aL[i * 64 + chl] = av; xL[i * 64 + chl] = mult * ig * uv[r]; }
        }
        __syncthreads();
        const int sch = tid & 63, sg = tid >> 6;
        float hacc = 0.f, pacc = 1.f;
#pragma unroll 1
        for (int t = 0; t < 16; ++t) { const int tau = sg * 16 + t, i = d ? 127 - tau : tau;
            const float av = aL[i * 64 + sch]; hacc = av * hacc + xL[i * 64 + sch]; pacc *= av; xL[i * 64 + sch] = hacc; aL[i * 64 + sch] = pacc; }
        segA[sg * 64 + sch] = pacc; segH[sg * 64 + sch] = hacc;
        __syncthreads();
        float carry = 0.f, cp = 1.f;
        for (int s2 = 0; s2 < sg; ++s2) { carry = carry * segA[s2 * 64 + sch] + segH[s2 * 64 + sch]; cp *= segA[s2 * 64 + sch]; }
        bf16_t* Hh = HB + (size_t)(2 * d) * NTOK * 256; bf16_t* Hp = HB + (size_t)(2 * d + 1) * NTOK * 256;
        float hl = 0.f, pl = 1.f;
#pragma unroll 1
        for (int t = 0; t < 16; ++t) { const int tau = sg * 16 + t, i = d ? 127 - tau : tau;
            hl = xL[i * 64 + sch] + aL[i * 64 + sch] * carry; pl = aL[i * 64 + sch] * cp;
            Hh[(size_t)(row0 + i) * 256 + kb * 64 + sch] = f2bf(hl); Hp[(size_t)(row0 + i) * 256 + kb * 64 + sch] = f2bf(pl); }
        if (sg == 7) { const int s = d ? bwd_seq(cb) : cb; const size_t o = ((size_t)(b * 2 + d) * NCHK + s) * 256 + kb * 64 + sch;
            LC[o] = hl; LC[(size_t)NB * 2 * NCHK * 256 + o] = pl; }
        __syncthreads();
    }
}
DI int lru_fin_units(int l) { return NB * (l == 0 ? NCHK : NCHK - 2); }
DI void lru_fin_unit(const Params& p, int l, int u, char* smem) {
    const int tid = tidx();
    const int nper = l == 0 ? NCHK : NCHK - 2;
    const int b = u / nper, cb = u % nper + (l == 0 ? 0 : 2);
    const int row0 = blk_row0(b, cb);
    const bf16_t* HB = (const bf16_t*)(p.ws + OFF_LRUH);
    const bf16_t* proj = (const bf16_t*)(p.ws + OFF_RA);
    bf16_t* mix = (bf16_t*)(p.ws + OFF_RB);
    const int c = (tid & 31) * 8;
    const float* CF = (const float*)(p.ws + OFF_CARRY) + ((size_t)(b * 2 + 0) * NCHK + cb) * 256 + c;
    const float* CB2 = (const float*)(p.ws + OFF_CARRY) + ((size_t)(b * 2 + 1) * NCHK + bwd_seq(cb)) * 256 + c;
    float cf[8], cbk[8];
    { const f32x4 a0 = *(const f32x4*)CF, a1 = *(const f32x4*)(CF + 4), b0 = *(const f32x4*)CB2, b1 = *(const f32x4*)(CB2 + 4);
#pragma unroll
      for (int e = 0; e < 4; ++e) { cf[e] = a0[e]; cf[4 + e] = a1[e]; cbk[e] = b0[e]; cbk[4 + e] = b1[e]; } }
#pragma unroll 1
    for (int k4 = 0; k4 < 2; ++k4) {
    u32x4 hfv[4], pfv[4], hbv[4], pbv[4], gv[4];
#pragma unroll
    for (int kk = 0; kk < 4; ++kk) { const int ri = (tid >> 5) + 16 * (4 * k4 + kk); const size_t o = (size_t)(row0 + ri) * 256 + c;
        hfv[kk] = *(const u32x4*)(HB + o); pfv[kk] = *(const u32x4*)(HB + (size_t)NTOK * 256 + o); hbv[kk] = *(const u32x4*)(HB + (size_t)2 * NTOK * 256 + o); pbv[kk] = *(const u32x4*)(HB + (size_t)3 * NTOK * 256 + o);
        gv[kk] = *(const u32x4*)(proj + (size_t)(row0 + ri) * INPP + CC_G + c); }
    __builtin_amdgcn_sched_barrier(0);
#pragma unroll
    for (int kk = 0; kk < 4; ++kk) {
        const int k = 4 * k4 + kk;
        const int ri = (tid >> 5) + 16 * k;
        const u32x4 hf = hfv[kk], pf = pfv[kk], hb = hbv[kk], pb = pbv[kk], g = gv[kk];
        u32x4 out;
#pragma unroll
        for (int e = 0; e < 4; ++e) {
            const float lo = (__uint_as_float(hf[e] << 16) + __uint_as_float(pf[e] << 16) * cf[2 * e] + __uint_as_float(hb[e] << 16) + __uint_as_float(pb[e] << 16) * cbk[2 * e]) * gelu_tanh_(__uint_as_float(g[e] << 16));
            const float hh = (__uint_as_float(hf[e] & 0xffff0000u) + __uint_as_float(pf[e] & 0xffff0000u) * cf[2 * e + 1] + __uint_as_float(hb[e] & 0xffff0000u) + __uint_as_float(pb[e] & 0xffff0000u) * cbk[2 * e + 1]) * gelu_tanh_(__uint_as_float(g[e] & 0xffff0000u));
            out[e] = pack2(lo, hh); }
        *(u32x4*)(mix + (size_t)(row0 + ri) * DM + 512 + c) = out;
    }
    }
}

#define XB_TMO      128
#define XB_XCNT(j)  (256  + 64 * (j))
#define XB_XSUB(j)  (1280 + 64 * (j))
#define XB_XGEN(j)  (2304 + 64 * (j))
#define XB_TOP      3328
#define XB_TOPGEN   3392
#define XCD_BAR_WORDS 3456
#define XB_SPIN_CAP (1u << 18)
#define LAS __attribute__((address_space(3)))

__device__ __forceinline__ unsigned xb_ld(unsigned* p)              { return __hip_atomic_load(p, __ATOMIC_RELAXED, __HIP_MEMORY_SCOPE_AGENT); }
__device__ __forceinline__ unsigned xb_add(unsigned* p, unsigned v) { return __hip_atomic_fetch_add(p, v, __ATOMIC_RELAXED, __HIP_MEMORY_SCOPE_AGENT); }
__device__ __forceinline__ unsigned xb_xcc_id() { return (unsigned)__builtin_amdgcn_s_getreg((3 << 11) | 20) & 0xFu; }
#define XB_SPIN(cond, bar) do { unsigned _sp = 0; while (cond) { __builtin_amdgcn_s_sleep(1); \
    if ((++_sp & 255u) == 0u) { if (xb_ld(&(bar)[XB_TMO])) break; if (_sp > XB_SPIN_CAP) { atomicAdd(&(bar)[XB_TMO], 1u); break; } } } } while (0)

struct XcdBarrier {
    unsigned* bar; unsigned x;
    volatile LAS unsigned* st;
};

__device__ __forceinline__ XcdBarrier xcd_barrier_post(unsigned* bar, volatile LAS unsigned* st) {
    XcdBarrier b; b.bar = bar; b.x = xb_xcc_id(); b.st = st;
    if (threadIdx.x == 0) (void)xb_add(&bar[XB_XCNT(b.x)], 1u);
    return b;
}
__device__ __forceinline__ void xcd_barrier_complete(unsigned* bar, unsigned x, unsigned& nloc, unsigned& nx) {
    const unsigned G = gridDim.x * gridDim.y * gridDim.z;
    unsigned sum, cnt, mine, sp = 0u;
    for (;;) {
        sum = 0u; cnt = 0u; mine = 0u;
#pragma unroll
        for (unsigned j = 0; j < 16; ++j) { const unsigned c = xb_ld(&bar[XB_XCNT(j)]); sum += c; cnt += (c > 0u) ? 1u : 0u; mine = (j == x) ? c : mine; }
        if (sum == G) break;
        __builtin_amdgcn_s_sleep(1);
        if ((++sp & 255u) == 0u) { if (xb_ld(&bar[XB_TMO])) break; if (sp > XB_SPIN_CAP) { atomicAdd(&bar[XB_TMO], 1u); break; } }
    }
    nloc = mine > 0u ? mine : 1u; nx = cnt > 0u ? cnt : 1u;
}

__device__ __forceinline__ void xcd_barrier(const XcdBarrier& b) {
    asm volatile("s_waitcnt vmcnt(0)" ::: "memory");
    __syncthreads();
    if (threadIdx.x == 0) {
        unsigned* bar = b.bar;
        __builtin_amdgcn_s_waitcnt(0);
        unsigned nloc = b.st[0], nx = b.st[1];
        if (nloc == 0u) { xcd_barrier_complete(bar, b.x, nloc, nx); b.st[0] = nloc; b.st[1] = nx; }
        const unsigned old = xb_add(&bar[XB_XSUB(b.x)], 1u);
        const unsigned gen = old / nloc;
        if (old + 1u == (gen + 1u) * nloc) {
            __builtin_amdgcn_fence(__ATOMIC_RELEASE, "agent");
            asm volatile("s_waitcnt vmcnt(0)" ::: "memory");
            const unsigned og = xb_add(&bar[XB_TOP], 1u);
            const unsigned tg = og / nx;
            if (og + 1u == (tg + 1u) * nx) xb_add(&bar[XB_TOPGEN], 1u);
            else XB_SPIN(xb_ld(&bar[XB_TOPGEN]) == tg, bar);
            __builtin_amdgcn_fence(__ATOMIC_ACQUIRE, "agent");
            xb_add(&bar[XB_XGEN(b.x)], 1u);
            asm volatile("s_waitcnt vmcnt(0)" ::: "memory");
        } else {
            XB_SPIN(xb_ld(&bar[XB_XGEN(b.x)]) == gen, bar);
            __builtin_amdgcn_fence(__ATOMIC_ACQUIRE, "agent");
            asm volatile("s_waitcnt vmcnt(0)" ::: "memory");
        }
    }
    __syncthreads();
}


#define PROBE_SUB 0
enum { PH_PRO = 0, PH_CONVEXP, PH_PRE0, PH_INPROJ, PH_PREP, PH_MIX, PH_OUTPROJ, PH_POST1, PH_MOE1, PH_MOE2, PH_POST2, PH_POST3, PH_MIXB };
constexpr int MAX_LDS = 140 * 1024;

template <int PH>
DI void run_phase(const Params& p, int l, int hf, char* smem) {
    const int G = gridDim.x, B = blockIdx.x;
    if (PH == PH_PRO) {
        const int n0 = MOD_UNITS, n1 = n0 + ROPE_UNITS + RWT_UNITS;
        for (int u = B; u < n1; u += G) {
            if (u < n0) mod_unit(p, u, smem);
            else if (u < n0 + RWT_UNITS) rwt_unit(p, u - n0, smem);
            else rope_unit(p, u - n0 - RWT_UNITS);
        }
        convert_run(p, 0, smem);
    } else if (PH == PH_CONVEXP) {
        convert_run(p, 1, smem);
    } else if (PH == PH_PRE0) {
        for (int u = B; u < NTOK / 16; u += G) rowpost_unit<0>(p, 0, 0, u * 16, smem);
    } else if (PH == PH_INPROJ) {
        InprojS S{p, l}; gemm8<true>(smem, p.ws + OFF_RB, DM, S);
        if (l == 0) { const int nu = (NTOK / 256) * (INPP / 256), nb = nu % G;
            if (nb && B >= nb) { __syncthreads(); convert_run(p, 5, smem, 0, CONV_A, B - nb, G - nb); } }
    } else if (PH == PH_PREP) {
        const int n0 = ssd_chunk_units(), n1 = n0 + lru_chunk_units(), n2 = n1 + PREP_UNITS;
        for (int u = B; u < n2; u += G) {
            if (u < n0) ssd_chunk_unit(p, l, u, smem);
            else if (u < n1) lru_chunk_unit(p, l, u - n0, smem);
            else prep_unit(p, l, u - n1);
        }
        if (PROBE_SUB == 1) for (int u = B; u < n0; u += G) ssd_chunk_unit(p, l, u, smem);
        if (PROBE_SUB == 2) for (int u = B; u < n1 - n0; u += G) lru_chunk_unit(p, l, u, smem);
        if (PROBE_SUB == 3) for (int u = B; u < PREP_UNITS; u += G) prep_unit(p, l, u);
    } else if (PH == PH_MIX) {
        const int n0 = SCAN_UNITS, n1 = n0 + attn_units(l);
        for (int u = B; u < n1; u += G) {
            if (u < n0) scan_unit(p, u);
            else attn_dispatch(p, l, u - n0, smem);
        }
    } else if (PH == PH_MIXB) {
        const int n0 = ssd_fin_units(l), n1 = n0 + lru_fin_units(l);
        for (int u = B; u < n1; u += G) {
            if (u < n0) ssd_fin_unit(p, l, u, smem);
            else lru_fin_unit(p, l, u - n0, smem);
        }
    } else if (PH == PH_OUTPROJ) {
        OutprojS S{p, l}; gemm8<true>(smem, p.ws + OFF_RB, DM, S);
        if (l == 0) { const int nb = (68 * 4) % G;
            if (nb && B >= nb) { __syncthreads(); convert_run(p, 5, smem, CONV_A, CONV_B, B - nb, G - nb); } }
    } else if (PH == PH_POST1) {
        const int lo = l == 0 ? 0 : NCTX, per = l == 0 ? 68 : 64;
        if (l == 0) { convert_run(p, 5, smem, CONV_A + CONV_B, CONV_SUPER - CONV_A - CONV_B);
            if (((NTOK / 256) * (INPP / 256)) % G == 0) convert_run(p, 5, smem, 0, CONV_A);
            if ((68 * 4) % G == 0) convert_run(p, 5, smem, CONV_A, CONV_B); }
        for (int u = B; u < 256; u += G) route_unit(p, l, lo + u * per, lo + (u + 1) * per, smem);
    } else if (PH == PH_MOE1 || PH == PH_MOE2) {
        MoeTab* tb = (MoeTab*)(smem + GEMM_LDS);
        moe_table(p, l, hf, tb);
        if (PH == PH_MOE1) { Moe1S S{p, l, hf, tb}; gemm8<true>(smem, p.ws + OFF_RA, 1024, S); }
        else { Moe2S S{p, l, hf, tb}; gemm8<true>(smem, p.ws + OFF_HID, 256, S); }
        __syncthreads();
    } else if (PH == PH_POST2 || PH == PH_POST3) {
        const int lo = half_lo(l, hf), n = (half_hi(l, hf) - lo) / 16;
        moe_table(p, l, hf, (MoeTab*)(smem + GEMM_LDS));
        for (int u = B; u < n; u += G) { if (PH == PH_POST2) rowpost_unit<2>(p, l, hf, lo + u * 16, smem); else rowpost_unit<3>(p, l, hf, lo + u * 16, smem); }
    }
}

#ifndef MULTI_LAUNCH
#define MULTI_LAUNCH 0
#endif
#define PROBE_PH -1
#define PROBE_TMASK 0ull
#define TSTAMP() do { if (PROBE_TMASK != 0ull && blockIdx.x == 0 && threadIdx.x == 0) tsl[bk] = wall_clock64(); ++bk; } while (0)
#define GBAR() do { XcdBarrier b2_ = bar; asm volatile("" : "+s"(b2_.x)); asm volatile("" : "+s"(b2_.bar)); xcd_barrier(b2_); TSTAMP(); } while (0)
#define RUNP(PH, l, hf) do { run_phase<PH>(p, l, hf, smem); if (PROBE_PH == PH) run_phase<PH>(p, l, hf, smem); } while (0)
static_assert(XCD_BAR_WORDS * 4 <= 16 * 1024, "barrier words fit their region");
__global__ void __launch_bounds__(NTHR, 2) k_mega(Params p) {
    extern __shared__ __attribute__((aligned(16))) char smem[];
    uint4* xbw = (uint4*)(smem + MAX_LDS - 16);
    if (threadIdx.x == 0) *xbw = make_uint4(0u, 0u, 0u, 0u);
    __syncthreads();
    XcdBarrier bar = xcd_barrier_post((unsigned*)(p.ws + OFF_BAR), (volatile LAS unsigned*)xbw);
    unsigned long long* tsl = (unsigned long long*)(smem + MAX_LDS - 16 - 32 * 8); int bk = 1;
    if (PROBE_TMASK != 0ull && blockIdx.x == 0 && threadIdx.x == 0) tsl[0] = wall_clock64();
    if (PROBE_STAGE >= 0 && threadIdx.x == 0) { unsigned long long* tacc0 = (unsigned long long*)(smem + MAX_LDS - 16 - 32 * 8 - 64); for (int k = 0; k < 4; ++k) tacc0[k] = 0ull; }
    RUNP(PH_PRO, 0, 0);
    GBAR();
    RUNP(PH_PRE0, 0, 0);
    GBAR();
#pragma unroll 1
    for (int l = 0; l < 2; ++l) {
        if (l == 1) RUNP(PH_CONVEXP, 1, 0);
        RUNP(PH_INPROJ, l, 0);
        GBAR();
        RUNP(PH_PREP, l, 0);
        GBAR();
        RUNP(PH_MIX, l, 0);
        GBAR();
        RUNP(PH_MIXB, l, 0);
        GBAR();
        RUNP(PH_OUTPROJ, l, 0);
        GBAR();
        RUNP(PH_POST1, l, 0);
        GBAR();
        RUNP(PH_MOE1, l, 0);
        GBAR();
        RUNP(PH_MOE2, l, 0);
        GBAR();
        if (l == 0) { RUNP(PH_POST2, l, 0); GBAR(); } else RUNP(PH_POST3, l, 0);
    }
    if ((PROBE_TMASK != 0ull || PROBE_STAGE >= 0) && blockIdx.x == 0) {
        __syncthreads();
        if (threadIdx.x == 0) { tsl[bk] = wall_clock64(); unsigned long long acc = 0ull;
            if (PROBE_STAGE >= 0) acc += ((unsigned long long*)(smem + MAX_LDS - 16 - 32 * 8 - 64))[PROBE_STAGE >= 0 ? PROBE_STAGE : 0];
            for (int k = 1; k <= bk; ++k) if ((PROBE_TMASK >> (k - 1)) & 1ull) acc += tsl[k] - tsl[k - 1];
            const unsigned long long t0 = wall_clock64(); while (wall_clock64() - t0 < acc) __builtin_amdgcn_s_sleep(32); }
    }
}

#if MULTI_LAUNCH
template <int PH>
__global__ void __launch_bounds__(NTHR, 2) k_phase(Params p, int l, int hf) {
    extern __shared__ __attribute__((aligned(16))) char smem[];
    run_phase<PH>(p, l, hf, smem);
}
template <int PH>
static void launch_phase(const Params& p, int l, int hf, int grid, hipStream_t st) {
    static bool inited = false;
    if (!inited) { (void)hipFuncSetAttribute((const void*)k_phase<PH>, hipFuncAttributeMaxDynamicSharedMemorySize, MAX_LDS); inited = true; }
    k_phase<PH><<<grid, NTHR, MAX_LDS, st>>>(p, l, hf);
}
#endif

extern "C" void kernel_launch(void* const* d_in, const int* in_sizes, int n_in, void* d_out, int out_size, void* d_ws, size_t ws_size, hipStream_t stream) {
    if (ws_size < WS_NEED || n_in < 36) return;
    Params p{};
    for (int i = 0; i < 36; ++i) p.in[i] = (const float*)d_in[i];
    p.out = (float*)d_out; p.ws = (char*)d_ws;
    (void)hipMemsetAsync(d_ws, 0, ZERO_BYTES, stream);
#if MULTI_LAUNCH
    const int G = 256;
    launch_phase<PH_PRO>(p, 0, 0, G, stream);
    launch_phase<PH_PRE0>(p, 0, 0, G, stream);
    for (int l = 0; l < 2; ++l) {
        if (l == 1) launch_phase<PH_CONVEXP>(p, 1, 0, G, stream);
        launch_phase<PH_INPROJ>(p, l, 0, G, stream);
        launch_phase<PH_PREP>(p, l, 0, G, stream);
        launch_phase<PH_MIX>(p, l, 0, G, stream);
        launch_phase<PH_MIXB>(p, l, 0, G, stream);
        launch_phase<PH_OUTPROJ>(p, l, 0, G, stream);
        launch_phase<PH_POST1>(p, l, 0, G, stream);
        for (int hf = 0; hf < 1; ++hf) {
            launch_phase<PH_MOE1>(p, l, hf, G, stream);
            launch_phase<PH_MOE2>(p, l, hf, G, stream);
            if (l == 0) launch_phase<PH_POST2>(p, l, hf, G, stream); else launch_phase<PH_POST3>(p, l, hf, G, stream);
        }
    }
#else
    static int grid = 0;
    if (!grid) {
        int dev = 0, cus = 0, per_cu = 0;
        (void)hipGetDevice(&dev);
        (void)hipDeviceGetAttribute(&cus, hipDeviceAttributeMultiprocessorCount, dev);
        (void)hipFuncSetAttribute((const void*)k_mega, hipFuncAttributeMaxDynamicSharedMemorySize, MAX_LDS);
        (void)hipOccupancyMaxActiveBlocksPerMultiprocessor(&per_cu, (const void*)k_mega, NTHR, MAX_LDS);
        grid = per_cu >= 1 ? cus : 0;
    }
    if (grid > 0) k_mega<<<grid, NTHR, MAX_LDS, stream>>>(p);
#endif
}
```

```cpp
#include <hip/hip_runtime.h>
#include <stdint.h>

#define DI __device__ __forceinline__
typedef unsigned short bf16_t;
typedef short bf16x8 __attribute__((ext_vector_type(8)));
typedef short s16x4 __attribute__((ext_vector_type(4)));
typedef float f32x4 __attribute__((ext_vector_type(4)));
typedef float f32x16 __attribute__((ext_vector_type(16)));
typedef unsigned u32x4 __attribute__((ext_vector_type(4)));

constexpr int NTHR = 512;
constexpr int DM = 1024, NB = 4, SEQ = 4096, CTXL = 256;
constexpr int NCTX = NB * CTXL, NLAT = NB * SEQ, NTOK = NCTX + NLAT;
constexpr int INP = 2312, INPP = 2560;
constexpr int CA_Q = 0, CA_K = 256, CA_V = 384, CB_Z = 512, CB_X = 768, CB_B = 1024, CB_C = 1152, CB_DTF = 1280, CB_DTB = 1284,
              CC_X = 1288, CC_G = 1544, CD_Q = 1800, CD_K = 2056, CD_V = 2184;
constexpr int NCHK = 34;
constexpr int HCAP = NTOK;
constexpr float EPS = 1e-6f;
constexpr float YE_SCALE = 4.f;
typedef float f32x2 __attribute__((ext_vector_type(2)));

constexpr size_t MB = 1024 * 1024;
constexpr size_t OFF_BAR = 0;
constexpr size_t OFF_CNT = 16 * 1024;
constexpr size_t OFF_MOD = 32 * 1024;
constexpr size_t ZERO_BYTES = 32 * 1024 + 2 * 5 * 6144 * 4;
constexpr size_t OFF_ROPE = 512 * 1024;
constexpr size_t OFF_SLOT_TOK = 2 * MB;
constexpr size_t OFF_SLOT_W = 7 * MB;
constexpr size_t OFF_TOKSLOT = 12 * MB;
constexpr size_t OFF_LRUC = 13 * MB;
constexpr size_t OFF_SSDDEC = 14 * MB;
constexpr size_t OFF_RWT = 14 * MB + 64 * 1024;
constexpr size_t OFF_TOKW = 15 * MB;
constexpr size_t OFF_WIN = 20 * MB;
constexpr size_t SZ_WIN1 = (size_t)INPP * DM * 2;
constexpr size_t OFF_WOUT = OFF_WIN + 2 * SZ_WIN1;
constexpr size_t SZ_WOUT1 = (size_t)DM * DM * 2;
constexpr size_t OFF_WGU = 36 * MB;
constexpr size_t OFF_WD = OFF_WGU + (size_t)65 * 512 * 1024 * 2;
constexpr size_t OFF_Y = 134 * MB;
constexpr size_t OFF_XB = 168 * MB;
constexpr size_t OFF_RA = 202 * MB;
constexpr size_t OFF_HID = OFF_RA + (size_t)NTOK * DM * 2;
constexpr size_t OFF_RB = 321 * MB;
constexpr size_t OFF_RC = 355 * MB;
constexpr size_t OFF_QA = OFF_RC;
constexpr size_t OFF_KA = OFF_QA + (size_t)NTOK * 256 * 2;
constexpr size_t OFF_QD = OFF_KA + (size_t)NTOK * 128 * 2;
constexpr size_t OFF_KD = OFF_QD + (size_t)NTOK * 256 * 2;
constexpr size_t OFF_SSDST = OFF_KD + (size_t)NTOK * 128 * 2;
constexpr size_t OFF_YPART = OFF_SSDST + (size_t)4 * 4 * 2 * 34 * 4096 * 4;
constexpr size_t OFF_CC = OFF_YPART + (size_t)NTOK * 256 * 4;
constexpr size_t OFF_EA = OFF_CC + (size_t)NTOK * 128 * 4;
constexpr size_t OFF_LRUH = OFF_EA + (size_t)NTOK * 8 * 4;
constexpr size_t OFF_START = OFF_LRUH + (size_t)4 * NTOK * 256 * 2;
constexpr size_t OFF_CARRY = OFF_START + (size_t)4 * 4 * 2 * 34 * 4096 * 2;
static_assert(OFF_CARRY + 4 * 2 * 34 * 256 * 4 <= OFF_RC + (size_t)8 * HCAP * 1024, "phase scratch fits under ye");
constexpr size_t OFF_YE = OFF_RC;
constexpr size_t OFF_WD2 = OFF_RC + (size_t)8 * HCAP * 1024 + MB;
constexpr size_t WS_NEED = OFF_WD2 + (size_t)65 * 1024 * 256 * 2 + MB;
static_assert(OFF_HID + (size_t)(8 * NTOK + 64 * 255 + NTOK + 256) * 512 <= OFF_RB, "hid fits between the tokens and h");

struct Params {
    const float* in[36];
    float* out;
    char* ws;
};
enum { I_X = 0, I_C, I_CTX, I_CCTX, I_WADA, I_BADA, I_GMIXPRE, I_GMIXPOST, I_GFFNPRE, I_GFFNPOST, I_WIN, I_WOUT, I_ASINK, I_SSDCW, I_SSDCB, I_SSDDTB, I_SSDALOG,
       I_SSDD, I_SSDNORM, I_LRUCW, I_LRUCB, I_LRUWA, I_LRUBA, I_LRUWI, I_LRUBI, I_LRULAM, I_DQN, I_DKN, I_RW, I_RB, I_EG, I_EU, I_ED, I_SG, I_SU, I_SD };

DI int tidx() { int t = threadIdx.x; asm volatile("" : "+v"(t)); return t; }
DI float bf2f(bf16_t v) { return __uint_as_float(((unsigned)v) << 16); }
DI unsigned pack2(float lo, float hi) { unsigned r; asm("v_cvt_pk_bf16_f32 %0, %1, %2" : "=v"(r) : "v"(lo), "v"(hi)); return r; }
DI bf16_t f2bf(float f) { return (bf16_t)(pack2(f, 0.f) & 0xffffu); }
#define DPPF(v, ctrl) __int_as_float(__builtin_amdgcn_update_dpp(0, __float_as_int(v), ctrl, 0xf, 0xf, true))
#define DPPI(v, ctrl) __builtin_amdgcn_update_dpp(0, (v), ctrl, 0xf, 0xf, true)
DI float row16_sum(float v) { v += DPPF(v, 0xB1); v += DPPF(v, 0x4E); v += DPPF(v, 0x141); v += DPPF(v, 0x140); return v; }
DI float wave_sum(float v) {
    v = row16_sum(v);
    return __int_as_float(__builtin_amdgcn_readlane(__float_as_int(v), 0)) + __int_as_float(__builtin_amdgcn_readlane(__float_as_int(v), 16))
         + __int_as_float(__builtin_amdgcn_readlane(__float_as_int(v), 32)) + __int_as_float(__builtin_amdgcn_readlane(__float_as_int(v), 48));
}
DI float xhalf_max(float v) { auto rr = __builtin_amdgcn_permlane32_swap(__float_as_uint(v), __float_as_uint(v), false, false); return fmaxf(__uint_as_float(rr[0]), __uint_as_float(rr[1])); }
DI float xhalf_sum(float v) { auto rr = __builtin_amdgcn_permlane32_swap(__float_as_uint(v), __float_as_uint(v), false, false); return __uint_as_float(rr[0]) + __uint_as_float(rr[1]); }
DI float grp8_max(float v) { v = fmaxf(v, DPPF(v, 0xB1)); v = fmaxf(v, DPPF(v, 0x4E)); v = fmaxf(v, DPPF(v, 0x141)); return v; }
DI int grp8_min(int v) { v = min(v, DPPI(v, 0xB1)); v = min(v, DPPI(v, 0x4E)); v = min(v, DPPI(v, 0x141)); return v; }
DI float sigmoid_(float x) { return __builtin_amdgcn_rcpf(1.f + __builtin_amdgcn_exp2f(-1.4426950408889634f * x)); }
DI float silu_(float x) { return x * sigmoid_(x); }
DI float softplus_(float x) { return x > 20.f ? x : log1pf(__expf(x)); }
DI float gelu_tanh_(float x) { const float u = 0.7978845608028654f * (x + 0.044715f * x * x * x); const float th = 1.f - 2.f * __builtin_amdgcn_rcpf(1.f + __builtin_amdgcn_exp2f(2.8853900817779268f * u)); return 0.5f * x * (1.f + th); }
DI void lds_barrier() { asm volatile("s_waitcnt lgkmcnt(0)" ::: "memory"); __builtin_amdgcn_s_barrier(); asm volatile("" ::: "memory"); }
DI int crow(int reg, int h) { return (reg & 3) + 8 * (reg >> 2) + 4 * h; }

DI void ld8bf(const bf16_t* q, f32x4& a, f32x4& b) { const u32x4 v = *(const u32x4*)q; a = (f32x4){__uint_as_float(v[0] << 16), __uint_as_float(v[0] & 0xffff0000u), __uint_as_float(v[1] << 16), __uint_as_float(v[1] & 0xffff0000u)};
    b = (f32x4){__uint_as_float(v[2] << 16), __uint_as_float(v[2] & 0xffff0000u), __uint_as_float(v[3] << 16), __uint_as_float(v[3] & 0xffff0000u)}; }
DI void st8bf(bf16_t* q, const f32x4& a, const f32x4& b) { u32x4 o; o[0] = pack2(a[0], a[1]); o[1] = pack2(a[2], a[3]); o[2] = pack2(b[0], b[1]); o[3] = pack2(b[2], b[3]); *(u32x4*)q = o; }
DI const float* xin_row(const Params& p, int r) { return r < NCTX ? p.in[I_CTX] + (size_t)r * DM : p.in[I_X] + (size_t)(r - NCTX) * DM; }
DI int mod_idx(int r) { return r < NCTX ? 4 : ((r - NCTX) >> 12); }
DI const float* modp(const Params& p, int l, int bidx, int k) { return (const float*)(p.ws + OFF_MOD) + ((size_t)(l * 5 + bidx) * 6 + k) * DM; }
DI int half_lo(int l, int hf) { return hf == 0 ? (l == 0 ? 0 : NCTX) : NTOK; }
DI int half_hi(int l, int hf) { return NTOK; }

DI void transpose_tile(const float* __restrict__ src, int ld, int N, int k0, int n0, bf16_t* __restrict__ dst, int ldd, int mode, float* tile) {
    const int t = tidx();
    {
        const int col = t & 63, r8 = t >> 6;
#pragma unroll
        for (int i = 0; i < 8; ++i) { const int row = r8 + 8 * i; tile[row * 65 + col] = (n0 + col < N) ? src[(size_t)(k0 + row) * ld + n0 + col] : 0.f; }
    }
    __syncthreads();
    {
        const int n = t >> 3, kc = (t & 7) * 8;
        uint4 v;
        v.x = pack2(tile[(kc + 0) * 65 + n], tile[(kc + 1) * 65 + n]); v.y = pack2(tile[(kc + 2) * 65 + n], tile[(kc + 3) * 65 + n]);
        v.z = pack2(tile[(kc + 4) * 65 + n], tile[(kc + 5) * 65 + n]); v.w = pack2(tile[(kc + 6) * 65 + n], tile[(kc + 7) * 65 + n]);
        const int nn = n0 + n;
        int R = nn;
        if (mode) R = 256 * (nn >> 7) + (nn & 127) + (mode == 2 ? 128 : 0);
        *(uint4*)(dst + (size_t)R * ldd + k0 + kc) = v;
    }
    __syncthreads();
}
constexpr int CONV_UNITS_SMALL = 640 + 256, CONV_UNITS_EXP = 3 * 4160;
DI void convert_small_unit(const Params& p, int l, int u, char* smem) {
    float* tile = (float*)smem;
    if (u < 640) { const int kt = u / 40, nt = u % 40;
        transpose_tile(p.in[I_WIN] + (size_t)l * DM * INP, INP, INP, kt * 64, nt * 64, (bf16_t*)(p.ws + OFF_WIN + l * SZ_WIN1), DM, 0, tile); return; }
    u -= 640; { const int kt = u / 16, nt = u % 16;
        transpose_tile(p.in[I_WOUT] + (size_t)l * DM * DM, DM, DM, kt * 64, nt * 64, (bf16_t*)(p.ws + OFF_WOUT + l * SZ_WOUT1), DM, 0, tile); }
}
struct ConvDesc { const float* src; bf16_t* dst; int ld, ldd, k0, n0, mode, nvalid; };
constexpr int CONV_SUPER = 65 * 3 * 16;
DI ConvDesc conv_exp_desc(const Params& p, int l, int su) {
    ConvDesc d; const int mi = su >> 4, r = su & 15;
    if (mi < 130) { const int up = mi >= 65, e = up ? mi - 65 : mi;
        d.src = e < 64 ? p.in[up ? I_EU : I_EG] + ((size_t)l * 64 + e) * DM * 256 : p.in[up ? I_SU : I_SG] + (size_t)l * DM * 256;
        d.ld = 256; d.k0 = (r >> 2) * 256; d.n0 = (r & 3) * 64; d.dst = (bf16_t*)(p.ws + OFF_WGU) + (size_t)e * 512 * 1024; d.ldd = 1024; d.mode = up ? 2 : 1; d.nvalid = 64; return d; }
    { const int e = mi - 130;
        d.src = e < 64 ? p.in[I_ED] + ((size_t)l * 64 + e) * 256 * DM : p.in[I_SD] + (size_t)l * 256 * DM;
        d.ld = DM; d.k0 = 0; d.n0 = r * 64; d.dst = (bf16_t*)(p.ws + (l == 0 ? OFF_WD : OFF_WD2)) + (size_t)e * 1024 * 256; d.ldd = 256; d.mode = 0; d.nvalid = 64; return d; }
}
constexpr int CONV_SMALL_SUPER = 4 * 40 + 4 * 16;
DI ConvDesc conv_small_desc(const Params& p, int l, int su) {
    ConvDesc d; d.mode = 0; d.ldd = DM;
    if (su < 160) { const int kq = su / 40, nt = su % 40; d.src = p.in[I_WIN] + (size_t)l * DM * INP; d.ld = INP; d.k0 = kq * 256; d.n0 = nt * 64; d.dst = (bf16_t*)(p.ws + OFF_WIN + l * SZ_WIN1); d.nvalid = INP - nt * 64; return d; }
    su -= 160; { const int kq = su >> 4, nt = su & 15; d.src = p.in[I_WOUT] + (size_t)l * DM * DM; d.ld = DM; d.k0 = kq * 256; d.n0 = nt * 64; d.dst = (bf16_t*)(p.ws + OFF_WOUT + l * SZ_WOUT1); d.nvalid = 64; return d; }
}
DI int conv_count(int which) { return which == 0 ? 2 * CONV_SMALL_SUPER : CONV_SUPER; }
DI ConvDesc conv_any_desc(const Params& p, int which, int su) {
    if (which == 1) return conv_exp_desc(p, 1, su);
    if (which == 5) return conv_exp_desc(p, 0, su);
    return conv_small_desc(p, su / CONV_SMALL_SUPER, su % CONV_SMALL_SUPER);
}
DI void convert_run(const Params& p, int which, char* smem, int su0 = 0, int cnt = -1, int rank = -1, int stride = 0) {
    float* tile = (float*)smem;
    const int t = tidx(), G = stride > 0 ? stride : (int)gridDim.x;
    const int lr = t >> 4, lc = (t & 15) * 4;
    const int sn = t >> 3, sk = (t & 7) * 8;
    int u = su0 + (rank >= 0 ? rank : (int)blockIdx.x);
    const int NSU = cnt >= 0 ? su0 + cnt : conv_count(which);
    if (u >= NSU) return;
    ConvDesc d = conv_any_desc(p, which, u);
    f32x4 v[4][2], w[4][2];
#pragma unroll
    for (int j = 0; j < 4; ++j) { const float* sp = d.src + (size_t)(d.k0 + 64 * j + lr) * d.ld + d.n0 + lc; const bool ok = lc < d.nvalid; v[j][0] = ok ? *(const f32x4*)sp : (f32x4){0.f, 0.f, 0.f, 0.f}; v[j][1] = ok ? *(const f32x4*)(sp + (size_t)32 * d.ld) : (f32x4){0.f, 0.f, 0.f, 0.f}; }
    for (;;) {
        const int un = u + G; const bool more = un < NSU;
        ConvDesc dn = d;
        if (more) { dn = conv_any_desc(p, which, un);
#pragma unroll
            for (int j = 0; j < 4; ++j) { const float* sp = dn.src + (size_t)(dn.k0 + 64 * j + lr) * dn.ld + dn.n0 + lc; const bool ok = lc < dn.nvalid; w[j][0] = ok ? *(const f32x4*)sp : (f32x4){0.f, 0.f, 0.f, 0.f}; w[j][1] = ok ? *(const f32x4*)(sp + (size_t)32 * dn.ld) : (f32x4){0.f, 0.f, 0.f, 0.f}; } }
#pragma unroll
        for (int j = 0; j < 4; ++j)
#pragma unroll
            for (int e = 0; e < 4; ++e) { tile[j * 64 * 65 + lr * 65 + lc + e] = v[j][0][e]; tile[j * 64 * 65 + (lr + 32) * 65 + lc + e] = v[j][1][e]; }
        __syncthreads();
        const int nn = d.n0 + sn;
        const int R = d.mode ? 256 * (nn >> 7) + (nn & 127) + (d.mode == 2 ? 128 : 0) : nn;
#pragma unroll
        for (int j = 0; j < 4; ++j) { const float* tb = tile + j * 64 * 65; u32x4 o;
            o[0] = pack2(tb[(sk + 0) * 65 + sn], tb[(sk + 1) * 65 + sn]); o[1] = pack2(tb[(sk + 2) * 65 + sn], tb[(sk + 3) * 65 + sn]);
            o[2] = pack2(tb[(sk + 4) * 65 + sn], tb[(sk + 5) * 65 + sn]); o[3] = pack2(tb[(sk + 6) * 65 + sn], tb[(sk + 7) * 65 + sn]);
            *(u32x4*)(d.dst + (size_t)R * d.ldd + d.k0 + 64 * j + sk) = o; }
        __syncthreads();
        if (!more) break;
        d = dn; u = un;
#pragma unroll
        for (int j = 0; j < 4; ++j) { v[j][0] = w[j][0]; v[j][1] = w[j][1]; }
    }
}
constexpr int CONV_A = 88 * 9, CONV_B = 240 * 9, CONV_GU = 130 * 16, CONV_L1TAIL = 7, CONV_M1TAIL = 5;
constexpr int MOD_UNITS = 2 * 96;
DI void mod_unit(const Params& p, int u, char* smem) {
    float* s = (float*)smem;
    float* part = s + 5 * 1024;
    const int l = u / 96, cb = u % 96, t = tidx(), col = t & 63, kg = t >> 6;
    for (int i = t; i < 5 * 1024; i += NTHR) { const int v = i >> 10, k = i & 1023; const float c = v < 4 ? p.in[I_C][v * DM + k] : p.in[I_CCTX][k]; s[i] = silu_(c); }
    __syncthreads();
    const int j = cb * 64 + col;
    const float* w = p.in[I_WADA] + (size_t)l * DM * 6144 + (size_t)(kg * 128) * 6144 + j;
    float a0 = 0, a1 = 0, a2 = 0, a3 = 0, a4 = 0;
#pragma unroll 16
    for (int k = 0; k < 128; ++k) { const float wv = w[(size_t)k * 6144]; const int kk = kg * 128 + k;
        a0 += s[kk] * wv; a1 += s[1024 + kk] * wv; a2 += s[2048 + kk] * wv; a3 += s[3072 + kk] * wv; a4 += s[4096 + kk] * wv; }
    part[(kg * 5 + 0) * 64 + col] = a0; part[(kg * 5 + 1) * 64 + col] = a1; part[(kg * 5 + 2) * 64 + col] = a2; part[(kg * 5 + 3) * 64 + col] = a3; part[(kg * 5 + 4) * 64 + col] = a4;
    __syncthreads();
    if (t < 320) { const int v = t >> 6, c = t & 63; float acc = p.in[I_BADA][l * 6144 + cb * 64 + c];
#pragma unroll
        for (int g = 0; g < 8; ++g) acc += part[(g * 5 + v) * 64 + c];
        const int k = cb >> 4, col = (cb & 15) * 64 + c;
        if (k == 1) acc = (1.f + acc) * p.in[I_GMIXPRE][l * DM + col]; else if (k == 2) acc = acc * p.in[I_GMIXPOST][l * DM + col];
        else if (k == 4) acc = (1.f + acc) * p.in[I_GFFNPRE][l * DM + col]; else if (k == 5) acc = acc * p.in[I_GFFNPOST][l * DM + col];
        ((float*)(p.ws + OFF_MOD))[(size_t)(l * 5 + v) * 6144 + cb * 64 + c] = acc; }
    __syncthreads();
}
constexpr int RWT_UNITS = 2 * 16;
DI void rwt_unit(const Params& p, int u, char* smem) {
    float* tile = (float*)smem; const int t = tidx(), l = u >> 4, k0 = (u & 15) * 64;
#pragma unroll
    for (int i = 0; i < 8; ++i) { const int idx = t + NTHR * i, k = idx >> 6, e = idx & 63; tile[k * 65 + e] = p.in[I_RW][(size_t)l * DM * 64 + (size_t)(k0 + k) * 64 + e]; }
    __syncthreads();
#pragma unroll
    for (int i = 0; i < 8; ++i) { const int idx = t + NTHR * i, e = idx >> 6, k = idx & 63; const float v = tile[k * 65 + e];
        const bf16_t hi = f2bf(v), lo = f2bf(v - bf2f(hi)); bf16_t* W = (bf16_t*)(p.ws + OFF_RWT) + (size_t)l * 2 * 64 * DM;
        const int kk = k0 + k;
        const size_t o = (((size_t)((kk >> 7) * 4 + ((kk >> 5) & 3)) * 2) * 4 + (e >> 4)) * 512 + (size_t)(((kk >> 3) & 3) * 16 + (e & 15)) * 8 + (kk & 7);
        W[o] = hi; W[o + 4 * 512] = lo; }
    __syncthreads();
}
constexpr int ROPE_UNITS = 4096 * 32 / NTHR;
DI void rope_unit(const Params& p, int u) {
    const int idx = u * NTHR + tidx(), t = idx >> 5, i = idx & 31;
    const float pos = (float)(i < 16 ? (t >> 6) : (t & 63));
    const float inv = powf(10000.f, -(float)(2 * (i & 15)) / 32.f);
    const float ang = pos * inv;
    ((float2*)(p.ws + OFF_ROPE))[idx] = make_float2(cosf(ang), sinf(ang));
}

constexpr int GEMM_LDS = 131072;
struct MoeTab { int cnt[65]; int mstart[66]; int hoffP[65]; int hoffU[65]; };
constexpr int HP = 1028;
#define PROBE_STAGE -1
#define STG(k) do { if (PROBE_STAGE >= 0) { __syncthreads(); if (blockIdx.x == 0 && threadIdx.x == 0) { const unsigned long long t_ = wall_clock64(); tacc[k] += t_ - tlast; tlast = t_; } } } while (0)
template <int MODE>
DI void rowpost_row(const Params& p, int l, int r, int lane, const int* hoffU, float* hdst) {
    const int bidx = mod_idx(r);
    f32x4 xv[4];
    if (MODE == 0) {
        const float* xs = xin_row(p, r);
#pragma unroll
        for (int i = 0; i < 2; ++i) { xv[2 * i] = *(const f32x4*)(xs + 8 * lane + 512 * i); xv[2 * i + 1] = *(const f32x4*)(xs + 8 * lane + 512 * i + 4); }
    } else {
        f32x4 yv[4];
        const bf16_t* Y = (const bf16_t*)(p.ws + OFF_Y) + (size_t)r * DM;
        const bf16_t* xb = (const bf16_t*)(p.ws + OFF_XB) + (size_t)r * DM;
        uint2 q[8][2];
        if (MODE >= 2) {
            const int* ts = (const int*)(p.ws + OFF_TOKSLOT) + (size_t)r * 8;
            const int4 t0 = *(const int4*)ts, t1 = *(const int4*)(ts + 4);
            const int tv[8] = {t0.x, t0.y, t0.z, t0.w, t1.x, t1.y, t1.z, t1.w};
            const unsigned char* ye = (const unsigned char*)(p.ws + OFF_YE);
#pragma unroll
            for (int k = 0; k < 8; ++k) { const unsigned char* yr = ye + (size_t)(hoffU[tv[k] >> 15] + (tv[k] & 32767)) * DM + 8 * lane;
                q[k][0] = *(const uint2*)(yr); q[k][1] = *(const uint2*)(yr + 512); }
        }
#pragma unroll
        for (int i = 0; i < 2; ++i) { ld8bf(Y + 8 * lane + 512 * i, yv[2 * i], yv[2 * i + 1]);
            if (MODE == 1 && l == 0) { const float* xs = xin_row(p, r); xv[2 * i] = *(const f32x4*)(xs + 8 * lane + 512 * i); xv[2 * i + 1] = *(const f32x4*)(xs + 8 * lane + 512 * i + 4); }
            else ld8bf(xb + 8 * lane + 512 * i, xv[2 * i], xv[2 * i + 1]); }
        if (MODE >= 2) {
            f32x4 ys[4];
#pragma unroll
            for (int i = 0; i < 4; ++i) ys[i] = (f32x4){0.f, 0.f, 0.f, 0.f};
#pragma unroll
            for (int k = 0; k < 8; ++k) { const float wk = ((const float*)(p.ws + OFF_TOKW))[(size_t)r * 8 + k];
#pragma unroll
                for (int i = 0; i < 2; ++i) { const uint2 v = q[k][i];
                    const f32x2 a = __builtin_amdgcn_cvt_pk_f32_fp8((int)v.x, false), b = __builtin_amdgcn_cvt_pk_f32_fp8((int)v.x, true), c = __builtin_amdgcn_cvt_pk_f32_fp8((int)v.y, false), d = __builtin_amdgcn_cvt_pk_f32_fp8((int)v.y, true);
                    ys[2 * i][0] += wk * a[0]; ys[2 * i][1] += wk * a[1]; ys[2 * i][2] += wk * b[0]; ys[2 * i][3] += wk * b[1];
                    ys[2 * i + 1][0] += wk * c[0]; ys[2 * i + 1][1] += wk * c[1]; ys[2 * i + 1][2] += wk * d[0]; ys[2 * i + 1][3] += wk * d[1]; } }
#pragma unroll
            for (int i = 0; i < 4; ++i) yv[i] = yv[i] + ys[i];
        }
        float ss = 0.f;
#pragma unroll
        for (int i = 0; i < 4; ++i) ss += yv[i][0] * yv[i][0] + yv[i][1] * yv[i][1] + yv[i][2] * yv[i][2] + yv[i][3] * yv[i][3];
        ss = wave_sum(ss);
        const float rs = rsqrtf(ss * (1.f / DM) + EPS);
        const float* gate = modp(p, l, bidx, MODE == 1 ? 2 : 5);
#pragma unroll
        for (int i = 0; i < 4; ++i) { const int c = 8 * lane + 512 * (i >> 1) + 4 * (i & 1);
            const f32x4 g = *(const f32x4*)(gate + c);
            xv[i] = xv[i] + g * (yv[i] * rs);
            if (MODE == 3) *(f32x4*)(p.out + (size_t)(r - NCTX) * DM + c) = xv[i]; }
        if (MODE != 3) { bf16_t* xo = (bf16_t*)(p.ws + OFF_XB) + (size_t)r * DM; st8bf(xo + 8 * lane, xv[0], xv[1]); st8bf(xo + 8 * lane + 512, xv[2], xv[3]); }
    }
    if (MODE != 3) {
        const int lp = MODE == 2 ? l + 1 : l;
        float ss = 0.f;
#pragma unroll
        for (int i = 0; i < 4; ++i) ss += xv[i][0] * xv[i][0] + xv[i][1] * xv[i][1] + xv[i][2] * xv[i][2] + xv[i][3] * xv[i][3];
        ss = wave_sum(ss);
        const float rs = rsqrtf(ss * (1.f / DM) + EPS);
        const float* sh = modp(p, lp, bidx, MODE == 1 ? 3 : 0);
        const float* sc = modp(p, lp, bidx, MODE == 1 ? 4 : 1);
        bf16_t* hb = (bf16_t*)(p.ws + (MODE == 1 ? OFF_RA : OFF_RB)) + (size_t)r * DM;
#pragma unroll
        for (int i = 0; i < 2; ++i) { const int c = 8 * lane + 512 * i;
            f32x4 h[2];
#pragma unroll
            for (int j = 0; j < 2; ++j) { const f32x4 s1 = *(const f32x4*)(sh + c + 4 * j), s2 = *(const f32x4*)(sc + c + 4 * j);
                h[j] = xv[2 * i + j] * rs * s2 + s1;
                if (MODE == 1) *(f32x4*)(hdst + c + 4 * j) = h[j]; }
            u32x4 o; o[0] = pack2(h[0][0], h[0][1]); o[1] = pack2(h[0][2], h[0][3]); o[2] = pack2(h[1][0], h[1][1]); o[3] = pack2(h[1][2], h[1][3]);
            *(u32x4*)(hb + c) = o; }
    }
}
DI void rowpre_load(const Params& p, int r, int lane, f32x4 (&xv)[2][4]) {
#pragma unroll
    for (int rr = 0; rr < 2; ++rr) { const float* xs = xin_row(p, r + rr);
#pragma unroll
        for (int i = 0; i < 2; ++i) { xv[rr][2 * i] = *(const f32x4*)(xs + 8 * lane + 512 * i); xv[rr][2 * i + 1] = *(const f32x4*)(xs + 8 * lane + 512 * i + 4); } }
}
DI void rowpre_compute(const Params& p, int r, int lane, const f32x4 (&xv)[2][4]) {
    const int bidx = mod_idx(r);
    float rs[2];
#pragma unroll
    for (int rr = 0; rr < 2; ++rr) { float ss = 0.f;
#pragma unroll
        for (int i = 0; i < 4; ++i) ss += xv[rr][i][0] * xv[rr][i][0] + xv[rr][i][1] * xv[rr][i][1] + xv[rr][i][2] * xv[rr][i][2] + xv[rr][i][3] * xv[rr][i][3];
        ss = wave_sum(ss); rs[rr] = rsqrtf(ss * (1.f / DM) + EPS); }
    const float* sh = modp(p, 0, bidx, 0); const float* sc = modp(p, 0, bidx, 1);
#pragma unroll
    for (int i = 0; i < 2; ++i) { const int c = 8 * lane + 512 * i; f32x4 h[2][2];
#pragma unroll
        for (int j = 0; j < 2; ++j) { const f32x4 s1 = *(const f32x4*)(sh + c + 4 * j), sv = *(const f32x4*)(sc + c + 4 * j);
#pragma unroll
            for (int rr = 0; rr < 2; ++rr) h[rr][j] = xv[rr][2 * i + j] * rs[rr] * sv + s1; }
#pragma unroll
        for (int rr = 0; rr < 2; ++rr) st8bf((bf16_t*)(p.ws + OFF_RB) + (size_t)(r + rr) * DM + c, h[rr][0], h[rr][1]); }
}
DI void rowpre_run(const Params& p, int n16) {
    const int tid = tidx(), lane = tid & 63, w = tid >> 6, G = gridDim.x;
    int u = blockIdx.x; if (u >= n16) return;
    f32x4 xa[2][4], xb[2][4];
    rowpre_load(p, u * 16 + 2 * w, lane, xa);
    for (;;) {
        const int un = u + G; const bool more = un < n16;
        if (more) rowpre_load(p, un * 16 + 2 * w, lane, xb);
        rowpre_compute(p, u * 16 + 2 * w, lane, xa);
        if (!more) break;
#pragma unroll
        for (int rr = 0; rr < 2; ++rr)
#pragma unroll
            for (int i = 0; i < 4; ++i) xa[rr][i] = xb[rr][i];
        u = un;
    }
}
template <int MODE>
DI void rowpost_unit(const Params& p, int l, int hf, int r0, char* smem) {
    const int* hoffU = ((const MoeTab*)(smem + GEMM_LDS))->hoffU;
    const int tid = tidx(), lane = tid & 63, w = tid >> 6;
    if (MODE == 0) {
#pragma unroll
        for (int rr = 0; rr < 2; ++rr) rowpost_row<MODE>(p, l, r0 + 2 * w + rr, lane, hoffU, nullptr);
        return;
    }
    int4 t0[2], t1[2]; f32x4 rw0[2], rw1[2]; u32x4 yraw[2][2], xraw[2][2]; uint2 q[2][8][2];
#pragma unroll
    for (int rr = 0; rr < 2; ++rr) { const int r = r0 + 2 * w + rr;
        const int* ts = (const int*)(p.ws + OFF_TOKSLOT) + (size_t)r * 8; t0[rr] = *(const int4*)ts; t1[rr] = *(const int4*)(ts + 4);
        const float* tw = (const float*)(p.ws + OFF_TOKW) + (size_t)r * 8; rw0[rr] = *(const f32x4*)tw; rw1[rr] = *(const f32x4*)(tw + 4);
        const bf16_t* Y = (const bf16_t*)(p.ws + OFF_Y) + (size_t)r * DM + 8 * lane; const bf16_t* xb = (const bf16_t*)(p.ws + OFF_XB) + (size_t)r * DM + 8 * lane;
        yraw[rr][0] = *(const u32x4*)Y; yraw[rr][1] = *(const u32x4*)(Y + 512); xraw[rr][0] = *(const u32x4*)xb; xraw[rr][1] = *(const u32x4*)(xb + 512); }
#pragma unroll
    for (int rr = 0; rr < 2; ++rr) {
        const int tv[8] = {t0[rr].x, t0[rr].y, t0[rr].z, t0[rr].w, t1[rr].x, t1[rr].y, t1[rr].z, t1[rr].w};
        const unsigned char* ye = (const unsigned char*)(p.ws + OFF_YE);
#pragma unroll
        for (int k = 0; k < 8; ++k) { const unsigned char* yr = ye + (size_t)(hoffU[tv[k] >> 15] + (tv[k] & 32767)) * DM + 8 * lane; q[rr][k][0] = *(const uint2*)(yr); q[rr][k][1] = *(const uint2*)(yr + 512); } }
    __builtin_amdgcn_sched_barrier(0);
    const int rA = r0 + 2 * w, bidx = mod_idx(rA);
    f32x4 yv[2][4], xv[2][4]; float rs[2];
#pragma unroll
    for (int rr = 0; rr < 2; ++rr) {
        f32x4 ys[4];
#pragma unroll
        for (int i = 0; i < 2; ++i) { const u32x4 a = yraw[rr][i], b = xraw[rr][i];
            yv[rr][2 * i] = (f32x4){__uint_as_float(a[0] << 16), __uint_as_float(a[0] & 0xffff0000u), __uint_as_float(a[1] << 16), __uint_as_float(a[1] & 0xffff0000u)};
            yv[rr][2 * i + 1] = (f32x4){__uint_as_float(a[2] << 16), __uint_as_float(a[2] & 0xffff0000u), __uint_as_float(a[3] << 16), __uint_as_float(a[3] & 0xffff0000u)};
            xv[rr][2 * i] = (f32x4){__uint_as_float(b[0] << 16), __uint_as_float(b[0] & 0xffff0000u), __uint_as_float(b[1] << 16), __uint_as_float(b[1] & 0xffff0000u)};
            xv[rr][2 * i + 1] = (f32x4){__uint_as_float(b[2] << 16), __uint_as_float(b[2] & 0xffff0000u), __uint_as_float(b[3] << 16), __uint_as_float(b[3] & 0xffff0000u)}; }
#pragma unroll
        for (int i = 0; i < 4; ++i) ys[i] = (f32x4){0.f, 0.f, 0.f, 0.f};
#pragma unroll
        for (int k = 0; k < 8; ++k) { const float wk = k < 4 ? rw0[rr][k & 3] : rw1[rr][k & 3];
#pragma unroll
            for (int i = 0; i < 2; ++i) { const uint2 v = q[rr][k][i];
                const f32x2 a = __builtin_amdgcn_cvt_pk_f32_fp8((int)v.x, false), b = __builtin_amdgcn_cvt_pk_f32_fp8((int)v.x, true), c = __builtin_amdgcn_cvt_pk_f32_fp8((int)v.y, false), d = __builtin_amdgcn_cvt_pk_f32_fp8((int)v.y, true);
                ys[2 * i][0] += wk * a[0]; ys[2 * i][1] += wk * a[1]; ys[2 * i][2] += wk * b[0]; ys[2 * i][3] += wk * b[1];
                ys[2 * i + 1][0] += wk * c[0]; ys[2 * i + 1][1] += wk * c[1]; ys[2 * i + 1][2] += wk * d[0]; ys[2 * i + 1][3] += wk * d[1]; } }
        float ss = 0.f;
#pragma unroll
        for (int i = 0; i < 4; ++i) { yv[rr][i] = yv[rr][i] + ys[i]; ss += yv[rr][i][0] * yv[rr][i][0] + yv[rr][i][1] * yv[rr][i][1] + yv[rr][i][2] * yv[rr][i][2] + yv[rr][i][3] * yv[rr][i][3]; }
        ss = wave_sum(ss);
        rs[rr] = rsqrtf(ss * (1.f / DM) + EPS);
    }
    const float* gate = modp(p, l, bidx, 5);
#pragma unroll
    for (int i = 0; i < 4; ++i) { const int c = 8 * lane + 512 * (i >> 1) + 4 * (i & 1);
        const f32x4 g = *(const f32x4*)(gate + c);
#pragma unroll
        for (int rr = 0; rr < 2; ++rr) { xv[rr][i] = xv[rr][i] + g * (yv[rr][i] * rs[rr]);
            if (MODE == 3) *(f32x4*)(p.out + (size_t)(rA + rr - NCTX) * DM + c) = xv[rr][i]; } }
    if (MODE != 3) {
        float r2[2];
#pragma unroll
        for (int rr = 0; rr < 2; ++rr) { bf16_t* xo = (bf16_t*)(p.ws + OFF_XB) + (size_t)(rA + rr) * DM; st8bf(xo + 8 * lane, xv[rr][0], xv[rr][1]); st8bf(xo + 8 * lane + 512, xv[rr][2], xv[rr][3]);
            float s2 = 0.f;
#pragma unroll
            for (int i = 0; i < 4; ++i) s2 += xv[rr][i][0] * xv[rr][i][0] + xv[rr][i][1] * xv[rr][i][1] + xv[rr][i][2] * xv[rr][i][2] + xv[rr][i][3] * xv[rr][i][3];
            s2 = wave_sum(s2); r2[rr] = rsqrtf(s2 * (1.f / DM) + EPS); }
        const float* sh = modp(p, l + 1, bidx, 0); const float* sc = modp(p, l + 1, bidx, 1);
#pragma unroll
        for (int i = 0; i < 2; ++i) { const int c = 8 * lane + 512 * i; f32x4 h[2][2];
#pragma unroll
            for (int j = 0; j < 2; ++j) { const f32x4 s1 = *(const f32x4*)(sh + c + 4 * j), sv = *(const f32x4*)(sc + c + 4 * j);
#pragma unroll
                for (int rr = 0; rr < 2; ++rr) h[rr][j] = xv[rr][2 * i + j] * r2[rr] * sv + s1; }
#pragma unroll
            for (int rr = 0; rr < 2; ++rr) st8bf((bf16_t*)(p.ws + OFF_RB) + (size_t)(rA + rr) * DM + c, h[rr][0], h[rr][1]); }
    }
}
DI void rp1_load(const Params& p, int l, int r, int lane, f32x4 (&yv)[4], f32x4 (&xv)[4]) {
    const bf16_t* Y = (const bf16_t*)(p.ws + OFF_Y) + (size_t)r * DM;
#pragma unroll
    for (int i = 0; i < 2; ++i) { ld8bf(Y + 8 * lane + 512 * i, yv[2 * i], yv[2 * i + 1]);
        if (l == 0) { const float* xs = xin_row(p, r); xv[2 * i] = *(const f32x4*)(xs + 8 * lane + 512 * i); xv[2 * i + 1] = *(const f32x4*)(xs + 8 * lane + 512 * i + 4); }
        else ld8bf((const bf16_t*)(p.ws + OFF_XB) + (size_t)r * DM + 8 * lane + 512 * i, xv[2 * i], xv[2 * i + 1]); }
}
DI void rp1_compute2(const Params& p, int l, int r, int lane, const f32x4 (&yv)[2][4], f32x4 (&xv)[2][4], float* hdst) {
    const int bidx = mod_idx(r);
    const float* gate = modp(p, l, bidx, 2);
    const float* sh = modp(p, l, bidx, 3);
    const float* sc = modp(p, l, bidx, 4);
    f32x4 gv[4], s1v[4], svv[4];
#pragma unroll
    for (int i = 0; i < 4; ++i) { const int c = 8 * lane + 512 * (i >> 1) + 4 * (i & 1); gv[i] = *(const f32x4*)(gate + c); s1v[i] = *(const f32x4*)(sh + c); svv[i] = *(const f32x4*)(sc + c); }
    float rs[2];
#pragma unroll
    for (int rr = 0; rr < 2; ++rr) { float ss = 0.f;
#pragma unroll
        for (int i = 0; i < 4; ++i) ss += yv[rr][i][0] * yv[rr][i][0] + yv[rr][i][1] * yv[rr][i][1] + yv[rr][i][2] * yv[rr][i][2] + yv[rr][i][3] * yv[rr][i][3];
        ss = wave_sum(ss); rs[rr] = rsqrtf(ss * (1.f / DM) + EPS); }
#pragma unroll
    for (int i = 0; i < 4; ++i)
#pragma unroll
        for (int rr = 0; rr < 2; ++rr) xv[rr][i] = xv[rr][i] + gv[i] * (yv[rr][i] * rs[rr]);
    float r2[2];
#pragma unroll
    for (int rr = 0; rr < 2; ++rr) { bf16_t* xo = (bf16_t*)(p.ws + OFF_XB) + (size_t)(r + rr) * DM; st8bf(xo + 8 * lane, xv[rr][0], xv[rr][1]); st8bf(xo + 8 * lane + 512, xv[rr][2], xv[rr][3]);
        float s2 = 0.f;
#pragma unroll
        for (int i = 0; i < 4; ++i) s2 += xv[rr][i][0] * xv[rr][i][0] + xv[rr][i][1] * xv[rr][i][1] + xv[rr][i][2] * xv[rr][i][2] + xv[rr][i][3] * xv[rr][i][3];
        s2 = wave_sum(s2); r2[rr] = rsqrtf(s2 * (1.f / DM) + EPS); }
#pragma unroll
    for (int i = 0; i < 2; ++i) { const int c = 8 * lane + 512 * i;
        f32x4 h[2][2];
#pragma unroll
        for (int j = 0; j < 2; ++j)
#pragma unroll
            for (int rr = 0; rr < 2; ++rr) { h[rr][j] = xv[rr][2 * i + j] * r2[rr] * svv[2 * i + j] + s1v[2 * i + j]; *(f32x4*)(hdst + rr * HP + c + 4 * j) = h[rr][j]; }
#pragma unroll
        for (int rr = 0; rr < 2; ++rr) { u32x4 o; o[0] = pack2(h[rr][0][0], h[rr][0][1]); o[1] = pack2(h[rr][0][2], h[rr][0][3]); o[2] = pack2(h[rr][1][0], h[rr][1][1]); o[3] = pack2(h[rr][1][2], h[rr][1][3]);
            *(u32x4*)((bf16_t*)(p.ws + OFF_RA) + (size_t)(r + rr) * DM + c) = o; } }
}
constexpr int RP_PART = 16 * HP * 4, RP_HIST = RP_PART + 8 * 16 * 64 * 4, RP_BASE = RP_HIST + 256, RP_SEL = RP_BASE + 256, RP_SELW = RP_SEL + 68 * 8 * 4;
DI void route_unit(const Params& p, int l, int rlo, int rhi, char* smem) {
    float* hrow = (float*)smem;
    float* part = (float*)(smem + RP_PART);
    int* hist = (int*)(smem + RP_HIST);
    int* base = (int*)(smem + RP_BASE);
    int* selv = (int*)(smem + RP_SEL);
    float* selw = (float*)(smem + RP_SELW);
    const int tid = tidx(), lane = tid & 63, w = tid >> 6;
    if (tid < 64) hist[tid] = 0;
    unsigned long long* tacc = (unsigned long long*)(smem + 140 * 1024 - 16 - 32 * 8 - 64); unsigned long long tlast = (PROBE_STAGE >= 0) ? wall_clock64() : 0ull;
    const float rbias = p.in[I_RB][l * 64 + lane];
    const float* rw = p.in[I_RW] + (size_t)l * DM * 64;
    f32x4 pyv[2][4], pxv[2][4];
#pragma unroll
    for (int rr = 0; rr < 2; ++rr) { const int r = rlo + 2 * w + rr; if (r < rhi) rp1_load(p, l, r, lane, pyv[rr], pxv[rr]); }
#pragma unroll 1
    for (int rb = rlo; rb < rhi; rb += 16) {
        { const int r = rb + 2 * w; if (r < rhi) rp1_compute2(p, l, r, lane, pyv, pxv, hrow + (2 * w) * HP); }
#pragma unroll
        for (int rr = 0; rr < 2; ++rr) { const int r = rb + 16 + 2 * w + rr; if (r < rhi) rp1_load(p, l, r, lane, pyv[rr], pxv[rr]); }
        lds_barrier();
        STG(0);
        {
            const int i16 = lane & 15, kq = lane >> 4;
            const bf16_t* wt = (const bf16_t*)(p.ws + OFF_RWT) + (size_t)l * 2 * 64 * DM + (size_t)w * 4 * 2 * 4 * 512 + lane * 8;
            const float* hp = hrow + i16 * HP + 128 * w + 8 * kq;
            bf16x8 bh[4][4], bl[4][4];
#pragma unroll
            for (int ks = 0; ks < 4; ++ks)
#pragma unroll
                for (int n = 0; n < 4; ++n) { bh[ks][n] = *(const bf16x8*)(wt + ((ks * 2 + 0) * 4 + n) * 512); bl[ks][n] = *(const bf16x8*)(wt + ((ks * 2 + 1) * 4 + n) * 512); }
            f32x4 acc[4];
#pragma unroll
            for (int n = 0; n < 4; ++n) acc[n] = (f32x4){0.f, 0.f, 0.f, 0.f};
#pragma unroll
            for (int ks = 0; ks < 4; ++ks) {
                const f32x4 a0 = *(const f32x4*)(hp + 32 * ks), a1 = *(const f32x4*)(hp + 32 * ks + 4);
                union { unsigned u[4]; bf16x8 v; } ah, al;
                ah.u[0] = pack2(a0[0], a0[1]); ah.u[1] = pack2(a0[2], a0[3]); ah.u[2] = pack2(a1[0], a1[1]); ah.u[3] = pack2(a1[2], a1[3]);
                al.u[0] = pack2(a0[0] - __uint_as_float(ah.u[0] << 16), a0[1] - __uint_as_float(ah.u[0] & 0xffff0000u)); al.u[1] = pack2(a0[2] - __uint_as_float(ah.u[1] << 16), a0[3] - __uint_as_float(ah.u[1] & 0xffff0000u));
                al.u[2] = pack2(a1[0] - __uint_as_float(ah.u[2] << 16), a1[1] - __uint_as_float(ah.u[2] & 0xffff0000u)); al.u[3] = pack2(a1[2] - __uint_as_float(ah.u[3] << 16), a1[3] - __uint_as_float(ah.u[3] & 0xffff0000u));
#pragma unroll
                for (int n = 0; n < 4; ++n) {
                    acc[n] = __builtin_amdgcn_mfma_f32_16x16x32_bf16(ah.v, bh[ks][n], acc[n], 0, 0, 0);
                    acc[n] = __builtin_amdgcn_mfma_f32_16x16x32_bf16(ah.v, bl[ks][n], acc[n], 0, 0, 0);
                    acc[n] = __builtin_amdgcn_mfma_f32_16x16x32_bf16(al.v, bh[ks][n], acc[n], 0, 0, 0); }
            }
#pragma unroll
            for (int n = 0; n < 4; ++n)
#pragma unroll
                for (int j = 0; j < 4; ++j) part[(w * 16 + kq * 4 + j) * 64 + n * 16 + i16] = acc[n][j];
        }
        lds_barrier();
        STG(1);
#pragma unroll 1
        for (int rr = 0; rr < 2; ++rr) {
            const int r = rb + 2 * w + rr;
            if (r < rhi) {
                float lg = 0.f;
#pragma unroll
                for (int g = 0; g < 8; ++g) lg += part[(g * 16 + 2 * w + rr) * 64 + lane];
                const float s = sigmoid_(lg);
                const float v = s + rbias;
                const float m1 = grp8_max(v);
                const int ix = grp8_min((v == m1) ? lane : 64);
                const float m2 = grp8_max((lane == ix) ? -INFINITY : v);
                const float gs = m1 + m2;
                const int g = lane >> 3; int grank = 0;
#pragma unroll
                for (int gg = 0; gg < 8; ++gg) { const float o = __int_as_float(__builtin_amdgcn_readlane(__float_as_int(gs), gg * 8)); grank += (o > gs); }
                bool gsel = grank < 4;
                float vm = gsel ? v : -INFINITY;
                int rk = 0;
                const unsigned long long gmask = __ballot(gsel);
#pragma unroll
                for (int gg = 0; gg < 8; ++gg) {
                    if ((gmask >> (8 * gg)) & 1ull) {
#pragma unroll
                        for (int e8 = 0; e8 < 8; ++e8) { const float o = __int_as_float(__builtin_amdgcn_readlane(__float_as_int(v), gg * 8 + e8)); rk += (o > vm); }
                    }
                }
                if (__builtin_amdgcn_readfirstlane(__float_as_int(wave_sum(gsel ? (float)rk : 0.f))) != __float_as_int(496.f)) {
                    grank = 0;
#pragma unroll 1
                    for (int gg = 0; gg < 8; ++gg) { const float o = __int_as_float(__builtin_amdgcn_readlane(__float_as_int(gs), gg * 8)); grank += (o > gs) || (o == gs && gg < g); }
                    gsel = grank < 4; vm = gsel ? v : -INFINITY;
                    rk = 0;
#pragma unroll 1
                    for (int ee = 0; ee < 64; ++ee) { const float o = __int_as_float(__builtin_amdgcn_readlane(__float_as_int(vm), ee)); rk += (o > vm) || (o == vm && ee < lane); }
                }
                const bool sel = gsel && rk < 8;
                const float scs = sel ? s : 0.f;
                const float tot = wave_sum(scs);
                if (sel) { const int lr = atomicAdd(&hist[lane], 1); selv[(r - rlo) * 8 + rk] = (lane << 8) | lr; selw[(r - rlo) * 8 + rk] = scs * (2.5f * __builtin_amdgcn_rcpf(tot)); }
            }
        }
        STG(2);
    }
    __syncthreads();
    const int hh = rlo >= half_lo(l, 1) ? 1 : 0;
    if (tid < 64) { const int n = hist[tid]; base[tid] = n ? atomicAdd((int*)(p.ws + OFF_CNT) + (l * 2 + hh) * 64 + tid, n) : 0; }
    __syncthreads();
    for (int it = tid; it < (rhi - rlo) * 8; it += NTHR) { const int v = selv[it], e = v >> 8, pos = base[e] + (v & 255), r = rlo + (it >> 3);
        ((int*)(p.ws + OFF_SLOT_TOK))[(size_t)(hh * 64 + e) * HCAP + pos] = r;
        ((float*)(p.ws + OFF_TOKW))[(size_t)r * 8 + (it & 7)] = selw[it] * (1.f / YE_SCALE);
        ((int*)(p.ws + OFF_TOKSLOT))[(size_t)r * 8 + (it & 7)] = (e << 15) | pos; }
    __syncthreads();
}

#define G8_LAS __attribute__((address_space(3)))
constexpr int LDT = 72;
constexpr int G8_HTB = 128 * 64 * 2;
static_assert(GEMM_LDS == 8 * G8_HTB, "stage region");
DI int g8_lds_byte(int r, int c) { const int st = (r >> 4) * 2 + (c >> 5), rr = r & 15, cc = c & 31, ob = rr * 64 + cc * 2; return st * 1024 + (ob ^ (((ob >> 9) & 1) << 5)); }
DI void g8_stage_rc(int b, int& R, int& C) { const int st = b / 1024, sb = b % 1024, swz = sb ^ (((sb >> 9) & 1) << 5); R = (st >> 1) * 16 + swz / 64; C = (st & 1) * 32 + (swz % 64) / 2; }
DI int g8_perm32(int rho) { const int n = rho >> 4, i = rho & 15; return 8 * (i >> 2) + 4 * n + (i & 3); }
#define PROBE_G8 -1
#define G8_T0() do { if (PROBE_G8 == Sched::ID && blockIdx.x == 0 && threadIdx.x == 0) g8t = wall_clock64(); } while (0)
#define G8_T1(k) do { if (PROBE_G8 == Sched::ID && blockIdx.x == 0 && threadIdx.x == 0) { const unsigned long long t_ = wall_clock64(); ((unsigned long long*)(smem + 140 * 1024 - 16 - 32 * 8 - 64))[k] += t_ - g8t; g8t = t_; } } while (0)
template <bool PERM, class Sched>
DI void gemm8(char* smem, const char* Abase, int K, Sched& S) {
    G8_LAS unsigned char* lds = (G8_LAS unsigned char*)smem;
    const int tid = tidx(), wid = __builtin_amdgcn_readfirstlane(tid >> 6), lane = tid & 63, wr = wid >> 2, wc = wid & 3, fr = lane & 15, fq = lane >> 4;
    const int nt = K / 64;
    unsigned voffB[2];
#pragma unroll
    for (int i = 0; i < 2; ++i) { int R, C; g8_stage_rc(tid * 16 + i * 8192, R, C); const int Rb = PERM ? ((R & ~31) + g8_perm32(R & 31)) : R; voffB[i] = (unsigned)(Rb * K + C) * 2u; }
    const size_t kstep = 128, hstep = (size_t)128 * K * 2;
    const unsigned ldsw = (unsigned)wid * 1024u;
    const int aoff = g8_lds_byte(wr * 64 + fr, fq * 8), boff = g8_lds_byte(wc * 32 + fr, fq * 8);
#define G8_SA(b, h) (((b) * 2 + (h)) * G8_HTB)
#define G8_SB(b, h) ((4 + (b) * 2 + (h)) * G8_HTB)
#define G8_STAGEB(bufoff, gbase) do { _Pragma("unroll") for (int _i = 0; _i < 2; ++_i) \
        __builtin_amdgcn_global_load_lds((const unsigned*)((const char*)(gbase) + voffB[_i]), (G8_LAS unsigned*)(lds + (bufoff) + ldsw + _i * 8192), 16, 0, 0); } while (0)
#define G8_STAGEA(bufoff, ao, h, kb) do { _Pragma("unroll") for (int _i = 0; _i < 2; ++_i) \
        __builtin_amdgcn_global_load_lds((const unsigned*)(Abase + (size_t)(ao)[h][_i] + (kb)), (G8_LAS unsigned*)(lds + (bufoff) + ldsw + _i * 8192), 16, 0, 0); } while (0)
#define G8_LDA(dst, b, h) do { _Pragma("unroll") for (int m = 0; m < 4; ++m) _Pragma("unroll") for (int k = 0; k < 2; ++k) dst[m][k] = *(const G8_LAS bf16x8*)(lds + G8_SA(b, h) + aoff + m * 2048 + k * 1024); } while (0)
#define G8_LDB(dst, b, h) do { _Pragma("unroll") for (int n = 0; n < 2; ++n) _Pragma("unroll") for (int k = 0; k < 2; ++k) dst[n][k] = *(const G8_LAS bf16x8*)(lds + G8_SB(b, h) + boff + n * 2048 + k * 1024); } while (0)
#define G8_MMA(ai, bj, At, Bt) do { __builtin_amdgcn_s_setprio(1); _Pragma("unroll") for (int m = 0; m < 4; ++m) _Pragma("unroll") for (int n = 0; n < 2; ++n) _Pragma("unroll") for (int k = 0; k < 2; ++k) \
        acc[ai][bj][m][n] = __builtin_amdgcn_mfma_f32_16x16x32_bf16(Bt[n][k], At[m][k], acc[ai][bj][m][n], 0, 0, 0); __builtin_amdgcn_s_setprio(0); } while (0)
#define G8_WAIT_V(n) asm volatile("s_waitcnt vmcnt(" #n ")" ::: "memory")
#define G8_WAIT_L(n) asm volatile("s_waitcnt lgkmcnt(" #n ")" ::: "memory")
#define G8_BAR __builtin_amdgcn_s_barrier()
#define G8_SCHED __builtin_amdgcn_sched_barrier(0)
    typename Sched::U cur, nxt; int ui = 0; unsigned long long g8t = 0ull;
    if (!S.next(0, cur)) return;
    f32x4 acc[2][2][4][2];
#pragma unroll
    for (int a = 0; a < 2; ++a)
#pragma unroll
        for (int b = 0; b < 2; ++b)
#pragma unroll
            for (int m = 0; m < 4; ++m)
#pragma unroll
                for (int n = 0; n < 2; ++n) acc[a][b][m][n] = (f32x4){0.f, 0.f, 0.f, 0.f};
    bf16x8 At[4][2], B0[2][2], B1[2][2];
    unsigned cao[2][2];
    S.aoffs(cur, cao);
    const char* cB = S.bbase(cur);
    G8_STAGEB(G8_SB(0, 0), cB); G8_STAGEA(G8_SA(0, 0), cao, 0, 0); G8_STAGEB(G8_SB(0, 1), cB + hstep); G8_STAGEA(G8_SA(0, 1), cao, 1, 0);
    if (wr == 1) G8_BAR;
    G8_WAIT_V(4); G8_BAR;
    G8_STAGEB(G8_SB(1, 0), cB + kstep); G8_STAGEA(G8_SA(1, 0), cao, 0, kstep); G8_STAGEB(G8_SB(1, 1), cB + hstep + kstep);
    G8_WAIT_V(6); G8_BAR;
    for (;;) {
        nxt = cur;
        const bool has_next = S.next(ui + 1, nxt);
        const char* nB = cB;
        G8_T0();
#pragma unroll 1
        for (int t = 0; t < nt; t += 2) {
            const bool last = (t == nt - 2);
            if (last && has_next) nB = S.bbase(nxt);
            const size_t k1 = (size_t)(t + 1) * kstep;
            const size_t k2 = last ? 0 : (size_t)(t + 2) * kstep, k3 = k2 + kstep;
            const char* b2 = last ? nB : cB + k2; const char* b3 = b2 + kstep;
            G8_LDB(B0, 0, 0); G8_SCHED; G8_LDA(At, 0, 0); G8_STAGEA(G8_SA(1, 1), cao, 1, k1);
            if (last && has_next) S.aoffs(nxt, cao);
            G8_WAIT_L(8); G8_BAR; G8_WAIT_L(0); G8_MMA(0, 0, At, B0); G8_BAR; G8_SCHED;
            G8_LDB(B1, 0, 1); G8_STAGEB(G8_SB(0, 0), b2);
            G8_BAR; G8_WAIT_L(0); G8_MMA(0, 1, At, B1); G8_BAR;
            G8_LDA(At, 0, 1); G8_STAGEA(G8_SA(0, 0), cao, 0, k2);
            G8_BAR; G8_WAIT_L(0); G8_MMA(1, 0, At, B0); G8_BAR; G8_SCHED;
            G8_STAGEB(G8_SB(0, 1), b2 + hstep);
            G8_WAIT_V(6); G8_BAR; G8_MMA(1, 1, At, B1); G8_BAR;
            G8_LDB(B0, 1, 0); G8_SCHED; G8_LDA(At, 1, 0); G8_STAGEA(G8_SA(0, 1), cao, 1, k2);
            G8_WAIT_L(8); G8_BAR; G8_WAIT_L(0); G8_MMA(0, 0, At, B0); G8_BAR; G8_SCHED;
            G8_LDB(B1, 1, 1); G8_STAGEB(G8_SB(1, 0), b3);
            G8_BAR; G8_WAIT_L(0); G8_MMA(0, 1, At, B1); G8_BAR;
            G8_LDA(At, 1, 1); G8_STAGEA(G8_SA(1, 0), cao, 0, k3);
            G8_BAR; G8_WAIT_L(0); G8_MMA(1, 0, At, B0); G8_BAR; G8_SCHED;
            G8_STAGEB(G8_SB(1, 1), b3 + hstep);
            G8_WAIT_V(6); G8_BAR; G8_MMA(1, 1, At, B1); G8_BAR;
        }
        G8_T1(0);
        S.epi(acc, cur, wr, wc, fr, fq);
        G8_T1(1);
        if (!has_next) break;
#pragma unroll
        for (int a = 0; a < 2; ++a)
#pragma unroll
            for (int b = 0; b < 2; ++b)
#pragma unroll
                for (int m = 0; m < 4; ++m)
#pragma unroll
                    for (int n = 0; n < 2; ++n) acc[a][b][m][n] = (f32x4){0.f, 0.f, 0.f, 0.f};
        cur = nxt; cB = nB; ++ui;
    }
    G8_WAIT_V(0);
    if (wr == 0) G8_BAR;
    G8_BAR;
#undef G8_SA
#undef G8_SB
#undef G8_STAGEA
#undef G8_STAGEB
#undef G8_LDA
#undef G8_LDB
#undef G8_MMA
#undef G8_WAIT_V
#undef G8_WAIT_L
#undef G8_BAR
#undef G8_SCHED
}
DI bool g8_static(int i, int nM, int nN, int& pm, int& pn) {
    const int G = gridDim.x, nwg = nM * nN; const long L = (long)i * G + blockIdx.x; if (L >= nwg) return false;
    int wgid = (int)L; { const int q = nwg / 8, r = nwg % 8, xcd = wgid % 8, off = wgid / 8; wgid = (xcd < r ? xcd * (q + 1) : r * (q + 1) + (xcd - r) * q) + off; }
    const int nig = 8 * nN, gid = wgid / nig, fm = gid * 8, gsz = (nM - fm) < 8 ? (nM - fm) : 8;
    pm = fm + ((wgid % nig) % gsz); pn = (wgid % nig) / gsz; return true;
}
DI int g8_xcd_linear(int i, int n) {
    const long L = (long)i * gridDim.x + blockIdx.x; if (L >= n) return -1;
    const int q = n / 8, r = n % 8, xcd = (int)(L % 8), off = (int)(L / 8);
    return (xcd < r ? xcd * (q + 1) : r * (q + 1) + (xcd - r) * q) + off;
}
DI void g8_store_bf16(bf16_t* rowp, const f32x4& a, const f32x4& b) { u32x4 o; o[0] = pack2(a[0], a[1]); o[1] = pack2(a[2], a[3]); o[2] = pack2(b[0], b[1]); o[3] = pack2(b[2], b[3]); *(u32x4*)rowp = o; }

struct InprojS {
    static constexpr int ID = 0;
    struct U { int pm, pn; };
    const Params& p; int l;
    DI bool next(int i, U& u) const { return g8_static(i, NTOK / 256, INPP / 256, u.pm, u.pn); }
    DI void aoffs(const U& u, unsigned (&ao)[2][2]) const { int R[2], C[2]; { const int t_ = tidx(); g8_stage_rc(t_ * 16, R[0], C[0]); g8_stage_rc(t_ * 16 + 8192, R[1], C[1]); }
#pragma unroll
        for (int h = 0; h < 2; ++h)
#pragma unroll
            for (int i = 0; i < 2; ++i) ao[h][i] = (unsigned)((u.pm * 256 + h * 128 + R[i]) * DM + C[i]) * 2u; }
    DI const char* bbase(const U& u) const { return p.ws + OFF_WIN + l * SZ_WIN1 + (size_t)u.pn * 256 * DM * 2; }
    DI void epi(const f32x4 (&acc)[2][2][4][2], const U& u, int wr, int wc, int fr, int fq) const {
        bf16_t* C = (bf16_t*)(p.ws + OFF_RA) + (size_t)(u.pm * 256 + wr * 64 + fr) * INPP + u.pn * 256 + wc * 32 + 8 * fq;
#pragma unroll
        for (int ai = 0; ai < 2; ++ai)
#pragma unroll
            for (int m = 0; m < 4; ++m)
#pragma unroll
                for (int bj = 0; bj < 2; ++bj) g8_store_bf16(C + (size_t)(ai * 128 + m * 16) * INPP + bj * 128, acc[ai][bj][m][0], acc[ai][bj][m][1]);
    }
};
struct OutprojS {
    static constexpr int ID = 1;
    struct U { int pm, pn; };
    const Params& p; int l;
    DI bool next(int i, U& u) const { return g8_static(i, l == 0 ? 68 : 64, 4, u.pm, u.pn); }
    DI void aoffs(const U& u, unsigned (&ao)[2][2]) const { int R[2], C[2]; { const int t_ = tidx(); g8_stage_rc(t_ * 16, R[0], C[0]); g8_stage_rc(t_ * 16 + 8192, R[1], C[1]); }
        const int row0 = (l == 0 ? 0 : NCTX) + u.pm * 256;
#pragma unroll
        for (int h = 0; h < 2; ++h)
#pragma unroll
            for (int i = 0; i < 2; ++i) ao[h][i] = (unsigned)((row0 + h * 128 + R[i]) * DM + C[i]) * 2u; }
    DI const char* bbase(const U& u) const { return p.ws + OFF_WOUT + l * SZ_WOUT1 + (size_t)u.pn * 256 * DM * 2; }
    DI void epi(const f32x4 (&acc)[2][2][4][2], const U& u, int wr, int wc, int fr, int fq) const {
        const int row0 = (l == 0 ? 0 : NCTX) + u.pm * 256;
        bf16_t* C = (bf16_t*)(p.ws + OFF_Y) + (size_t)(row0 + wr * 64 + fr) * DM + u.pn * 256 + wc * 32 + 8 * fq;
#pragma unroll
        for (int ai = 0; ai < 2; ++ai)
#pragma unroll
            for (int m = 0; m < 4; ++m)
#pragma unroll
                for (int bj = 0; bj < 2; ++bj) g8_store_bf16(C + (size_t)(ai * 128 + m * 16) * DM + bj * 128, acc[ai][bj][m][0], acc[ai][bj][m][1]);
    }
};
DI void moe_table(const Params& p, int l, int hf, MoeTab* tb) {
    const int tid = tidx();
    __syncthreads();
    if (tid < 64) {
        const int c = ((const int*)(p.ws + OFF_CNT))[(l * 2 + hf) * 64 + tid];
        const int mt = (c + 255) >> 8;
        int ms = mt, hu = c;
#pragma unroll
        for (int o = 1; o < 64; o <<= 1) { const int a = __shfl_up(ms, o), b = __shfl_up(hu, o); if (tid >= o) { ms += a; hu += b; } }
        tb->cnt[tid] = c; tb->mstart[tid] = ms - mt; tb->hoffP[tid] = (ms - mt) * 256; tb->hoffU[tid] = hu - c;
        if (tid == 63) { const int cs = half_hi(l, hf) - half_lo(l, hf); tb->cnt[64] = cs; tb->mstart[64] = ms; tb->hoffP[64] = ms * 256; tb->hoffU[64] = hu; tb->mstart[65] = ms + ((cs + 255) >> 8); }
    }
    __syncthreads();
}
DI void moe_find(const MoeTab* tb, int g, int hint, int& e, int& mt) { int lo = hint; while (tb->mstart[lo + 1] <= g) ++lo; e = lo; mt = g - tb->mstart[lo]; }
struct Moe1S {
    static constexpr int ID = 2;
    struct U { int e, mt, pn, cnt, hrow0; };
    const Params& p; int l, hf; const MoeTab* tb;
    DI bool next(int i, U& u) const { const int g2 = g8_xcd_linear(i, tb->mstart[65] * 2); if (g2 < 0) return false;
        int e, mt; moe_find(tb, g2 >> 1, i ? u.e : 0, e, mt); e = __builtin_amdgcn_readfirstlane(e); mt = __builtin_amdgcn_readfirstlane(mt); u.e = e; u.mt = mt; u.pn = g2 & 1; u.cnt = __builtin_amdgcn_readfirstlane(tb->cnt[e]); u.hrow0 = __builtin_amdgcn_readfirstlane(tb->hoffP[e]) + mt * 256; return true; }
    DI void aoffs(const U& u, unsigned (&ao)[2][2]) const { int R[2], C[2]; { const int t_ = tidx(); g8_stage_rc(t_ * 16, R[0], C[0]); g8_stage_rc(t_ * 16 + 8192, R[1], C[1]); }
        const int* stok = (const int*)(p.ws + OFF_SLOT_TOK) + (size_t)(hf * 64 + (u.e & 63)) * HCAP; const int lo = half_lo(l, hf);
#pragma unroll
        for (int h = 0; h < 2; ++h)
#pragma unroll
            for (int i = 0; i < 2; ++i) { int pos = u.mt * 256 + h * 128 + R[i]; pos = pos < u.cnt ? pos : u.cnt - 1; const int tok = u.e < 64 ? stok[pos] : lo + pos;
                ao[h][i] = (unsigned)(tok * DM + C[i]) * 2u; } }
    DI const char* bbase(const U& u) const { return p.ws + OFF_WGU + ((size_t)u.e * 512 + u.pn * 256) * 1024 * 2; }
    DI void epi(const f32x4 (&acc)[2][2][4][2], const U& u, int wr, int wc, int fr, int fq) const {
        bf16_t* H = (bf16_t*)(p.ws + OFF_HID) + (size_t)(u.hrow0 + wr * 64 + fr) * 256 + u.pn * 128 + wc * 32 + 8 * fq;
#pragma unroll
        for (int ai = 0; ai < 2; ++ai)
#pragma unroll
            for (int m = 0; m < 4; ++m) { f32x4 o[2];
#pragma unroll
                for (int n = 0; n < 2; ++n) { const f32x4 gt = acc[ai][0][m][n], up = acc[ai][1][m][n]; o[n] = (f32x4){silu_(gt[0]) * up[0], silu_(gt[1]) * up[1], silu_(gt[2]) * up[2], silu_(gt[3]) * up[3]}; }
                g8_store_bf16(H + (size_t)(ai * 128 + m * 16) * 256, o[0], o[1]); }
    }
};
struct Moe2S {
    static constexpr int ID = 3;
    struct U { int e, mt, pn, cnt, hrow0, yrow0; };
    const Params& p; int l, hf; const MoeTab* tb;
    DI bool next(int i, U& u) const { const int g4 = g8_xcd_linear(i, tb->mstart[65] * 4); if (g4 < 0) return false;
        int e, mt; moe_find(tb, g4 >> 2, i ? u.e : 0, e, mt); e = __builtin_amdgcn_readfirstlane(e); mt = __builtin_amdgcn_readfirstlane(mt); u.e = e; u.mt = mt; u.pn = g4 & 3; u.cnt = __builtin_amdgcn_readfirstlane(tb->cnt[e]); u.hrow0 = __builtin_amdgcn_readfirstlane(tb->hoffP[e]) + mt * 256; u.yrow0 = __builtin_amdgcn_readfirstlane(tb->hoffU[e]) + mt * 256; return true; }
    DI void aoffs(const U& u, unsigned (&ao)[2][2]) const { int R[2], C[2]; { const int t_ = tidx(); g8_stage_rc(t_ * 16, R[0], C[0]); g8_stage_rc(t_ * 16 + 8192, R[1], C[1]); }
#pragma unroll
        for (int h = 0; h < 2; ++h)
#pragma unroll
            for (int i = 0; i < 2; ++i) ao[h][i] = (unsigned)((u.hrow0 + h * 128 + R[i]) * 256 + C[i]) * 2u; }
    DI const char* bbase(const U& u) const { return p.ws + (l == 0 ? OFF_WD : OFF_WD2) + ((size_t)u.e * 1024 + u.pn * 256) * 256 * 2; }
    DI void epi(const f32x4 (&acc)[2][2][4][2], const U& u, int wr, int wc, int fr, int fq) const {
        const int colb = u.pn * 256 + wc * 32 + 8 * fq;
#pragma unroll
        for (int ai = 0; ai < 2; ++ai)
#pragma unroll
            for (int m = 0; m < 4; ++m) { const int row = ai * 128 + wr * 64 + m * 16 + fr, pos = u.mt * 256 + row;
                if (pos < u.cnt) {
                    if (u.e < 64) { const float wv = YE_SCALE; unsigned char* yr = (unsigned char*)(p.ws + OFF_YE) + (size_t)(u.yrow0 + row) * DM + colb;
#pragma unroll
                        for (int bj = 0; bj < 2; ++bj) { const f32x4 a = acc[ai][bj][m][0] * wv, b = acc[ai][bj][m][1] * wv; uint2 o; int t = 0;
                            t = __builtin_amdgcn_cvt_pk_fp8_f32(a[0], a[1], t, false); t = __builtin_amdgcn_cvt_pk_fp8_f32(a[2], a[3], t, true); o.x = (unsigned)t;
                            t = __builtin_amdgcn_cvt_pk_fp8_f32(b[0], b[1], t, false); t = __builtin_amdgcn_cvt_pk_fp8_f32(b[2], b[3], t, true); o.y = (unsigned)t;
                            *(uint2*)(yr + bj * 128) = o; }
                    } else { bf16_t* yr = (bf16_t*)(p.ws + OFF_Y) + (size_t)(half_lo(l, hf) + pos) * DM + colb;
#pragma unroll
                        for (int bj = 0; bj < 2; ++bj) g8_store_bf16(yr + bj * 128, acc[ai][bj][m][0], acc[ai][bj][m][1]); } } }
    }
};

constexpr int PREP_UNITS = NTOK / 32;
constexpr float LOG2E = 1.4426950408889634f, QSCALE = 0.125f * LOG2E;
DI void rope2(float& a, float& b, const float2 cs) { const float x1 = a, x2 = b; a = x1 * cs.x - x2 * cs.y; b = x1 * cs.y + x2 * cs.x; }
DI void prep_unit(const Params& p, int l, int u) {
    const int tid = tidx(), lane = tid & 63, w = tid >> 6, pi = lane & 31;
    const float gq0 = p.in[I_DQN][l * 64 + 2 * pi], gq1 = p.in[I_DQN][l * 64 + 2 * pi + 1], gk0 = p.in[I_DKN][l * 64 + 2 * pi], gk1 = p.in[I_DKN][l * 64 + 2 * pi + 1];
    unsigned vqa[4][2], vqd[4][2], vka[4], vkd[4]; float2 cs[4];
#pragma unroll
    for (int k = 0; k < 4; ++k) { const int r = u * 32 + 8 * k + w;
        const bf16_t* pr = (const bf16_t*)(p.ws + OFF_RA) + (size_t)r * INPP;
        vqa[k][0] = *(const unsigned*)(pr + CA_Q + 2 * lane); vqa[k][1] = *(const unsigned*)(pr + CA_Q + 2 * lane + 128);
        vqd[k][0] = *(const unsigned*)(pr + CD_Q + 2 * lane); vqd[k][1] = *(const unsigned*)(pr + CD_Q + 2 * lane + 128);
        vka[k] = *(const unsigned*)(pr + CA_K + 2 * lane); vkd[k] = *(const unsigned*)(pr + CD_K + 2 * lane);
        cs[k] = r >= NCTX ? ((const float2*)(p.ws + OFF_ROPE))[(size_t)((r - NCTX) & (SEQ - 1)) * 32 + pi] : make_float2(1.f, 0.f); }
    __builtin_amdgcn_sched_barrier(0);
#pragma unroll
    for (int k = 0; k < 4; ++k) { const int r = u * 32 + 8 * k + w;
        unsigned* QA = (unsigned*)(p.ws + OFF_QA) + (size_t)r * 128; unsigned* KA = (unsigned*)(p.ws + OFF_KA) + (size_t)r * 64;
        unsigned* QD = (unsigned*)(p.ws + OFF_QD) + (size_t)r * 128; unsigned* KD = (unsigned*)(p.ws + OFF_KD) + (size_t)r * 64;
#pragma unroll
        for (int i = 0; i < 2; ++i) {
            { float a = __uint_as_float(vqa[k][i] << 16), b = __uint_as_float(vqa[k][i] & 0xffff0000u); rope2(a, b, cs[k]); QA[lane + 64 * i] = pack2(a * QSCALE, b * QSCALE); }
            { float a = __uint_as_float(vqd[k][i] << 16), b = __uint_as_float(vqd[k][i] & 0xffff0000u);
              float ss = row16_sum(a * a + b * b); ss += __shfl_xor(ss, 16);
              const float rs = rsqrtf(ss * (1.f / 64.f) + EPS);
              a = a * rs * gq0; b = b * rs * gq1; rope2(a, b, cs[k]); QD[lane + 64 * i] = pack2(a * QSCALE, b * QSCALE); }
        }
        { float a = __uint_as_float(vka[k] << 16), b = __uint_as_float(vka[k] & 0xffff0000u); rope2(a, b, cs[k]); KA[lane] = pack2(a, b); }
        { float a = __uint_as_float(vkd[k] << 16), b = __uint_as_float(vkd[k] & 0xffff0000u);
          float ss = row16_sum(a * a + b * b); ss += __shfl_xor(ss, 16);
          const float rs = rsqrtf(ss * (1.f / 64.f) + EPS);
          a = a * rs * gk0; b = b * rs * gk1; rope2(a, b, cs[k]); KD[lane] = pack2(a, b); }
    }
}

constexpr int ATT_LDS = 2 * 2 * 64 * LDT * 2;
struct AttnArgs {
    const bf16_t* Q; const bf16_t* K; const bf16_t* V;
    int qrow0;
    int g;
    int k0row, k0tiles;
    int k1row, k1t0, k1t1;
    int qpos0;
    const float* sink;
    bf16_t* O;
};
DI void attn_unit(const AttnArgs& a, char* smem) {
    const int tid = tidx(), lane = tid & 63, w = tid >> 6, r32 = lane & 31, hi = lane >> 5;
    const int head = 2 * a.g + (w >> 2), qoff = (w & 3) * 32 + r32;
    bf16_t* Ks = (bf16_t*)smem;
    bf16_t* Vs = Ks + 2 * 64 * LDT;
    bf16x8 qr[4];
    { const bf16_t* qp = a.Q + (size_t)(a.qrow0 + qoff) * 256 + head * 64 + hi * 8;
#pragma unroll
      for (int d0 = 0; d0 < 4; ++d0) qr[d0] = *(const bf16x8*)(qp + d0 * 16); }
    float m_run, l_run;
    if (a.sink) { m_run = a.sink[head] * LOG2E; l_run = hi == 0 ? 1.f : 0.f; } else { m_run = -1e30f; l_run = 0.f; }
    f32x16 o0, o1;
#pragma unroll
    for (int i = 0; i < 16; ++i) { o0[i] = 0.f; o1[i] = 0.f; }
    const int nt = a.k0tiles + (a.k1t1 - a.k1t0);
    const int lrow = tid >> 3, lc = (tid & 7) * 8;
    auto tile_row0 = [&](int t) { return t < a.k0tiles ? a.k0row + t * 64 : a.k1row + (a.k1t0 + t - a.k0tiles) * 64; };
    u32x4 rk, rv;
    { const int kr = tile_row0(0) + lrow; rk = *(const u32x4*)(a.K + (size_t)kr * 128 + a.g * 64 + lc); rv = *(const u32x4*)(a.V + (size_t)kr * INPP + a.g * 64 + lc); }
    *(u32x4*)(Ks + lrow * LDT + lc) = rk; *(u32x4*)(Vs + lrow * LDT + lc) = rv;
    __syncthreads();
    const int q4 = (lane & 15) >> 2, p4 = lane & 3, blk = (lane >> 4) & 1;
#pragma unroll 1
    for (int t = 0; t < nt; ++t) {
        const bool more = t + 1 < nt;
        if (more) { const int kr = tile_row0(t + 1) + lrow; rk = *(const u32x4*)(a.K + (size_t)kr * 128 + a.g * 64 + lc); rv = *(const u32x4*)(a.V + (size_t)kr * INPP + a.g * 64 + lc); }
        const bf16_t* Kc = Ks + (t & 1) * 64 * LDT;
        const bf16_t* Vc = Vs + (t & 1) * 64 * LDT;
        f32x16 s0, s1;
#pragma unroll
        for (int i = 0; i < 16; ++i) { s0[i] = 0.f; s1[i] = 0.f; }
#pragma unroll
        for (int d0 = 0; d0 < 4; ++d0) {
            const bf16x8 k0 = *(const bf16x8*)(Kc + r32 * LDT + d0 * 16 + hi * 8);
            const bf16x8 k1 = *(const bf16x8*)(Kc + (32 + r32) * LDT + d0 * 16 + hi * 8);
            s0 = __builtin_amdgcn_mfma_f32_32x32x16_bf16(k0, qr[d0], s0, 0, 0, 0);
            s1 = __builtin_amdgcn_mfma_f32_32x32x16_bf16(k1, qr[d0], s1, 0, 0, 0);
        }
        if (a.qpos0 >= 0 && t >= a.k0tiles) {
            const int kb = (a.k1t0 + t - a.k0tiles) * 64, qp = a.qpos0 + qoff;
#pragma unroll
            for (int i = 0; i < 16; ++i) { const int kp = kb + crow(i, hi); int d = kp - qp; d = d < 0 ? -d : d; if (d > 128) s0[i] = -1e30f; d = kp + 32 - qp; d = d < 0 ? -d : d; if (d > 128) s1[i] = -1e30f; }
        }
        float mx = s0[0];
#pragma unroll
        for (int i = 1; i < 16; ++i) mx = fmaxf(mx, s0[i]);
#pragma unroll
        for (int i = 0; i < 16; ++i) mx = fmaxf(mx, s1[i]);
        mx = xhalf_max(mx);
        const float m_new = fmaxf(m_run, mx);
        if (__any(m_new > m_run)) {
            const float alpha = __builtin_amdgcn_exp2f(m_run - m_new);
            l_run *= alpha;
#pragma unroll
            for (int i = 0; i < 16; ++i) { o0[i] *= alpha; o1[i] *= alpha; }
            m_run = m_new;
        }
        float ps = 0.f;
#pragma unroll
        for (int i = 0; i < 16; ++i) { s0[i] = __builtin_amdgcn_exp2f(s0[i] - m_run); s1[i] = __builtin_amdgcn_exp2f(s1[i] - m_run); ps += s0[i] + s1[i]; }
        l_run += ps;
#pragma unroll
        for (int ks = 0; ks < 4; ++ks) {
            bf16x8 pf;
            {
                union { unsigned u[4]; bf16x8 v; } pk;
#pragma unroll
                for (int j = 0; j < 4; ++j) { const int rg = (ks & 1) * 8 + 2 * j; pk.u[j] = (ks < 2) ? pack2(s0[rg], s0[rg + 1]) : pack2(s1[rg], s1[rg + 1]); }
                pf = pk.v;
            }
#pragma unroll
            for (int ds = 0; ds < 2; ++ds) {
                const bf16_t* vp = Vc + (16 * ks + 4 * hi + q4) * LDT + 32 * ds + 16 * blk + 4 * p4;
                const s16x4 lo = __builtin_bit_cast(s16x4, __builtin_amdgcn_ds_read_tr16_b64_v4i16((__attribute__((address_space(3))) s16x4*)(vp)));
                const s16x4 hh = __builtin_bit_cast(s16x4, __builtin_amdgcn_ds_read_tr16_b64_v4i16((__attribute__((address_space(3))) s16x4*)(vp + 8 * LDT)));
                const bf16x8 vf = (bf16x8){lo[0], lo[1], lo[2], lo[3], hh[0], hh[1], hh[2], hh[3]};
                if (ds == 0) o0 = __builtin_amdgcn_mfma_f32_32x32x16_bf16(vf, pf, o0, 0, 0, 0);
                else o1 = __builtin_amdgcn_mfma_f32_32x32x16_bf16(vf, pf, o1, 0, 0, 0);
            }
        }
        if (more) { bf16_t* Kn = Ks + ((t + 1) & 1) * 64 * LDT; bf16_t* Vn = Vs + ((t + 1) & 1) * 64 * LDT; *(u32x4*)(Kn + lrow * LDT + lc) = rk; *(u32x4*)(Vn + lrow * LDT + lc) = rv; }
        __syncthreads();
    }
    l_run = xhalf_sum(l_run);
    const float inv = 1.f / l_run;
    bf16_t* op = a.O + (size_t)(a.qrow0 + qoff) * DM + head * 64;
#pragma unroll
    for (int g4 = 0; g4 < 4; ++g4) {
        uint2 q; q.x = pack2(o0[4 * g4] * inv, o0[4 * g4 + 1] * inv); q.y = pack2(o0[4 * g4 + 2] * inv, o0[4 * g4 + 3] * inv);
        *(uint2*)(op + 8 * g4 + 4 * hi) = q;
        q.x = pack2(o1[4 * g4] * inv, o1[4 * g4 + 1] * inv); q.y = pack2(o1[4 * g4 + 2] * inv, o1[4 * g4 + 3] * inv);
        *(uint2*)(op + 32 + 8 * g4 + 4 * hi) = q;
    }
}
DI int attn_units(int l) { return l == 0 ? 544 : 512; }
DI void attn_dispatch(const Params& p, int l, int u, char* smem) {
    AttnArgs a;
    const bf16_t* proj = (const bf16_t*)(p.ws + OFF_RA);
    bf16_t* mix = (bf16_t*)(p.ws + OFF_RB);
    int type, b, g, tb;
    if (u < 512) { type = u >> 8; const int v = u & 255; b = v >> 6; g = (v >> 5) & 1; tb = v & 31; }
    else { const int v = u - 512; type = 2 + (v >> 4); b = (v >> 2) & 3; g = (v >> 1) & 1; tb = v & 1; }
    const bool isA = (type & 1);
    a.Q = (const bf16_t*)(p.ws + (isA ? OFF_QA : OFF_QD)); a.K = (const bf16_t*)(p.ws + (isA ? OFF_KA : OFF_KD)); a.V = proj + (isA ? CA_V : CD_V);
    a.g = g; a.sink = isA ? p.in[I_ASINK] + l * 4 : nullptr; a.O = mix + (isA ? 0 : 768);
    a.k0row = b * CTXL; a.k0tiles = 4; a.k1row = NCTX + b * SEQ; a.qpos0 = -1;
    if (type < 2) {
        a.qrow0 = NCTX + b * SEQ + tb * 128;
        if (isA) { a.qpos0 = tb * 128; int t0 = 2 * tb - 2, t1 = 2 * tb + 4; a.k1t0 = t0 < 0 ? 0 : t0; a.k1t1 = t1 > 64 ? 64 : t1; }
        else { a.k1t0 = 0; a.k1t1 = 64; }
    } else { a.qrow0 = b * CTXL + tb * 128; a.k1t0 = 0; a.k1t1 = 0; }
    attn_unit(a, smem);
}

DI int blk_row0(int b, int cb) { return cb < 2 ? b * CTXL + cb * 128 : NCTX + b * SEQ + (cb - 2) * 128; }
DI int bwd_seq(int cb) { return cb < 2 ? 1 - cb : 35 - cb; }
DI s16x4 tr16(const bf16_t* p) { return __builtin_bit_cast(s16x4, __builtin_amdgcn_ds_read_tr16_b64_v4i16((__attribute__((address_space(3))) s16x4*)(p))); }
DI bf16x8 cat8(const s16x4 lo, const s16x4 hh) { return (bf16x8){lo[0], lo[1], lo[2], lo[3], hh[0], hh[1], hh[2], hh[3]}; }
DI bf16x8 packf8(float a0, float a1, float a2, float a3, float a4, float a5, float a6, float a7) { union { unsigned u[4]; bf16x8 v; } k; k.u[0] = pack2(a0, a1); k.u[1] = pack2(a2, a3); k.u[2] = pack2(a4, a5); k.u[3] = pack2(a6, a7); return k.v; }
constexpr int SC_RP = 200;
constexpr int SC_RAW = 0, SC_XS = 52480, SC_BS = SC_XS + 128 * LDT * 2, SC_CS = SC_BS + 128 * LDT * 2, SC_CW = SC_CS + 128 * LDT * 2, SC_VEC = SC_CW + 5 * 192 * 4, SSD_LDS = SC_VEC + 6 * 128 * 4;
DI int ssd_chunk_units() { return NB * NCHK * 4; }
DI void ssd_chunk_unit(const Params& p, int l, int u, char* smem) {
    const int tid = tidx(), lane = tid & 63, w = __builtin_amdgcn_readfirstlane(tid >> 6), r32 = lane & 31, hi = lane >> 5;
    const int h = u & 3, cb = (u >> 2) % NCHK, b = (u >> 2) / NCHK, grp = h >> 1;
    const int row0 = blk_row0(b, cb);
    const int part0 = cb < 2 ? b * CTXL : NCTX + b * SEQ, partN = cb < 2 ? CTXL : SEQ;
    bf16_t* raw = (bf16_t*)(smem + SC_RAW);
    bf16_t* Xs = (bf16_t*)(smem + SC_XS);
    bf16_t* Bs = (bf16_t*)(smem + SC_BS);
    bf16_t* Cs = (bf16_t*)(smem + SC_CS);
    float* cwl = (float*)(smem + SC_CW);
    float* dtf = (float*)(smem + SC_VEC); float* dtb = dtf + 128; float* Af = dtb + 128; float* Ab = Af + 128; float* wef = Ab + 128; float* web = wef + 128;
    const bf16_t* proj = (const bf16_t*)(p.ws + OFF_RA);
    const float aneg_f = -__expf(p.in[I_SSDALOG][l * 8 + h]), aneg_b = -__expf(p.in[I_SSDALOG][l * 8 + 4 + h]);
    {
        u32x4 v[7];
#pragma unroll
        for (int k = 0; k < 7; ++k) { const int item = tid + NTHR * k; v[k] = (u32x4){0u, 0u, 0u, 0u};
            if (item < 131 * 24) { const int r = item / 24, c = item % 24, gr = row0 - 2 + r;
                const int col = c < 8 ? CB_X + h * 64 + 8 * c : (c < 16 ? CB_B + grp * 64 + 8 * (c - 8) : CB_C + grp * 64 + 8 * (c - 16));
                if (gr >= part0 && gr < part0 + partN) v[k] = *(const u32x4*)(proj + (size_t)gr * INPP + col); } }
#pragma unroll
        for (int k = 0; k < 7; ++k) { const int item = tid + NTHR * k; if (item < 131 * 24) { const int r = item / 24, c = item % 24; *(u32x4*)(raw + r * SC_RP + 8 * c) = v[k]; } }
        for (int i = tid; i < 5 * 192; i += NTHR) { const int j = i / 192, cc = i % 192; const int ch = cc < 64 ? h * 64 + cc : (cc < 128 ? 256 + grp * 64 + cc - 64 : 384 + grp * 64 + cc - 128);
            cwl[i] = j < 4 ? p.in[I_SSDCW][l * 2048 + j * 512 + ch] : p.in[I_SSDCB][l * 512 + ch]; }
        if (tid < 256) { const int i = tid & 127, d = tid >> 7;
            const float rawdt = bf2f(proj[(size_t)(row0 + i) * INPP + (d ? CB_DTB : CB_DTF) + h]);
            (d ? dtb : dtf)[i] = softplus_(rawdt + p.in[I_SSDDTB][l * 8 + d * 4 + h]); }
    }
    __syncthreads();
#pragma unroll 2
    for (int k = 0; k < 6; ++k) { const int item = tid + NTHR * k, i = item / 24, c = item % 24;
        float acc[8];
        { const f32x4 b0 = *(const f32x4*)(cwl + 4 * 192 + 8 * c), b1 = *(const f32x4*)(cwl + 4 * 192 + 8 * c + 4);
          acc[0] = b0[0]; acc[1] = b0[1]; acc[2] = b0[2]; acc[3] = b0[3]; acc[4] = b1[0]; acc[5] = b1[1]; acc[6] = b1[2]; acc[7] = b1[3]; }
#pragma unroll
        for (int j = 0; j < 4; ++j) { const u32x4 q = *(const u32x4*)(raw + (i + j) * SC_RP + 8 * c);
            const f32x4 w0 = *(const f32x4*)(cwl + j * 192 + 8 * c), w1 = *(const f32x4*)(cwl + j * 192 + 8 * c + 4);
            acc[0] += w0[0] * __uint_as_float(q[0] << 16); acc[1] += w0[1] * __uint_as_float(q[0] & 0xffff0000u); acc[2] += w0[2] * __uint_as_float(q[1] << 16); acc[3] += w0[3] * __uint_as_float(q[1] & 0xffff0000u);
            acc[4] += w1[0] * __uint_as_float(q[2] << 16); acc[5] += w1[1] * __uint_as_float(q[2] & 0xffff0000u); acc[6] += w1[2] * __uint_as_float(q[3] << 16); acc[7] += w1[3] * __uint_as_float(q[3] & 0xffff0000u); }
        u32x4 o; o[0] = pack2(silu_(acc[0]), silu_(acc[1])); o[1] = pack2(silu_(acc[2]), silu_(acc[3])); o[2] = pack2(silu_(acc[4]), silu_(acc[5])); o[3] = pack2(silu_(acc[6]), silu_(acc[7]));
        bf16_t* dst = c < 8 ? Xs : (c < 16 ? Bs : Cs);
        *(u32x4*)(dst + i * LDT + 8 * (c & 7)) = o; }
    if (tid < 128) {
        const int ln = tid & 63, bw = tid >> 6;
        const int i0 = bw ? 127 - 2 * ln : 2 * ln, i1 = bw ? 126 - 2 * ln : 2 * ln + 1;
        const float* dt = bw ? dtb : dtf; const float an = bw ? aneg_b : aneg_f;
        const float v0 = dt[i0] * an, v1 = dt[i1] * an;
        float sc = v0 + v1;
#pragma unroll
        for (int o = 1; o < 64; o <<= 1) { const float a = __shfl_up(sc, o); if (ln >= o) sc += a; }
        float* A = bw ? Ab : Af;
        A[i1] = sc; A[i0] = sc - v1;
    }
    __syncthreads();
    if (tid < 128) { wef[tid] = __expf(Af[127] - Af[tid]) * dtf[tid]; web[tid] = __expf(Ab[0] - Ab[tid]) * dtb[tid];
        float* EA = (float*)(p.ws + OFF_EA) + (size_t)(row0 + tid) * 8; EA[h] = __expf(Af[tid]); EA[4 + h] = __expf(Ab[tid]); }
    __syncthreads();
    bf16_t* Bwf = raw; bf16_t* Bwb = raw + 128 * LDT;
    if ((h & 1) == 0) { bf16_t* CC = (bf16_t*)(p.ws + OFF_CC);
        for (int it = tid; it < 1024; it += NTHR) { const int i = it >> 3, c = it & 7; *(u32x4*)(CC + (size_t)(row0 + i) * 128 + grp * 64 + 8 * c) = *(const u32x4*)(Cs + i * LDT + 8 * c); } }
#pragma unroll
    for (int k = 0; k < 4; ++k) { const int it = tid + NTHR * k, d = it >> 10, j = (it >> 3) & 127, c = it & 7;
        const u32x4 q = *(const u32x4*)(Bs + j * LDT + 8 * c); const float sc = d ? web[j] : wef[j];
        u32x4 o;
#pragma unroll
        for (int e = 0; e < 4; ++e) o[e] = pack2(__uint_as_float(q[e] << 16) * sc, __uint_as_float(q[e] & 0xffff0000u) * sc);
        *(u32x4*)((d ? Bwb : Bwf) + j * LDT + 8 * c) = o; }
    __syncthreads();
    const int q4 = (lane & 15) >> 2, p4 = lane & 3, blk = (lane >> 4) & 1;
    {
        const int ib = w & 3, ph = w >> 2, i = 32 * ib + r32;
        bf16x8 cq[4];
#pragma unroll
        for (int s4 = 0; s4 < 4; ++s4) cq[s4] = *(const bf16x8*)(Cs + i * LDT + 16 * s4 + 8 * hi);
        const float Afi = Af[i], Abi = Ab[i];
        f32x16 y;
#pragma unroll
        for (int r = 0; r < 16; ++r) y[r] = 0.f;
#pragma unroll
        for (int jt = 0; jt < 4; ++jt) {
            f32x16 g;
#pragma unroll
            for (int r = 0; r < 16; ++r) g[r] = 0.f;
#pragma unroll
            for (int s4 = 0; s4 < 4; ++s4) { const bf16x8 bq = *(const bf16x8*)(Bs + (32 * jt + r32) * LDT + 16 * s4 + 8 * hi); g = __builtin_amdgcn_mfma_f32_32x32x16_bf16(bq, cq[s4], g, 0, 0, 0); }
#pragma unroll
            for (int g4 = 0; g4 < 4; ++g4) { const int j0 = 32 * jt + 8 * g4 + 4 * hi;
                f32x4 wv = (f32x4){0.f, 0.f, 0.f, 0.f};
                if (jt <= ib) { const f32x4 aj = *(const f32x4*)(Af + j0), dj = *(const f32x4*)(dtf + j0);
#pragma unroll
                    for (int e = 0; e < 4; ++e) { const float t = __expf(Afi - aj[e]) * dj[e]; wv[e] += (jt < ib || j0 + e <= i) ? t : 0.f; } }
                if (jt >= ib) { const f32x4 aj = *(const f32x4*)(Ab + j0), dj = *(const f32x4*)(dtb + j0);
#pragma unroll
                    for (int e = 0; e < 4; ++e) { const float t = __expf(Abi - aj[e]) * dj[e]; wv[e] += (jt > ib || j0 + e >= i) ? t : 0.f; } }
#pragma unroll
                for (int e = 0; e < 4; ++e) g[4 * g4 + e] *= wv[e]; }
#pragma unroll
            for (int s2 = 0; s2 < 2; ++s2) {
                const bf16x8 pf = packf8(g[8 * s2], g[8 * s2 + 1], g[8 * s2 + 2], g[8 * s2 + 3], g[8 * s2 + 4], g[8 * s2 + 5], g[8 * s2 + 6], g[8 * s2 + 7]);
                const bf16_t* xp = Xs + (32 * jt + 16 * s2 + 4 * hi + q4) * LDT + 32 * ph + 16 * blk + 4 * p4;
                const bf16x8 xf = cat8(tr16(xp), tr16(xp + 8 * LDT));
                y = __builtin_amdgcn_mfma_f32_32x32x16_bf16(xf, pf, y, 0, 0, 0); }
        }
        const float dsk = p.in[I_SSDD][l * 4 + h];
        float* YP = (float*)(p.ws + OFF_YPART) + (size_t)(row0 + i) * 256 + h * 64 + 32 * ph;
#pragma unroll
        for (int g4 = 0; g4 < 4; ++g4) { const uint2 xq = *(const uint2*)(Xs + i * LDT + 32 * ph + 8 * g4 + 4 * hi);
            *(f32x4*)(YP + 8 * g4 + 4 * hi) = (f32x4){y[4 * g4] + dsk * __uint_as_float(xq.x << 16), y[4 * g4 + 1] + dsk * __uint_as_float(xq.x & 0xffff0000u),
                                                    y[4 * g4 + 2] + dsk * __uint_as_float(xq.y << 16), y[4 * g4 + 3] + dsk * __uint_as_float(xq.y & 0xffff0000u)}; }
    }
    {
        const int d = w >> 2, pt = (w >> 1) & 1, nt2 = w & 1;
        const bf16_t* Bw = d ? Bwb : Bwf;
        f32x16 st;
#pragma unroll
        for (int r = 0; r < 16; ++r) st[r] = 0.f;
#pragma unroll
        for (int ks = 0; ks < 8; ++ks) {
            const bf16_t* xp = Xs + (16 * ks + 8 * hi + q4) * LDT + 32 * pt + 16 * blk + 4 * p4;
            const bf16_t* bp = Bw + (16 * ks + 8 * hi + q4) * LDT + 32 * nt2 + 16 * blk + 4 * p4;
            st = __builtin_amdgcn_mfma_f32_32x32x16_bf16(cat8(tr16(xp), tr16(xp + 4 * LDT)), cat8(tr16(bp), tr16(bp + 4 * LDT)), st, 0, 0, 0); }
        const int s = d ? bwd_seq(cb) : cb;
        float* ST = (float*)(p.ws + OFF_SSDST) + ((size_t)((b * 4 + h) * 2 + d) * NCHK + s) * 4096 + 32 * nt2 + r32;
#pragma unroll
        for (int r = 0; r < 16; ++r) ST[(32 * pt + crow(r, hi)) * 64] = st[r];
        if ((tid & 255) == 0) ((float*)(p.ws + OFF_SSDDEC))[((b * 4 + h) * 2 + d) * NCHK + s] = d ? __expf(Ab[0]) : __expf(Af[127]);
    }
    __syncthreads();
}
constexpr int SCAN_UNITS = 32 * 8 + 4;
DI void scan_unit(const Params& p, int u) {
    const int tid = tidx();
    if (u < 256) {
        const int seq = u >> 3, e = (u & 7) * 512 + tid;
        const float* ST = (const float*)(p.ws + OFF_SSDST) + (size_t)seq * NCHK * 4096 + e;
        const float* DEC = (const float*)(p.ws + OFF_SSDDEC) + seq * NCHK;
        bf16_t* SS = (bf16_t*)(p.ws + OFF_START) + (size_t)seq * NCHK * 4096 + e;
        float v[NCHK];
#pragma unroll
        for (int s = 0; s < NCHK; ++s) v[s] = ST[(size_t)s * 4096];
        float st = 0.f;
#pragma unroll
        for (int s = 0; s < NCHK; ++s) { SS[(size_t)s * 4096] = f2bf(st); st = st * DEC[s] + v[s]; }
    } else {
        const int q = (u - 256) * 512 + tid, sq = q >> 8, ch = q & 255;
        const float* LH = (const float*)(p.ws + OFF_LRUC) + (size_t)sq * NCHK * 256 + ch; const float* LA = LH + (size_t)NB * 2 * NCHK * 256;
        float* CR = (float*)(p.ws + OFF_CARRY) + (size_t)sq * NCHK * 256 + ch;
        float hv[NCHK], av[NCHK];
#pragma unroll
        for (int s = 0; s < NCHK; ++s) { hv[s] = LH[s * 256]; av[s] = LA[s * 256]; }
        float c = 0.f;
#pragma unroll
        for (int s = 0; s < NCHK; ++s) { CR[s * 256] = c; c = c * av[s] + hv[s]; }
    }
}
constexpr int SF_ST = 0, SF_CC = 2 * 64 * LDT * 2, SF_YB = SF_CC + 128 * LDT * 2, SF_SQ = SF_YB + 128 * 256 * 2, SSDF_LDS = SF_SQ + 8 * 128 * 4;
DI int ssd_fin_units(int l) { return NB * (l == 0 ? NCHK : NCHK - 2); }
DI void ssd_fin_unit(const Params& p, int l, int u, char* smem) {
    const int tid = tidx(), lane = tid & 63, w = __builtin_amdgcn_readfirstlane(tid >> 6), r32 = lane & 31, hi = lane >> 5;
    const int nper = l == 0 ? NCHK : NCHK - 2;
    const int b = u / nper, cb = u % nper + (l == 0 ? 0 : 2);
    const int row0 = blk_row0(b, cb);
    bf16_t* St = (bf16_t*)(smem + SF_ST);
    bf16_t* Cc = (bf16_t*)(smem + SF_CC);
    bf16_t* ybuf = (bf16_t*)(smem + SF_YB);
    float* ssqp = (float*)(smem + SF_SQ);
    const bf16_t* proj = (const bf16_t*)(p.ws + OFF_RA);
    const int it = w & 3, pt = w >> 2, i = 32 * it + r32, r = row0 + i;
    bf16x8 cq[4];
#pragma unroll 1
    for (int h = 0; h < 4; ++h) {
        {
            const int d = tid >> 8, e8 = (tid & 255) * 16, s = d ? bwd_seq(cb) : cb;
            const bf16_t* SS = (const bf16_t*)(p.ws + OFF_START) + ((size_t)((b * 4 + h) * 2 + d) * NCHK + s) * 4096 + e8;
            const u32x4 v0 = *(const u32x4*)SS, v1 = *(const u32x4*)(SS + 8);
            bf16_t* dst = St + d * 64 * LDT + (e8 >> 6) * LDT + (e8 & 63);
            *(u32x4*)dst = v0; *(u32x4*)(dst + 8) = v1;
            if ((h & 1) == 0) { const bf16_t* CC = (const bf16_t*)(p.ws + OFF_CC);
#pragma unroll
                for (int k = 0; k < 2; ++k) { const int item = tid + NTHR * k, ri = item >> 3, c = item & 7; *(u32x4*)(Cc + ri * LDT + 8 * c) = *(const u32x4*)(CC + (size_t)(row0 + ri) * 128 + (h >> 1) * 64 + 8 * c); } }
        }
        __syncthreads();
        if ((h & 1) == 0) {
#pragma unroll
            for (int s4 = 0; s4 < 4; ++s4) cq[s4] = *(const bf16x8*)(Cc + i * LDT + 16 * s4 + 8 * hi);
        }
        const float* EA = (const float*)(p.ws + OFF_EA) + (size_t)r * 8;
        const float ef = EA[h], eb = EA[4 + h];
        const float* YP = (const float*)(p.ws + OFF_YPART) + (size_t)r * 256 + h * 64 + 32 * pt;
        const bf16_t* zp = proj + (size_t)r * INPP + CB_Z + h * 64 + 32 * pt;
        f32x4 ypv[4]; uint2 zqv[4];
#pragma unroll
        for (int g4 = 0; g4 < 4; ++g4) { ypv[g4] = *(const f32x4*)(YP + 8 * g4 + 4 * hi); zqv[g4] = *(const uint2*)(zp + 8 * g4 + 4 * hi); }
        f32x16 af, ab;
#pragma unroll
        for (int k = 0; k < 16; ++k) { af[k] = 0.f; ab[k] = 0.f; }
#pragma unroll
        for (int s4 = 0; s4 < 4; ++s4) {
            const bf16x8 sf = *(const bf16x8*)(St + (32 * pt + r32) * LDT + 16 * s4 + 8 * hi);
            const bf16x8 sb = *(const bf16x8*)(St + (64 + 32 * pt + r32) * LDT + 16 * s4 + 8 * hi);
            af = __builtin_amdgcn_mfma_f32_32x32x16_bf16(sf, cq[s4], af, 0, 0, 0);
            ab = __builtin_amdgcn_mfma_f32_32x32x16_bf16(sb, cq[s4], ab, 0, 0, 0);
        }
        float sq = 0.f;
#pragma unroll
        for (int g4 = 0; g4 < 4; ++g4) {
            const f32x4 yp = ypv[g4];
            const uint2 zq = zqv[g4];
            const float z[4] = {__uint_as_float(zq.x << 16), __uint_as_float(zq.x & 0xffff0000u), __uint_as_float(zq.y << 16), __uint_as_float(zq.y & 0xffff0000u)};
            float yg[4];
#pragma unroll
            for (int e = 0; e < 4; ++e) { const float y = yp[e] + ef * af[4 * g4 + e] + eb * ab[4 * g4 + e]; yg[e] = y * silu_(z[e]); sq += yg[e] * yg[e]; }
            uint2 o; o.x = pack2(yg[0], yg[1]); o.y = pack2(yg[2], yg[3]);
            *(uint2*)(ybuf + i * 256 + h * 64 + 32 * pt + 8 * g4 + 4 * hi) = o;
        }
        sq = xhalf_sum(sq);
        if (hi == 0) ssqp[(h * 2 + pt) * 128 + i] = sq;
        __syncthreads();
    }
    {
        const float* gn = p.in[I_SSDNORM] + l * 256;
        bf16_t* mix = (bf16_t*)(p.ws + OFF_RB);
#pragma unroll 2
        for (int k = 0; k < 8; ++k) { const int item = tid + NTHR * k, ri = item >> 5, c = (item & 31) * 8;
            float ss = 0.f;
#pragma unroll
            for (int q = 0; q < 8; ++q) ss += ssqp[q * 128 + ri];
            const float rs = rsqrtf(ss * (1.f / 256.f) + EPS);
            const u32x4 v = *(const u32x4*)(ybuf + ri * 256 + c);
            const f32x4 g0 = *(const f32x4*)(gn + c), g1 = *(const f32x4*)(gn + c + 4);
            u32x4 o;
            o[0] = pack2(__uint_as_float(v[0] << 16) * rs * g0[0], __uint_as_float(v[0] & 0xffff0000u) * rs * g0[1]);
            o[1] = pack2(__uint_as_float(v[1] << 16) * rs * g0[2], __uint_as_float(v[1] & 0xffff0000u) * rs * g0[3]);
            o[2] = pack2(__uint_as_float(v[2] << 16) * rs * g1[0], __uint_as_float(v[2] & 0xffff0000u) * rs * g1[1]);
            o[3] = pack2(__uint_as_float(v[3] << 16) * rs * g1[2], __uint_as_float(v[3] & 0xffff0000u) * rs * g1[3]);
            *(u32x4*)(mix + (size_t)(row0 + ri) * DM + 256 + c) = o; }
    }
    __syncthreads();
}

constexpr int LC_WB = 0, LC_RAW = 4 * 64 * LDT * 2, LC_US = 65536, LC_CW = LC_US + 128 * LDT * 2, LC_SEG = LC_CW + 5 * 64 * 4, LRU_LDS = LC_SEG + 2 * 8 * 64 * 4;
static_assert(LC_RAW + 131 * LDT * 2 <= 65536, "raw rows fit under the scan arrays");
DI int lru_chunk_units() { return NB * NCHK * 4; }
DI void lru_chunk_unit(const Params& p, int l, int u, char* smem) {
    const int tid = tidx(), lane = tid & 63, w = __builtin_amdgcn_readfirstlane(tid >> 6), r32 = lane & 31, hi = lane >> 5;
    const int kb = u & 3, cb = (u >> 2) % NCHK, b = (u >> 2) / NCHK;
    const int row0 = blk_row0(b, cb);
    const int part0 = cb < 2 ? b * CTXL : NCTX + b * SEQ, partN = cb < 2 ? CTXL : SEQ;
    bf16_t* Wb = (bf16_t*)(smem + LC_WB);
    bf16_t* raw = (bf16_t*)(smem + LC_RAW);
    float* aL = (float*)smem;
    float* xL = aL + 128 * 64;
    bf16_t* Us = (bf16_t*)(smem + LC_US);
    float* cwl = (float*)(smem + LC_CW);
    float* segA = (float*)(smem + LC_SEG); float* segH = segA + 8 * 64;
    const bf16_t* proj = (const bf16_t*)(p.ws + OFF_RA);
    {
        u32x4 v[3];
#pragma unroll
        for (int k = 0; k < 3; ++k) { const int item = tid + NTHR * k; v[k] = (u32x4){0u, 0u, 0u, 0u};
            if (item < 131 * 8) { const int r = item >> 3, c = item & 7, gr = row0 - 2 + r;
                if (gr >= part0 && gr < part0 + partN) v[k] = *(const u32x4*)(proj + (size_t)gr * INPP + CC_X + kb * 64 + 8 * c); } }
        f32x4 wv[8];
#pragma unroll
        for (int k = 0; k < 8; ++k) { const int idx = tid + NTHR * k, g = idx >> 10, e4 = idx & 1023, d = g >> 1;
            wv[k] = *(const f32x4*)(p.in[(g & 1) ? I_LRUWI : I_LRUWA] + ((size_t)((l * 2 + d) * 4 + kb)) * 4096 + 4 * e4); }
#pragma unroll
        for (int k = 0; k < 3; ++k) { const int item = tid + NTHR * k; if (item < 131 * 8) *(u32x4*)(raw + (item >> 3) * LDT + 8 * (item & 7)) = v[k]; }
#pragma unroll
        for (int k = 0; k < 8; ++k) { const int idx = tid + NTHR * k, g = idx >> 10, e4 = idx & 1023, i = e4 >> 4, j4 = (e4 & 15) * 4;
            uint2 q; q.x = pack2(wv[k][0], wv[k][1]); q.y = pack2(wv[k][2], wv[k][3]); *(uint2*)(Wb + (g * 64 + i) * LDT + j4) = q; }
        if (tid < 320) { const int j = tid >> 6, c = tid & 63; cwl[tid] = j < 4 ? p.in[I_LRUCW][l * 1024 + j * 256 + kb * 64 + c] : p.in[I_LRUCB][l * 256 + kb * 64 + c]; }
    }
    __syncthreads();
#pragma unroll
    for (int k = 0; k < 2; ++k) { const int item = tid + NTHR * k, i = item >> 3, c = item & 7;
        float acc[8];
        { const f32x4 b0 = *(const f32x4*)(cwl + 256 + 8 * c), b1 = *(const f32x4*)(cwl + 256 + 8 * c + 4);
          acc[0] = b0[0]; acc[1] = b0[1]; acc[2] = b0[2]; acc[3] = b0[3]; acc[4] = b1[0]; acc[5] = b1[1]; acc[6] = b1[2]; acc[7] = b1[3]; }
#pragma unroll
        for (int j = 0; j < 4; ++j) { const u32x4 q = *(const u32x4*)(raw + (i + j) * LDT + 8 * c);
            const f32x4 w0 = *(const f32x4*)(cwl + j * 64 + 8 * c), w1 = *(const f32x4*)(cwl + j * 64 + 8 * c + 4);
            acc[0] += w0[0] * __uint_as_float(q[0] << 16); acc[1] += w0[1] * __uint_as_float(q[0] & 0xffff0000u); acc[2] += w0[2] * __uint_as_float(q[1] << 16); acc[3] += w0[3] * __uint_as_float(q[1] & 0xffff0000u);
            acc[4] += w1[0] * __uint_as_float(q[2] << 16); acc[5] += w1[1] * __uint_as_float(q[2] & 0xffff0000u); acc[6] += w1[2] * __uint_as_float(q[3] << 16); acc[7] += w1[3] * __uint_as_float(q[3] & 0xffff0000u); }
        u32x4 o; o[0] = pack2(acc[0], acc[1]); o[1] = pack2(acc[2], acc[3]); o[2] = pack2(acc[4], acc[5]); o[3] = pack2(acc[6], acc[7]);
        *(u32x4*)(Us + i * LDT + 8 * c) = o; }
    __syncthreads();
    const int tt = w & 3, jt = w >> 2, q4 = (lane & 15) >> 2, p4 = lane & 3, blk = (lane >> 4) & 1;
    f32x16 acc[4];
#pragma unroll
    for (int g = 0; g < 4; ++g)
#pragma unroll
        for (int r = 0; r < 16; ++r) acc[g][r] = 0.f;
#pragma unroll
    for (int s4 = 0; s4 < 4; ++s4) {
        const bf16x8 uf = *(const bf16x8*)(Us + (32 * tt + r32) * LDT + 16 * s4 + 8 * hi);
#pragma unroll
        for (int g = 0; g < 4; ++g) { const bf16_t* wp = Wb + (g * 64 + 16 * s4 + 8 * hi + q4) * LDT + 32 * jt + 16 * blk + 4 * p4;
            acc[g] = __builtin_amdgcn_mfma_f32_32x32x16_bf16(uf, cat8(tr16(wp), tr16(wp + 4 * LDT)), acc[g], 0, 0, 0); }
    }
    float uv[16];
    const int chl = 32 * jt + r32, ch = kb * 64 + chl;
#pragma unroll
    for (int r = 0; r < 16; ++r) uv[r] = bf2f(Us[(32 * tt + crow(r, hi)) * LDT + chl]);
    __syncthreads();
    bf16_t* HB = (bf16_t*)(p.ws + OFF_LRUH);
    float* LC = (float*)(p.ws + OFF_LRUC);
#pragma unroll
    for (int d = 0; d < 2; ++d) {
        {
            const float ba = p.in[I_LRUBA][(l * 2 + d) * 256 + ch], bi = p.in[I_LRUBI][(l * 2 + d) * 256 + ch];
            const float spl = softplus_(-p.in[I_LRULAM][(l * 2 + d) * 256 + ch]);
#pragma unroll
            for (int r = 0; r < 16; ++r) { const int i = 32 * tt + crow(r, hi);
                const float rg = sigmoid_(acc[2 * d][r] + ba), ig = sigmoid_(acc[2 * d + 1][r] + bi);
                const float la = -8.f * rg * spl;
                const float av = __expf(la);
                const float mult = __builtin_amdgcn_sqrtf(fmaxf(0.f, 1.f - av * av));
                aL[i * 64 + chl] = av; xL[i * 64 + chl] = mult * ig * uv[r]; }
        }
        __syncthreads();
        const int sch = tid & 63, sg = tid >> 6;
        float hacc = 0.f, pacc = 1.f;
#pragma unroll 1
        for (int t = 0; t < 16; ++t) { const int tau = sg * 16 + t, i = d ? 127 - tau : tau;
            const float av = aL[i * 64 + sch]; hacc = av * hacc + xL[i * 64 + sch]; pacc *= av; xL[i * 64 + sch] = hacc; aL[i * 64 + sch] = pacc; }
        segA[sg * 64 + sch] = pacc; segH[sg * 64 + sch] = hacc;
        __syncthreads();
        float carry = 0.f, cp = 1.f;
        for (int s2 = 0; s2 < sg; ++s2) { carry = carry * segA[s2 * 64 + sch] + segH[s2 * 64 + sch]; cp *= segA[s2 * 64 + sch]; }
        bf16_t* Hh = HB + (size_t)(2 * d) * NTOK * 256; bf16_t* Hp = HB + (size_t)(2 * d + 1) * NTOK * 256;
        float hl = 0.f, pl = 1.f;
#pragma unroll 1
        for (int t = 0; t < 16; ++t) { const int tau = sg * 16 + t, i = d ? 127 - tau : tau;
            hl = xL[i * 64 + sch] + aL[i * 64 + sch] * carry; pl = aL[i * 64 + sch] * cp;
            Hh[(size_t)(row0 + i) * 256 + kb * 64 + sch] = f2bf(hl); Hp[(size_t)(row0 + i) * 256 + kb * 64 + sch] = f2bf(pl); }
        if (sg == 7) { const int s = d ? bwd_seq(cb) : cb; const size_t o = ((size_t)(b * 2 + d) * NCHK + s) * 256 + kb * 64 + sch;
            LC[o] = hl; LC[(size_t)NB * 2 * NCHK * 256 + o] = pl; }
        __syncthreads();
    }
}
DI int lru_fin_units(int l) { return NB * (l == 0 ? NCHK : NCHK - 2); }
DI void lru_fin_unit(const Params& p, int l, int u, char* smem) {
    const int tid = tidx();
    const int nper = l == 0 ? NCHK : NCHK - 2;
    const int b = u / nper, cb = u % nper + (l == 0 ? 0 : 2);
    const int row0 = blk_row0(b, cb);
    const bf16_t* HB = (const bf16_t*)(p.ws + OFF_LRUH);
    const bf16_t* proj = (const bf16_t*)(p.ws + OFF_RA);
    bf16_t* mix = (bf16_t*)(p.ws + OFF_RB);
    const int c = (tid & 31) * 8;
    const float* CF = (const float*)(p.ws + OFF_CARRY) + ((size_t)(b * 2 + 0) * NCHK + cb) * 256 + c;
    const float* CB2 = (const float*)(p.ws + OFF_CARRY) + ((size_t)(b * 2 + 1) * NCHK + bwd_seq(cb)) * 256 + c;
    float cf[8], cbk[8];
    { const f32x4 a0 = *(const f32x4*)CF, a1 = *(const f32x4*)(CF + 4), b0 = *(const f32x4*)CB2, b1 = *(const f32x4*)(CB2 + 4);
#pragma unroll
      for (int e = 0; e < 4; ++e) { cf[e] = a0[e]; cf[4 + e] = a1[e]; cbk[e] = b0[e]; cbk[4 + e] = b1[e]; } }
#pragma unroll 1
    for (int k4 = 0; k4 < 2; ++k4) {
    u32x4 hfv[4], pfv[4], hbv[4], pbv[4], gv[4];
#pragma unroll
    for (int kk = 0; kk < 4; ++kk) { const int ri = (tid >> 5) + 16 * (4 * k4 + kk); const size_t o = (size_t)(row0 + ri) * 256 + c;
        hfv[kk] = *(const u32x4*)(HB + o); pfv[kk] = *(const u32x4*)(HB + (size_t)NTOK * 256 + o); hbv[kk] = *(const u32x4*)(HB + (size_t)2 * NTOK * 256 + o); pbv[kk] = *(const u32x4*)(HB + (size_t)3 * NTOK * 256 + o);
        gv[kk] = *(const u32x4*)(proj + (size_t)(row0 + ri) * INPP + CC_G + c); }
    __builtin_amdgcn_sched_barrier(0);
#pragma unroll
    for (int kk = 0; kk < 4; ++kk) {
        const int k = 4 * k4 + kk;
        const int ri = (tid >> 5) + 16 * k;
        const u32x4 hf = hfv[kk], pf = pfv[kk], hb = hbv[kk], pb = pbv[kk], g = gv[kk];
        u32x4 out;
#pragma unroll
        for (int e = 0; e < 4; ++e) {
            const float lo = (__uint_as_float(hf[e] << 16) + __uint_as_float(pf[e] << 16) * cf[2 * e] + __uint_as_float(hb[e] << 16) + __uint_as_float(pb[e] << 16) * cbk[2 * e]) * gelu_tanh_(__uint_as_float(g[e] << 16));
            const float hh = (__uint_as_float(hf[e] & 0xffff0000u) + __uint_as_float(pf[e] & 0xffff0000u) * cf[2 * e + 1] + __uint_as_float(hb[e] & 0xffff0000u) + __uint_as_float(pb[e] & 0xffff0000u) * cbk[2 * e + 1]) * gelu_tanh_(__uint_as_float(g[e] & 0xffff0000u));
            out[e] = pack2(lo, hh); }
        *(u32x4*)(mix + (size_t)(row0 + ri) * DM + 512 + c) = out;
    }
    }
}

#define XB_TMO      128
#define XB_XCNT(j)  (256  + 64 * (j))
#define XB_XSUB(j)  (1280 + 64 * (j))
#define XB_XGEN(j)  (2304 + 64 * (j))
#define XB_TOP      3328
#define XB_TOPGEN   3392
#define XCD_BAR_WORDS 3456
#define XB_SPIN_CAP (1u << 18)
#define LAS __attribute__((address_space(3)))

__device__ __forceinline__ unsigned xb_ld(unsigned* p)              { return __hip_atomic_load(p, __ATOMIC_RELAXED, __HIP_MEMORY_SCOPE_AGENT); }
__device__ __forceinline__ unsigned xb_add(unsigned* p, unsigned v) { return __hip_atomic_fetch_add(p, v, __ATOMIC_RELAXED, __HIP_MEMORY_SCOPE_AGENT); }
__device__ __forceinline__ unsigned xb_xcc_id() { return (unsigned)__builtin_amdgcn_s_getreg((3 << 11) | 20) & 0xFu; }
#define XB_SPIN(cond, bar) do { unsigned _sp = 0; while (cond) { __builtin_amdgcn_s_sleep(1); \
    if ((++_sp & 255u) == 0u) { if (xb_ld(&(bar)[XB_TMO])) break; if (_sp > XB_SPIN_CAP) { atomicAdd(&(bar)[XB_TMO], 1u); break; } } } } while (0)

struct XcdBarrier {
    unsigned* bar; unsigned x;
    volatile LAS unsigned* st;
};

__device__ __forceinline__ XcdBarrier xcd_barrier_post(unsigned* bar, volatile LAS unsigned* st) {
    XcdBarrier b; b.bar = bar; b.x = xb_xcc_id(); b.st = st;
    if (threadIdx.x == 0) (void)xb_add(&bar[XB_XCNT(b.x)], 1u);
    return b;
}
__device__ __forceinline__ void xcd_barrier_complete(unsigned* bar, unsigned x, unsigned& nloc, unsigned& nx) {
    const unsigned G = gridDim.x * gridDim.y * gridDim.z;
    unsigned sum, cnt, mine, sp = 0u;
    for (;;) {
        sum = 0u; cnt = 0u; mine = 0u;
#pragma unroll
        for (unsigned j = 0; j < 16; ++j) { const unsigned c = xb_ld(&bar[XB_XCNT(j)]); sum += c; cnt += (c > 0u) ? 1u : 0u; mine = (j == x) ? c : mine; }
        if (sum == G) break;
        __builtin_amdgcn_s_sleep(1);
        if ((++sp & 255u) == 0u) { if (xb_ld(&bar[XB_TMO])) break; if (sp > XB_SPIN_CAP) { atomicAdd(&bar[XB_TMO], 1u); break; } }
    }
    nloc = mine > 0u ? mine : 1u; nx = cnt > 0u ? cnt : 1u;
}

__device__ __forceinline__ void xcd_barrier(const XcdBarrier& b) {
    asm volatile("s_waitcnt vmcnt(0)" ::: "memory");
    __syncthreads();
    if (threadIdx.x == 0) {
        unsigned* bar = b.bar;
        __builtin_amdgcn_s_waitcnt(0);
        unsigned nloc = b.st[0], nx = b.st[1];
        if (nloc == 0u) { xcd_barrier_complete(bar, b.x, nloc, nx); b.st[0] = nloc; b.st[1] = nx; }
        const unsigned old = xb_add(&bar[XB_XSUB(b.x)], 1u);
        const unsigned gen = old / nloc;
        if (old + 1u == (gen + 1u) * nloc) {
            __builtin_amdgcn_fence(__ATOMIC_RELEASE, "agent");
            asm volatile("s_waitcnt vmcnt(0)" ::: "memory");
            const unsigned og = xb_add(&bar[XB_TOP], 1u);
            const unsigned tg = og / nx;
            if (og + 1u == (tg + 1u) * nx) xb_add(&bar[XB_TOPGEN], 1u);
            else XB_SPIN(xb_ld(&bar[XB_TOPGEN]) == tg, bar);
            __builtin_amdgcn_fence(__ATOMIC_ACQUIRE, "agent");
            xb_add(&bar[XB_XGEN(b.x)], 1u);
            asm volatile("s_waitcnt vmcnt(0)" ::: "memory");
        } else {
            XB_SPIN(xb_ld(&bar[XB_XGEN(b.x)]) == gen, bar);
            __builtin_amdgcn_fence(__ATOMIC_ACQUIRE, "agent");
            asm volatile("s_waitcnt vmcnt(0)" ::: "memory");
        }
    }
    __syncthreads();
}


#define PROBE_SUB 0
enum { PH_PRO = 0, PH_CONVEXP, PH_PRE0, PH_INPROJ, PH_PREP, PH_MIX, PH_OUTPROJ, PH_POST1, PH_MOE1, PH_MOE2, PH_POST2, PH_POST3, PH_MIXB };
constexpr int MAX_LDS = 140 * 1024;

template <int PH>
DI void run_phase(const Params& p, int l, int hf, char* smem) {
    const int G = gridDim.x, B = blockIdx.x;
    if (PH == PH_PRO) {
        const int n0 = MOD_UNITS, n1 = n0 + ROPE_UNITS + RWT_UNITS;
        for (int u = B; u < n1; u += G) {
            if (u < n0) mod_unit(p, u, smem);
            else if (u < n0 + RWT_UNITS) rwt_unit(p, u - n0, smem);
            else rope_unit(p, u - n0 - RWT_UNITS);
        }
        convert_run(p, 0, smem);
    } else if (PH == PH_CONVEXP) {
        { MoeTab* tb = (MoeTab*)(smem + GEMM_LDS); moe_table(p, 0, 0, tb);
          const int nb1 = (tb->mstart[65] * 2) % G, nb2 = (tb->mstart[65] * 4) % G;
          const int kd = nb1 ? min(CONV_SUPER - CONV_GU, (G - nb1) * CONV_M1TAIL) : 0;
          const int k2 = nb2 ? min(CONV_GU, (G - nb2) * 4) : 0, end = CONV_SUPER - kd;
          const int nbi = ((NTOK / 256) * (INPP / 256)) % G, dfr = nbi ? min(end - k2, (G - nbi) * CONV_L1TAIL) : 0;
          __syncthreads();
          convert_run(p, 1, smem, k2, end - dfr - k2); }
    } else if (PH == PH_PRE0) {
        rowpre_run(p, NTOK / 16);
    } else if (PH == PH_INPROJ) {
        InprojS S{p, l}; gemm8<true>(smem, p.ws + OFF_RB, DM, S);
        { const int nu = (NTOK / 256) * (INPP / 256), nb = nu % G;
            if (nb && B >= nb) { __syncthreads();
                if (l == 0) convert_run(p, 5, smem, 0, CONV_A, B - nb, G - nb);
                else { MoeTab* tb = (MoeTab*)(smem + GEMM_LDS); moe_table(p, 0, 0, tb);
                    const int nb1 = (tb->mstart[65] * 2) % G, nb2 = (tb->mstart[65] * 4) % G;
                    const int kd = nb1 ? min(CONV_SUPER - CONV_GU, (G - nb1) * CONV_M1TAIL) : 0;
                    const int k2 = nb2 ? min(CONV_GU, (G - nb2) * 4) : 0, end = CONV_SUPER - kd, dfr = min(end - k2, (G - nb) * CONV_L1TAIL);
                    __syncthreads();
                    convert_run(p, 1, smem, end - dfr, dfr, B - nb, G - nb); } } }
    } else if (PH == PH_PREP) {
        const int n0 = ssd_chunk_units(), n1 = n0 + lru_chunk_units(), n2 = n1 + PREP_UNITS;
        const int kl = (n1 - 1) / G;
        for (int k = 0; k <= kl; ++k) {
            const int u = k * G + ((k == kl && kl > 0) ? G - 1 - B : B);
            if (u >= n1) continue;
            if (u < n0) ssd_chunk_unit(p, l, u, smem);
            else lru_chunk_unit(p, l, u - n0, smem);
        }
        {
            const int nh = n1 % G, nlight = nh ? G - nh : G, rank = (nh && kl > 0) ? (B < G - nh ? B : -1) : (nh ? B - nh : B);
            if (rank >= 0) for (int u = rank; u < PREP_UNITS; u += nlight) prep_unit(p, l, u);
        }
        (void)n2;
        if (PROBE_SUB == 1) for (int u = B; u < n0; u += G) ssd_chunk_unit(p, l, u, smem);
        if (PROBE_SUB == 2) for (int u = B; u < n1 - n0; u += G) lru_chunk_unit(p, l, u, smem);
        if (PROBE_SUB == 3) for (int u = B; u < PREP_UNITS; u += G) prep_unit(p, l, u);
    } else if (PH == PH_MIX) {
        const int n0 = SCAN_UNITS, n1 = n0 + attn_units(l);
        for (int u = B; u < n1; u += G) {
            if (u < n0) scan_unit(p, u);
            else attn_dispatch(p, l, u - n0, smem);
        }
    } else if (PH == PH_MIXB) {
        const int n0 = ssd_fin_units(l), n1 = n0 + lru_fin_units(l);
        for (int k = 0; k * G < n1; ++k) {
            const int u = k * G + ((k & 1) ? G - 1 - B : B);
            if (u >= n1) continue;
            if (u < n0) ssd_fin_unit(p, l, u, smem);
            else lru_fin_unit(p, l, u - n0, smem);
        }
    } else if (PH == PH_OUTPROJ) {
        OutprojS S{p, l}; gemm8<true>(smem, p.ws + OFF_RB, DM, S);
        if (l == 0) { const int nb = (68 * 4) % G;
            if (nb && B >= nb) { __syncthreads(); convert_run(p, 5, smem, CONV_A, CONV_B, B - nb, G - nb); } }
    } else if (PH == PH_POST1) {
        const int lo = l == 0 ? 0 : NCTX, per = l == 0 ? 68 : 64;
        if (l == 0) { convert_run(p, 5, smem, CONV_A + CONV_B, CONV_SUPER - CONV_A - CONV_B);
            if (((NTOK / 256) * (INPP / 256)) % G == 0) convert_run(p, 5, smem, 0, CONV_A);
            if ((68 * 4) % G == 0) convert_run(p, 5, smem, CONV_A, CONV_B); }
        for (int u = B; u < 256; u += G) route_unit(p, l, lo + u * per, lo + (u + 1) * per, smem);
    } else if (PH == PH_MOE1 || PH == PH_MOE2) {
        MoeTab* tb = (MoeTab*)(smem + GEMM_LDS);
        moe_table(p, l, hf, tb);
        if (PH == PH_MOE1) { Moe1S S{p, l, hf, tb}; gemm8<true>(smem, p.ws + OFF_RA, 1024, S); }
        else { Moe2S S{p, l, hf, tb}; gemm8<true>(smem, p.ws + OFF_HID, 256, S); }
        __syncthreads();
        if (l == 0) {
            const int nb = (tb->mstart[65] * (PH == PH_MOE1 ? 2 : 4)) % G;
            if (nb && B >= nb) { if (PH == PH_MOE1) { const int kd = min(CONV_SUPER - CONV_GU, (G - nb) * CONV_M1TAIL); convert_run(p, 1, smem, CONV_SUPER - kd, kd, B - nb, G - nb); }
                                 else { const int k2 = min(CONV_GU, (G - nb) * 4); convert_run(p, 1, smem, 0, k2, B - nb, G - nb); } }
        }
    } else if (PH == PH_POST2 || PH == PH_POST3) {
        const int lo = half_lo(l, hf), n = (half_hi(l, hf) - lo) / 16;
        moe_table(p, l, hf, (MoeTab*)(smem + GEMM_LDS));
        for (int u = B; u < n; u += G) { if (PH == PH_POST2) rowpost_unit<2>(p, l, hf, lo + u * 16, smem); else rowpost_unit<3>(p, l, hf, lo + u * 16, smem); }
    }
}

#ifndef MULTI_LAUNCH
#define MULTI_LAUNCH 0
#endif
#define PROBE_PH -1
#define PROBE_TMASK 0ull
#define TSTAMP() do { if (PROBE_TMASK != 0ull && blockIdx.x == 0 && threadIdx.x == 0) tsl[bk] = wall_clock64(); ++bk; } while (0)
#define GBAR() do { XcdBarrier b2_ = bar; asm volatile("" : "+s"(b2_.x)); asm volatile("" : "+s"(b2_.bar)); xcd_barrier(b2_); TSTAMP(); } while (0)
#define RUNP(PH, l, hf) do { run_phase<PH>(p, l, hf, smem); if (PROBE_PH == PH) run_phase<PH>(p, l, hf, smem); } while (0)
static_assert(XCD_BAR_WORDS * 4 <= 16 * 1024, "barrier words fit their region");
__global__ void __launch_bounds__(NTHR, 2) k_mega(Params p) {
    extern __shared__ __attribute__((aligned(16))) char smem[];
    uint4* xbw = (uint4*)(smem + MAX_LDS - 16);
    if (threadIdx.x == 0) *xbw = make_uint4(0u, 0u, 0u, 0u);
    __syncthreads();
    XcdBarrier bar = xcd_barrier_post((unsigned*)(p.ws + OFF_BAR), (volatile LAS unsigned*)xbw);
    unsigned long long* tsl = (unsigned long long*)(smem + MAX_LDS - 16 - 32 * 8); int bk = 1;
    if (PROBE_TMASK != 0ull && blockIdx.x == 0 && threadIdx.x == 0) tsl[0] = wall_clock64();
    if (PROBE_STAGE >= 0 && threadIdx.x == 0) { unsigned long long* tacc0 = (unsigned long long*)(smem + MAX_LDS - 16 - 32 * 8 - 64); for (int k = 0; k < 4; ++k) tacc0[k] = 0ull; }
    RUNP(PH_PRO, 0, 0);
    GBAR();
    RUNP(PH_PRE0, 0, 0);
    GBAR();
#pragma unroll 1
    for (int l = 0; l < 2; ++l) {
        if (l == 1) RUNP(PH_CONVEXP, 1, 0);
        RUNP(PH_INPROJ, l, 0);
        GBAR();
        RUNP(PH_PREP, l, 0);
        GBAR();
        RUNP(PH_MIX, l, 0);
        GBAR();
        RUNP(PH_MIXB, l, 0);
        GBAR();
        RUNP(PH_OUTPROJ, l, 0);
        GBAR();
        RUNP(PH_POST1, l, 0);
        GBAR();
        RUNP(PH_MOE1, l, 0);
        GBAR();
        RUNP(PH_MOE2, l, 0);
        GBAR();
        if (l == 0) { RUNP(PH_POST2, l, 0); GBAR(); } else RUNP(PH_POST3, l, 0);
    }
    if ((PROBE_TMASK != 0ull || PROBE_STAGE >= 0) && blockIdx.x == 0) {
        __syncthreads();
        if (threadIdx.x == 0) { tsl[bk] = wall_clock64(); unsigned long long acc = 0ull;
            if (PROBE_STAGE >= 0) acc += ((unsigned long long*)(smem + MAX_LDS - 16 - 32 * 8 - 64))[PROBE_STAGE >= 0 ? PROBE_STAGE : 0];
            for (int k = 1; k <= bk; ++k) if ((PROBE_TMASK >> (k - 1)) & 1ull) acc += tsl[k] - tsl[k - 1];
            const unsigned long long t0 = wall_clock64(); while (wall_clock64() - t0 < acc) __builtin_amdgcn_s_sleep(32); }
    }
}

#if MULTI_LAUNCH
template <int PH>
__global__ void __launch_bounds__(NTHR, 2) k_phase(Params p, int l, int hf) {
    extern __shared__ __attribute__((aligned(16))) char smem[];
    run_phase<PH>(p, l, hf, smem);
}
template <int PH>
static void launch_phase(const Params& p, int l, int hf, int grid, hipStream_t st) {
    static bool inited = false;
    if (!inited) { (void)hipFuncSetAttribute((const void*)k_phase<PH>, hipFuncAttributeMaxDynamicSharedMemorySize, MAX_LDS); inited = true; }
    k_phase<PH><<<grid, NTHR, MAX_LDS, st>>>(p, l, hf);
}
#endif

extern "C" void kernel_launch(void* const* d_in, const int* in_sizes, int n_in, void* d_out, int out_size, void* d_ws, size_t ws_size, hipStream_t stream) {
    if (ws_size < WS_NEED || n_in < 36) return;
    Params p{};
    for (int i = 0; i < 36; ++i) p.in[i] = (const float*)d_in[i];
    p.out = (float*)d_out; p.ws = (char*)d_ws;
    (void)hipMemsetAsync(d_ws, 0, ZERO_BYTES, stream);
#if MULTI_LAUNCH
    const int G = 256;
    launch_phase<PH_PRO>(p, 0, 0, G, stream);
    launch_phase<PH_PRE0>(p, 0, 0, G, stream);
    for (int l = 0; l < 2; ++l) {
        if (l == 1) launch_phase<PH_CONVEXP>(p, 1, 0, G, stream);
        launch_phase<PH_INPROJ>(p, l, 0, G, stream);
        launch_phase<PH_PREP>(p, l, 0, G, stream);
        launch_phase<PH_MIX>(p, l, 0, G, stream);
        launch_phase<PH_MIXB>(p, l, 0, G, stream);
        launch_phase<PH_OUTPROJ>(p, l, 0, G, stream);
        launch_phase<PH_POST1>(p, l, 0, G, stream);
        for (int hf = 0; hf < 1; ++hf) {
            launch_phase<PH_MOE1>(p, l, hf, G, stream);
            launch_phase<PH_MOE2>(p, l, hf, G, stream);
            if (l == 0) launch_phase<PH_POST2>(p, l, hf, G, stream); else launch_phase<PH_POST3>(p, l, hf, G, stream);
        }
    }
#else
    static int grid = 0;
    if (!grid) {
        int dev = 0, cus = 0, per_cu = 0;
        (void)hipGetDevice(&dev);
        (void)hipDeviceGetAttribute(&cus, hipDeviceAttributeMultiprocessorCount, dev);
        (void)hipFuncSetAttribute((const void*)k_mega, hipFuncAttributeMaxDynamicSharedMemorySize, MAX_LDS);
        (void)hipOccupancyMaxActiveBlocksPerMultiprocessor(&per_cu, (const void*)k_mega, NTHR, MAX_LDS);
        grid = per_cu >= 1 ? cus : 0;
    }
    if (grid > 0) k_mega<<<grid, NTHR, MAX_LDS, stream>>>(p);
#endif
}
```
